# Optimizing an MI355X kernel written in HIP

```python
import jax, jax.numpy as jnp
from jax import lax
import numpy as np

D_MODEL = 1024
BATCH = 8
SEQ = 2048
DEPTH = 1
DEC_BATCH = 128
DEC_SEQ = 4
PAST_LEN = 16384
PAGE_SIZE = 128

A_WIDTH = D_MODEL // 2
A_HEAD_K = 128
A_HEADS = A_WIDTH // A_HEAD_K
A_HEAD_V = A_WIDTH // A_HEADS
A_CHUNK = 64
B_WIDTH = D_MODEL // 2
B_HEAD = 64
B_HEADS = B_WIDTH // B_HEAD
DECAY_LORA = 64
AAA_LORA = 64
GATE_LORA = 128
D_FF = 4 * D_MODEL
NORM_EPS = 1e-6
HGRN_NORM_EPS = 1e-5
GN_EPS = 64e-5
DECAY_SCALE = 0.6065306597126334
A_COLS = 4 * A_WIDTH
B_COLS = 3 * B_WIDTH + DECAY_LORA + AAA_LORA + GATE_LORA
GATE_COLS = 2 * D_MODEL
IN_COLS = A_COLS + B_COLS + GATE_COLS

kernel_name = "hgrn2_rwkv7_gated_hybrid_step"


def _rmsnorm(x, g, eps=NORM_EPS):
    xf = x.astype(jnp.float32)
    var = jnp.mean(jnp.square(xf), axis=-1, keepdims=True)
    return (xf * lax.rsqrt(var + eps) * g.astype(jnp.float32)).astype(x.dtype)


def _chunk_len(T):
    for c in (A_CHUNK, 32, 16, 8, 4, 2, 1):
        if T % c == 0:
            return c
    return 1


def _gla_chunked(q, k, v, logf, s0):
    B, T, H, dk = q.shape
    dv = v.shape[-1]
    C = _chunk_len(T)
    n = T // C

    def to_chunks(a):
        return a.reshape(B, n, C, H, a.shape[-1]).transpose(1, 0, 3, 2, 4)

    mask = jnp.tril(jnp.ones((C, C), dtype=bool))[:, :, None]

    def step(S, xs):
        qc, kc, vc, gc = xs
        b = jnp.cumsum(gc, axis=2)
        inter = jnp.einsum('bhtk,bhkv->bhtv', qc * jnp.exp(b), S)
        diff = b[:, :, :, None, :] - b[:, :, None, :, :]
        decay = jnp.exp(jnp.where(mask, diff, -jnp.inf))
        att = jnp.einsum('bhtk,bhtsk,bhsk->bhts', qc, decay, kc)
        intra = jnp.einsum('bhts,bhsv->bhtv', att, vc)
        b_last = b[:, :, -1:, :]
        S_new = S * jnp.exp(b_last[:, :, 0, :, None]) + jnp.einsum(
            'bhsk,bhsv->bhkv', kc * jnp.exp(b_last - b), vc)
        return S_new, inter + intra

    S, o = lax.scan(step, s0, (to_chunks(q), to_chunks(k), to_chunks(v), to_chunks(logf)))
    o = o.transpose(1, 0, 3, 2, 4).reshape(B, T, H, dv)
    return o, S


def _hgrn2_branch(u_a, lb, hgrn_norm_w, s0):
    B, T, _ = u_a.shape
    uf = u_a.astype(jnp.float32)
    q, fz, i, g = jnp.split(uf, 4, axis=-1)
    lbh = lb.reshape(A_HEADS, A_HEAD_K)
    fz = fz.reshape(B, T, A_HEADS, A_HEAD_K)
    logf = jnp.log(lbh + (1.0 - lbh) * jax.nn.sigmoid(fz))
    k = (1.0 - lbh) * jax.nn.sigmoid(-fz)
    q = jax.nn.silu(q).reshape(B, T, A_HEADS, A_HEAD_K)
    i = i.reshape(B, T, A_HEADS, A_HEAD_V)
    o, S = _gla_chunked(q, k, i, logf, s0.astype(jnp.float32))
    o = o * lax.rsqrt(jnp.mean(jnp.square(o), axis=-1, keepdims=True) + HGRN_NORM_EPS)
    o = o * hgrn_norm_w.astype(jnp.float32).reshape(A_HEADS, A_HEAD_V)
    o = o.reshape(B, T, A_WIDTH) * jax.nn.silu(g)
    return o, S


def _rwkv7_branch(u_b, u_b_prev, s0, mu_shift, w_decay0, w_decay_up, a0, w_aaa_up,
                  w_gate_up, k_k, k_a, r_k, ln_x_w, ln_x_b):
    B, T, _ = u_b.shape
    f32 = jnp.float32
    ub = u_b.astype(f32)
    up = jnp.concatenate([u_b_prev.astype(f32)[:, None, :], ub[:, :-1]], axis=1)
    xm = ub + (up - ub) * mu_shift.astype(f32)
    s1, s2, s3 = B_WIDTH, 2 * B_WIDTH, 3 * B_WIDTH
    s4, s5 = s3 + DECAY_LORA, s3 + DECAY_LORA + AAA_LORA
    r, k, v = xm[..., :s1], xm[..., s1:s2], xm[..., s2:s3]
    wd, ad, gd = xm[..., s3:s4], xm[..., s4:s5], xm[..., s5:]
    logw = -DECAY_SCALE * jax.nn.sigmoid(w_decay0.astype(f32) + jnp.tanh(wd) @ w_decay_up.astype(f32))
    a = jax.nn.sigmoid(a0.astype(f32) + ad @ w_aaa_up.astype(f32))
    g = jax.nn.sigmoid(gd) @ w_gate_up.astype(f32)
    hs = (B, T, B_HEADS, B_HEAD)
    kk = (k * k_k.astype(f32)).reshape(hs)
    kk = kk / jnp.maximum(jnp.sqrt(jnp.sum(jnp.square(kk), axis=-1, keepdims=True)), 1e-12)
    k = k * (1.0 + (a - 1.0) * k_a.astype(f32))
    r, k, v, w, a = (t.reshape(hs) for t in (r, k, v, jnp.exp(logw), a))

    def step(S, xs):
        rt, wt, kt, vt, kkt, at = xs
        sk = jnp.einsum('bhij,bhj->bhi', S, kkt)
        S = S * wt[:, :, None, :] - sk[..., None] * (kkt * at)[:, :, None, :] + vt[..., None] * kt[:, :, None, :]
        return S, jnp.einsum('bhij,bhj->bhi', S, rt)

    tr = lambda t: jnp.swapaxes(t, 0, 1)
    S, y = lax.scan(step, s0.astype(f32), (tr(r), tr(w), tr(k), tr(v), tr(kk), tr(a)))
    y = tr(y)
    mean = jnp.mean(y, axis=-1, keepdims=True)
    var = jnp.mean(jnp.square(y - mean), axis=-1, keepdims=True)
    yn = (y - mean) * lax.rsqrt(var + GN_EPS)
    yn = yn * ln_x_w.astype(f32).reshape(B_HEADS, B_HEAD) + ln_x_b.astype(f32).reshape(B_HEADS, B_HEAD)
    bonus = jnp.sum(r * k * r_k.astype(f32), axis=-1, keepdims=True) * v
    o = (yn + bonus).reshape(B, T, B_WIDTH) * g
    return o, S


def _layer(x, h_prev, s_a, s_b, lb, norm_mix_g, w_in, mu_shift, w_decay0, w_decay_up, a0,
           w_aaa_up, w_gate_up, k_k, k_a, r_k, ln_x_w, ln_x_b, hgrn_norm_w, w_a_out, w_b_out,
           w_out, norm_mlp_g, w_up, w_down):
    h = _rmsnorm(x, norm_mix_g)
    u = jnp.einsum('btd,dc->btc', h, w_in)
    u_a = u[..., :A_COLS]
    u_b = u[..., A_COLS:A_COLS + B_COLS]
    u_g = u[..., A_COLS + B_COLS:]
    u_b_prev = h_prev @ w_in[:, A_COLS:A_COLS + B_COLS]
    o_a, s_a_new = _hgrn2_branch(u_a, lb, hgrn_norm_w, s_a)
    o_b, s_b_new = _rwkv7_branch(u_b, u_b_prev, s_b, mu_shift, w_decay0, w_decay_up, a0,
                                 w_aaa_up, w_gate_up, k_k, k_a, r_k, ln_x_w, ln_x_b)
    y_a = o_a.astype(x.dtype) @ w_a_out
    y_b = o_b.astype(x.dtype) @ w_b_out
    gate_a = jax.nn.sigmoid(u_g[..., :D_MODEL])
    gate_b = jax.nn.sigmoid(u_g[..., D_MODEL:])
    x = x + (gate_a * y_a + gate_b * y_b) @ w_out
    h2 = _rmsnorm(x, norm_mlp_g)
    x = x + jnp.square(jax.nn.relu(h2 @ w_up)) @ w_down
    return x, h[:, -1, :], s_a_new, s_b_new


def _trunk(x, shift0, sa0, sb0, norm_mix_g, w_in, mu_shift, w_decay0, w_decay_up, a0, w_aaa_up,
           w_gate_up, k_k, k_a, r_k, ln_x_w, ln_x_b, lb_logits, hgrn_norm_w, w_a_out, w_b_out,
           w_out, norm_mlp_g, w_up, w_down, norm_final_g, state_dtype):
    lb_all = jnp.cumsum(jax.nn.softmax(lb_logits.astype(jnp.float32), axis=0), axis=0)
    shifts, sas, sbs = [], [], []
    for l in range(DEPTH):
        x, sh, sa, sb = _layer(
            x, shift0[l], sa0[l], sb0[l], lb_all[l], norm_mix_g[l], w_in[l], mu_shift[l],
            w_decay0[l], w_decay_up[l], a0[l], w_aaa_up[l], w_gate_up[l], k_k[l], k_a[l], r_k[l],
            ln_x_w[l], ln_x_b[l], hgrn_norm_w[l], w_a_out[l], w_b_out[l], w_out[l],
            norm_mlp_g[l], w_up[l], w_down[l])
        shifts.append(sh)
        sas.append(sa.astype(state_dtype))
        sbs.append(sb.astype(state_dtype))
    y = _rmsnorm(x, norm_final_g)
    return y, jnp.stack(sas, axis=0), jnp.stack(sbs, axis=0), jnp.stack(shifts, axis=0)


def setup_inputs(seed: int = 0) -> dict:
    key = jax.random.key(seed)
    ks = jax.random.split(key, 32)
    f32 = jnp.float32
    nrm = lambda k, shape, s: jax.random.normal(k, shape, f32) * s
    L = DEPTH
    return {
        "x_prompt": nrm(ks[0], (BATCH, SEQ, D_MODEL), 1.0),
        "x_sample": nrm(ks[1], (DEC_BATCH, DEC_SEQ, D_MODEL), 1.0),
        "state_hgrn": nrm(ks[2], (L, DEC_BATCH, A_HEADS, A_HEAD_K, A_HEAD_V), 0.3),
        "state_wkv": nrm(ks[3], (L, DEC_BATCH, B_HEADS, B_HEAD, B_HEAD), 0.3),
        "state_shift": nrm(ks[4], (L, DEC_BATCH, D_MODEL), 1.0),
        "norm_mix_g": 1.0 + nrm(ks[5], (L, D_MODEL), 0.02),
        "w_in": nrm(ks[6], (L, D_MODEL, IN_COLS), D_MODEL ** -0.5),
        "mu_shift": jax.random.uniform(ks[7], (L, B_COLS), f32),
        "w_decay0": nrm(ks[8], (L, B_WIDTH), 0.5),
        "w_decay_up": nrm(ks[9], (L, DECAY_LORA, B_WIDTH), DECAY_LORA ** -0.5),
        "a0": nrm(ks[10], (L, B_WIDTH), 0.3),
        "w_aaa_up": nrm(ks[11], (L, AAA_LORA, B_WIDTH), AAA_LORA ** -0.5),
        "w_gate_up": nrm(ks[12], (L, GATE_LORA, B_WIDTH), GATE_LORA ** -0.5),
        "k_k": 0.85 + nrm(ks[13], (L, B_WIDTH), 0.05),
        "k_a": 1.0 + nrm(ks[14], (L, B_WIDTH), 0.05),
        "r_k": nrm(ks[15], (L, B_HEADS, B_HEAD), 0.1),
        "ln_x_w": 1.0 + nrm(ks[16], (L, B_WIDTH), 0.02),
        "ln_x_b": nrm(ks[17], (L, B_WIDTH), 0.02),
        "lb_logits": nrm(ks[18], (L + 1, A_WIDTH), 0.5),
        "hgrn_norm_w": 1.0 + nrm(ks[19], (L, A_WIDTH), 0.02),
        "w_a_out": nrm(ks[20], (L, A_WIDTH, D_MODEL), A_WIDTH ** -0.5),
        "w_b_out": nrm(ks[21], (L, B_WIDTH, D_MODEL), B_WIDTH ** -0.5),
        "w_out": nrm(ks[22], (L, D_MODEL, D_MODEL), D_MODEL ** -0.5),
        "norm_mlp_g": 1.0 + nrm(ks[23], (L, D_MODEL), 0.02),
        "w_up": nrm(ks[24], (L, D_MODEL, D_FF), D_MODEL ** -0.5),
        "w_down": nrm(ks[25], (L, D_FF, D_MODEL), D_FF ** -0.5),
        "norm_final_g": 1.0 + nrm(ks[26], (D_MODEL,), 0.02),
    }


def reference(x_prompt, x_sample, state_hgrn, state_wkv, state_shift, norm_mix_g, w_in, mu_shift,
              w_decay0, w_decay_up, a0, w_aaa_up, w_gate_up, k_k, k_a, r_k, ln_x_w, ln_x_b,
              lb_logits, hgrn_norm_w, w_a_out, w_b_out, w_out, norm_mlp_g, w_up, w_down,
              norm_final_g):
    weights = (norm_mix_g, w_in, mu_shift, w_decay0, w_decay_up, a0, w_aaa_up, w_gate_up, k_k,
               k_a, r_k, ln_x_w, ln_x_b, lb_logits, hgrn_norm_w, w_a_out, w_b_out, w_out,
               norm_mlp_g, w_up, w_down, norm_final_g)
    sdt = state_hgrn.dtype
    bp = x_prompt.shape[0]
    shift0 = jnp.zeros((DEPTH, bp, D_MODEL), x_prompt.dtype)
    sa0 = jnp.zeros((DEPTH, bp, A_HEADS, A_HEAD_K, A_HEAD_V), jnp.float32)
    sb0 = jnp.zeros((DEPTH, bp, B_HEADS, B_HEAD, B_HEAD), jnp.float32)
    y_prompt, hgrn_p, wkv_p, shift_p = _trunk(x_prompt, shift0, sa0, sb0, *weights, sdt)
    y_sample, hgrn_s, wkv_s, shift_s = _trunk(x_sample, state_shift, state_hgrn, state_wkv,
                                              *weights, sdt)
    return (y_prompt, y_sample, hgrn_p, wkv_p, shift_p, hgrn_s, wkv_s, shift_s)
```

```cpp
#include <hip/hip_runtime.h>
#include <cstdio>
#include <cstdint>
namespace pg8 {
#define PG8_LAS __attribute__((address_space(3)))
typedef unsigned short bf16_t;
typedef short bf16x8 __attribute__((ext_vector_type(8)));
typedef float f32x4 __attribute__((ext_vector_type(4)));
typedef unsigned u32x4 __attribute__((ext_vector_type(4)));
constexpr int BM = 256, BK = 64, HALF = 128, HTB = HALF * BK * 2  , STAGE_BYTES = 8 * HTB, NXCD = 8, WGM = 8;

__host__ __device__ __forceinline__ int lds_byte(int r, int c) { const int st = (r >> 4) * 2 + (c >> 5), rr = r & 15, cc = c & 31, ob = rr * 64 + cc * 2; return st * 1024 + (ob ^ (((ob >> 9) & 1) << 5)); }
__host__ __device__ __forceinline__ void stage_rc(int b, int& R, int& C) { const int st = b / 1024, sb = b % 1024, swz = sb ^ (((sb >> 9) & 1) << 5); R = (st >> 1) * 16 + swz / 64; C = (st & 1) * 32 + (swz % 64) / 2; }
__host__ __device__ __forceinline__ int perm32(int rho) { const int n = rho >> 4, i = rho & 15; return 8 * (i >> 2) + 4 * n + (i & 3); }

struct Unit { int pm, pn; };
struct Gemm { const bf16_t* A; const bf16_t* Bt; int M, N, K, lda, ldb; };

struct StaticOrder {
    int nM, nN, nwg, G, c;
    __host__ __device__ void init(int M, int N, int G_, int c_) { nM = M / BM; nN = N / BM; nwg = nM * nN; G = G_; c = c_; }
    __host__ __device__ bool next(int i, Unit& u) const {
        const long L = (long)i * G + c; if (L >= nwg) return false;
        int wgid = (int)L; { const int q = nwg / NXCD, r = nwg % NXCD, xcd = wgid % NXCD, off = wgid / NXCD; wgid = (xcd < r ? xcd * (q + 1) : r * (q + 1) + (xcd - r) * q) + off; }
        const int nig = WGM * nN, gid = wgid / nig, fm = gid * WGM, gsz = (nM - fm) < WGM ? (nM - fm) : WGM;
        u.pm = fm + ((wgid % nig) % gsz); u.pn = (wgid % nig) / gsz; return true;
    }
    __device__ __forceinline__ void a_ready(const Unit&) const {}
    __device__ __forceinline__ void done(const Unit&) const {}
};

__device__ __forceinline__ unsigned cvt_pk_bf16(float lo, float hi) { unsigned r; asm volatile("v_cvt_pk_bf16_f32 %0, %1, %2" : "=v"(r) : "v"(lo), "v"(hi)); return r; }
typedef float f32x2 __attribute__((ext_vector_type(2)));
__device__ __forceinline__ f32x2 gelu_pk(f32x2 v) {
    const f32x2 av = __builtin_elementwise_abs(v), d = av * 0.2316418882f + 1.0f;
    f32x2 t; t.x = __builtin_amdgcn_rcpf(d.x); t.y = __builtin_amdgcn_rcpf(d.y);
    f32x2 q = t * 0.5307027145f + (-0.7265760135f); q = q * t + 0.7107068705f; q = q * t + (-0.142248368f); q = q * t + 0.127414796f; q = q * t;
    const f32x2 s = (v * v) * (-0.72134752044f);
    f32x2 e; e.x = __builtin_amdgcn_exp2f(s.x); e.y = __builtin_amdgcn_exp2f(s.y);
    const f32x2 m = v * (q * e), r = v - m;
    f32x2 o; o.x = v.x < 0.f ? m.x : r.x; o.y = v.y < 0.f ? m.y : r.y; return o;
}

template <class Epi, class Sched, bool ALIGN_EPI = false, bool SP2 = false>
__device__ __forceinline__ void gemm_phase(PG8_LAS unsigned char* lds, const Gemm g, const Sched& S, const Epi& E) {
    const int tid = threadIdx.x, wid = __builtin_amdgcn_readfirstlane(tid >> 6), lane = tid & 63, wr = wid >> 2, wc = wid & 3, fr = lane & 15, fq = lane >> 4;
    const int K = g.K, nt = K / BK;
    unsigned voffA[2], voffB[2];
#pragma unroll
    for (int i = 0; i < 2; ++i) { int R, C; stage_rc(tid * 16 + i * 8192, R, C); const int Rb = Epi::PERM ? ((R & ~31) + perm32(R & 31)) : R;
        voffA[i] = (unsigned)(R * g.lda + C) * 2u; voffB[i] = (unsigned)(Rb * g.ldb + C) * 2u; }
    const size_t kstep = (size_t)(BK * 2);
    const size_t hstepA = (size_t)HALF * g.lda * 2, hstepB = (size_t)HALF * g.ldb * 2;
    const size_t tstepA = 2 * hstepA, tstepB = 2 * hstepB;
    const unsigned ldsw = (unsigned)wid * 1024u;
    const int aoff = lds_byte(wr * 64 + fr, fq * 8), boff = lds_byte(wc * 32 + fr, fq * 8);
#define PG8_SA(b, h) (((b) * 2 + (h)) * HTB)
#define PG8_SB(b, h) ((4 + (b) * 2 + (h)) * HTB)
#define PG8_STAGE(bufoff, gbase, voff) do { _Pragma("unroll") for (int _i = 0; _i < 2; ++_i) \
        __builtin_amdgcn_global_load_lds((const unsigned*)((const char*)(gbase) + (voff)[_i]), (PG8_LAS unsigned*)(lds + (bufoff) + ldsw + _i * 8192), 16, 0, 0); } while (0)
#define PG8_LDA(dst, b, h) do { _Pragma("unroll") for (int m = 0; m < 4; ++m) _Pragma("unroll") for (int k = 0; k < 2; ++k) dst[m][k] = *(const PG8_LAS bf16x8*)(lds + PG8_SA(b, h) + aoff + m * 2048 + k * 1024); } while (0)
#define PG8_LDB(dst, b, h) do { _Pragma("unroll") for (int n = 0; n < 2; ++n) _Pragma("unroll") for (int k = 0; k < 2; ++k) dst[n][k] = *(const PG8_LAS bf16x8*)(lds + PG8_SB(b, h) + boff + n * 2048 + k * 1024); } while (0)
#define PG8_MMA(ai, bj, At, Bt) do { __builtin_amdgcn_s_setprio(1); _Pragma("unroll") for (int m = 0; m < 4; ++m) _Pragma("unroll") for (int n = 0; n < 2; ++n) _Pragma("unroll") for (int k = 0; k < 2; ++k) \
        acc[ai][bj][m][n] = __builtin_amdgcn_mfma_f32_16x16x32_bf16(Bt[n][k], At[m][k], acc[ai][bj][m][n], 0, 0, 0); __builtin_amdgcn_s_setprio(0); } while (0)
#define PG8_WAIT_V(n) asm volatile("s_waitcnt vmcnt(" #n ")" ::: "memory")
#define PG8_WAIT_L(n) asm volatile("s_waitcnt lgkmcnt(" #n ")" ::: "memory")
#define PG8_BAR __builtin_amdgcn_s_barrier()
#define PG8_SCHED __builtin_amdgcn_sched_barrier(0)
    Unit cur, nxt; int ui = 0;
    if (!S.next(0, cur)) return;
    f32x4 acc[2][2][4][2];
#pragma unroll
    for (int a = 0; a < 2; ++a)
#pragma unroll
        for (int b = 0; b < 2; ++b)
#pragma unroll
            for (int m = 0; m < 4; ++m)
#pragma unroll
                for (int n = 0; n < 2; ++n) acc[a][b][m][n] = (f32x4){0.f, 0.f, 0.f, 0.f};
    bf16x8 At[4][2], B0[2][2], B1[2][2];
    const char* cA = (const char*)g.A + (size_t)cur.pm * tstepA; const char* cB = (const char*)g.Bt + (size_t)cur.pn * tstepB;
    S.a_ready(cur);
    if constexpr (SP2) {
        PG8_STAGE(PG8_SB(0, 0), cB, voffB); PG8_STAGE(PG8_SB(0, 1), cB + hstepB, voffB); PG8_STAGE(PG8_SA(0, 0), cA, voffA); PG8_STAGE(PG8_SA(0, 1), cA + hstepA, voffA);
        if (wr == 1) PG8_BAR;
        PG8_WAIT_V(2); PG8_BAR;
        PG8_STAGE(PG8_SB(1, 0), cB + kstep, voffB); PG8_STAGE(PG8_SA(1, 0), cA + kstep, voffA); PG8_STAGE(PG8_SB(1, 1), cB + hstepB + kstep, voffB);
        PG8_WAIT_V(6); PG8_BAR;
    } else {
        PG8_STAGE(PG8_SB(0, 0), cB, voffB); PG8_STAGE(PG8_SA(0, 0), cA, voffA); PG8_STAGE(PG8_SB(0, 1), cB + hstepB, voffB); PG8_STAGE(PG8_SA(0, 1), cA + hstepA, voffA);
        if (wr == 1) PG8_BAR;
        PG8_WAIT_V(4); PG8_BAR;
        PG8_STAGE(PG8_SB(1, 0), cB + kstep, voffB); PG8_STAGE(PG8_SA(1, 0), cA + kstep, voffA); PG8_STAGE(PG8_SB(1, 1), cB + hstepB + kstep, voffB);
        PG8_WAIT_V(6); PG8_BAR;
    }
    for (;;) {
        const bool has_next = S.next(ui + 1, nxt);
        const char* nA = has_next ? (const char*)g.A + (size_t)nxt.pm * tstepA : cA; const char* nB = has_next ? (const char*)g.Bt + (size_t)nxt.pn * tstepB : cB;
        for (int t = 0; t < nt; t += 2) {
            const bool last = (t == nt - 2);
            const char* a1 = cA + (size_t)(t + 1) * kstep;
            const char* a2 = last ? nA : cA + (size_t)(t + 2) * kstep; const char* b2 = last ? nB : cB + (size_t)(t + 2) * kstep;
            const char* a3 = a2 + kstep; const char* b3 = b2 + kstep;
            if (last && has_next) S.a_ready(nxt);
            if constexpr (SP2) {
            PG8_LDB(B0, 0, 0); PG8_LDB(B1, 0, 1); PG8_SCHED; PG8_LDA(At, 0, 0); PG8_STAGE(PG8_SA(1, 1), a1 + hstepA, voffA);
            PG8_WAIT_V(8); PG8_WAIT_L(0); PG8_BAR; PG8_MMA(0, 0, At, B0); PG8_MMA(0, 1, At, B1); PG8_BAR; PG8_SCHED;
            PG8_LDA(At, 0, 1); PG8_STAGE(PG8_SB(0, 0), b2, voffB); PG8_STAGE(PG8_SB(0, 1), b2 + hstepB, voffB); PG8_STAGE(PG8_SA(0, 0), a2, voffA);
            PG8_WAIT_V(8); PG8_WAIT_L(0); PG8_BAR; PG8_MMA(1, 0, At, B0); PG8_MMA(1, 1, At, B1); PG8_BAR; PG8_SCHED;
            PG8_LDB(B0, 1, 0); PG8_LDB(B1, 1, 1); PG8_SCHED; PG8_LDA(At, 1, 0); PG8_STAGE(PG8_SA(0, 1), a2 + hstepA, voffA);
            PG8_WAIT_V(8); PG8_WAIT_L(0); PG8_BAR; PG8_MMA(0, 0, At, B0); PG8_MMA(0, 1, At, B1); PG8_BAR; PG8_SCHED;
            PG8_LDA(At, 1, 1); PG8_STAGE(PG8_SB(1, 0), b3, voffB); PG8_STAGE(PG8_SB(1, 1), b3 + hstepB, voffB); PG8_STAGE(PG8_SA(1, 0), a3, voffA);
            PG8_WAIT_V(8); PG8_WAIT_L(0); PG8_BAR; PG8_MMA(1, 0, At, B0); PG8_MMA(1, 1, At, B1); PG8_BAR; PG8_SCHED;
            } else {
            PG8_LDB(B0, 0, 0); PG8_SCHED; PG8_LDA(At, 0, 0); PG8_STAGE(PG8_SA(1, 1), a1 + hstepA, voffA);
            PG8_WAIT_L(8); PG8_BAR; PG8_WAIT_L(0); PG8_MMA(0, 0, At, B0); PG8_BAR; PG8_SCHED;
            PG8_LDB(B1, 0, 1); PG8_STAGE(PG8_SB(0, 0), b2, voffB);
            PG8_BAR; PG8_WAIT_L(0); PG8_MMA(0, 1, At, B1); PG8_BAR;
            PG8_LDA(At, 0, 1); PG8_STAGE(PG8_SA(0, 0), a2, voffA);
            PG8_BAR; PG8_WAIT_L(0); PG8_MMA(1, 0, At, B0); PG8_BAR; PG8_SCHED;
            PG8_STAGE(PG8_SB(0, 1), b2 + hstepB, voffB);
            PG8_WAIT_V(6); PG8_BAR; PG8_MMA(1, 1, At, B1); PG8_BAR;
            PG8_LDB(B0, 1, 0); PG8_SCHED; PG8_LDA(At, 1, 0); PG8_STAGE(PG8_SA(0, 1), a2 + hstepA, voffA);
            PG8_WAIT_L(8); PG8_BAR; PG8_WAIT_L(0); PG8_MMA(0, 0, At, B0); PG8_BAR; PG8_SCHED;
            PG8_LDB(B1, 1, 1); PG8_STAGE(PG8_SB(1, 0), b3, voffB);
            PG8_BAR; PG8_WAIT_L(0); PG8_MMA(0, 1, At, B1); PG8_BAR;
            PG8_LDA(At, 1, 1); PG8_STAGE(PG8_SA(1, 0), a3, voffA);
            PG8_BAR; PG8_WAIT_L(0); PG8_MMA(1, 0, At, B0); PG8_BAR; PG8_SCHED;
            PG8_STAGE(PG8_SB(1, 1), b3 + hstepB, voffB);
            PG8_WAIT_V(6); PG8_BAR; PG8_MMA(1, 1, At, B1); PG8_BAR;
            }
        }
        if constexpr (ALIGN_EPI) { if (wr == 0) PG8_BAR; }
        if constexpr (!Epi::AFTER_DRAIN) { E(acc, cur, wr, wc, fr, fq); S.done(cur); }
        if (!has_next) break;
#pragma unroll
        for (int a = 0; a < 2; ++a)
#pragma unroll
            for (int b = 0; b < 2; ++b)
#pragma unroll
                for (int m = 0; m < 4; ++m)
#pragma unroll
                    for (int n = 0; n < 2; ++n) acc[a][b][m][n] = (f32x4){0.f, 0.f, 0.f, 0.f};
        cur = nxt; cA = nA; cB = nB; ++ui;
        if constexpr (ALIGN_EPI) { if (wr == 1) PG8_BAR; }
    }
    PG8_WAIT_V(0);
    if constexpr (!ALIGN_EPI) { if (wr == 0) PG8_BAR; }
    PG8_BAR;
    if constexpr (Epi::AFTER_DRAIN) { E.fused(acc, cur, wr, wc, fr, fq, lds, wid, lane); S.done(cur); }
#undef PG8_SA
#undef PG8_SB
#undef PG8_STAGE
#undef PG8_LDA
#undef PG8_LDB
#undef PG8_MMA
#undef PG8_WAIT_V
#undef PG8_WAIT_L
#undef PG8_BAR
#undef PG8_SCHED
}
}

#ifndef MK_N_LAUNCHES
#define MK_N_LAUNCHES 10
#endif
constexpr int NPHASE = 10;
constexpr int NWAVES = 8;

constexpr int D = 1024, SEQ = 2048, NBP = 8, NBS = 128, TS = 4;
constexpr int MP = NBP * SEQ;
constexpr int MS = NBS * TS;
constexpr int MT = MP + MS;
constexpr int MH = MT + 256;
constexpr int ACOLS = 2048, BCOLS = 1792, GCOLS = 2048, NIN = ACOLS + BCOLS + GCOLS, DFF = 4096;
constexpr int AW = 512, BW = 512;
constexpr float NORM_EPS = 1e-6f, HGRN_EPS = 1e-5f, GN_EPS = 64e-5f, DECAY_SCALE = 0.6065306597126334f;

constexpr size_t O_Y = 0, O_HGRN_P = (size_t)MT * D, O_WKV_P = O_HGRN_P + (size_t)NBP * 4 * 128 * 128, O_SHIFT_P = O_WKV_P + (size_t)NBP * 8 * 64 * 64,
                 O_HGRN_S = O_SHIFT_P + (size_t)NBP * D, O_WKV_S = O_HGRN_S + (size_t)NBS * 4 * 128 * 128, O_SHIFT_S = O_WKV_S + (size_t)NBS * 8 * 64 * 64,
                 O_END = O_SHIFT_S + (size_t)NBS * D;
static_assert(O_END == 30810112, "d_out size");

constexpr size_t WS_CTL = 0, CTL_BYTES = 65536;
constexpr size_t WS_WIN = WS_CTL + CTL_BYTES;
constexpr size_t WS_WA  = WS_WIN + (size_t)NIN * D * 2;
constexpr size_t WS_WB  = WS_WA + (size_t)D * AW * 2;
constexpr size_t WS_WO  = WS_WB + (size_t)D * BW * 2;
constexpr size_t WS_WUP = WS_WO + (size_t)D * D * 2;
constexpr size_t WS_WDN = WS_WUP + (size_t)DFF * D * 2;
constexpr size_t WS_UB  = WS_WDN + (size_t)D * DFF * 2;
constexpr size_t WS_UA  = WS_UB + (size_t)MH * BCOLS * 2;
constexpr size_t WS_UG  = WS_UA + (size_t)MT * ACOLS * 2;
constexpr size_t WS_BONUS = WS_UG + (size_t)MT * GCOLS * 2;
constexpr size_t WS_SSQ1 = WS_BONUS + (size_t)MT * 8 * 4;
constexpr size_t WS_SSQ2 = WS_SSQ1 + (size_t)MT * 16 * 4;
constexpr size_t WS_END = WS_SSQ2 + (size_t)MT * 16 * 4;
static_assert(WS_END <= 268435456, "d_ws map");
static_assert(WS_UA + (size_t)MT * DFF * 2 == WS_BONUS, "hidden overlays UA|UG exactly");
static_assert((size_t)MT * 2048 * 2 == (size_t)MT * D * 4, "P fits the y region exactly");

constexpr int CW_TMO = 0, CW_BAR = 1024;

constexpr int RING_BYTES = 131072, LDSCTL_OFF = RING_BYTES, MISC_OFF = LDSCTL_OFF + 320, LDS_BYTES = 147456;

#define GAS __attribute__((address_space(1)))
#define LAS __attribute__((address_space(3)))
typedef unsigned short bf16;
typedef unsigned v4u __attribute__((ext_vector_type(4)));
typedef unsigned v2u __attribute__((ext_vector_type(2)));
typedef float f32x4 __attribute__((ext_vector_type(4)));
typedef GAS unsigned gu32;
#define RLX_AGENT __ATOMIC_RELAXED, __HIP_MEMORY_SCOPE_AGENT
#define LDS_WAIT() asm volatile("s_waitcnt lgkmcnt(0)" ::: "memory")
#define VM_WAIT() asm volatile("s_waitcnt vmcnt(0)" ::: "memory")
__device__ __forceinline__ unsigned f2bf(float f) { unsigned u = __builtin_bit_cast(unsigned, f); return (u + 0x7fffu + ((u >> 16) & 1u)) >> 16; }
__device__ __forceinline__ unsigned pk2(float lo, float hi) { return f2bf(lo) | (f2bf(hi) << 16); }
__device__ __forceinline__ float bf2f(unsigned b) { return __builtin_bit_cast(float, b << 16); }
__device__ __forceinline__ float bflo(unsigned w) { return __builtin_bit_cast(float, w << 16); }
__device__ __forceinline__ float bfhi(unsigned w) { return __builtin_bit_cast(float, w & 0xffff0000u); }
__device__ __forceinline__ float sigmoidf_(float x) { return 1.0f / (1.0f + __expf(-x)); }
__device__ __forceinline__ float tanhf_(float x) { return 1.0f - 2.0f / (1.0f + __expf(2.0f * x)); }
__device__ __forceinline__ float wave_sum(float v) {
#pragma unroll
    for (int o = 1; o < 64; o <<= 1) v += __shfl_xor(v, o);
    return v;
}
__device__ __forceinline__ float row_sum16(float x) {
    x += __builtin_bit_cast(float, __builtin_amdgcn_update_dpp(0, __builtin_bit_cast(int, x), 0xB1, 0xF, 0xF, true));
    x += __builtin_bit_cast(float, __builtin_amdgcn_update_dpp(0, __builtin_bit_cast(int, x), 0x4E, 0xF, 0xF, true));
    x += __builtin_bit_cast(float, __builtin_amdgcn_update_dpp(0, __builtin_bit_cast(int, x), 0x141, 0xF, 0xF, true));
    x += __builtin_bit_cast(float, __builtin_amdgcn_update_dpp(0, __builtin_bit_cast(int, x), 0x140, 0xF, 0xF, true));
    return x;
}
#define XB_TMO      128
#define XB_XCNT(j)  (256  + 64 * (j))
#define XB_XSUB(j)  (1280 + 64 * (j))
#define XB_XGEN(j)  (2304 + 64 * (j))
#define XB_TOP      3328
#define XB_TOPGEN   3392
#define XCD_BAR_WORDS 3456
#define XB_SPIN_CAP (1u << 18)

__device__ __forceinline__ unsigned xb_ld(unsigned* p)              { return __hip_atomic_load(p, __ATOMIC_RELAXED, __HIP_MEMORY_SCOPE_AGENT); }
__device__ __forceinline__ unsigned xb_add(unsigned* p, unsigned v) { return __hip_atomic_fetch_add(p, v, __ATOMIC_RELAXED, __HIP_MEMORY_SCOPE_AGENT); }
__device__ __forceinline__ unsigned xb_xcc_id() { return (unsigned)__builtin_amdgcn_s_getreg((3 << 11) | 20) & 0xFu; }
#define XB_SPIN(cond, bar) do { unsigned _sp = 0; while (cond) { __builtin_amdgcn_s_sleep(1); \
    if ((++_sp & 255u) == 0u) { if (xb_ld(&(bar)[XB_TMO])) break; if (_sp > XB_SPIN_CAP) { atomicAdd(&(bar)[XB_TMO], 1u); break; } } } } while (0)

struct XcdBarrier {
    unsigned* bar; unsigned x;
    volatile LAS unsigned* st;
};

__device__ __forceinline__ XcdBarrier xcd_barrier_post(unsigned* bar, volatile LAS unsigned* st) {
    XcdBarrier b; b.bar = bar; b.x = xb_xcc_id(); b.st = st;
    if (threadIdx.x == 0) (void)xb_add(&bar[XB_XCNT(b.x)], 1u);
    return b;
}
__device__ __forceinline__ void xcd_barrier_complete(unsigned* bar, unsigned x, unsigned& nloc, unsigned& nx) {
    const unsigned G = gridDim.x * gridDim.y * gridDim.z;
    unsigned sum, cnt, mine, sp = 0u;
    for (;;) {
        sum = 0u; cnt = 0u; mine = 0u;
#pragma unroll
        for (unsigned j = 0; j < 16; ++j) { const unsigned c = xb_ld(&bar[XB_XCNT(j)]); sum += c; cnt += (c > 0u) ? 1u : 0u; mine = (j == x) ? c : mine; }
        if (sum == G) break;
        __builtin_amdgcn_s_sleep(1);
        if ((++sp & 255u) == 0u) { if (xb_ld(&bar[XB_TMO])) break; if (sp > XB_SPIN_CAP) { atomicAdd(&bar[XB_TMO], 1u); break; } }
    }
    nloc = mine > 0u ? mine : 1u; nx = cnt > 0u ? cnt : 1u;
}

__device__ __forceinline__ void xcd_barrier(const XcdBarrier& b) {
    asm volatile("s_waitcnt vmcnt(0)" ::: "memory");
    __syncthreads();
    if (threadIdx.x == 0) {
        unsigned* bar = b.bar;
        __builtin_amdgcn_s_waitcnt(0);
        unsigned nloc = b.st[0], nx = b.st[1];
        if (nloc == 0u) { xcd_barrier_complete(bar, b.x, nloc, nx); b.st[0] = nloc; b.st[1] = nx; }
        const unsigned old = xb_add(&bar[XB_XSUB(b.x)], 1u);
        const unsigned gen = old / nloc;
        if (old + 1u == (gen + 1u) * nloc) {
            __builtin_amdgcn_fence(__ATOMIC_RELEASE, "agent");
            asm volatile("s_waitcnt vmcnt(0)" ::: "memory");
            const unsigned og = xb_add(&bar[XB_TOP], 1u);
            const unsigned tg = og / nx;
            if (og + 1u == (tg + 1u) * nx) xb_add(&bar[XB_TOPGEN], 1u);
            else XB_SPIN(xb_ld(&bar[XB_TOPGEN]) == tg, bar);
            __builtin_amdgcn_fence(__ATOMIC_ACQUIRE, "agent");
            xb_add(&bar[XB_XGEN(b.x)], 1u);
            asm volatile("s_waitcnt vmcnt(0)" ::: "memory");
        } else {
            XB_SPIN(xb_ld(&bar[XB_XGEN(b.x)]) == gen, bar);
            __builtin_amdgcn_fence(__ATOMIC_ACQUIRE, "agent");
            asm volatile("s_waitcnt vmcnt(0)" ::: "memory");
        }
    }
    __syncthreads();
}


struct Args { const float* in[27]; float* out; unsigned char* ws; int ph_lo, ph_hi; };
struct Frame {
    LAS unsigned char* lds;
    int tid, lane, wave, vcu, G;
};

struct SchedMN {
    pg8::StaticOrder so;
    __device__ void init(int M, int N, int G, int c) { so.init(M, N, G, c); }
    __device__ __forceinline__ bool next(int i, pg8::Unit& u) const { return so.next(i, u); }
    __device__ __forceinline__ void a_ready(const pg8::Unit&) const {}
    __device__ __forceinline__ void done(const pg8::Unit&) const {}
};
struct SchedG1 {
    pg8::StaticOrder so; int G, c;
    __device__ void init(int G_, int c_) { so.init(MT, NIN, G_, c_); G = G_; c = c_; }
    __device__ __forceinline__ bool next(int i, pg8::Unit& u) const {
        const int L = i * G + c;
        if (L < so.nwg) return so.next(i, u);
        if (L < so.nwg + 7) { u.pm = MT / 256; u.pn = 8 + (L - so.nwg); return true; }
        return false;
    }
    __device__ __forceinline__ void a_ready(const pg8::Unit&) const {}
    __device__ __forceinline__ void done(const pg8::Unit&) const {}
};

using pg8::f32x4; using pg8::Unit;
typedef unsigned u32x4 __attribute__((ext_vector_type(4)));
struct EpiG1 {
    static constexpr bool PERM = true, AFTER_DRAIN = false;
    bf16 *UA, *UB, *UG;
    __device__ __forceinline__ void operator()(const f32x4 (&acc)[2][2][4][2], const Unit& u, int wr, int wc, int fr, int fq) const {
        bf16* base; int ld, colt;
        if (u.pn < 8) { base = UA; ld = ACOLS; colt = u.pn * 256; } else if (u.pn < 15) { base = UB; ld = BCOLS; colt = (u.pn - 8) * 256; } else { base = UG; ld = GCOLS; colt = (u.pn - 15) * 256; }
        const int row0 = u.pm * 256 + wr * 64 + fr, col0 = colt + wc * 32 + 8 * fq;
#pragma unroll
        for (int ai = 0; ai < 2; ++ai)
#pragma unroll
            for (int m = 0; m < 4; ++m) { bf16* rowp = base + (size_t)(row0 + ai * 128 + m * 16) * ld + col0;
#pragma unroll
                for (int bj = 0; bj < 2; ++bj) { const f32x4 v0 = acc[ai][bj][m][0], v1 = acc[ai][bj][m][1];
                    u32x4 w; w.x = pk2(v0[0], v0[1]); w.y = pk2(v0[2], v0[3]); w.z = pk2(v1[0], v1[1]); w.w = pk2(v1[2], v1[3]);
                    *(u32x4*)(rowp + bj * 128) = w; } }
    }
};
template <bool ADD> struct EpiMerge {
    static constexpr bool PERM = true, AFTER_DRAIN = false;
    bf16* Mg; const bf16* UG; int goff;
    __device__ __forceinline__ void operator()(const f32x4 (&acc)[2][2][4][2], const Unit& u, int wr, int wc, int fr, int fq) const {
        const int row0 = u.pm * 256 + wr * 64 + fr, col0 = u.pn * 256 + wc * 32 + 8 * fq;
#pragma unroll
        for (int ai = 0; ai < 2; ++ai)
#pragma unroll
            for (int m = 0; m < 4; ++m) { const size_t row = (size_t)(row0 + ai * 128 + m * 16);
#pragma unroll
                for (int bj = 0; bj < 2; ++bj) { const f32x4 v0 = acc[ai][bj][m][0], v1 = acc[ai][bj][m][1];
                    const u32x4 gq = *(const u32x4*)(UG + row * GCOLS + goff + col0 + bj * 128);
                    float o[8];
                    o[0] = sigmoidf_(bflo(gq.x)) * v0[0]; o[1] = sigmoidf_(bfhi(gq.x)) * v0[1]; o[2] = sigmoidf_(bflo(gq.y)) * v0[2]; o[3] = sigmoidf_(bfhi(gq.y)) * v0[3];
                    o[4] = sigmoidf_(bflo(gq.z)) * v1[0]; o[5] = sigmoidf_(bfhi(gq.z)) * v1[1]; o[6] = sigmoidf_(bflo(gq.w)) * v1[2]; o[7] = sigmoidf_(bfhi(gq.w)) * v1[3];
                    bf16* dst = Mg + row * ACOLS + col0 + bj * 128;
                    if (ADD) { const u32x4 p = *(const u32x4*)dst;
                        o[0] += bflo(p.x); o[1] += bfhi(p.x); o[2] += bflo(p.y); o[3] += bfhi(p.y); o[4] += bflo(p.z); o[5] += bfhi(p.z); o[6] += bflo(p.w); o[7] += bfhi(p.w); }
                    u32x4 w; w.x = pk2(o[0], o[1]); w.y = pk2(o[2], o[3]); w.z = pk2(o[4], o[5]); w.w = pk2(o[6], o[7]);
                    *(u32x4*)dst = w; } }
    }
};
template <bool RES_IS_X, bool WRITE_BF> struct EpiRes {
    static constexpr bool PERM = false, AFTER_DRAIN = false;
    const float* xp; const float* xs; float* out; bf16* xb; int ldb; float* ssq;
    __device__ __forceinline__ void operator()(const f32x4 (&acc)[2][2][4][2], const Unit& u, int wr, int wc, int fr, int fq) const {
        const int row0 = u.pm * 256 + wr * 64 + fr, col0 = u.pn * 256 + wc * 32 + 4 * fq;
#pragma unroll
        for (int ai = 0; ai < 2; ++ai)
#pragma unroll
            for (int m = 0; m < 4; ++m) { const int row = row0 + ai * 128 + m * 16;
                const float* rp = RES_IS_X ? (row < MP ? xp + (size_t)row * D : xs + (size_t)(row - MP) * D) : out + (size_t)row * D;
                float s = 0.f;
#pragma unroll
                for (int bj = 0; bj < 2; ++bj)
#pragma unroll
                    for (int n = 0; n < 2; ++n) { const int col = col0 + bj * 128 + n * 16;
                        const f32x4 r = *(const f32x4*)(rp + col); const f32x4 o = r + acc[ai][bj][m][n];
                        *(f32x4*)(out + (size_t)row * D + col) = o;
                        s += (o[0] * o[0] + o[1] * o[1]) + (o[2] * o[2] + o[3] * o[3]);
                        if (WRITE_BF) { v2u w; w.x = pk2(o[0], o[1]); w.y = pk2(o[2], o[3]); *(v2u*)(xb + (size_t)row * ldb + col) = w; } }
                s += __shfl_xor(s, 16); s += __shfl_xor(s, 32);
                if (fq == 0) ssq[(size_t)row * 16 + u.pn * 4 + wc] = s; }
    }
};
struct EpiUp {
    static constexpr bool PERM = true, AFTER_DRAIN = false;
    bf16* Hd; const float* ssq;
    __device__ __forceinline__ void operator()(const f32x4 (&acc)[2][2][4][2], const Unit& u, int wr, int wc, int fr, int fq) const {
        const int row0 = u.pm * 256 + wr * 64 + fr, col0 = u.pn * 256 + wc * 32 + 8 * fq;
#pragma unroll
        for (int ai = 0; ai < 2; ++ai)
#pragma unroll
            for (int m = 0; m < 4; ++m) { const size_t row = (size_t)(row0 + ai * 128 + m * 16);
                const f32x4* sp = (const f32x4*)(ssq + row * 16); const f32x4 a = sp[0], b = sp[1], c = sp[2], d = sp[3];
                const float tot = ((a[0] + a[1]) + (a[2] + a[3])) + ((b[0] + b[1]) + (b[2] + b[3])) + ((c[0] + c[1]) + (c[2] + c[3])) + ((d[0] + d[1]) + (d[2] + d[3]));
                const float rstd = rsqrtf(tot * (1.0f / D) + NORM_EPS);
#pragma unroll
                for (int bj = 0; bj < 2; ++bj) { const f32x4 v0 = acc[ai][bj][m][0], v1 = acc[ai][bj][m][1];
                    float o[8] = {v0[0], v0[1], v0[2], v0[3], v1[0], v1[1], v1[2], v1[3]};
#pragma unroll
                    for (int e = 0; e < 8; ++e) { const float t = fmaxf(o[e] * rstd, 0.f); o[e] = t * t; }
                    u32x4 w; w.x = pk2(o[0], o[1]); w.y = pk2(o[2], o[3]); w.z = pk2(o[4], o[5]); w.w = pk2(o[6], o[7]);
                    *(u32x4*)(Hd + row * DFF + col0 + bj * 128) = w; } }
    }
};

__device__ __forceinline__ void p0_transpose_item(const float* W, int K, int N, bf16* WT, const float* kscale, LAS float* scr, int item, int lane) {
    const int nblk = N / 32, kb = item / nblk, nb = item % nblk, k0 = 64 * kb, n0 = 32 * nb;
#pragma unroll 8
    for (int i = 0; i < 32; ++i) { const int kk = 2 * i + (lane >> 5); float v = W[(size_t)(k0 + kk) * N + n0 + (lane & 31)]; if (kscale) v *= kscale[k0 + kk]; scr[kk * 33 + (lane & 31)] = v; }
    LDS_WAIT(); asm volatile("" ::: "memory");
    const int c = lane & 7;
#pragma unroll
    for (int j = 0; j < 4; ++j) { const int n = (lane >> 3) + 8 * j; const LAS float* s = scr + (8 * c) * 33 + n;
        v4u o; o.x = pk2(s[0 * 33], s[1 * 33]); o.y = pk2(s[2 * 33], s[3 * 33]); o.z = pk2(s[4 * 33], s[5 * 33]); o.w = pk2(s[6 * 33], s[7 * 33]);
        *(GAS v4u*)(WT + (size_t)(n0 + n) * K + k0 + 8 * c) = o; }
    LDS_WAIT(); asm volatile("" ::: "memory");
}
__device__ __forceinline__ void p0_prologue(const Frame& F, const Args& A) {
    LAS float* scr = (LAS float*)(F.lds + F.wave * 16384);
    const int gw = F.vcu * NWAVES + F.wave, NGW = F.G * NWAVES;
    unsigned char* ws = A.ws;
    constexpr int I_IN = (D / 64) * (NIN / 32), I_A = (AW / 64) * (D / 32), I_O = (D / 64) * (D / 32), I_UP = (D / 64) * (DFF / 32), I_DN = (DFF / 64) * (D / 32);
    constexpr int NITEMS = I_IN + 2 * I_A + I_O + I_UP + I_DN;
    for (int it = gw; it < NITEMS; it += NGW) {
        int r = it;
        if (r < I_IN) { p0_transpose_item(A.in[6], D, NIN, (bf16*)(ws + WS_WIN), nullptr, scr, r, F.lane); continue; } r -= I_IN;
        if (r < I_A) { p0_transpose_item(A.in[20], AW, D, (bf16*)(ws + WS_WA), nullptr, scr, r, F.lane); continue; } r -= I_A;
        if (r < I_A) { p0_transpose_item(A.in[21], BW, D, (bf16*)(ws + WS_WB), nullptr, scr, r, F.lane); continue; } r -= I_A;
        if (r < I_O) { p0_transpose_item(A.in[22], D, D, (bf16*)(ws + WS_WO), nullptr, scr, r, F.lane); continue; } r -= I_O;
        if (r < I_UP) { p0_transpose_item(A.in[24], D, DFF, (bf16*)(ws + WS_WUP), A.in[23], scr, r, F.lane); continue; } r -= I_UP;
        p0_transpose_item(A.in[25], DFF, D, (bf16*)(ws + WS_WDN), nullptr, scr, r, F.lane);
    }
    bf16* H = (bf16*)A.out;
    const float* g = A.in[5];
    f32x4 gv[4];
#pragma unroll
    for (int j = 0; j < 4; ++j) gv[j] = ((const f32x4*)g)[F.lane + 64 * j];
    for (int m = gw; m < MH; m += NGW) {
        GAS unsigned long long* o8 = (GAS unsigned long long*)(H + (size_t)m * D) + F.lane;
        if (m < MT) {
            const float* xrow = m < MP ? A.in[0] + (size_t)m * D : A.in[1] + (size_t)(m - MP) * D;
            const f32x4* xr = (const f32x4*)xrow + F.lane;
            f32x4 v[4]; float s = 0.f;
#pragma unroll
            for (int j = 0; j < 4; ++j) { v[j] = xr[64 * j]; s += (v[j][0] * v[j][0] + v[j][1] * v[j][1]) + (v[j][2] * v[j][2] + v[j][3] * v[j][3]); }
            const float rstd = rsqrtf(wave_sum(s) * (1.0f / D) + NORM_EPS);
#pragma unroll
            for (int j = 0; j < 4; ++j) v[j] = v[j] * rstd * gv[j];
#pragma unroll
            for (int j = 0; j < 4; ++j) o8[64 * j] = (unsigned long long)pk2(v[j][0], v[j][1]) | ((unsigned long long)pk2(v[j][2], v[j][3]) << 32);
            float* so = nullptr;
            if (m < MP) { if ((m & (SEQ - 1)) == SEQ - 1) so = A.out + O_SHIFT_P + (size_t)(m >> 11) * D; }
            else { const int s_ = m - MP; if ((s_ & 3) == 3) so = A.out + O_SHIFT_S + (size_t)(s_ >> 2) * D; }
            if (so) {
#pragma unroll
                for (int j = 0; j < 4; ++j) ((f32x4*)so)[F.lane + 64 * j] = v[j];
            }
        } else if (m < MT + NBS) {
            const f32x4* xr = (const f32x4*)(A.in[4] + (size_t)(m - MT) * D) + F.lane;
#pragma unroll
            for (int j = 0; j < 4; ++j) { const f32x4 v = xr[64 * j]; o8[64 * j] = (unsigned long long)pk2(v[0], v[1]) | ((unsigned long long)pk2(v[2], v[3]) << 32); }
        } else {
#pragma unroll
            for (int j = 0; j < 4; ++j) o8[64 * j] = 0ull;
        }
    }
}

__device__ __forceinline__ int prev_row(int row) {
    if (row < MP) return (row & (SEQ - 1)) ? row - 1 : -1;
    const int s = row - MP; return (s & 3) ? row - 1 : MT + (s >> 2);
}
__device__ __forceinline__ float shifted(const bf16* UB, int row, int prow, int col, float mu) {
    const float ub = bf2f(UB[(size_t)row * BCOLS + col]);
    const float up = prow >= 0 ? bf2f(UB[(size_t)prow * BCOLS + col]) : 0.f;
    return ub + (up - ub) * mu;
}
__device__ __forceinline__ void p2_rwkv_prep(const Frame& F, const Args& A) {
    const bf16* UB = (const bf16*)(A.ws + WS_UB);
    bf16* P = (bf16*)A.out;
    float* bonus = (float*)(A.ws + WS_BONUS);
    LAS float* lw = (LAS float*)F.lds;
    const int c = F.tid;
    const float* mu = A.in[7];
    const float w0 = A.in[8][c], a0 = A.in[10][c], kkc = A.in[13][c], kac = A.in[14][c], rkc = A.in[15][c];
    const float mu_r = mu[c], mu_k = mu[512 + c];
    for (int tile = F.vcu; tile < MT / 32; tile += F.G) {
        const int r0 = tile * 32;
#pragma unroll
        for (int n = 0; n < 8; ++n) { const int idx = F.tid + 512 * n, tok = idx >> 7, k = idx & 127, row = r0 + tok;
            const float xm = shifted(UB, row, prev_row(row), 1536 + k, mu[1536 + k]);
            lw[tok * 128 + k] = k < 64 ? tanhf_(xm) : xm; }
        __syncthreads();
        {
            float Wd[64];
            const float* wp = A.in[9] + c; asm volatile("" : "+v"(wp));
#pragma unroll
            for (int k = 0; k < 64; ++k) Wd[k] = wp[k * BW];
#pragma unroll 1
            for (int tok = 0; tok < 32; ++tok) {
                float dec = 0.f;
                const LAS f32x4* l4 = (const LAS f32x4*)(lw + tok * 128);
#pragma unroll
                for (int k4 = 0; k4 < 16; ++k4) { const f32x4 t = l4[k4]; dec += t[0] * Wd[4 * k4] + t[1] * Wd[4 * k4 + 1] + t[2] * Wd[4 * k4 + 2] + t[3] * Wd[4 * k4 + 3]; }
                const float w = __expf(-DECAY_SCALE * sigmoidf_(w0 + dec));
                P[(size_t)(r0 + tok) * 2048 + c] = (bf16)f2bf(w);
            }
        }
        {
            float Wa[64];
            const float* wp = A.in[11] + c; asm volatile("" : "+v"(wp));
#pragma unroll
            for (int k = 0; k < 64; ++k) Wa[k] = wp[k * BW];
#pragma unroll 1
            for (int tok = 0; tok < 32; ++tok) {
                const int row = r0 + tok, prow = prev_row(row);
                float aa = 0.f;
                const LAS f32x4* l4 = (const LAS f32x4*)(lw + tok * 128 + 64);
#pragma unroll
                for (int k4 = 0; k4 < 16; ++k4) { const f32x4 u = l4[k4]; aa += u[0] * Wa[4 * k4] + u[1] * Wa[4 * k4 + 1] + u[2] * Wa[4 * k4 + 2] + u[3] * Wa[4 * k4 + 3]; }
                const float a = sigmoidf_(a0 + aa);
                const float xr = shifted(UB, row, prow, c, mu_r), xk = shifted(UB, row, prow, 512 + c, mu_k);
                const float kp = xk * kkc;
                const float nrm = fmaxf(sqrtf(wave_sum(kp * kp)), 1e-12f);
                const float kk = kp / nrm;
                const float k2 = xk * (1.0f + (a - 1.0f) * kac);
                const float bs = wave_sum(xr * k2 * rkc);
                bf16* pr = P + (size_t)row * 2048 + c;
                pr[512] = (bf16)f2bf(k2); pr[1024] = (bf16)f2bf(kk); pr[1536] = (bf16)f2bf(kk * a);
                if (F.lane == 0) bonus[(size_t)row * 8 + F.wave] = bs;
            }
        }
        __syncthreads();
    }
}

constexpr int TB = 32;
__device__ __forceinline__ void rwkv_scan_unit(const Frame& F, const Args& A, int row0, int T, int h, int half, const float* s_in, float* s_out) {
    const bf16* P = (const bf16*)A.out;
    bf16* UB = (bf16*)(A.ws + WS_UB);
    LAS float* buf = (LAS float*)F.lds;
    constexpr int STEPF = 384, BUFF = TB * STEPF;
    const int cg = F.lane & 15, i = half * 32 + F.wave * 4 + (F.lane >> 4);
    const int e = F.tid * 16, ls = e >> 8, lq = (e >> 6) & 3, lj = e & 63;
    const int lslot = lq == 0 ? 0 : (lq == 1 ? 3 : (lq == 2 ? 1 : 2));
    const int e2 = F.tid * 8, ls2 = e2 >> 7, lq2 = (e2 >> 6) & 1, lj2 = e2 & 63;
    const int ucol = lq2 * 1024 + h * 64 + lj2;
    float mu8[8];
#pragma unroll
    for (int k = 0; k < 8; ++k) mu8[k] = A.in[7][ucol + k];
    f32x4 S;
    if (s_in) S = *(const f32x4*)(s_in + i * 64 + 4 * cg); else S = (f32x4){0.f, 0.f, 0.f, 0.f};
    const int nblk = (T + TB - 1) / TB;
    v4u p0, p1, uc, up;
    auto load_block = [&](int blk) {
        const int t0 = blk * TB;
        p0 = (v4u){0, 0, 0, 0}; p1 = p0; uc = p0; up = p0;
        if (t0 + ls < T) { const v4u* src = (const v4u*)(P + (size_t)(row0 + t0 + ls) * 2048 + lq * 512 + h * 64 + lj); p0 = src[0]; p1 = src[1]; }
        if (t0 + ls2 < T) { const int row = row0 + t0 + ls2, prow = prev_row(row);
            uc = *(const v4u*)(UB + (size_t)row * BCOLS + ucol);
            if (prow >= 0) up = *(const v4u*)(UB + (size_t)prow * BCOLS + ucol); }
    };
    auto store_block = [&](int b) {
        LAS float* d = buf + b * BUFF + ls * STEPF + lslot * 64 + lj;
        *(LAS f32x4*)(d) = (f32x4){bflo(p0.x), bfhi(p0.x), bflo(p0.y), bfhi(p0.y)};
        *(LAS f32x4*)(d + 4) = (f32x4){bflo(p0.z), bfhi(p0.z), bflo(p0.w), bfhi(p0.w)};
        *(LAS f32x4*)(d + 8) = (f32x4){bflo(p1.x), bfhi(p1.x), bflo(p1.y), bfhi(p1.y)};
        *(LAS f32x4*)(d + 12) = (f32x4){bflo(p1.z), bfhi(p1.z), bflo(p1.w), bfhi(p1.w)};
        LAS float* d2 = buf + b * BUFF + ls2 * STEPF + (4 + lq2) * 64 + lj2;
        float c8[8] = {bflo(uc.x), bfhi(uc.x), bflo(uc.y), bfhi(uc.y), bflo(uc.z), bfhi(uc.z), bflo(uc.w), bfhi(uc.w)};
        float q8[8] = {bflo(up.x), bfhi(up.x), bflo(up.y), bfhi(up.y), bflo(up.z), bfhi(up.z), bflo(up.w), bfhi(up.w)};
#pragma unroll
        for (int k = 0; k < 8; ++k) c8[k] = c8[k] + (q8[k] - c8[k]) * mu8[k];
        *(LAS f32x4*)(d2) = (f32x4){c8[0], c8[1], c8[2], c8[3]};
        *(LAS f32x4*)(d2 + 4) = (f32x4){c8[4], c8[5], c8[6], c8[7]};
    };
    __syncthreads();
    load_block(0); store_block(0);
    __syncthreads();
    for (int blk = 0; blk < nblk; ++blk) {
        if (blk + 1 < nblk) load_block(blk + 1);
        const LAS float* bb = buf + (blk & 1) * BUFF;
        const int ns = (T - blk * TB) < TB ? (T - blk * TB) : TB;
        bf16* yout = UB + (size_t)(row0 + blk * TB) * BCOLS + 512 + h * 64 + i;
        for (int s = 0; s < ns; ++s) {
            const LAS float* v = bb + s * STEPF;
            const f32x4 w4 = *(const LAS f32x4*)(v + 4 * cg), kk4 = *(const LAS f32x4*)(v + 64 + 4 * cg), ka4 = *(const LAS f32x4*)(v + 128 + 4 * cg),
                        k4 = *(const LAS f32x4*)(v + 192 + 4 * cg), r4 = *(const LAS f32x4*)(v + 256 + 4 * cg);
            const float vi = v[320 + i];
            float sk = (S[0] * kk4[0] + S[1] * kk4[1]) + (S[2] * kk4[2] + S[3] * kk4[3]);
            sk = row_sum16(sk);
            S[0] = S[0] * w4[0] - sk * ka4[0] + vi * k4[0];
            S[1] = S[1] * w4[1] - sk * ka4[1] + vi * k4[1];
            S[2] = S[2] * w4[2] - sk * ka4[2] + vi * k4[2];
            S[3] = S[3] * w4[3] - sk * ka4[3] + vi * k4[3];
            float y = (S[0] * r4[0] + S[1] * r4[1]) + (S[2] * r4[2] + S[3] * r4[3]);
            y = row_sum16(y);
            if (cg == 0) yout[(size_t)s * BCOLS] = (bf16)f2bf(y);
        }
        if (blk + 1 < nblk) store_block((blk + 1) & 1);
        __syncthreads();
    }
    *(f32x4*)(s_out + i * 64 + 4 * cg) = S;
}
__device__ __forceinline__ void hgrn_scan_unit(const Frame& F, const Args& A, int row0, int T, int h, int vq, const float* s_in, float* s_out) {
    bf16* UA = (bf16*)(A.ws + WS_UA);
    LAS float* buf = (LAS float*)F.lds;
    constexpr int STEPF = 416, BUFF = TB * STEPF;
    const int kg = F.lane & 15, vl = F.tid >> 4, v = vq * 32 + vl;
    const int e = F.tid * 16, ls = e >> 8, lwhich = (e >> 7) & 1, lk = e & 127;
    const int e3 = F.tid * 8, ls3 = e3 >> 5, lv3 = e3 & 31;
    float lb16[16];
#pragma unroll
    for (int k = 0; k < 16; ++k) { const int ch = h * 128 + lk + k; lb16[k] = 1.0f / (1.0f + __expf(A.in[18][512 + ch] - A.in[18][ch])); }
    float S[8];
#pragma unroll
    for (int j = 0; j < 8; ++j) S[j] = s_in ? s_in[(size_t)(kg * 8 + j) * 128 + v] : 0.f;
    const int nblk = (T + TB - 1) / TB;
    v4u p0, p1, pi;
    auto load_block = [&](int blk) {
        const int t0 = blk * TB;
        p0 = (v4u){0, 0, 0, 0}; p1 = p0; pi = p0;
        if (t0 + ls < T) { const v4u* src = (const v4u*)(UA + (size_t)(row0 + t0 + ls) * ACOLS + (lwhich ? 0 : 512) + h * 128 + lk); p0 = src[0]; p1 = src[1]; }
        if (F.tid < 128 && t0 + ls3 < T) pi = *(const v4u*)(UA + (size_t)(row0 + t0 + ls3) * ACOLS + 1024 + h * 128 + vq * 32 + lv3);
    };
    auto store_block = [&](int b) {
        float x[16] = {bflo(p0.x), bfhi(p0.x), bflo(p0.y), bfhi(p0.y), bflo(p0.z), bfhi(p0.z), bflo(p0.w), bfhi(p0.w),
                       bflo(p1.x), bfhi(p1.x), bflo(p1.y), bfhi(p1.y), bflo(p1.z), bfhi(p1.z), bflo(p1.w), bfhi(p1.w)};
        LAS float* d = buf + b * BUFF + ls * STEPF + lk;
        if (lwhich == 0) {
            float f[16], kd[16];
#pragma unroll
            for (int k = 0; k < 16; ++k) { const float sg = sigmoidf_(x[k]); f[k] = lb16[k] + (1.0f - lb16[k]) * sg; kd[k] = (1.0f - lb16[k]) * (1.0f - sg); }
#pragma unroll
            for (int k = 0; k < 4; ++k) { *(LAS f32x4*)(d + 4 * k) = (f32x4){f[4 * k], f[4 * k + 1], f[4 * k + 2], f[4 * k + 3]};
                                          *(LAS f32x4*)(d + 128 + 4 * k) = (f32x4){kd[4 * k], kd[4 * k + 1], kd[4 * k + 2], kd[4 * k + 3]}; }
        } else {
#pragma unroll
            for (int k = 0; k < 16; ++k) x[k] = x[k] * sigmoidf_(x[k]);
#pragma unroll
            for (int k = 0; k < 4; ++k) *(LAS f32x4*)(d + 256 + 4 * k) = (f32x4){x[4 * k], x[4 * k + 1], x[4 * k + 2], x[4 * k + 3]};
        }
        if (F.tid < 128) { LAS float* d3 = buf + b * BUFF + ls3 * STEPF + 384 + lv3;
            *(LAS f32x4*)(d3) = (f32x4){bflo(pi.x), bfhi(pi.x), bflo(pi.y), bfhi(pi.y)};
            *(LAS f32x4*)(d3 + 4) = (f32x4){bflo(pi.z), bfhi(pi.z), bflo(pi.w), bfhi(pi.w)}; }
    };
    __syncthreads();
    load_block(0); store_block(0);
    __syncthreads();
    for (int blk = 0; blk < nblk; ++blk) {
        if (blk + 1 < nblk) load_block(blk + 1);
        const LAS float* bb = buf + (blk & 1) * BUFF;
        const int ns = (T - blk * TB) < TB ? (T - blk * TB) : TB;
        bf16* oout = UA + (size_t)(row0 + blk * TB) * ACOLS + 1024 + h * 128 + v;
        for (int s = 0; s < ns; ++s) {
            const LAS float* p = bb + s * STEPF;
            const f32x4 f0 = *(const LAS f32x4*)(p + 8 * kg), f1 = *(const LAS f32x4*)(p + 8 * kg + 4);
            const f32x4 d0 = *(const LAS f32x4*)(p + 128 + 8 * kg), d1 = *(const LAS f32x4*)(p + 128 + 8 * kg + 4);
            const f32x4 q0 = *(const LAS f32x4*)(p + 256 + 8 * kg), q1 = *(const LAS f32x4*)(p + 256 + 8 * kg + 4);
            const float iv = p[384 + vl];
            float o = 0.f;
#pragma unroll
            for (int j = 0; j < 4; ++j) { S[j] = f0[j] * S[j] + d0[j] * iv; S[4 + j] = f1[j] * S[4 + j] + d1[j] * iv; }
            o = ((S[0] * q0[0] + S[1] * q0[1]) + (S[2] * q0[2] + S[3] * q0[3])) + ((S[4] * q1[0] + S[5] * q1[1]) + (S[6] * q1[2] + S[7] * q1[3]));
            o = row_sum16(o);
            if (kg == 0) oout[(size_t)s * ACOLS] = (bf16)f2bf(o);
        }
        if (blk + 1 < nblk) store_block((blk + 1) & 1);
        __syncthreads();
    }
#pragma unroll
    for (int j = 0; j < 8; ++j) s_out[(size_t)(kg * 8 + j) * 128 + v] = S[j];
}
__device__ __forceinline__ void p3_scans(const Frame& F, const Args& A) {
    for (int u = F.vcu; u < 256; u += F.G) {
        if (u < 128) { const int b = u >> 4, h = (u >> 1) & 7, half = u & 1;
            rwkv_scan_unit(F, A, b * SEQ, SEQ, h, half, nullptr, A.out + O_WKV_P + (size_t)(b * 8 + h) * 4096); }
        else { const int x = u - 128, b = x >> 4, h = (x >> 2) & 3, vq = x & 3;
            hgrn_scan_unit(F, A, b * SEQ, SEQ, h, vq, nullptr, A.out + O_HGRN_P + (size_t)(b * 4 + h) * 16384); }
    }
    for (int u = F.vcu; u < 2048; u += F.G) { const int bh = u >> 1, half = u & 1, b = bh >> 3, h = bh & 7;
        rwkv_scan_unit(F, A, MP + 4 * b, TS, h, half, A.in[3] + (size_t)bh * 4096, A.out + O_WKV_S + (size_t)bh * 4096); }
    for (int u = F.vcu; u < 2048; u += F.G) { const int bh = u >> 2, vq = u & 3, b = bh >> 2, h = bh & 3;
        hgrn_scan_unit(F, A, MP + 4 * b, TS, h, vq, A.in[2] + (size_t)bh * 16384, A.out + O_HGRN_S + (size_t)bh * 16384); }
}

__device__ __forceinline__ void p4_post(const Frame& F, const Args& A) {
    bf16* UB = (bf16*)(A.ws + WS_UB);
    bf16* UA = (bf16*)(A.ws + WS_UA);
    const float* bonus = (const float*)(A.ws + WS_BONUS);
    LAS float* lg = (LAS float*)F.lds;
    LAS float* red = lg + 32 * 128;
    const int c = F.tid;
    const float* mu = A.in[7];
    LAS float* gbuf = red + 32 * 8;
    const float lnw = A.in[16][c], lnb = A.in[17][c], mu_v = mu[1024 + c], nw = A.in[19][c];
    for (int tile = F.vcu; tile < MT / 32; tile += F.G) {
        const int r0 = tile * 32;
#pragma unroll
        for (int n = 0; n < 8; ++n) { const int idx = F.tid + 512 * n, tok = idx >> 7, k = idx & 127, row = r0 + tok;
            lg[tok * 128 + k] = sigmoidf_(shifted(UB, row, prev_row(row), 1664 + k, mu[1664 + k])); }
        for (int tok = 0; tok < 32; ++tok) { const float o_ = bf2f(UA[(size_t)(r0 + tok) * ACOLS + 1024 + c]); const float ss = wave_sum(o_ * o_); if (F.lane == 0) red[tok * 8 + F.wave] = ss; }
        __syncthreads();
        {
            float Wg[64];
            const float* wp = A.in[12] + c; asm volatile("" : "+v"(wp));
#pragma unroll
            for (int k = 0; k < 64; ++k) Wg[k] = wp[k * BW];
#pragma unroll 1
            for (int tok = 0; tok < 32; ++tok) {
                float g = 0.f;
                const LAS f32x4* l4 = (const LAS f32x4*)(lg + tok * 128);
#pragma unroll
                for (int k4 = 0; k4 < 16; ++k4) { const f32x4 t = l4[k4]; g += t[0] * Wg[4 * k4] + t[1] * Wg[4 * k4 + 1] + t[2] * Wg[4 * k4 + 2] + t[3] * Wg[4 * k4 + 3]; }
                gbuf[tok * 512 + c] = g;
            }
        }
        {
            float Wg[64];
            const float* wp = A.in[12] + 64 * BW + c; asm volatile("" : "+v"(wp));
#pragma unroll
            for (int k = 0; k < 64; ++k) Wg[k] = wp[k * BW];
#pragma unroll 1
            for (int tok = 0; tok < 32; ++tok) {
                const int row = r0 + tok, prow = prev_row(row);
                float g = gbuf[tok * 512 + c];
                const LAS f32x4* l4 = (const LAS f32x4*)(lg + tok * 128 + 64);
#pragma unroll
                for (int k4 = 0; k4 < 16; ++k4) { const f32x4 t = l4[k4]; g += t[0] * Wg[4 * k4] + t[1] * Wg[4 * k4 + 1] + t[2] * Wg[4 * k4 + 2] + t[3] * Wg[4 * k4 + 3]; }
                const float y = bf2f(UB[(size_t)row * BCOLS + 512 + c]);
                const float mean = wave_sum(y) * (1.0f / 64.0f), dlt = y - mean;
                const float var = wave_sum(dlt * dlt) * (1.0f / 64.0f);
                const float yn = dlt * rsqrtf(var + GN_EPS) * lnw + lnb;
                const float vv = shifted(UB, row, prow, 1024 + c, mu_v);
                const float ob = (yn + bonus[(size_t)row * 8 + F.wave] * vv) * g;
                const float ss = red[tok * 8 + (F.wave & ~1)] + red[tok * 8 + (F.wave | 1)];
                const float gg = bf2f(UA[(size_t)row * ACOLS + 1536 + c]);
                const float oav = bf2f(UA[(size_t)row * ACOLS + 1024 + c]) * rsqrtf(ss * (1.0f / 128.0f) + HGRN_EPS) * nw * (gg * sigmoidf_(gg));
                UB[(size_t)row * BCOLS + 512 + c] = (bf16)f2bf(ob);
                UA[(size_t)row * ACOLS + 1024 + c] = (bf16)f2bf(oav);
            }
        }
        __syncthreads();
    }
}

__device__ __forceinline__ void p9_final(const Frame& F, const Args& A) {
    const int gw = F.vcu * NWAVES + F.wave, NGW = F.G * NWAVES;
    const float* ssq = (const float*)(A.ws + WS_SSQ2);
    f32x4 gv[4];
#pragma unroll
    for (int j = 0; j < 4; ++j) gv[j] = ((const f32x4*)A.in[26])[F.lane + 64 * j];
    for (int m = gw; m < MT; m += NGW) {
        const f32x4* sp = (const f32x4*)(ssq + (size_t)m * 16); const f32x4 a = sp[0], b = sp[1], c = sp[2], d = sp[3];
        const float tot = ((a[0] + a[1]) + (a[2] + a[3])) + ((b[0] + b[1]) + (b[2] + b[3])) + ((c[0] + c[1]) + (c[2] + c[3])) + ((d[0] + d[1]) + (d[2] + d[3]));
        const float rstd = rsqrtf(tot * (1.0f / D) + NORM_EPS);
        f32x4* xr = (f32x4*)(A.out + (size_t)m * D) + F.lane;
#pragma unroll
        for (int j = 0; j < 4; ++j) xr[64 * j] = xr[64 * j] * rstd * gv[j];
    }
}

__global__ void __launch_bounds__(NWAVES * 64, 2) fwd(Args args) {
    extern __shared__ __attribute__((aligned(16))) unsigned char lds[];
    Frame F;
    F.lds = (LAS unsigned char*)lds;
    F.tid = threadIdx.x; F.lane = F.tid & 63; F.wave = __builtin_amdgcn_readfirstlane(F.tid >> 6);
    F.G = gridDim.x; { const int bx = blockIdx.x; F.vcu = (F.G % 8 == 0) ? (bx % 8) * (F.G / 8) + bx / 8 : bx; }
    unsigned char* ws = args.ws;
    gu32* ctl = (gu32*)(ws + WS_CTL);
    for (int u = F.tid; u < (LDS_BYTES - LDSCTL_OFF) / 4; u += NWAVES * 64) ((LAS unsigned*)(F.lds + LDSCTL_OFF))[u] = 0u;
    __syncthreads();
    volatile LAS unsigned* MISC = (volatile LAS unsigned*)(F.lds + MISC_OFF);
    XcdBarrier bar; bar.bar = (unsigned*)(ctl + CW_BAR); bar.x = 0; bar.st = nullptr;
    if (MK_N_LAUNCHES == 1) bar = xcd_barrier_post((unsigned*)(ctl + CW_BAR), MISC + 8);
    const int lo = args.ph_lo, hi = args.ph_hi;
#ifndef PH_MASK
#define PH_MASK 0x3ff
#endif
#define IN(k) (((PH_MASK >> (k)) & 1) && lo <= (k) && (k) < hi)
#define SEAM(k) do { if (IN(k) && IN((k) + 1)) xcd_barrier(bar); } while (0)
    bf16* UA = (bf16*)(ws + WS_UA); bf16* UB = (bf16*)(ws + WS_UB); bf16* UG = (bf16*)(ws + WS_UG);

    if (IN(0)) { p0_prologue(F, args); } SEAM(0);
    if (IN(1)) {
        pg8::Gemm g{(const bf16*)args.out, (const bf16*)(ws + WS_WIN), MH, NIN, D, D, D};
        SchedG1 S; S.init(F.G, (int)blockIdx.x);
        EpiG1 E{UA, UB, UG};
        pg8::gemm_phase<EpiG1, SchedG1, true, true>(F.lds, g, S, E);
    } SEAM(1);
    if (IN(2)) { p2_rwkv_prep(F, args); } SEAM(2);
    if (IN(3)) { p3_scans(F, args); } SEAM(3);
    if (IN(4)) { p4_post(F, args); } SEAM(4);
    if (IN(5)) {
        SchedMN S; S.init(MT, D, F.G, (int)blockIdx.x);
        { pg8::Gemm g{UA + 1024, (const bf16*)(ws + WS_WA), MT, D, AW, ACOLS, AW}; EpiMerge<false> E{UA, UG, 0};
          pg8::gemm_phase<EpiMerge<false>, SchedMN, true, true>(F.lds, g, S, E); }
        { pg8::Gemm g{UB + 512, (const bf16*)(ws + WS_WB), MT, D, BW, BCOLS, BW}; EpiMerge<true> E{UA, UG, 1024};
          pg8::gemm_phase<EpiMerge<true>, SchedMN, true, true>(F.lds, g, S, E); }
    } SEAM(5);
    if (IN(6)) {
        SchedMN S; S.init(MT, D, F.G, (int)blockIdx.x);
        pg8::Gemm g{UA, (const bf16*)(ws + WS_WO), MT, D, D, ACOLS, D};
        EpiRes<true, true> E{args.in[0], args.in[1], args.out, UB, BCOLS, (float*)(ws + WS_SSQ1)};
        pg8::gemm_phase<EpiRes<true, true>, SchedMN, true, true>(F.lds, g, S, E);
    } SEAM(6);
    if (IN(7)) {
        SchedMN S; S.init(MT, DFF, F.G, (int)blockIdx.x);
        pg8::Gemm g{UB, (const bf16*)(ws + WS_WUP), MT, DFF, D, BCOLS, D};
        EpiUp E{UA, (const float*)(ws + WS_SSQ1)};
        pg8::gemm_phase<EpiUp, SchedMN, true, true>(F.lds, g, S, E);
    } SEAM(7);
    if (IN(8)) {
        SchedMN S; S.init(MT, D, F.G, (int)blockIdx.x);
        pg8::Gemm g{UA, (const bf16*)(ws + WS_WDN), MT, D, DFF, DFF, DFF};
        EpiRes<false, false> E{nullptr, nullptr, args.out, nullptr, 0, (float*)(ws + WS_SSQ2)};
        pg8::gemm_phase<EpiRes<false, false>, SchedMN, true, true>(F.lds, g, S, E);
    } SEAM(8);
    if (IN(9)) { p9_final(F, args); }
#undef IN
#undef SEAM
}

extern "C" void kernel_launch(void* const* d_in, const int* in_sizes, int n_in, void* d_out, int out_size, void* d_ws, size_t ws_size, hipStream_t stream) {
    static int grid = 0;
    if (grid == 0) {
        if (n_in != 27 || out_size != (int)O_END || ws_size < WS_END) { fprintf(stderr, "kernel_launch: unexpected shapes (n_in %d, out %d, ws %zu)\n", n_in, out_size, ws_size); grid = -1; return; }
        int dev = 0, cus = 0, per_cu = 0;
        if (hipGetDevice(&dev) != hipSuccess || hipDeviceGetAttribute(&cus, hipDeviceAttributeMultiprocessorCount, dev) != hipSuccess) { grid = -1; return; }
        if (hipFuncSetAttribute((const void*)fwd, hipFuncAttributeMaxDynamicSharedMemorySize, LDS_BYTES) != hipSuccess) { fprintf(stderr, "kernel_launch: hipFuncSetAttribute failed\n"); grid = -1; return; }
        if (hipOccupancyMaxActiveBlocksPerMultiprocessor(&per_cu, (const void*)fwd, NWAVES * 64, LDS_BYTES) != hipSuccess || per_cu < 1) { fprintf(stderr, "kernel_launch: occupancy query says %d\n", per_cu); }
        (void)hipGetLastError();
        grid = cus;
    }
    if (grid < 0) return;
    (void)hipMemsetAsync((char*)d_ws + WS_CTL, 0, CTL_BYTES, stream);
    Args a{};
    for (int i = 0; i < 27; ++i) a.in[i] = (const float*)d_in[i];
    a.out = (float*)d_out; a.ws = (unsigned char*)d_ws;
    if (MK_N_LAUNCHES == 1) { a.ph_lo = 0; a.ph_hi = NPHASE; hipLaunchKernelGGL(fwd, dim3(grid), dim3(NWAVES * 64), LDS_BYTES, stream, a); }
    else for (int p = 0; p < NPHASE; ++p) { a.ph_lo = p; a.ph_hi = p + 1; hipLaunchKernelGGL(fwd, dim3(grid), dim3(NWAVES * 64), LDS_BYTES, stream, a); }
}
```

```cpp
#include <hip/hip_runtime.h>
#include <cstdio>
#include <cstdint>
namespace pg8 {
#define PG8_LAS __attribute__((address_space(3)))
typedef unsigned short bf16_t;
typedef short bf16x8 __attribute__((ext_vector_type(8)));
typedef float f32x4 __attribute__((ext_vector_type(4)));
typedef unsigned u32x4 __attribute__((ext_vector_type(4)));
constexpr int BM = 256, BK = 64, HALF = 128, HTB = HALF * BK * 2  , STAGE_BYTES = 8 * HTB, NXCD = 8, WGM = 8;

__host__ __device__ __forceinline__ int lds_byte(int r, int c) { const int st = (r >> 4) * 2 + (c >> 5), rr = r & 15, cc = c & 31, ob = rr * 64 + cc * 2; return st * 1024 + (ob ^ (((ob >> 9) & 1) << 5)); }
__host__ __device__ __forceinline__ void stage_rc(int b, int& R, int& C) { const int st = b / 1024, sb = b % 1024, swz = sb ^ (((sb >> 9) & 1) << 5); R = (st >> 1) * 16 + swz / 64; C = (st & 1) * 32 + (swz % 64) / 2; }
__host__ __device__ __forceinline__ int perm32(int rho) { const int n = rho >> 4, i = rho & 15; return 8 * (i >> 2) + 4 * n + (i & 3); }

struct Unit { int pm, pn; };
struct Gemm { const bf16_t* A; const bf16_t* Bt; int M, N, K, lda, ldb; };

struct StaticOrder {
    int nM, nN, nwg, G, c;
    __host__ __device__ void init(int M, int N, int G_, int c_) { nM = M / BM; nN = N / BM; nwg = nM * nN; G = G_; c = c_; }
    __host__ __device__ bool next(int i, Unit& u) const {
        const long L = (long)i * G + c; if (L >= nwg) return false;
        int wgid = (int)L; { const int q = nwg / NXCD, r = nwg % NXCD, xcd = wgid % NXCD, off = wgid / NXCD; wgid = (xcd < r ? xcd * (q + 1) : r * (q + 1) + (xcd - r) * q) + off; }
        const int nig = WGM * nN, gid = wgid / nig, fm = gid * WGM, gsz = (nM - fm) < WGM ? (nM - fm) : WGM;
        u.pm = fm + ((wgid % nig) % gsz); u.pn = (wgid % nig) / gsz; return true;
    }
    __device__ __forceinline__ void a_ready(const Unit&) const {}
    __device__ __forceinline__ void done(const Unit&) const {}
};

__device__ __forceinline__ unsigned cvt_pk_bf16(float lo, float hi) { unsigned r; asm volatile("v_cvt_pk_bf16_f32 %0, %1, %2" : "=v"(r) : "v"(lo), "v"(hi)); return r; }
typedef float f32x2 __attribute__((ext_vector_type(2)));
__device__ __forceinline__ f32x2 gelu_pk(f32x2 v) {
    const f32x2 av = __builtin_elementwise_abs(v), d = av * 0.2316418882f + 1.0f;
    f32x2 t; t.x = __builtin_amdgcn_rcpf(d.x); t.y = __builtin_amdgcn_rcpf(d.y);
    f32x2 q = t * 0.5307027145f + (-0.7265760135f); q = q * t + 0.7107068705f; q = q * t + (-0.142248368f); q = q * t + 0.127414796f; q = q * t;
    const f32x2 s = (v * v) * (-0.72134752044f);
    f32x2 e; e.x = __builtin_amdgcn_exp2f(s.x); e.y = __builtin_amdgcn_exp2f(s.y);
    const f32x2 m = v * (q * e), r = v - m;
    f32x2 o; o.x = v.x < 0.f ? m.x : r.x; o.y = v.y < 0.f ? m.y : r.y; return o;
}

template <class Epi, class Sched, bool ALIGN_EPI = false, bool SP2 = false>
__device__ __forceinline__ void gemm_phase(PG8_LAS unsigned char* lds, const Gemm g, const Sched& S, const Epi& E) {
    const int tid = threadIdx.x, wid = __builtin_amdgcn_readfirstlane(tid >> 6), lane = tid & 63, wr = wid >> 2, wc = wid & 3, fr = lane & 15, fq = lane >> 4;
    const int K = g.K, nt = K / BK;
    unsigned voffA[2], voffB[2];
#pragma unroll
    for (int i = 0; i < 2; ++i) { int R, C; stage_rc(tid * 16 + i * 8192, R, C); const int Rb = Epi::PERM ? ((R & ~31) + perm32(R & 31)) : R;
        voffA[i] = (unsigned)(R * g.lda + C) * 2u; voffB[i] = (unsigned)(Rb * g.ldb + C) * 2u; }
    const size_t kstep = (size_t)(BK * 2);
    const size_t hstepA = (size_t)HALF * g.lda * 2, hstepB = (size_t)HALF * g.ldb * 2;
    const size_t tstepA = 2 * hstepA, tstepB = 2 * hstepB;
    const unsigned ldsw = (unsigned)wid * 1024u;
    const int aoff = lds_byte(wr * 64 + fr, fq * 8), boff = lds_byte(wc * 32 + fr, fq * 8);
#define PG8_SA(b, h) (((b) * 2 + (h)) * HTB)
#define PG8_SB(b, h) ((4 + (b) * 2 + (h)) * HTB)
#define PG8_STAGE(bufoff, gbase, voff) do { _Pragma("unroll") for (int _i = 0; _i < 2; ++_i) \
        __builtin_amdgcn_global_load_lds((const unsigned*)((const char*)(gbase) + (voff)[_i]), (PG8_LAS unsigned*)(lds + (bufoff) + ldsw + _i * 8192), 16, 0, 0); } while (0)
#define PG8_LDA(dst, b, h) do { _Pragma("unroll") for (int m = 0; m < 4; ++m) _Pragma("unroll") for (int k = 0; k < 2; ++k) dst[m][k] = *(const PG8_LAS bf16x8*)(lds + PG8_SA(b, h) + aoff + m * 2048 + k * 1024); } while (0)
#define PG8_LDB(dst, b, h) do { _Pragma("unroll") for (int n = 0; n < 2; ++n) _Pragma("unroll") for (int k = 0; k < 2; ++k) dst[n][k] = *(const PG8_LAS bf16x8*)(lds + PG8_SB(b, h) + boff + n * 2048 + k * 1024); } while (0)
#define PG8_MMA(ai, bj, At, Bt) do { __builtin_amdgcn_s_setprio(1); _Pragma("unroll") for (int m = 0; m < 4; ++m) _Pragma("unroll") for (int n = 0; n < 2; ++n) _Pragma("unroll") for (int k = 0; k < 2; ++k) \
        acc[ai][bj][m][n] = __builtin_amdgcn_mfma_f32_16x16x32_bf16(Bt[n][k], At[m][k], acc[ai][bj][m][n], 0, 0, 0); __builtin_amdgcn_s_setprio(0); } while (0)
#define PG8_WAIT_V(n) asm volatile("s_waitcnt vmcnt(" #n ")" ::: "memory")
#define PG8_WAIT_L(n) asm volatile("s_waitcnt lgkmcnt(" #n ")" ::: "memory")
#define PG8_BAR __builtin_amdgcn_s_barrier()
#define PG8_SCHED __builtin_amdgcn_sched_barrier(0)
    Unit cur, nxt; int ui = 0;
    if (!S.next(0, cur)) return;
    f32x4 acc[2][2][4][2];
#pragma unroll
    for (int a = 0; a < 2; ++a)
#pragma unroll
        for (int b = 0; b < 2; ++b)
#pragma unroll
            for (int m = 0; m < 4; ++m)
#pragma unroll
                for (int n = 0; n < 2; ++n) acc[a][b][m][n] = (f32x4){0.f, 0.f, 0.f, 0.f};
    bf16x8 At[4][2], B0[2][2], B1[2][2];
    const char* cA = (const char*)g.A + (size_t)cur.pm * tstepA; const char* cB = (const char*)g.Bt + (size_t)cur.pn * tstepB;
    S.a_ready(cur);
    if constexpr (SP2) {
        PG8_STAGE(PG8_SB(0, 0), cB, voffB); PG8_STAGE(PG8_SB(0, 1), cB + hstepB, voffB); PG8_STAGE(PG8_SA(0, 0), cA, voffA); PG8_STAGE(PG8_SA(0, 1), cA + hstepA, voffA);
        if (wr == 1) PG8_BAR;
        PG8_WAIT_V(2); PG8_BAR;
        PG8_STAGE(PG8_SB(1, 0), cB + kstep, voffB); PG8_STAGE(PG8_SA(1, 0), cA + kstep, voffA); PG8_STAGE(PG8_SB(1, 1), cB + hstepB + kstep, voffB);
        PG8_WAIT_V(6); PG8_BAR;
    } else {
        PG8_STAGE(PG8_SB(0, 0), cB, voffB); PG8_STAGE(PG8_SA(0, 0), cA, voffA); PG8_STAGE(PG8_SB(0, 1), cB + hstepB, voffB); PG8_STAGE(PG8_SA(0, 1), cA + hstepA, voffA);
        if (wr == 1) PG8_BAR;
        PG8_WAIT_V(4); PG8_BAR;
        PG8_STAGE(PG8_SB(1, 0), cB + kstep, voffB); PG8_STAGE(PG8_SA(1, 0), cA + kstep, voffA); PG8_STAGE(PG8_SB(1, 1), cB + hstepB + kstep, voffB);
        PG8_WAIT_V(6); PG8_BAR;
    }
    for (;;) {
        const bool has_next = S.next(ui + 1, nxt);
        const char* nA = has_next ? (const char*)g.A + (size_t)nxt.pm * tstepA : cA; const char* nB = has_next ? (const char*)g.Bt + (size_t)nxt.pn * tstepB : cB;
        for (int t = 0; t < nt; t += 2) {
            const bool last = (t == nt - 2);
            const char* a1 = cA + (size_t)(t + 1) * kstep;
            const char* a2 = last ? nA : cA + (size_t)(t + 2) * kstep; const char* b2 = last ? nB : cB + (size_t)(t + 2) * kstep;
            const char* a3 = a2 + kstep; const char* b3 = b2 + kstep;
            if (last && has_next) S.a_ready(nxt);
            if constexpr (SP2) {
            PG8_LDB(B0, 0, 0); PG8_LDB(B1, 0, 1); PG8_SCHED; PG8_LDA(At, 0, 0); PG8_STAGE(PG8_SA(1, 1), a1 + hstepA, voffA);
            PG8_WAIT_V(8); PG8_WAIT_L(0); PG8_BAR; PG8_MMA(0, 0, At, B0); PG8_MMA(0, 1, At, B1); PG8_BAR; PG8_SCHED;
            PG8_LDA(At, 0, 1); PG8_STAGE(PG8_SB(0, 0), b2, voffB); PG8_STAGE(PG8_SB(0, 1), b2 + hstepB, voffB); PG8_STAGE(PG8_SA(0, 0), a2, voffA);
            PG8_WAIT_V(8); PG8_WAIT_L(0); PG8_BAR; PG8_MMA(1, 0, At, B0); PG8_MMA(1, 1, At, B1); PG8_BAR; PG8_SCHED;
            PG8_LDB(B0, 1, 0); PG8_LDB(B1, 1, 1); PG8_SCHED; PG8_LDA(At, 1, 0); PG8_STAGE(PG8_SA(0, 1), a2 + hstepA, voffA);
            PG8_WAIT_V(8); PG8_WAIT_L(0); PG8_BAR; PG8_MMA(0, 0, At, B0); PG8_MMA(0, 1, At, B1); PG8_BAR; PG8_SCHED;
            PG8_LDA(At, 1, 1); PG8_STAGE(PG8_SB(1, 0), b3, voffB); PG8_STAGE(PG8_SB(1, 1), b3 + hstepB, voffB); PG8_STAGE(PG8_SA(1, 0), a3, voffA);
            PG8_WAIT_V(8); PG8_WAIT_L(0); PG8_BAR; PG8_MMA(1, 0, At, B0); PG8_MMA(1, 1, At, B1); PG8_BAR; PG8_SCHED;
            } else {
            PG8_LDB(B0, 0, 0); PG8_SCHED; PG8_LDA(At, 0, 0); PG8_STAGE(PG8_SA(1, 1), a1 + hstepA, voffA);
            PG8_WAIT_L(8); PG8_BAR; PG8_WAIT_L(0); PG8_MMA(0, 0, At, B0); PG8_BAR; PG8_SCHED;
            PG8_LDB(B1, 0, 1); PG8_STAGE(PG8_SB(0, 0), b2, voffB);
            PG8_BAR; PG8_WAIT_L(0); PG8_MMA(0, 1, At, B1); PG8_BAR;
            PG8_LDA(At, 0, 1); PG8_STAGE(PG8_SA(0, 0), a2, voffA);
            PG8_BAR; PG8_WAIT_L(0); PG8_MMA(1, 0, At, B0); PG8_BAR; PG8_SCHED;
            PG8_STAGE(PG8_SB(0, 1), b2 + hstepB, voffB);
            PG8_WAIT_V(6); PG8_BAR; PG8_MMA(1, 1, At, B1); PG8_BAR;
            PG8_LDB(B0, 1, 0); PG8_SCHED; PG8_LDA(At, 1, 0); PG8_STAGE(PG8_SA(0, 1), a2 + hstepA, voffA);
            PG8_WAIT_L(8); PG8_BAR; PG8_WAIT_L(0); PG8_MMA(0, 0, At, B0); PG8_BAR; PG8_SCHED;
            PG8_LDB(B1, 1, 1); PG8_STAGE(PG8_SB(1, 0), b3, voffB);
            PG8_BAR; PG8_WAIT_L(0); PG8_MMA(0, 1, At, B1); PG8_BAR;
            PG8_LDA(At, 1, 1); PG8_STAGE(PG8_SA(1, 0), a3, voffA);
            PG8_BAR; PG8_WAIT_L(0); PG8_MMA(1, 0, At, B0); PG8_BAR; PG8_SCHED;
            PG8_STAGE(PG8_SB(1, 1), b3 + hstepB, voffB);
            PG8_WAIT_V(6); PG8_BAR; PG8_MMA(1, 1, At, B1); PG8_BAR;
            }
        }
        if constexpr (ALIGN_EPI) { if (wr == 0) PG8_BAR; }
        if constexpr (!Epi::AFTER_DRAIN) { E(acc, cur, wr, wc, fr, fq); S.done(cur); }
        if (!has_next) break;
#pragma unroll
        for (int a = 0; a < 2; ++a)
#pragma unroll
            for (int b = 0; b < 2; ++b)
#pragma unroll
                for (int m = 0; m < 4; ++m)
#pragma unroll
                    for (int n = 0; n < 2; ++n) acc[a][b][m][n] = (f32x4){0.f, 0.f, 0.f, 0.f};
        cur = nxt; cA = nA; cB = nB; ++ui;
        if constexpr (ALIGN_EPI) { if (wr == 1) PG8_BAR; }
    }
    PG8_WAIT_V(0);
    if constexpr (!ALIGN_EPI) { if (wr == 0) PG8_BAR; }
    PG8_BAR;
    if constexpr (Epi::AFTER_DRAIN) { E.fused(acc, cur, wr, wc, fr, fq, lds, wid, lane); S.done(cur); }
#undef PG8_SA
#undef PG8_SB
#undef PG8_STAGE
#undef PG8_LDA
#undef PG8_LDB
#undef PG8_MMA
#undef PG8_WAIT_V
#undef PG8_WAIT_L
#undef PG8_BAR
#undef PG8_SCHED
}
}

#ifndef MK_N_LAUNCHES
#define MK_N_LAUNCHES 1
#endif
constexpr int NPHASE = 10;
constexpr int NWAVES = 8;

constexpr int D = 1024, SEQ = 2048, NBP = 8, NBS = 128, TS = 4;
constexpr int MP = NBP * SEQ;
constexpr int MS = NBS * TS;
constexpr int MT = MP + MS;
constexpr int MH = MT + 256;
constexpr int ACOLS = 2048, BCOLS = 1792, GCOLS = 2048, NIN = ACOLS + BCOLS + GCOLS, DFF = 4096;
constexpr int AW = 512, BW = 512;
constexpr float NORM_EPS = 1e-6f, HGRN_EPS = 1e-5f, GN_EPS = 64e-5f, DECAY_SCALE = 0.6065306597126334f;

constexpr size_t O_Y = 0, O_HGRN_P = (size_t)MT * D, O_WKV_P = O_HGRN_P + (size_t)NBP * 4 * 128 * 128, O_SHIFT_P = O_WKV_P + (size_t)NBP * 8 * 64 * 64,
                 O_HGRN_S = O_SHIFT_P + (size_t)NBP * D, O_WKV_S = O_HGRN_S + (size_t)NBS * 4 * 128 * 128, O_SHIFT_S = O_WKV_S + (size_t)NBS * 8 * 64 * 64,
                 O_END = O_SHIFT_S + (size_t)NBS * D;
static_assert(O_END == 30810112, "d_out size");

constexpr size_t WS_CTL = 0, CTL_BYTES = 65536;
constexpr size_t WS_WIN = WS_CTL + CTL_BYTES;
constexpr size_t WS_WA  = WS_WIN + (size_t)NIN * D * 2;
constexpr size_t WS_WB  = WS_WA + (size_t)D * AW * 2;
constexpr size_t WS_WO  = WS_WB + (size_t)D * BW * 2;
constexpr size_t WS_WUP = WS_WO + (size_t)D * D * 2;
constexpr size_t WS_WDN = WS_WUP + (size_t)DFF * D * 2;
constexpr size_t WS_UB  = WS_WDN + (size_t)D * DFF * 2;
constexpr size_t WS_UA  = WS_UB + (size_t)MH * BCOLS * 2;
constexpr size_t WS_UG  = WS_UA + (size_t)MT * ACOLS * 2;
constexpr size_t WS_BONUS = WS_UG + (size_t)MT * GCOLS * 2;
constexpr size_t WS_SSQ1 = WS_BONUS + (size_t)MT * 8 * 4;
constexpr size_t WS_SSQ2 = WS_SSQ1 + (size_t)MT * 16 * 4;
constexpr size_t WS_END = WS_SSQ2 + (size_t)MT * 16 * 4;
static_assert(WS_END <= 268435456, "d_ws map");
static_assert(WS_UA + (size_t)MT * DFF * 2 == WS_BONUS, "hidden overlays UA|UG exactly");
static_assert((size_t)MT * 2048 * 2 == (size_t)MT * D * 4, "P fits the y region exactly");

constexpr int CW_TMO = 0, CW_BAR = 1024;

constexpr int RING_BYTES = 131072, LDSCTL_OFF = RING_BYTES, MISC_OFF = LDSCTL_OFF + 320, LDS_BYTES = 147456;

#define GAS __attribute__((address_space(1)))
#define LAS __attribute__((address_space(3)))
typedef unsigned short bf16;
typedef unsigned v4u __attribute__((ext_vector_type(4)));
typedef unsigned v2u __attribute__((ext_vector_type(2)));
typedef float f32x4 __attribute__((ext_vector_type(4)));
typedef GAS unsigned gu32;
#define RLX_AGENT __ATOMIC_RELAXED, __HIP_MEMORY_SCOPE_AGENT
#define LDS_WAIT() asm volatile("s_waitcnt lgkmcnt(0)" ::: "memory")
#define VM_WAIT() asm volatile("s_waitcnt vmcnt(0)" ::: "memory")
__device__ __forceinline__ unsigned f2bf(float f) { unsigned u = __builtin_bit_cast(unsigned, f); return (u + 0x7fffu + ((u >> 16) & 1u)) >> 16; }
__device__ __forceinline__ unsigned pk2(float lo, float hi) { return f2bf(lo) | (f2bf(hi) << 16); }
__device__ __forceinline__ float bf2f(unsigned b) { return __builtin_bit_cast(float, b << 16); }
__device__ __forceinline__ float bflo(unsigned w) { return __builtin_bit_cast(float, w << 16); }
__device__ __forceinline__ float bfhi(unsigned w) { return __builtin_bit_cast(float, w & 0xffff0000u); }
__device__ __forceinline__ float sigmoidf_(float x) { return 1.0f / (1.0f + __expf(-x)); }
__device__ __forceinline__ float tanhf_(float x) { return 1.0f - 2.0f / (1.0f + __expf(2.0f * x)); }
__device__ __forceinline__ float wave_sum(float v) {
#pragma unroll
    for (int o = 1; o < 64; o <<= 1) v += __shfl_xor(v, o);
    return v;
}
__device__ __forceinline__ float row_sum16(float x) {
    x += __builtin_bit_cast(float, __builtin_amdgcn_update_dpp(0, __builtin_bit_cast(int, x), 0xB1, 0xF, 0xF, true));
    x += __builtin_bit_cast(float, __builtin_amdgcn_update_dpp(0, __builtin_bit_cast(int, x), 0x4E, 0xF, 0xF, true));
    x += __builtin_bit_cast(float, __builtin_amdgcn_update_dpp(0, __builtin_bit_cast(int, x), 0x141, 0xF, 0xF, true));
    x += __builtin_bit_cast(float, __builtin_amdgcn_update_dpp(0, __builtin_bit_cast(int, x), 0x140, 0xF, 0xF, true));
    return x;
}
#define XB_TMO      128
#define XB_XCNT(j)  (256  + 64 * (j))
#define XB_XSUB(j)  (1280 + 64 * (j))
#define XB_XGEN(j)  (2304 + 64 * (j))
#define XB_TOP      3328
#define XB_TOPGEN   3392
#define XCD_BAR_WORDS 3456
#define XB_SPIN_CAP (1u << 18)

__device__ __forceinline__ unsigned xb_ld(unsigned* p)              { return __hip_atomic_load(p, __ATOMIC_RELAXED, __HIP_MEMORY_SCOPE_AGENT); }
__device__ __forceinline__ unsigned xb_add(unsigned* p, unsigned v) { return __hip_atomic_fetch_add(p, v, __ATOMIC_RELAXED, __HIP_MEMORY_SCOPE_AGENT); }
__device__ __forceinline__ unsigned xb_xcc_id() { return (unsigned)__builtin_amdgcn_s_getreg((3 << 11) | 20) & 0xFu; }
#define XB_SPIN(cond, bar) do { unsigned _sp = 0; while (cond) { __builtin_amdgcn_s_sleep(1); \
    if ((++_sp & 255u) == 0u) { if (xb_ld(&(bar)[XB_TMO])) break; if (_sp > XB_SPIN_CAP) { atomicAdd(&(bar)[XB_TMO], 1u); break; } } } } while (0)

struct XcdBarrier {
    unsigned* bar; unsigned x;
    volatile LAS unsigned* st;
};

__device__ __forceinline__ XcdBarrier xcd_barrier_post(unsigned* bar, volatile LAS unsigned* st) {
    XcdBarrier b; b.bar = bar; b.x = xb_xcc_id(); b.st = st;
    if (threadIdx.x == 0) (void)xb_add(&bar[XB_XCNT(b.x)], 1u);
    return b;
}
__device__ __forceinline__ void xcd_barrier_complete(unsigned* bar, unsigned x, unsigned& nloc, unsigned& nx) {
    const unsigned G = gridDim.x * gridDim.y * gridDim.z;
    unsigned sum, cnt, mine, sp = 0u;
    for (;;) {
        sum = 0u; cnt = 0u; mine = 0u;
#pragma unroll
        for (unsigned j = 0; j < 16; ++j) { const unsigned c = xb_ld(&bar[XB_XCNT(j)]); sum += c; cnt += (c > 0u) ? 1u : 0u; mine = (j == x) ? c : mine; }
        if (sum == G) break;
        __builtin_amdgcn_s_sleep(1);
        if ((++sp & 255u) == 0u) { if (xb_ld(&bar[XB_TMO])) break; if (sp > XB_SPIN_CAP) { atomicAdd(&bar[XB_TMO], 1u); break; } }
    }
    nloc = mine > 0u ? mine : 1u; nx = cnt > 0u ? cnt : 1u;
}

__device__ __forceinline__ void xcd_barrier(const XcdBarrier& b) {
    asm volatile("s_waitcnt vmcnt(0)" ::: "memory");
    __syncthreads();
    if (threadIdx.x == 0) {
        unsigned* bar = b.bar;
        __builtin_amdgcn_s_waitcnt(0);
        unsigned nloc = b.st[0], nx = b.st[1];
        if (nloc == 0u) { xcd_barrier_complete(bar, b.x, nloc, nx); b.st[0] = nloc; b.st[1] = nx; }
        const unsigned old = xb_add(&bar[XB_XSUB(b.x)], 1u);
        const unsigned gen = old / nloc;
        if (old + 1u == (gen + 1u) * nloc) {
            __builtin_amdgcn_fence(__ATOMIC_RELEASE, "agent");
            asm volatile("s_waitcnt vmcnt(0)" ::: "memory");
            const unsigned og = xb_add(&bar[XB_TOP], 1u);
            const unsigned tg = og / nx;
            if (og + 1u == (tg + 1u) * nx) xb_add(&bar[XB_TOPGEN], 1u);
            else XB_SPIN(xb_ld(&bar[XB_TOPGEN]) == tg, bar);
            __builtin_amdgcn_fence(__ATOMIC_ACQUIRE, "agent");
            xb_add(&bar[XB_XGEN(b.x)], 1u);
            asm volatile("s_waitcnt vmcnt(0)" ::: "memory");
        } else {
            XB_SPIN(xb_ld(&bar[XB_XGEN(b.x)]) == gen, bar);
            __builtin_amdgcn_fence(__ATOMIC_ACQUIRE, "agent");
            asm volatile("s_waitcnt vmcnt(0)" ::: "memory");
        }
    }
    __syncthreads();
}


struct Args { const float* in[27]; float* out; unsigned char* ws; int ph_lo, ph_hi; };
struct Frame {
    LAS unsigned char* lds;
    int tid, lane, wave, vcu, G;
};

struct SchedMN {
    pg8::StaticOrder so;
    __device__ void init(int M, int N, int G, int c) { so.init(M, N, G, c); }
    __device__ __forceinline__ bool next(int i, pg8::Unit& u) const { return so.next(i, u); }
    __device__ __forceinline__ void a_ready(const pg8::Unit&) const {}
    __device__ __forceinline__ void done(const pg8::Unit&) const {}
};
struct SchedG1 {
    pg8::StaticOrder so; int G, c;
    __device__ void init(int G_, int c_) { so.init(MT, NIN, G_, c_); G = G_; c = c_; }
    __device__ __forceinline__ bool next(int i, pg8::Unit& u) const {
        const int L = i * G + c;
        if (L < so.nwg) return so.next(i, u);
        if (L < so.nwg + 7) { u.pm = MT / 256; u.pn = 8 + (L - so.nwg); return true; }
        return false;
    }
    __device__ __forceinline__ void a_ready(const pg8::Unit&) const {}
    __device__ __forceinline__ void done(const pg8::Unit&) const {}
};

using pg8::f32x4; using pg8::Unit;
typedef unsigned u32x4 __attribute__((ext_vector_type(4)));
struct EpiG1 {
    static constexpr bool PERM = true, AFTER_DRAIN = false;
    bf16 *UA, *UB, *UG;
    __device__ __forceinline__ void operator()(const f32x4 (&acc)[2][2][4][2], const Unit& u, int wr, int wc, int fr, int fq) const {
        bf16* base; int ld, colt;
        if (u.pn < 8) { base = UA; ld = ACOLS; colt = u.pn * 256; } else if (u.pn < 15) { base = UB; ld = BCOLS; colt = (u.pn - 8) * 256; } else { base = UG; ld = GCOLS; colt = (u.pn - 15) * 256; }
        const int row0 = u.pm * 256 + wr * 64 + fr, col0 = colt + wc * 32 + 8 * fq;
#pragma unroll
        for (int ai = 0; ai < 2; ++ai)
#pragma unroll
            for (int m = 0; m < 4; ++m) { bf16* rowp = base + (size_t)(row0 + ai * 128 + m * 16) * ld + col0;
#pragma unroll
                for (int bj = 0; bj < 2; ++bj) { const f32x4 v0 = acc[ai][bj][m][0], v1 = acc[ai][bj][m][1];
                    u32x4 w; w.x = pk2(v0[0], v0[1]); w.y = pk2(v0[2], v0[3]); w.z = pk2(v1[0], v1[1]); w.w = pk2(v1[2], v1[3]);
                    *(u32x4*)(rowp + bj * 128) = w; } }
    }
};
template <bool ADD> struct EpiMerge {
    static constexpr bool PERM = true, AFTER_DRAIN = false;
    bf16* Mg; const bf16* UG; int goff;
    __device__ __forceinline__ void operator()(const f32x4 (&acc)[2][2][4][2], const Unit& u, int wr, int wc, int fr, int fq) const {
        const int row0 = u.pm * 256 + wr * 64 + fr, col0 = u.pn * 256 + wc * 32 + 8 * fq;
#pragma unroll
        for (int ai = 0; ai < 2; ++ai)
#pragma unroll
            for (int m = 0; m < 4; ++m) { const size_t row = (size_t)(row0 + ai * 128 + m * 16);
#pragma unroll
                for (int bj = 0; bj < 2; ++bj) { const f32x4 v0 = acc[ai][bj][m][0], v1 = acc[ai][bj][m][1];
                    const u32x4 gq = *(const u32x4*)(UG + row * GCOLS + goff + col0 + bj * 128);
                    float o[8];
                    o[0] = sigmoidf_(bflo(gq.x)) * v0[0]; o[1] = sigmoidf_(bfhi(gq.x)) * v0[1]; o[2] = sigmoidf_(bflo(gq.y)) * v0[2]; o[3] = sigmoidf_(bfhi(gq.y)) * v0[3];
                    o[4] = sigmoidf_(bflo(gq.z)) * v1[0]; o[5] = sigmoidf_(bfhi(gq.z)) * v1[1]; o[6] = sigmoidf_(bflo(gq.w)) * v1[2]; o[7] = sigmoidf_(bfhi(gq.w)) * v1[3];
                    bf16* dst = Mg + row * ACOLS + col0 + bj * 128;
                    if (ADD) { const u32x4 p = *(const u32x4*)dst;
                        o[0] += bflo(p.x); o[1] += bfhi(p.x); o[2] += bflo(p.y); o[3] += bfhi(p.y); o[4] += bflo(p.z); o[5] += bfhi(p.z); o[6] += bflo(p.w); o[7] += bfhi(p.w); }
                    u32x4 w; w.x = pk2(o[0], o[1]); w.y = pk2(o[2], o[3]); w.z = pk2(o[4], o[5]); w.w = pk2(o[6], o[7]);
                    *(u32x4*)dst = w; } }
    }
};
template <bool RES_IS_X, bool WRITE_BF> struct EpiRes {
    static constexpr bool PERM = false, AFTER_DRAIN = false;
    const float* xp; const float* xs; float* out; bf16* xb; int ldb; float* ssq;
    __device__ __forceinline__ void operator()(const f32x4 (&acc)[2][2][4][2], const Unit& u, int wr, int wc, int fr, int fq) const {
        const int row0 = u.pm * 256 + wr * 64 + fr, col0 = u.pn * 256 + wc * 32 + 4 * fq;
#pragma unroll
        for (int ai = 0; ai < 2; ++ai)
#pragma unroll
            for (int m = 0; m < 4; ++m) { const int row = row0 + ai * 128 + m * 16;
                const float* rp = RES_IS_X ? (row < MP ? xp + (size_t)row * D : xs + (size_t)(row - MP) * D) : out + (size_t)row * D;
                float s = 0.f;
#pragma unroll
                for (int bj = 0; bj < 2; ++bj)
#pragma unroll
                    for (int n = 0; n < 2; ++n) { const int col = col0 + bj * 128 + n * 16;
                        const f32x4 r = *(const f32x4*)(rp + col); const f32x4 o = r + acc[ai][bj][m][n];
                        *(f32x4*)(out + (size_t)row * D + col) = o;
                        s += (o[0] * o[0] + o[1] * o[1]) + (o[2] * o[2] + o[3] * o[3]);
                        if (WRITE_BF) { v2u w; w.x = pk2(o[0], o[1]); w.y = pk2(o[2], o[3]); *(v2u*)(xb + (size_t)row * ldb + col) = w; } }
                s += __shfl_xor(s, 16); s += __shfl_xor(s, 32);
                if (fq == 0) ssq[(size_t)row * 16 + u.pn * 4 + wc] = s; }
    }
};
struct EpiUp {
    static constexpr bool PERM = true, AFTER_DRAIN = false;
    bf16* Hd; const float* ssq;
    __device__ __forceinline__ void operator()(const f32x4 (&acc)[2][2][4][2], const Unit& u, int wr, int wc, int fr, int fq) const {
        const int row0 = u.pm * 256 + wr * 64 + fr, col0 = u.pn * 256 + wc * 32 + 8 * fq;
#pragma unroll
        for (int ai = 0; ai < 2; ++ai)
#pragma unroll
            for (int m = 0; m < 4; ++m) { const size_t row = (size_t)(row0 + ai * 128 + m * 16);
                const f32x4* sp = (const f32x4*)(ssq + row * 16); const f32x4 a = sp[0], b = sp[1], c = sp[2], d = sp[3];
                const float tot = ((a[0] + a[1]) + (a[2] + a[3])) + ((b[0] + b[1]) + (b[2] + b[3])) + ((c[0] + c[1]) + (c[2] + c[3])) + ((d[0] + d[1]) + (d[2] + d[3]));
                const float rstd = rsqrtf(tot * (1.0f / D) + NORM_EPS);
#pragma unroll
                for (int bj = 0; bj < 2; ++bj) { const f32x4 v0 = acc[ai][bj][m][0], v1 = acc[ai][bj][m][1];
                    float o[8] = {v0[0], v0[1], v0[2], v0[3], v1[0], v1[1], v1[2], v1[3]};
#pragma unroll
                    for (int e = 0; e < 8; ++e) { const float t = fmaxf(o[e] * rstd, 0.f); o[e] = t * t; }
                    u32x4 w; w.x = pk2(o[0], o[1]); w.y = pk2(o[2], o[3]); w.z = pk2(o[4], o[5]); w.w = pk2(o[6], o[7]);
                    *(u32x4*)(Hd + row * DFF + col0 + bj * 128) = w; } }
    }
};

__device__ __forceinline__ void p0_transpose_item(const float* W, int K, int N, bf16* WT, const float* kscale, LAS float* scr, int item, int lane) {
    const int nblk = N / 32, kb = item / nblk, nb = item % nblk, k0 = 64 * kb, n0 = 32 * nb;
#pragma unroll 8
    for (int i = 0; i < 32; ++i) { const int kk = 2 * i + (lane >> 5); float v = W[(size_t)(k0 + kk) * N + n0 + (lane & 31)]; if (kscale) v *= kscale[k0 + kk]; scr[kk * 33 + (lane & 31)] = v; }
    LDS_WAIT(); asm volatile("" ::: "memory");
    const int c = lane & 7;
#pragma unroll
    for (int j = 0; j < 4; ++j) { const int n = (lane >> 3) + 8 * j; const LAS float* s = scr + (8 * c) * 33 + n;
        v4u o; o.x = pk2(s[0 * 33], s[1 * 33]); o.y = pk2(s[2 * 33], s[3 * 33]); o.z = pk2(s[4 * 33], s[5 * 33]); o.w = pk2(s[6 * 33], s[7 * 33]);
        *(GAS v4u*)(WT + (size_t)(n0 + n) * K + k0 + 8 * c) = o; }
    LDS_WAIT(); asm volatile("" ::: "memory");
}
__device__ __forceinline__ void p0_prologue(const Frame& F, const Args& A) {
    LAS float* scr = (LAS float*)(F.lds + F.wave * 16384);
    const int gw = F.vcu * NWAVES + F.wave, NGW = F.G * NWAVES;
    unsigned char* ws = A.ws;
    constexpr int I_IN = (D / 64) * (NIN / 32), I_A = (AW / 64) * (D / 32), I_O = (D / 64) * (D / 32), I_UP = (D / 64) * (DFF / 32), I_DN = (DFF / 64) * (D / 32);
    constexpr int NITEMS = I_IN + 2 * I_A + I_O + I_UP + I_DN;
    for (int it = gw; it < NITEMS; it += NGW) {
        int r = it;
        if (r < I_IN) { p0_transpose_item(A.in[6], D, NIN, (bf16*)(ws + WS_WIN), nullptr, scr, r, F.lane); continue; } r -= I_IN;
        if (r < I_A) { p0_transpose_item(A.in[20], AW, D, (bf16*)(ws + WS_WA), nullptr, scr, r, F.lane); continue; } r -= I_A;
        if (r < I_A) { p0_transpose_item(A.in[21], BW, D, (bf16*)(ws + WS_WB), nullptr, scr, r, F.lane); continue; } r -= I_A;
        if (r < I_O) { p0_transpose_item(A.in[22], D, D, (bf16*)(ws + WS_WO), nullptr, scr, r, F.lane); continue; } r -= I_O;
        if (r < I_UP) { p0_transpose_item(A.in[24], D, DFF, (bf16*)(ws + WS_WUP), A.in[23], scr, r, F.lane); continue; } r -= I_UP;
        p0_transpose_item(A.in[25], DFF, D, (bf16*)(ws + WS_WDN), nullptr, scr, r, F.lane);
    }
    bf16* H = (bf16*)A.out;
    const float* g = A.in[5];
    f32x4 gv[4];
#pragma unroll
    for (int j = 0; j < 4; ++j) gv[j] = ((const f32x4*)g)[F.lane + 64 * j];
    for (int m = gw; m < MH; m += NGW) {
        GAS unsigned long long* o8 = (GAS unsigned long long*)(H + (size_t)m * D) + F.lane;
        if (m < MT) {
            const float* xrow = m < MP ? A.in[0] + (size_t)m * D : A.in[1] + (size_t)(m - MP) * D;
            const f32x4* xr = (const f32x4*)xrow + F.lane;
            f32x4 v[4]; float s = 0.f;
#pragma unroll
            for (int j = 0; j < 4; ++j) { v[j] = xr[64 * j]; s += (v[j][0] * v[j][0] + v[j][1] * v[j][1]) + (v[j][2] * v[j][2] + v[j][3] * v[j][3]); }
            const float rstd = rsqrtf(wave_sum(s) * (1.0f / D) + NORM_EPS);
#pragma unroll
            for (int j = 0; j < 4; ++j) v[j] = v[j] * rstd * gv[j];
#pragma unroll
            for (int j = 0; j < 4; ++j) o8[64 * j] = (unsigned long long)pk2(v[j][0], v[j][1]) | ((unsigned long long)pk2(v[j][2], v[j][3]) << 32);
            float* so = nullptr;
            if (m < MP) { if ((m & (SEQ - 1)) == SEQ - 1) so = A.out + O_SHIFT_P + (size_t)(m >> 11) * D; }
            else { const int s_ = m - MP; if ((s_ & 3) == 3) so = A.out + O_SHIFT_S + (size_t)(s_ >> 2) * D; }
            if (so) {
#pragma unroll
                for (int j = 0; j < 4; ++j) ((f32x4*)so)[F.lane + 64 * j] = v[j];
            }
        } else if (m < MT + NBS) {
            const f32x4* xr = (const f32x4*)(A.in[4] + (size_t)(m - MT) * D) + F.lane;
#pragma unroll
            for (int j = 0; j < 4; ++j) { const f32x4 v = xr[64 * j]; o8[64 * j] = (unsigned long long)pk2(v[0], v[1]) | ((unsigned long long)pk2(v[2], v[3]) << 32); }
        } else {
#pragma unroll
            for (int j = 0; j < 4; ++j) o8[64 * j] = 0ull;
        }
    }
}

__device__ __forceinline__ int prev_row(int row) {
    if (row < MP) return (row & (SEQ - 1)) ? row - 1 : -1;
    const int s = row - MP; return (s & 3) ? row - 1 : MT + (s >> 2);
}
__device__ __forceinline__ float shifted(const bf16* UB, int row, int prow, int col, float mu) {
    const float ub = bf2f(UB[(size_t)row * BCOLS + col]);
    const float up = prow >= 0 ? bf2f(UB[(size_t)prow * BCOLS + col]) : 0.f;
    return ub + (up - ub) * mu;
}
__device__ __forceinline__ void p2_rwkv_prep(const Frame& F, const Args& A) {
    const bf16* UB = (const bf16*)(A.ws + WS_UB);
    bf16* P = (bf16*)A.out;
    float* bonus = (float*)(A.ws + WS_BONUS);
    LAS float* lw = (LAS float*)F.lds;
    const int c = F.tid;
    const float* mu = A.in[7];
    const float w0 = A.in[8][c], a0 = A.in[10][c], kkc = A.in[13][c], kac = A.in[14][c], rkc = A.in[15][c];
    const float mu_r = mu[c], mu_k = mu[512 + c];
    for (int tile = F.vcu; tile < MT / 32; tile += F.G) {
        const int r0 = tile * 32;
#pragma unroll
        for (int n = 0; n < 8; ++n) { const int idx = F.tid + 512 * n, tok = idx >> 7, k = idx & 127, row = r0 + tok;
            const float xm = shifted(UB, row, prev_row(row), 1536 + k, mu[1536 + k]);
            lw[tok * 128 + k] = k < 64 ? tanhf_(xm) : xm; }
        __syncthreads();
        {
            float Wd[64];
            const float* wp = A.in[9] + c; asm volatile("" : "+v"(wp));
#pragma unroll
            for (int k = 0; k < 64; ++k) Wd[k] = wp[k * BW];
#pragma unroll 1
            for (int tok = 0; tok < 32; ++tok) {
                float dec = 0.f;
                const LAS f32x4* l4 = (const LAS f32x4*)(lw + tok * 128);
#pragma unroll
                for (int k4 = 0; k4 < 16; ++k4) { const f32x4 t = l4[k4]; dec += t[0] * Wd[4 * k4] + t[1] * Wd[4 * k4 + 1] + t[2] * Wd[4 * k4 + 2] + t[3] * Wd[4 * k4 + 3]; }
                const float w = __expf(-DECAY_SCALE * sigmoidf_(w0 + dec));
                P[(size_t)(r0 + tok) * 2048 + c] = (bf16)f2bf(w);
            }
        }
        {
            float Wa[64];
            const float* wp = A.in[11] + c; asm volatile("" : "+v"(wp));
#pragma unroll
            for (int k = 0; k < 64; ++k) Wa[k] = wp[k * BW];
#pragma unroll 1
            for (int tok = 0; tok < 32; ++tok) {
                const int row = r0 + tok, prow = prev_row(row);
                float aa = 0.f;
                const LAS f32x4* l4 = (const LAS f32x4*)(lw + tok * 128 + 64);
#pragma unroll
                for (int k4 = 0; k4 < 16; ++k4) { const f32x4 u = l4[k4]; aa += u[0] * Wa[4 * k4] + u[1] * Wa[4 * k4 + 1] + u[2] * Wa[4 * k4 + 2] + u[3] * Wa[4 * k4 + 3]; }
                const float a = sigmoidf_(a0 + aa);
                const float xr = shifted(UB, row, prow, c, mu_r), xk = shifted(UB, row, prow, 512 + c, mu_k);
                const float kp = xk * kkc;
                const float nrm = fmaxf(sqrtf(wave_sum(kp * kp)), 1e-12f);
                const float kk = kp / nrm;
                const float k2 = xk * (1.0f + (a - 1.0f) * kac);
                const float bs = wave_sum(xr * k2 * rkc);
                bf16* pr = P + (size_t)row * 2048 + c;
                pr[512] = (bf16)f2bf(k2); pr[1024] = (bf16)f2bf(kk); pr[1536] = (bf16)f2bf(kk * a);
                if (F.lane == 0) bonus[(size_t)row * 8 + F.wave] = bs;
            }
        }
        __syncthreads();
    }
}

constexpr int TB = 32;
__device__ __forceinline__ void rwkv_scan_unit(const Frame& F, const Args& A, int row0, int T, int h, int half, const float* s_in, float* s_out) {
    const bf16* P = (const bf16*)A.out;
    bf16* UB = (bf16*)(A.ws + WS_UB);
    LAS float* buf = (LAS float*)F.lds;
    constexpr int STEPF = 384, BUFF = TB * STEPF;
    const int cg = F.lane & 15, i = half * 32 + F.wave * 4 + (F.lane >> 4);
    const int e = F.tid * 16, ls = e >> 8, lq = (e >> 6) & 3, lj = e & 63;
    const int lslot = lq == 0 ? 0 : (lq == 1 ? 3 : (lq == 2 ? 1 : 2));
    const int e2 = F.tid * 8, ls2 = e2 >> 7, lq2 = (e2 >> 6) & 1, lj2 = e2 & 63;
    const int ucol = lq2 * 1024 + h * 64 + lj2;
    float mu8[8];
#pragma unroll
    for (int k = 0; k < 8; ++k) mu8[k] = A.in[7][ucol + k];
    f32x4 S;
    if (s_in) S = *(const f32x4*)(s_in + i * 64 + 4 * cg); else S = (f32x4){0.f, 0.f, 0.f, 0.f};
    const int nblk = (T + TB - 1) / TB;
    v4u p0, p1, uc, up;
    auto load_block = [&](int blk) {
        const int t0 = blk * TB;
        p0 = (v4u){0, 0, 0, 0}; p1 = p0; uc = p0; up = p0;
        if (t0 + ls < T) { const v4u* src = (const v4u*)(P + (size_t)(row0 + t0 + ls) * 2048 + lq * 512 + h * 64 + lj); p0 = src[0]; p1 = src[1]; }
        if (t0 + ls2 < T) { const int row = row0 + t0 + ls2, prow = prev_row(row);
            uc = *(const v4u*)(UB + (size_t)row * BCOLS + ucol);
            if (prow >= 0) up = *(const v4u*)(UB + (size_t)prow * BCOLS + ucol); }
    };
    auto store_block = [&](int b) {
        LAS float* d = buf + b * BUFF + ls * STEPF + lslot * 64 + lj;
        *(LAS f32x4*)(d) = (f32x4){bflo(p0.x), bfhi(p0.x), bflo(p0.y), bfhi(p0.y)};
        *(LAS f32x4*)(d + 4) = (f32x4){bflo(p0.z), bfhi(p0.z), bflo(p0.w), bfhi(p0.w)};
        *(LAS f32x4*)(d + 8) = (f32x4){bflo(p1.x), bfhi(p1.x), bflo(p1.y), bfhi(p1.y)};
        *(LAS f32x4*)(d + 12) = (f32x4){bflo(p1.z), bfhi(p1.z), bflo(p1.w), bfhi(p1.w)};
        LAS float* d2 = buf + b * BUFF + ls2 * STEPF + (4 + lq2) * 64 + lj2;
        float c8[8] = {bflo(uc.x), bfhi(uc.x), bflo(uc.y), bfhi(uc.y), bflo(uc.z), bfhi(uc.z), bflo(uc.w), bfhi(uc.w)};
        float q8[8] = {bflo(up.x), bfhi(up.x), bflo(up.y), bfhi(up.y), bflo(up.z), bfhi(up.z), bflo(up.w), bfhi(up.w)};
#pragma unroll
        for (int k = 0; k < 8; ++k) c8[k] = c8[k] + (q8[k] - c8[k]) * mu8[k];
        *(LAS f32x4*)(d2) = (f32x4){c8[0], c8[1], c8[2], c8[3]};
        *(LAS f32x4*)(d2 + 4) = (f32x4){c8[4], c8[5], c8[6], c8[7]};
    };
    __syncthreads();
    load_block(0); store_block(0);
    __syncthreads();
    for (int blk = 0; blk < nblk; ++blk) {
        if (blk + 1 < nblk) load_block(blk + 1);
        const LAS float* bb = buf + (blk & 1) * BUFF;
        const int ns = (T - blk * TB) < TB ? (T - blk * TB) : TB;
        bf16* yout = UB + (size_t)(row0 + blk * TB) * BCOLS + 512 + h * 64 + i;
        for (int s = 0; s < ns; ++s) {
            const LAS float* v = bb + s * STEPF;
            const f32x4 w4 = *(const LAS f32x4*)(v + 4 * cg), kk4 = *(const LAS f32x4*)(v + 64 + 4 * cg), ka4 = *(const LAS f32x4*)(v + 128 + 4 * cg),
                        k4 = *(const LAS f32x4*)(v + 192 + 4 * cg), r4 = *(const LAS f32x4*)(v + 256 + 4 * cg);
            const float vi = v[320 + i];
            float sk = (S[0] * kk4[0] + S[1] * kk4[1]) + (S[2] * kk4[2] + S[3] * kk4[3]);
            sk = row_sum16(sk);
            S[0] = S[0] * w4[0] - sk * ka4[0] + vi * k4[0];
            S[1] = S[1] * w4[1] - sk * ka4[1] + vi * k4[1];
            S[2] = S[2] * w4[2] - sk * ka4[2] + vi * k4[2];
            S[3] = S[3] * w4[3] - sk * ka4[3] + vi * k4[3];
            float y = (S[0] * r4[0] + S[1] * r4[1]) + (S[2] * r4[2] + S[3] * r4[3]);
            y = row_sum16(y);
            if (cg == 0) yout[(size_t)s * BCOLS] = (bf16)f2bf(y);
        }
        if (blk + 1 < nblk) store_block((blk + 1) & 1);
        __syncthreads();
    }
    *(f32x4*)(s_out + i * 64 + 4 * cg) = S;
}
__device__ __forceinline__ void hgrn_scan_unit(const Frame& F, const Args& A, int row0, int T, int h, int vq, const float* s_in, float* s_out) {
    bf16* UA = (bf16*)(A.ws + WS_UA);
    LAS float* buf = (LAS float*)F.lds;
    constexpr int STEPF = 416, BUFF = TB * STEPF;
    const int kg = F.lane & 15, vl = F.tid >> 4, v = vq * 32 + vl;
    const int e = F.tid * 16, ls = e >> 8, lwhich = (e >> 7) & 1, lk = e & 127;
    const int e3 = F.tid * 8, ls3 = e3 >> 5, lv3 = e3 & 31;
    float lb16[16];
#pragma unroll
    for (int k = 0; k < 16; ++k) { const int ch = h * 128 + lk + k; lb16[k] = 1.0f / (1.0f + __expf(A.in[18][512 + ch] - A.in[18][ch])); }
    float S[8];
#pragma unroll
    for (int j = 0; j < 8; ++j) S[j] = s_in ? s_in[(size_t)(kg * 8 + j) * 128 + v] : 0.f;
    const int nblk = (T + TB - 1) / TB;
    v4u p0, p1, pi;
    auto load_block = [&](int blk) {
        const int t0 = blk * TB;
        p0 = (v4u){0, 0, 0, 0}; p1 = p0; pi = p0;
        if (t0 + ls < T) { const v4u* src = (const v4u*)(UA + (size_t)(row0 + t0 + ls) * ACOLS + (lwhich ? 0 : 512) + h * 128 + lk); p0 = src[0]; p1 = src[1]; }
        if (F.tid < 128 && t0 + ls3 < T) pi = *(const v4u*)(UA + (size_t)(row0 + t0 + ls3) * ACOLS + 1024 + h * 128 + vq * 32 + lv3);
    };
    auto store_block = [&](int b) {
        float x[16] = {bflo(p0.x), bfhi(p0.x), bflo(p0.y), bfhi(p0.y), bflo(p0.z), bfhi(p0.z), bflo(p0.w), bfhi(p0.w),
                       bflo(p1.x), bfhi(p1.x), bflo(p1.y), bfhi(p1.y), bflo(p1.z), bfhi(p1.z), bflo(p1.w), bfhi(p1.w)};
        LAS float* d = buf + b * BUFF + ls * STEPF + lk;
        if (lwhich == 0) {
            float f[16], kd[16];
#pragma unroll
            for (int k = 0; k < 16; ++k) { const float sg = sigmoidf_(x[k]); f[k] = lb16[k] + (1.0f - lb16[k]) * sg; kd[k] = (1.0f - lb16[k]) * (1.0f - sg); }
#pragma unroll
            for (int k = 0; k < 4; ++k) { *(LAS f32x4*)(d + 4 * k) = (f32x4){f[4 * k], f[4 * k + 1], f[4 * k + 2], f[4 * k + 3]};
                                          *(LAS f32x4*)(d + 128 + 4 * k) = (f32x4){kd[4 * k], kd[4 * k + 1], kd[4 * k + 2], kd[4 * k + 3]}; }
        } else {
#pragma unroll
            for (int k = 0; k < 16; ++k) x[k] = x[k] * sigmoidf_(x[k]);
#pragma unroll
            for (int k = 0; k < 4; ++k) *(LAS f32x4*)(d + 256 + 4 * k) = (f32x4){x[4 * k], x[4 * k + 1], x[4 * k + 2], x[4 * k + 3]};
        }
        if (F.tid < 128) { LAS float* d3 = buf + b * BUFF + ls3 * STEPF + 384 + lv3;
            *(LAS f32x4*)(d3) = (f32x4){bflo(pi.x), bfhi(pi.x), bflo(pi.y), bfhi(pi.y)};
            *(LAS f32x4*)(d3 + 4) = (f32x4){bflo(pi.z), bfhi(pi.z), bflo(pi.w), bfhi(pi.w)}; }
    };
    __syncthreads();
    load_block(0); store_block(0);
    __syncthreads();
    for (int blk = 0; blk < nblk; ++blk) {
        if (blk + 1 < nblk) load_block(blk + 1);
        const LAS float* bb = buf + (blk & 1) * BUFF;
        const int ns = (T - blk * TB) < TB ? (T - blk * TB) : TB;
        bf16* oout = UA + (size_t)(row0 + blk * TB) * ACOLS + 1024 + h * 128 + v;
        for (int s = 0; s < ns; ++s) {
            const LAS float* p = bb + s * STEPF;
            const f32x4 f0 = *(const LAS f32x4*)(p + 8 * kg), f1 = *(const LAS f32x4*)(p + 8 * kg + 4);
            const f32x4 d0 = *(const LAS f32x4*)(p + 128 + 8 * kg), d1 = *(const LAS f32x4*)(p + 128 + 8 * kg + 4);
            const f32x4 q0 = *(const LAS f32x4*)(p + 256 + 8 * kg), q1 = *(const LAS f32x4*)(p + 256 + 8 * kg + 4);
            const float iv = p[384 + vl];
            float o = 0.f;
#pragma unroll
            for (int j = 0; j < 4; ++j) { S[j] = f0[j] * S[j] + d0[j] * iv; S[4 + j] = f1[j] * S[4 + j] + d1[j] * iv; }
            o = ((S[0] * q0[0] + S[1] * q0[1]) + (S[2] * q0[2] + S[3] * q0[3])) + ((S[4] * q1[0] + S[5] * q1[1]) + (S[6] * q1[2] + S[7] * q1[3]));
            o = row_sum16(o);
            if (kg == 0) oout[(size_t)s * ACOLS] = (bf16)f2bf(o);
        }
        if (blk + 1 < nblk) store_block((blk + 1) & 1);
        __syncthreads();
    }
#pragma unroll
    for (int j = 0; j < 8; ++j) s_out[(size_t)(kg * 8 + j) * 128 + v] = S[j];
}
__device__ __forceinline__ void p3_scans(const Frame& F, const Args& A) {
    for (int u = F.vcu; u < 256; u += F.G) {
        if (u < 128) { const int b = u >> 4, h = (u >> 1) & 7, half = u & 1;
            rwkv_scan_unit(F, A, b * SEQ, SEQ, h, half, nullptr, A.out + O_WKV_P + (size_t)(b * 8 + h) * 4096); }
        else { const int x = u - 128, b = x >> 4, h = (x >> 2) & 3, vq = x & 3;
            hgrn_scan_unit(F, A, b * SEQ, SEQ, h, vq, nullptr, A.out + O_HGRN_P + (size_t)(b * 4 + h) * 16384); }
    }
    for (int u = F.vcu; u < 2048; u += F.G) { const int bh = u >> 1, half = u & 1, b = bh >> 3, h = bh & 7;
        rwkv_scan_unit(F, A, MP + 4 * b, TS, h, half, A.in[3] + (size_t)bh * 4096, A.out + O_WKV_S + (size_t)bh * 4096); }
    for (int u = F.vcu; u < 2048; u += F.G) { const int bh = u >> 2, vq = u & 3, b = bh >> 2, h = bh & 3;
        hgrn_scan_unit(F, A, MP + 4 * b, TS, h, vq, A.in[2] + (size_t)bh * 16384, A.out + O_HGRN_S + (size_t)bh * 16384); }
}

__device__ __forceinline__ void p4_post(const Frame& F, const Args& A) {
    bf16* UB = (bf16*)(A.ws + WS_UB);
    bf16* UA = (bf16*)(A.ws + WS_UA);
    const float* bonus = (const float*)(A.ws + WS_BONUS);
    LAS float* lg = (LAS float*)F.lds;
    LAS float* red = lg + 32 * 128;
    const int c = F.tid;
    const float* mu = A.in[7];
    LAS float* gbuf = red + 32 * 8;
    const float lnw = A.in[16][c], lnb = A.in[17][c], mu_v = mu[1024 + c], nw = A.in[19][c];
    for (int tile = F.vcu; tile < MT / 32; tile += F.G) {
        const int r0 = tile * 32;
#pragma unroll
        for (int n = 0; n < 8; ++n) { const int idx = F.tid + 512 * n, tok = idx >> 7, k = idx & 127, row = r0 + tok;
            lg[tok * 128 + k] = sigmoidf_(shifted(UB, row, prev_row(row), 1664 + k, mu[1664 + k])); }
        for (int tok = 0; tok < 32; ++tok) { const float o_ = bf2f(UA[(size_t)(r0 + tok) * ACOLS + 1024 + c]); const float ss = wave_sum(o_ * o_); if (F.lane == 0) red[tok * 8 + F.wave] = ss; }
        __syncthreads();
        {
            float Wg[64];
            const float* wp = A.in[12] + c; asm volatile("" : "+v"(wp));
#pragma unroll
            for (int k = 0; k < 64; ++k) Wg[k] = wp[k * BW];
#pragma unroll 1
            for (int tok = 0; tok < 32; ++tok) {
                float g = 0.f;
                const LAS f32x4* l4 = (const LAS f32x4*)(lg + tok * 128);
#pragma unroll
                for (int k4 = 0; k4 < 16; ++k4) { const f32x4 t = l4[k4]; g += t[0] * Wg[4 * k4] + t[1] * Wg[4 * k4 + 1] + t[2] * Wg[4 * k4 + 2] + t[3] * Wg[4 * k4 + 3]; }
                gbuf[tok * 512 + c] = g;
            }
        }
        {
            float Wg[64];
            const float* wp = A.in[12] + 64 * BW + c; asm volatile("" : "+v"(wp));
#pragma unroll
            for (int k = 0; k < 64; ++k) Wg[k] = wp[k * BW];
#pragma unroll 1
            for (int tok = 0; tok < 32; ++tok) {
                const int row = r0 + tok, prow = prev_row(row);
                float g = gbuf[tok * 512 + c];
                const LAS f32x4* l4 = (const LAS f32x4*)(lg + tok * 128 + 64);
#pragma unroll
                for (int k4 = 0; k4 < 16; ++k4) { const f32x4 t = l4[k4]; g += t[0] * Wg[4 * k4] + t[1] * Wg[4 * k4 + 1] + t[2] * Wg[4 * k4 + 2] + t[3] * Wg[4 * k4 + 3]; }
                const float y = bf2f(UB[(size_t)row * BCOLS + 512 + c]);
                const float mean = wave_sum(y) * (1.0f / 64.0f), dlt = y - mean;
                const float var = wave_sum(dlt * dlt) * (1.0f / 64.0f);
                const float yn = dlt * rsqrtf(var + GN_EPS) * lnw + lnb;
                const float vv = shifted(UB, row, prow, 1024 + c, mu_v);
                const float ob = (yn + bonus[(size_t)row * 8 + F.wave] * vv) * g;
                const float ss = red[tok * 8 + (F.wave & ~1)] + red[tok * 8 + (F.wave | 1)];
                const float gg = bf2f(UA[(size_t)row * ACOLS + 1536 + c]);
                const float oav = bf2f(UA[(size_t)row * ACOLS + 1024 + c]) * rsqrtf(ss * (1.0f / 128.0f) + HGRN_EPS) * nw * (gg * sigmoidf_(gg));
                UB[(size_t)row * BCOLS + 512 + c] = (bf16)f2bf(ob);
                UA[(size_t)row * ACOLS + 1024 + c] = (bf16)f2bf(oav);
            }
        }
        __syncthreads();
    }
}

__device__ __forceinline__ void p9_final(const Frame& F, const Args& A) {
    const int gw = F.vcu * NWAVES + F.wave, NGW = F.G * NWAVES;
    const float* ssq = (const float*)(A.ws + WS_SSQ2);
    f32x4 gv[4];
#pragma unroll
    for (int j = 0; j < 4; ++j) gv[j] = ((const f32x4*)A.in[26])[F.lane + 64 * j];
    for (int m = gw; m < MT; m += NGW) {
        const f32x4* sp = (const f32x4*)(ssq + (size_t)m * 16); const f32x4 a = sp[0], b = sp[1], c = sp[2], d = sp[3];
        const float tot = ((a[0] + a[1]) + (a[2] + a[3])) + ((b[0] + b[1]) + (b[2] + b[3])) + ((c[0] + c[1]) + (c[2] + c[3])) + ((d[0] + d[1]) + (d[2] + d[3]));
        const float rstd = rsqrtf(tot * (1.0f / D) + NORM_EPS);
        f32x4* xr = (f32x4*)(A.out + (size_t)m * D) + F.lane;
#pragma unroll
        for (int j = 0; j < 4; ++j) xr[64 * j] = xr[64 * j] * rstd * gv[j];
    }
}

__global__ void __launch_bounds__(NWAVES * 64, 2) fwd(Args args) {
    extern __shared__ __attribute__((aligned(16))) unsigned char lds[];
    Frame F;
    F.lds = (LAS unsigned char*)lds;
    F.tid = threadIdx.x; F.lane = F.tid & 63; F.wave = __builtin_amdgcn_readfirstlane(F.tid >> 6);
    F.G = gridDim.x; { const int bx = blockIdx.x; F.vcu = (F.G % 8 == 0) ? (bx % 8) * (F.G / 8) + bx / 8 : bx; }
    unsigned char* ws = args.ws;
    gu32* ctl = (gu32*)(ws + WS_CTL);
    for (int u = F.tid; u < (LDS_BYTES - LDSCTL_OFF) / 4; u += NWAVES * 64) ((LAS unsigned*)(F.lds + LDSCTL_OFF))[u] = 0u;
    __syncthreads();
    volatile LAS unsigned* MISC = (volatile LAS unsigned*)(F.lds + MISC_OFF);
    XcdBarrier bar; bar.bar = (unsigned*)(ctl + CW_BAR); bar.x = 0; bar.st = nullptr;
    if (MK_N_LAUNCHES == 1) bar = xcd_barrier_post((unsigned*)(ctl + CW_BAR), MISC + 8);
    const int lo = args.ph_lo, hi = args.ph_hi;
#ifndef PH_MASK
#define PH_MASK 0x3ff
#endif
#define IN(k) (((PH_MASK >> (k)) & 1) && lo <= (k) && (k) < hi)
#define SEAM(k) do { if (IN(k) && IN((k) + 1)) xcd_barrier(bar); } while (0)
    bf16* UA = (bf16*)(ws + WS_UA); bf16* UB = (bf16*)(ws + WS_UB); bf16* UG = (bf16*)(ws + WS_UG);

    if (IN(0)) { p0_prologue(F, args); } SEAM(0);
    if (IN(1)) {
        pg8::Gemm g{(const bf16*)args.out, (const bf16*)(ws + WS_WIN), MH, NIN, D, D, D};
        SchedG1 S; S.init(F.G, (int)blockIdx.x);
        EpiG1 E{UA, UB, UG};
        pg8::gemm_phase<EpiG1, SchedG1, true, true>(F.lds, g, S, E);
    } SEAM(1);
    if (IN(2)) { p2_rwkv_prep(F, args); } SEAM(2);
    if (IN(3)) { p3_scans(F, args); } SEAM(3);
    if (IN(4)) { p4_post(F, args); } SEAM(4);
    if (IN(5)) {
        SchedMN S; S.init(MT, D, F.G, (int)blockIdx.x);
        { pg8::Gemm g{UA + 1024, (const bf16*)(ws + WS_WA), MT, D, AW, ACOLS, AW}; EpiMerge<false> E{UA, UG, 0};
          pg8::gemm_phase<EpiMerge<false>, SchedMN, true, true>(F.lds, g, S, E); }
        { pg8::Gemm g{UB + 512, (const bf16*)(ws + WS_WB), MT, D, BW, BCOLS, BW}; EpiMerge<true> E{UA, UG, 1024};
          pg8::gemm_phase<EpiMerge<true>, SchedMN, true, true>(F.lds, g, S, E); }
    } SEAM(5);
    if (IN(6)) {
        SchedMN S; S.init(MT, D, F.G, (int)blockIdx.x);
        pg8::Gemm g{UA, (const bf16*)(ws + WS_WO), MT, D, D, ACOLS, D};
        EpiRes<true, true> E{args.in[0], args.in[1], args.out, UB, BCOLS, (float*)(ws + WS_SSQ1)};
        pg8::gemm_phase<EpiRes<true, true>, SchedMN, true, true>(F.lds, g, S, E);
    } SEAM(6);
    if (IN(7)) {
        SchedMN S; S.init(MT, DFF, F.G, (int)blockIdx.x);
        pg8::Gemm g{UB, (const bf16*)(ws + WS_WUP), MT, DFF, D, BCOLS, D};
        EpiUp E{UA, (const float*)(ws + WS_SSQ1)};
        pg8::gemm_phase<EpiUp, SchedMN, true, true>(F.lds, g, S, E);
    } SEAM(7);
    if (IN(8)) {
        SchedMN S; S.init(MT, D, F.G, (int)blockIdx.x);
        pg8::Gemm g{UA, (const bf16*)(ws + WS_WDN), MT, D, DFF, DFF, DFF};
        EpiRes<false, false> E{nullptr, nullptr, args.out, nullptr, 0, (float*)(ws + WS_SSQ2)};
        pg8::gemm_phase<EpiRes<false, false>, SchedMN, true, true>(F.lds, g, S, E);
    } SEAM(8);
    if (IN(9)) { p9_final(F, args); }
#undef IN
#undef SEAM
}

extern "C" void kernel_launch(void* const* d_in, const int* in_sizes, int n_in, void* d_out, int out_size, void* d_ws, size_t ws_size, hipStream_t stream) {
    static int grid = 0;
    if (grid == 0) {
        if (n_in != 27 || out_size != (int)O_END || ws_size < WS_END) { fprintf(stderr, "kernel_launch: unexpected shapes (n_in %d, out %d, ws %zu)\n", n_in, out_size, ws_size); grid = -1; return; }
        int dev = 0, cus = 0, per_cu = 0;
        if (hipGetDevice(&dev) != hipSuccess || hipDeviceGetAttribute(&cus, hipDeviceAttributeMultiprocessorCount, dev) != hipSuccess) { grid = -1; return; }
        if (hipFuncSetAttribute((const void*)fwd, hipFuncAttributeMaxDynamicSharedMemorySize, LDS_BYTES) != hipSuccess) { fprintf(stderr, "kernel_launch: hipFuncSetAttribute failed\n"); grid = -1; return; }
        if (hipOccupancyMaxActiveBlocksPerMultiprocessor(&per_cu, (const void*)fwd, NWAVES * 64, LDS_BYTES) != hipSuccess || per_cu < 1) { fprintf(stderr, "kernel_launch: occupancy query says %d\n", per_cu); }
        (void)hipGetLastError();
        grid = cus;
    }
    if (grid < 0) return;
    (void)hipMemsetAsync((char*)d_ws + WS_CTL, 0, CTL_BYTES, stream);
    Args a{};
    for (int i = 0; i < 27; ++i) a.in[i] = (const float*)d_in[i];
    a.out = (float*)d_out; a.ws = (unsigned char*)d_ws;
    if (MK_N_LAUNCHES == 1) { a.ph_lo = 0; a.ph_hi = NPHASE; hipLaunchKernelGGL(fwd, dim3(grid), dim3(NWAVES * 64), LDS_BYTES, stream, a); }
    else for (int p = 0; p < NPHASE; ++p) { a.ph_lo = p; a.ph_hi = p + 1; hipLaunchKernelGGL(fwd, dim3(grid), dim3(NWAVES * 64), LDS_BYTES, stream, a); }
}
```

```cpp
#include <hip/hip_runtime.h>
#include <cstdio>
#include <cstdint>
namespace pg8 {
#define PG8_LAS __attribute__((address_space(3)))
typedef unsigned short bf16_t;
typedef short bf16x8 __attribute__((ext_vector_type(8)));
typedef float f32x4 __attribute__((ext_vector_type(4)));
typedef unsigned u32x4 __attribute__((ext_vector_type(4)));
constexpr int BM = 256, BK = 64, HALF = 128, HTB = HALF * BK * 2  , STAGE_BYTES = 8 * HTB, NXCD = 8, WGM = 8;

__host__ __device__ __forceinline__ int lds_byte(int r, int c) { const int st = (r >> 4) * 2 + (c >> 5), rr = r & 15, cc = c & 31, ob = rr * 64 + cc * 2; return st * 1024 + (ob ^ (((ob >> 9) & 1) << 5)); }
__host__ __device__ __forceinline__ void stage_rc(int b, int& R, int& C) { const int st = b / 1024, sb = b % 1024, swz = sb ^ (((sb >> 9) & 1) << 5); R = (st >> 1) * 16 + swz / 64; C = (st & 1) * 32 + (swz % 64) / 2; }
__host__ __device__ __forceinline__ int perm32(int rho) { const int n = rho >> 4, i = rho & 15; return 8 * (i >> 2) + 4 * n + (i & 3); }

struct Unit { int pm, pn; };
struct Gemm { const bf16_t* A; const bf16_t* Bt; int M, N, K, lda, ldb; };

struct StaticOrder {
    int nM, nN, nwg, G, c;
    __host__ __device__ void init(int M, int N, int G_, int c_) { nM = M / BM; nN = N / BM; nwg = nM * nN; G = G_; c = c_; }
    __host__ __device__ bool next(int i, Unit& u) const {
        const long L = (long)i * G + c; if (L >= nwg) return false;
        int wgid = (int)L; { const int q = nwg / NXCD, r = nwg % NXCD, xcd = wgid % NXCD, off = wgid / NXCD; wgid = (xcd < r ? xcd * (q + 1) : r * (q + 1) + (xcd - r) * q) + off; }
        const int nig = WGM * nN, gid = wgid / nig, fm = gid * WGM, gsz = (nM - fm) < WGM ? (nM - fm) : WGM;
        u.pm = fm + ((wgid % nig) % gsz); u.pn = (wgid % nig) / gsz; return true;
    }
    __device__ __forceinline__ void a_ready(const Unit&) const {}
    __device__ __forceinline__ void done(const Unit&) const {}
};

__device__ __forceinline__ unsigned cvt_pk_bf16(float lo, float hi) { unsigned r; asm volatile("v_cvt_pk_bf16_f32 %0, %1, %2" : "=v"(r) : "v"(lo), "v"(hi)); return r; }
typedef float f32x2 __attribute__((ext_vector_type(2)));
__device__ __forceinline__ f32x2 gelu_pk(f32x2 v) {
    const f32x2 av = __builtin_elementwise_abs(v), d = av * 0.2316418882f + 1.0f;
    f32x2 t; t.x = __builtin_amdgcn_rcpf(d.x); t.y = __builtin_amdgcn_rcpf(d.y);
    f32x2 q = t * 0.5307027145f + (-0.7265760135f); q = q * t + 0.7107068705f; q = q * t + (-0.142248368f); q = q * t + 0.127414796f; q = q * t;
    const f32x2 s = (v * v) * (-0.72134752044f);
    f32x2 e; e.x = __builtin_amdgcn_exp2f(s.x); e.y = __builtin_amdgcn_exp2f(s.y);
    const f32x2 m = v * (q * e), r = v - m;
    f32x2 o; o.x = v.x < 0.f ? m.x : r.x; o.y = v.y < 0.f ? m.y : r.y; return o;
}

template <class Epi, class Sched, bool ALIGN_EPI = false, bool SP2 = false>
__device__ __forceinline__ void gemm_phase(PG8_LAS unsigned char* lds, const Gemm g, const Sched& S, const Epi& E) {
    const int tid = threadIdx.x, wid = __builtin_amdgcn_readfirstlane(tid >> 6), lane = tid & 63, wr = wid >> 2, wc = wid & 3, fr = lane & 15, fq = lane >> 4;
    const int K = g.K, nt = K / BK;
    unsigned voffA[2], voffB[2];
#pragma unroll
    for (int i = 0; i < 2; ++i) { int R, C; stage_rc(tid * 16 + i * 8192, R, C); const int Rb = Epi::PERM ? ((R & ~31) + perm32(R & 31)) : R;
        voffA[i] = (unsigned)(R * g.lda + C) * 2u; voffB[i] = (unsigned)(Rb * g.ldb + C) * 2u; }
    const size_t kstep = (size_t)(BK * 2);
    const size_t hstepA = (size_t)HALF * g.lda * 2, hstepB = (size_t)HALF * g.ldb * 2;
    const size_t tstepA = 2 * hstepA, tstepB = 2 * hstepB;
    const unsigned ldsw = (unsigned)wid * 1024u;
    const int aoff = lds_byte(wr * 64 + fr, fq * 8), boff = lds_byte(wc * 32 + fr, fq * 8);
#define PG8_SA(b, h) (((b) * 2 + (h)) * HTB)
#define PG8_SB(b, h) ((4 + (b) * 2 + (h)) * HTB)
#define PG8_STAGE(bufoff, gbase, voff) do { _Pragma("unroll") for (int _i = 0; _i < 2; ++_i) \
        __builtin_amdgcn_global_load_lds((const unsigned*)((const char*)(gbase) + (voff)[_i]), (PG8_LAS unsigned*)(lds + (bufoff) + ldsw + _i * 8192), 16, 0, 0); } while (0)
#define PG8_LDA(dst, b, h) do { _Pragma("unroll") for (int m = 0; m < 4; ++m) _Pragma("unroll") for (int k = 0; k < 2; ++k) dst[m][k] = *(const PG8_LAS bf16x8*)(lds + PG8_SA(b, h) + aoff + m * 2048 + k * 1024); } while (0)
#define PG8_LDB(dst, b, h) do { _Pragma("unroll") for (int n = 0; n < 2; ++n) _Pragma("unroll") for (int k = 0; k < 2; ++k) dst[n][k] = *(const PG8_LAS bf16x8*)(lds + PG8_SB(b, h) + boff + n * 2048 + k * 1024); } while (0)
#define PG8_MMA(ai, bj, At, Bt) do { __builtin_amdgcn_s_setprio(1); _Pragma("unroll") for (int m = 0; m < 4; ++m) _Pragma("unroll") for (int n = 0; n < 2; ++n) _Pragma("unroll") for (int k = 0; k < 2; ++k) \
        acc[ai][bj][m][n] = __builtin_amdgcn_mfma_f32_16x16x32_bf16(Bt[n][k], At[m][k], acc[ai][bj][m][n], 0, 0, 0); __builtin_amdgcn_s_setprio(0); } while (0)
#define PG8_WAIT_V(n) asm volatile("s_waitcnt vmcnt(" #n ")" ::: "memory")
#define PG8_WAIT_L(n) asm volatile("s_waitcnt lgkmcnt(" #n ")" ::: "memory")
#define PG8_BAR __builtin_amdgcn_s_barrier()
#define PG8_SCHED __builtin_amdgcn_sched_barrier(0)
    Unit cur, nxt; int ui = 0;
    if (!S.next(0, cur)) return;
    f32x4 acc[2][2][4][2];
#pragma unroll
    for (int a = 0; a < 2; ++a)
#pragma unroll
        for (int b = 0; b < 2; ++b)
#pragma unroll
            for (int m = 0; m < 4; ++m)
#pragma unroll
                for (int n = 0; n < 2; ++n) acc[a][b][m][n] = (f32x4){0.f, 0.f, 0.f, 0.f};
    bf16x8 At[4][2], B0[2][2], B1[2][2];
    const char* cA = (const char*)g.A + (size_t)cur.pm * tstepA; const char* cB = (const char*)g.Bt + (size_t)cur.pn * tstepB;
    S.a_ready(cur);
    if constexpr (SP2) {
        PG8_STAGE(PG8_SB(0, 0), cB, voffB); PG8_STAGE(PG8_SB(0, 1), cB + hstepB, voffB); PG8_STAGE(PG8_SA(0, 0), cA, voffA); PG8_STAGE(PG8_SA(0, 1), cA + hstepA, voffA);
        if (wr == 1) PG8_BAR;
        PG8_WAIT_V(2); PG8_BAR;
        PG8_STAGE(PG8_SB(1, 0), cB + kstep, voffB); PG8_STAGE(PG8_SA(1, 0), cA + kstep, voffA); PG8_STAGE(PG8_SB(1, 1), cB + hstepB + kstep, voffB);
        PG8_WAIT_V(6); PG8_BAR;
    } else {
        PG8_STAGE(PG8_SB(0, 0), cB, voffB); PG8_STAGE(PG8_SA(0, 0), cA, voffA); PG8_STAGE(PG8_SB(0, 1), cB + hstepB, voffB); PG8_STAGE(PG8_SA(0, 1), cA + hstepA, voffA);
        if (wr == 1) PG8_BAR;
        PG8_WAIT_V(4); PG8_BAR;
        PG8_STAGE(PG8_SB(1, 0), cB + kstep, voffB); PG8_STAGE(PG8_SA(1, 0), cA + kstep, voffA); PG8_STAGE(PG8_SB(1, 1), cB + hstepB + kstep, voffB);
        PG8_WAIT_V(6); PG8_BAR;
    }
    for (;;) {
        const bool has_next = S.next(ui + 1, nxt);
        const char* nA = has_next ? (const char*)g.A + (size_t)nxt.pm * tstepA : cA; const char* nB = has_next ? (const char*)g.Bt + (size_t)nxt.pn * tstepB : cB;
        for (int t = 0; t < nt; t += 2) {
            const bool last = (t == nt - 2);
            const char* a1 = cA + (size_t)(t + 1) * kstep;
            const char* a2 = last ? nA : cA + (size_t)(t + 2) * kstep; const char* b2 = last ? nB : cB + (size_t)(t + 2) * kstep;
            const char* a3 = a2 + kstep; const char* b3 = b2 + kstep;
            if (last && has_next) S.a_ready(nxt);
            if constexpr (SP2) {
            PG8_LDB(B0, 0, 0); PG8_LDB(B1, 0, 1); PG8_SCHED; PG8_LDA(At, 0, 0); PG8_STAGE(PG8_SA(1, 1), a1 + hstepA, voffA);
            PG8_WAIT_V(8); PG8_WAIT_L(0); PG8_BAR; PG8_MMA(0, 0, At, B0); PG8_MMA(0, 1, At, B1); PG8_BAR; PG8_SCHED;
            PG8_LDA(At, 0, 1); PG8_STAGE(PG8_SB(0, 0), b2, voffB); PG8_STAGE(PG8_SB(0, 1), b2 + hstepB, voffB); PG8_STAGE(PG8_SA(0, 0), a2, voffA);
            PG8_WAIT_V(8); PG8_WAIT_L(0); PG8_BAR; PG8_MMA(1, 0, At, B0); PG8_MMA(1, 1, At, B1); PG8_BAR; PG8_SCHED;
            PG8_LDB(B0, 1, 0); PG8_LDB(B1, 1, 1); PG8_SCHED; PG8_LDA(At, 1, 0); PG8_STAGE(PG8_SA(0, 1), a2 + hstepA, voffA);
            PG8_WAIT_V(8); PG8_WAIT_L(0); PG8_BAR; PG8_MMA(0, 0, At, B0); PG8_MMA(0, 1, At, B1); PG8_BAR; PG8_SCHED;
            PG8_LDA(At, 1, 1); PG8_STAGE(PG8_SB(1, 0), b3, voffB); PG8_STAGE(PG8_SB(1, 1), b3 + hstepB, voffB); PG8_STAGE(PG8_SA(1, 0), a3, voffA);
            PG8_WAIT_V(8); PG8_WAIT_L(0); PG8_BAR; PG8_MMA(1, 0, At, B0); PG8_MMA(1, 1, At, B1); PG8_BAR; PG8_SCHED;
            } else {
            PG8_LDB(B0, 0, 0); PG8_SCHED; PG8_LDA(At, 0, 0); PG8_STAGE(PG8_SA(1, 1), a1 + hstepA, voffA);
            PG8_WAIT_L(8); PG8_BAR; PG8_WAIT_L(0); PG8_MMA(0, 0, At, B0); PG8_BAR; PG8_SCHED;
            PG8_LDB(B1, 0, 1); PG8_STAGE(PG8_SB(0, 0), b2, voffB);
            PG8_BAR; PG8_WAIT_L(0); PG8_MMA(0, 1, At, B1); PG8_BAR;
            PG8_LDA(At, 0, 1); PG8_STAGE(PG8_SA(0, 0), a2, voffA);
            PG8_BAR; PG8_WAIT_L(0); PG8_MMA(1, 0, At, B0); PG8_BAR; PG8_SCHED;
            PG8_STAGE(PG8_SB(0, 1), b2 + hstepB, voffB);
            PG8_WAIT_V(6); PG8_BAR; PG8_MMA(1, 1, At, B1); PG8_BAR;
            PG8_LDB(B0, 1, 0); PG8_SCHED; PG8_LDA(At, 1, 0); PG8_STAGE(PG8_SA(0, 1), a2 + hstepA, voffA);
            PG8_WAIT_L(8); PG8_BAR; PG8_WAIT_L(0); PG8_MMA(0, 0, At, B0); PG8_BAR; PG8_SCHED;
            PG8_LDB(B1, 1, 1); PG8_STAGE(PG8_SB(1, 0), b3, voffB);
            PG8_BAR; PG8_WAIT_L(0); PG8_MMA(0, 1, At, B1); PG8_BAR;
            PG8_LDA(At, 1, 1); PG8_STAGE(PG8_SA(1, 0), a3, voffA);
            PG8_BAR; PG8_WAIT_L(0); PG8_MMA(1, 0, At, B0); PG8_BAR; PG8_SCHED;
            PG8_STAGE(PG8_SB(1, 1), b3 + hstepB, voffB);
            PG8_WAIT_V(6); PG8_BAR; PG8_MMA(1, 1, At, B1); PG8_BAR;
            }
        }
        if constexpr (ALIGN_EPI) { if (wr == 0) PG8_BAR; }
        if constexpr (!Epi::AFTER_DRAIN) { E(acc, cur, wr, wc, fr, fq); S.done(cur); }
        if (!has_next) break;
#pragma unroll
        for (int a = 0; a < 2; ++a)
#pragma unroll
            for (int b = 0; b < 2; ++b)
#pragma unroll
                for (int m = 0; m < 4; ++m)
#pragma unroll
                    for (int n = 0; n < 2; ++n) acc[a][b][m][n] = (f32x4){0.f, 0.f, 0.f, 0.f};
        cur = nxt; cA = nA; cB = nB; ++ui;
        if constexpr (ALIGN_EPI) { if (wr == 1) PG8_BAR; }
    }
    PG8_WAIT_V(0);
    if constexpr (!ALIGN_EPI) { if (wr == 0) PG8_BAR; }
    PG8_BAR;
    if constexpr (Epi::AFTER_DRAIN) { E.fused(acc, cur, wr, wc, fr, fq, lds, wid, lane); S.done(cur); }
#undef PG8_SA
#undef PG8_SB
#undef PG8_STAGE
#undef PG8_LDA
#undef PG8_LDB
#undef PG8_MMA
#undef PG8_WAIT_V
#undef PG8_WAIT_L
#undef PG8_BAR
#undef PG8_SCHED
}
}

#ifndef MK_N_LAUNCHES
#define MK_N_LAUNCHES 1
#endif
constexpr int NPHASE = 10;
constexpr int NWAVES = 8;

constexpr int D = 1024, SEQ = 2048, NBP = 8, NBS = 128, TS = 4;
constexpr int MP = NBP * SEQ;
constexpr int MS = NBS * TS;
constexpr int MT = MP + MS;
constexpr int MH = MT + 256;
constexpr int ACOLS = 2048, BCOLS = 1792, GCOLS = 2048, NIN = ACOLS + BCOLS + GCOLS, DFF = 4096;
constexpr int AW = 512, BW = 512;
constexpr float NORM_EPS = 1e-6f, HGRN_EPS = 1e-5f, GN_EPS = 64e-5f, DECAY_SCALE = 0.6065306597126334f;

constexpr size_t O_Y = 0, O_HGRN_P = (size_t)MT * D, O_WKV_P = O_HGRN_P + (size_t)NBP * 4 * 128 * 128, O_SHIFT_P = O_WKV_P + (size_t)NBP * 8 * 64 * 64,
                 O_HGRN_S = O_SHIFT_P + (size_t)NBP * D, O_WKV_S = O_HGRN_S + (size_t)NBS * 4 * 128 * 128, O_SHIFT_S = O_WKV_S + (size_t)NBS * 8 * 64 * 64,
                 O_END = O_SHIFT_S + (size_t)NBS * D;
static_assert(O_END == 30810112, "d_out size");

constexpr size_t WS_CTL = 0, CTL_BYTES = 65536;
constexpr size_t WS_WIN = WS_CTL + CTL_BYTES;
constexpr size_t WS_WA  = WS_WIN + (size_t)NIN * D * 2;
constexpr size_t WS_WB  = WS_WA + (size_t)D * AW * 2;
constexpr size_t WS_WO  = WS_WB + (size_t)D * BW * 2;
constexpr size_t WS_WUP = WS_WO + (size_t)D * D * 2;
constexpr size_t WS_WDN = WS_WUP + (size_t)DFF * D * 2;
constexpr size_t WS_UB  = WS_WDN + (size_t)D * DFF * 2;
constexpr size_t WS_UA  = WS_UB + (size_t)MH * BCOLS * 2;
constexpr size_t WS_UG  = WS_UA + (size_t)MT * ACOLS * 2;
constexpr size_t WS_BONUS = WS_UG + (size_t)MT * GCOLS * 2;
constexpr size_t WS_NS = WS_BONUS + (size_t)MT * 8 * 4;
constexpr size_t WS_GAMMA = WS_NS + (size_t)1024 * 16384 * 2;
constexpr size_t WS_END = WS_GAMMA + (size_t)1024 * 128 * 4;
constexpr size_t WS_SSQ1 = WS_NS;
constexpr size_t WS_SSQ2 = WS_SSQ1 + (size_t)MT * 16 * 4;
static_assert(WS_END <= 268435456, "d_ws map");
static_assert(WS_UA + (size_t)MT * DFF * 2 == WS_BONUS, "hidden overlays UA|UG exactly");
static_assert((size_t)MT * 2048 * 2 == (size_t)MT * D * 4, "P fits the y region exactly");

constexpr int CW_TMO = 0, CW_BAR = 1024;

constexpr int RING_BYTES = 131072, LDSCTL_OFF = RING_BYTES, MISC_OFF = LDSCTL_OFF + 320, LDS_BYTES = 147456;

#define GAS __attribute__((address_space(1)))
#define LAS __attribute__((address_space(3)))
typedef unsigned short bf16;
typedef unsigned v4u __attribute__((ext_vector_type(4)));
typedef unsigned v2u __attribute__((ext_vector_type(2)));
typedef float f32x4 __attribute__((ext_vector_type(4)));
typedef GAS unsigned gu32;
#define RLX_AGENT __ATOMIC_RELAXED, __HIP_MEMORY_SCOPE_AGENT
#define LDS_WAIT() asm volatile("s_waitcnt lgkmcnt(0)" ::: "memory")
#define VM_WAIT() asm volatile("s_waitcnt vmcnt(0)" ::: "memory")
__device__ __forceinline__ unsigned f2bf(float f) { unsigned u = __builtin_bit_cast(unsigned, f); return (u + 0x7fffu + ((u >> 16) & 1u)) >> 16; }
__device__ __forceinline__ unsigned pk2(float lo, float hi) { return f2bf(lo) | (f2bf(hi) << 16); }
__device__ __forceinline__ float bf2f(unsigned b) { return __builtin_bit_cast(float, b << 16); }
__device__ __forceinline__ float bflo(unsigned w) { return __builtin_bit_cast(float, w << 16); }
__device__ __forceinline__ float bfhi(unsigned w) { return __builtin_bit_cast(float, w & 0xffff0000u); }
__device__ __forceinline__ float sigmoidf_(float x) { return 1.0f / (1.0f + __expf(-x)); }
__device__ __forceinline__ float tanhf_(float x) { return 1.0f - 2.0f / (1.0f + __expf(2.0f * x)); }
__device__ __forceinline__ float wave_sum(float v) {
#pragma unroll
    for (int o = 1; o < 64; o <<= 1) v += __shfl_xor(v, o);
    return v;
}
__device__ __forceinline__ float row_sum16(float x) {
    x += __builtin_bit_cast(float, __builtin_amdgcn_update_dpp(0, __builtin_bit_cast(int, x), 0xB1, 0xF, 0xF, true));
    x += __builtin_bit_cast(float, __builtin_amdgcn_update_dpp(0, __builtin_bit_cast(int, x), 0x4E, 0xF, 0xF, true));
    x += __builtin_bit_cast(float, __builtin_amdgcn_update_dpp(0, __builtin_bit_cast(int, x), 0x141, 0xF, 0xF, true));
    x += __builtin_bit_cast(float, __builtin_amdgcn_update_dpp(0, __builtin_bit_cast(int, x), 0x140, 0xF, 0xF, true));
    return x;
}
#define XB_TMO      128
#define XB_XCNT(j)  (256  + 64 * (j))
#define XB_XSUB(j)  (1280 + 64 * (j))
#define XB_XGEN(j)  (2304 + 64 * (j))
#define XB_TOP      3328
#define XB_TOPGEN   3392
#define XCD_BAR_WORDS 3456
#define XB_SPIN_CAP (1u << 18)

__device__ __forceinline__ unsigned xb_ld(unsigned* p)              { return __hip_atomic_load(p, __ATOMIC_RELAXED, __HIP_MEMORY_SCOPE_AGENT); }
__device__ __forceinline__ unsigned xb_add(unsigned* p, unsigned v) { return __hip_atomic_fetch_add(p, v, __ATOMIC_RELAXED, __HIP_MEMORY_SCOPE_AGENT); }
__device__ __forceinline__ unsigned xb_xcc_id() { return (unsigned)__builtin_amdgcn_s_getreg((3 << 11) | 20) & 0xFu; }
#define XB_SPIN(cond, bar) do { unsigned _sp = 0; while (cond) { __builtin_amdgcn_s_sleep(1); \
    if ((++_sp & 255u) == 0u) { if (xb_ld(&(bar)[XB_TMO])) break; if (_sp > XB_SPIN_CAP) { atomicAdd(&(bar)[XB_TMO], 1u); break; } } } } while (0)

struct XcdBarrier {
    unsigned* bar; unsigned x;
    volatile LAS unsigned* st;
};

__device__ __forceinline__ XcdBarrier xcd_barrier_post(unsigned* bar, volatile LAS unsigned* st) {
    XcdBarrier b; b.bar = bar; b.x = xb_xcc_id(); b.st = st;
    if (threadIdx.x == 0) (void)xb_add(&bar[XB_XCNT(b.x)], 1u);
    return b;
}
__device__ __forceinline__ void xcd_barrier_complete(unsigned* bar, unsigned x, unsigned& nloc, unsigned& nx) {
    const unsigned G = gridDim.x * gridDim.y * gridDim.z;
    unsigned sum, cnt, mine, sp = 0u;
    for (;;) {
        sum = 0u; cnt = 0u; mine = 0u;
#pragma unroll
        for (unsigned j = 0; j < 16; ++j) { const unsigned c = xb_ld(&bar[XB_XCNT(j)]); sum += c; cnt += (c > 0u) ? 1u : 0u; mine = (j == x) ? c : mine; }
        if (sum == G) break;
        __builtin_amdgcn_s_sleep(1);
        if ((++sp & 255u) == 0u) { if (xb_ld(&bar[XB_TMO])) break; if (sp > XB_SPIN_CAP) { atomicAdd(&bar[XB_TMO], 1u); break; } }
    }
    nloc = mine > 0u ? mine : 1u; nx = cnt > 0u ? cnt : 1u;
}

__device__ __forceinline__ void xcd_barrier(const XcdBarrier& b) {
    asm volatile("s_waitcnt vmcnt(0)" ::: "memory");
    __syncthreads();
    if (threadIdx.x == 0) {
        unsigned* bar = b.bar;
        __builtin_amdgcn_s_waitcnt(0);
        unsigned nloc = b.st[0], nx = b.st[1];
        if (nloc == 0u) { xcd_barrier_complete(bar, b.x, nloc, nx); b.st[0] = nloc; b.st[1] = nx; }
        const unsigned old = xb_add(&bar[XB_XSUB(b.x)], 1u);
        const unsigned gen = old / nloc;
        if (old + 1u == (gen + 1u) * nloc) {
            __builtin_amdgcn_fence(__ATOMIC_RELEASE, "agent");
            asm volatile("s_waitcnt vmcnt(0)" ::: "memory");
            const unsigned og = xb_add(&bar[XB_TOP], 1u);
            const unsigned tg = og / nx;
            if (og + 1u == (tg + 1u) * nx) xb_add(&bar[XB_TOPGEN], 1u);
            else XB_SPIN(xb_ld(&bar[XB_TOPGEN]) == tg, bar);
            __builtin_amdgcn_fence(__ATOMIC_ACQUIRE, "agent");
            xb_add(&bar[XB_XGEN(b.x)], 1u);
            asm volatile("s_waitcnt vmcnt(0)" ::: "memory");
        } else {
            XB_SPIN(xb_ld(&bar[XB_XGEN(b.x)]) == gen, bar);
            __builtin_amdgcn_fence(__ATOMIC_ACQUIRE, "agent");
            asm volatile("s_waitcnt vmcnt(0)" ::: "memory");
        }
    }
    __syncthreads();
}


struct Args { const float* in[27]; float* out; unsigned char* ws; int ph_lo, ph_hi; };
struct Frame {
    LAS unsigned char* lds;
    int tid, lane, wave, vcu, G;
};

struct SchedMN {
    pg8::StaticOrder so;
    __device__ void init(int M, int N, int G, int c) { so.init(M, N, G, c); }
    __device__ __forceinline__ bool next(int i, pg8::Unit& u) const { return so.next(i, u); }
    __device__ __forceinline__ void a_ready(const pg8::Unit&) const {}
    __device__ __forceinline__ void done(const pg8::Unit&) const {}
};
struct SchedG1 {
    pg8::StaticOrder so; int G, c;
    __device__ void init(int G_, int c_) { so.init(MT, NIN, G_, c_); G = G_; c = c_; }
    __device__ __forceinline__ bool next(int i, pg8::Unit& u) const {
        const int L = i * G + c;
        if (L < so.nwg) return so.next(i, u);
        if (L < so.nwg + 7) { u.pm = MT / 256; u.pn = 8 + (L - so.nwg); return true; }
        return false;
    }
    __device__ __forceinline__ void a_ready(const pg8::Unit&) const {}
    __device__ __forceinline__ void done(const pg8::Unit&) const {}
};

using pg8::f32x4; using pg8::Unit;
typedef unsigned u32x4 __attribute__((ext_vector_type(4)));
struct EpiG1 {
    static constexpr bool PERM = true, AFTER_DRAIN = false;
    bf16 *UA, *UB, *UG;
    __device__ __forceinline__ void operator()(const f32x4 (&acc)[2][2][4][2], const Unit& u, int wr, int wc, int fr, int fq) const {
        bf16* base; int ld, colt;
        if (u.pn < 8) { base = UA; ld = ACOLS; colt = u.pn * 256; } else if (u.pn < 15) { base = UB; ld = BCOLS; colt = (u.pn - 8) * 256; } else { base = UG; ld = GCOLS; colt = (u.pn - 15) * 256; }
        const int row0 = u.pm * 256 + wr * 64 + fr, col0 = colt + wc * 32 + 8 * fq;
#pragma unroll
        for (int ai = 0; ai < 2; ++ai)
#pragma unroll
            for (int m = 0; m < 4; ++m) { bf16* rowp = base + (size_t)(row0 + ai * 128 + m * 16) * ld + col0;
#pragma unroll
                for (int bj = 0; bj < 2; ++bj) { const f32x4 v0 = acc[ai][bj][m][0], v1 = acc[ai][bj][m][1];
                    u32x4 w; w.x = pk2(v0[0], v0[1]); w.y = pk2(v0[2], v0[3]); w.z = pk2(v1[0], v1[1]); w.w = pk2(v1[2], v1[3]);
                    *(u32x4*)(rowp + bj * 128) = w; } }
    }
};
template <bool ADD> struct EpiMerge {
    static constexpr bool PERM = true, AFTER_DRAIN = false;
    bf16* Mg; const bf16* UG; int goff;
    __device__ __forceinline__ void operator()(const f32x4 (&acc)[2][2][4][2], const Unit& u, int wr, int wc, int fr, int fq) const {
        const int row0 = u.pm * 256 + wr * 64 + fr, col0 = u.pn * 256 + wc * 32 + 8 * fq;
#pragma unroll
        for (int ai = 0; ai < 2; ++ai)
#pragma unroll
            for (int m = 0; m < 4; ++m) { const size_t row = (size_t)(row0 + ai * 128 + m * 16);
#pragma unroll
                for (int bj = 0; bj < 2; ++bj) { const f32x4 v0 = acc[ai][bj][m][0], v1 = acc[ai][bj][m][1];
                    const u32x4 gq = *(const u32x4*)(UG + row * GCOLS + goff + col0 + bj * 128);
                    float o[8];
                    o[0] = sigmoidf_(bflo(gq.x)) * v0[0]; o[1] = sigmoidf_(bfhi(gq.x)) * v0[1]; o[2] = sigmoidf_(bflo(gq.y)) * v0[2]; o[3] = sigmoidf_(bfhi(gq.y)) * v0[3];
                    o[4] = sigmoidf_(bflo(gq.z)) * v1[0]; o[5] = sigmoidf_(bfhi(gq.z)) * v1[1]; o[6] = sigmoidf_(bflo(gq.w)) * v1[2]; o[7] = sigmoidf_(bfhi(gq.w)) * v1[3];
                    bf16* dst = Mg + row * ACOLS + col0 + bj * 128;
                    if (ADD) { const u32x4 p = *(const u32x4*)dst;
                        o[0] += bflo(p.x); o[1] += bfhi(p.x); o[2] += bflo(p.y); o[3] += bfhi(p.y); o[4] += bflo(p.z); o[5] += bfhi(p.z); o[6] += bflo(p.w); o[7] += bfhi(p.w); }
                    u32x4 w; w.x = pk2(o[0], o[1]); w.y = pk2(o[2], o[3]); w.z = pk2(o[4], o[5]); w.w = pk2(o[6], o[7]);
                    *(u32x4*)dst = w; } }
    }
};
template <bool RES_IS_X, bool WRITE_BF> struct EpiRes {
    static constexpr bool PERM = false, AFTER_DRAIN = false;
    const float* xp; const float* xs; float* out; bf16* xb; int ldb; float* ssq;
    __device__ __forceinline__ void operator()(const f32x4 (&acc)[2][2][4][2], const Unit& u, int wr, int wc, int fr, int fq) const {
        const int row0 = u.pm * 256 + wr * 64 + fr, col0 = u.pn * 256 + wc * 32 + 4 * fq;
#pragma unroll
        for (int ai = 0; ai < 2; ++ai)
#pragma unroll
            for (int m = 0; m < 4; ++m) { const int row = row0 + ai * 128 + m * 16;
                const float* rp = RES_IS_X ? (row < MP ? xp + (size_t)row * D : xs + (size_t)(row - MP) * D) : out + (size_t)row * D;
                float s = 0.f;
#pragma unroll
                for (int bj = 0; bj < 2; ++bj)
#pragma unroll
                    for (int n = 0; n < 2; ++n) { const int col = col0 + bj * 128 + n * 16;
                        const f32x4 r = *(const f32x4*)(rp + col); const f32x4 o = r + acc[ai][bj][m][n];
                        *(f32x4*)(out + (size_t)row * D + col) = o;
                        s += (o[0] * o[0] + o[1] * o[1]) + (o[2] * o[2] + o[3] * o[3]);
                        if (WRITE_BF) { v2u w; w.x = pk2(o[0], o[1]); w.y = pk2(o[2], o[3]); *(v2u*)(xb + (size_t)row * ldb + col) = w; } }
                s += __shfl_xor(s, 16); s += __shfl_xor(s, 32);
                if (fq == 0) ssq[(size_t)row * 16 + u.pn * 4 + wc] = s; }
    }
};
struct EpiUp {
    static constexpr bool PERM = true, AFTER_DRAIN = false;
    bf16* Hd; const float* ssq;
    __device__ __forceinline__ void operator()(const f32x4 (&acc)[2][2][4][2], const Unit& u, int wr, int wc, int fr, int fq) const {
        const int row0 = u.pm * 256 + wr * 64 + fr, col0 = u.pn * 256 + wc * 32 + 8 * fq;
#pragma unroll
        for (int ai = 0; ai < 2; ++ai)
#pragma unroll
            for (int m = 0; m < 4; ++m) { const size_t row = (size_t)(row0 + ai * 128 + m * 16);
                const f32x4* sp = (const f32x4*)(ssq + row * 16); const f32x4 a = sp[0], b = sp[1], c = sp[2], d = sp[3];
                const float tot = ((a[0] + a[1]) + (a[2] + a[3])) + ((b[0] + b[1]) + (b[2] + b[3])) + ((c[0] + c[1]) + (c[2] + c[3])) + ((d[0] + d[1]) + (d[2] + d[3]));
                const float rstd = rsqrtf(tot * (1.0f / D) + NORM_EPS);
#pragma unroll
                for (int bj = 0; bj < 2; ++bj) { const f32x4 v0 = acc[ai][bj][m][0], v1 = acc[ai][bj][m][1];
                    float o[8] = {v0[0], v0[1], v0[2], v0[3], v1[0], v1[1], v1[2], v1[3]};
#pragma unroll
                    for (int e = 0; e < 8; ++e) { const float t = fmaxf(o[e] * rstd, 0.f); o[e] = t * t; }
                    u32x4 w; w.x = pk2(o[0], o[1]); w.y = pk2(o[2], o[3]); w.z = pk2(o[4], o[5]); w.w = pk2(o[6], o[7]);
                    *(u32x4*)(Hd + row * DFF + col0 + bj * 128) = w; } }
    }
};

__device__ __forceinline__ void p0_transpose_item(const float* W, int K, int N, bf16* WT, const float* kscale, LAS float* scr, int item, int lane) {
    const int nblk = N / 32, kb = item / nblk, nb = item % nblk, k0 = 64 * kb, n0 = 32 * nb;
#pragma unroll 8
    for (int i = 0; i < 32; ++i) { const int kk = 2 * i + (lane >> 5); float v = W[(size_t)(k0 + kk) * N + n0 + (lane & 31)]; if (kscale) v *= kscale[k0 + kk]; scr[kk * 33 + (lane & 31)] = v; }
    LDS_WAIT(); asm volatile("" ::: "memory");
    const int c = lane & 7;
#pragma unroll
    for (int j = 0; j < 4; ++j) { const int n = (lane >> 3) + 8 * j; const LAS float* s = scr + (8 * c) * 33 + n;
        v4u o; o.x = pk2(s[0 * 33], s[1 * 33]); o.y = pk2(s[2 * 33], s[3 * 33]); o.z = pk2(s[4 * 33], s[5 * 33]); o.w = pk2(s[6 * 33], s[7 * 33]);
        *(GAS v4u*)(WT + (size_t)(n0 + n) * K + k0 + 8 * c) = o; }
    LDS_WAIT(); asm volatile("" ::: "memory");
}
__device__ __forceinline__ void p0_prologue(const Frame& F, const Args& A) {
    LAS float* scr = (LAS float*)(F.lds + F.wave * 16384);
    const int gw = F.vcu * NWAVES + F.wave, NGW = F.G * NWAVES;
    unsigned char* ws = A.ws;
    constexpr int I_IN = (D / 64) * (NIN / 32), I_A = (AW / 64) * (D / 32), I_O = (D / 64) * (D / 32), I_UP = (D / 64) * (DFF / 32), I_DN = (DFF / 64) * (D / 32);
    constexpr int NITEMS = I_IN + 2 * I_A + I_O + I_UP + I_DN;
    for (int it = gw; it < NITEMS; it += NGW) {
        int r = it;
        if (r < I_IN) { p0_transpose_item(A.in[6], D, NIN, (bf16*)(ws + WS_WIN), nullptr, scr, r, F.lane); continue; } r -= I_IN;
        if (r < I_A) { p0_transpose_item(A.in[20], AW, D, (bf16*)(ws + WS_WA), nullptr, scr, r, F.lane); continue; } r -= I_A;
        if (r < I_A) { p0_transpose_item(A.in[21], BW, D, (bf16*)(ws + WS_WB), nullptr, scr, r, F.lane); continue; } r -= I_A;
        if (r < I_O) { p0_transpose_item(A.in[22], D, D, (bf16*)(ws + WS_WO), nullptr, scr, r, F.lane); continue; } r -= I_O;
        if (r < I_UP) { p0_transpose_item(A.in[24], D, DFF, (bf16*)(ws + WS_WUP), A.in[23], scr, r, F.lane); continue; } r -= I_UP;
        p0_transpose_item(A.in[25], DFF, D, (bf16*)(ws + WS_WDN), nullptr, scr, r, F.lane);
    }
    bf16* H = (bf16*)A.out;
    const float* g = A.in[5];
    f32x4 gv[4];
#pragma unroll
    for (int j = 0; j < 4; ++j) gv[j] = ((const f32x4*)g)[F.lane + 64 * j];
    for (int m = gw; m < MH; m += NGW) {
        GAS unsigned long long* o8 = (GAS unsigned long long*)(H + (size_t)m * D) + F.lane;
        if (m < MT) {
            const float* xrow = m < MP ? A.in[0] + (size_t)m * D : A.in[1] + (size_t)(m - MP) * D;
            const f32x4* xr = (const f32x4*)xrow + F.lane;
            f32x4 v[4]; float s = 0.f;
#pragma unroll
            for (int j = 0; j < 4; ++j) { v[j] = xr[64 * j]; s += (v[j][0] * v[j][0] + v[j][1] * v[j][1]) + (v[j][2] * v[j][2] + v[j][3] * v[j][3]); }
            const float rstd = rsqrtf(wave_sum(s) * (1.0f / D) + NORM_EPS);
#pragma unroll
            for (int j = 0; j < 4; ++j) v[j] = v[j] * rstd * gv[j];
#pragma unroll
            for (int j = 0; j < 4; ++j) o8[64 * j] = (unsigned long long)pk2(v[j][0], v[j][1]) | ((unsigned long long)pk2(v[j][2], v[j][3]) << 32);
            float* so = nullptr;
            if (m < MP) { if ((m & (SEQ - 1)) == SEQ - 1) so = A.out + O_SHIFT_P + (size_t)(m >> 11) * D; }
            else { const int s_ = m - MP; if ((s_ & 3) == 3) so = A.out + O_SHIFT_S + (size_t)(s_ >> 2) * D; }
            if (so) {
#pragma unroll
                for (int j = 0; j < 4; ++j) ((f32x4*)so)[F.lane + 64 * j] = v[j];
            }
        } else if (m < MT + NBS) {
            const f32x4* xr = (const f32x4*)(A.in[4] + (size_t)(m - MT) * D) + F.lane;
#pragma unroll
            for (int j = 0; j < 4; ++j) { const f32x4 v = xr[64 * j]; o8[64 * j] = (unsigned long long)pk2(v[0], v[1]) | ((unsigned long long)pk2(v[2], v[3]) << 32); }
        } else {
#pragma unroll
            for (int j = 0; j < 4; ++j) o8[64 * j] = 0ull;
        }
    }
}

__device__ __forceinline__ int prev_row(int row) {
    if (row < MP) return (row & (SEQ - 1)) ? row - 1 : -1;
    const int s = row - MP; return (s & 3) ? row - 1 : MT + (s >> 2);
}
__device__ __forceinline__ float shifted(const bf16* UB, int row, int prow, int col, float mu) {
    const float ub = bf2f(UB[(size_t)row * BCOLS + col]);
    const float up = prow >= 0 ? bf2f(UB[(size_t)prow * BCOLS + col]) : 0.f;
    return ub + (up - ub) * mu;
}
__device__ __forceinline__ void p2_rwkv_prep(const Frame& F, const Args& A) {
    const bf16* UB = (const bf16*)(A.ws + WS_UB);
    bf16* P = (bf16*)A.out;
    float* bonus = (float*)(A.ws + WS_BONUS);
    LAS float* lw = (LAS float*)F.lds;
    const int c = F.tid;
    const float* mu = A.in[7];
    const float w0 = A.in[8][c], a0 = A.in[10][c], kkc = A.in[13][c], kac = A.in[14][c], rkc = A.in[15][c];
    const float mu_r = mu[c], mu_k = mu[512 + c];
    for (int tile = F.vcu; tile < MT / 32; tile += F.G) {
        const int r0 = tile * 32;
#pragma unroll
        for (int n = 0; n < 8; ++n) { const int idx = F.tid + 512 * n, tok = idx >> 7, k = idx & 127, row = r0 + tok;
            const float xm = shifted(UB, row, prev_row(row), 1536 + k, mu[1536 + k]);
            lw[tok * 128 + k] = k < 64 ? tanhf_(xm) : xm; }
        __syncthreads();
        {
            float Wd[64];
            const float* wp = A.in[9] + c; asm volatile("" : "+v"(wp));
#pragma unroll
            for (int k = 0; k < 64; ++k) Wd[k] = wp[k * BW];
#pragma unroll 1
            for (int tok = 0; tok < 32; ++tok) {
                float dec = 0.f;
                const LAS f32x4* l4 = (const LAS f32x4*)(lw + tok * 128);
#pragma unroll
                for (int k4 = 0; k4 < 16; ++k4) { const f32x4 t = l4[k4]; dec += t[0] * Wd[4 * k4] + t[1] * Wd[4 * k4 + 1] + t[2] * Wd[4 * k4 + 2] + t[3] * Wd[4 * k4 + 3]; }
                const float w = __expf(-DECAY_SCALE * sigmoidf_(w0 + dec));
                P[(size_t)(r0 + tok) * 2048 + c] = (bf16)f2bf(w);
            }
        }
        {
            float Wa[64];
            const float* wp = A.in[11] + c; asm volatile("" : "+v"(wp));
#pragma unroll
            for (int k = 0; k < 64; ++k) Wa[k] = wp[k * BW];
#pragma unroll 1
            for (int tok = 0; tok < 32; ++tok) {
                const int row = r0 + tok, prow = prev_row(row);
                float aa = 0.f;
                const LAS f32x4* l4 = (const LAS f32x4*)(lw + tok * 128 + 64);
#pragma unroll
                for (int k4 = 0; k4 < 16; ++k4) { const f32x4 u = l4[k4]; aa += u[0] * Wa[4 * k4] + u[1] * Wa[4 * k4 + 1] + u[2] * Wa[4 * k4 + 2] + u[3] * Wa[4 * k4 + 3]; }
                const float a = sigmoidf_(a0 + aa);
                const float xr = shifted(UB, row, prow, c, mu_r), xk = shifted(UB, row, prow, 512 + c, mu_k);
                const float kp = xk * kkc;
                const float nrm = fmaxf(sqrtf(wave_sum(kp * kp)), 1e-12f);
                const float kk = kp / nrm;
                const float k2 = xk * (1.0f + (a - 1.0f) * kac);
                const float bs = wave_sum(xr * k2 * rkc);
                bf16* pr = P + (size_t)row * 2048 + c;
                pr[512] = (bf16)f2bf(k2); pr[1024] = (bf16)f2bf(kk); pr[1536] = (bf16)f2bf(kk * a);
                if (F.lane == 0) bonus[(size_t)row * 8 + F.wave] = bs;
            }
        }
        __syncthreads();
    }
}

constexpr int TB = 32;
__device__ __forceinline__ void rwkv_scan_unit(const Frame& F, const Args& A, int row0, int T, int h, int half, const float* s_in, float* s_out) {
    const bf16* P = (const bf16*)A.out;
    bf16* UB = (bf16*)(A.ws + WS_UB);
    LAS float* buf = (LAS float*)F.lds;
    constexpr int STEPF = 384, BUFF = TB * STEPF;
    const int cg = F.lane & 15, i = half * 32 + F.wave * 4 + (F.lane >> 4);
    const int e = F.tid * 16, ls = e >> 8, lq = (e >> 6) & 3, lj = e & 63;
    const int lslot = lq == 0 ? 0 : (lq == 1 ? 3 : (lq == 2 ? 1 : 2));
    const int e2 = F.tid * 8, ls2 = e2 >> 7, lq2 = (e2 >> 6) & 1, lj2 = e2 & 63;
    const int ucol = lq2 * 1024 + h * 64 + lj2;
    float mu8[8];
#pragma unroll
    for (int k = 0; k < 8; ++k) mu8[k] = A.in[7][ucol + k];
    f32x4 S;
    if (s_in) S = *(const f32x4*)(s_in + i * 64 + 4 * cg); else S = (f32x4){0.f, 0.f, 0.f, 0.f};
    const int nblk = (T + TB - 1) / TB;
    v4u p0, p1, uc, up;
    auto load_block = [&](int blk) {
        const int t0 = blk * TB;
        p0 = (v4u){0, 0, 0, 0}; p1 = p0; uc = p0; up = p0;
        if (t0 + ls < T) { const v4u* src = (const v4u*)(P + (size_t)(row0 + t0 + ls) * 2048 + lq * 512 + h * 64 + lj); p0 = src[0]; p1 = src[1]; }
        if (t0 + ls2 < T) { const int row = row0 + t0 + ls2, prow = prev_row(row);
            uc = *(const v4u*)(UB + (size_t)row * BCOLS + ucol);
            if (prow >= 0) up = *(const v4u*)(UB + (size_t)prow * BCOLS + ucol); }
    };
    auto store_block = [&](int b) {
        LAS float* d = buf + b * BUFF + ls * STEPF + lslot * 64 + lj;
        *(LAS f32x4*)(d) = (f32x4){bflo(p0.x), bfhi(p0.x), bflo(p0.y), bfhi(p0.y)};
        *(LAS f32x4*)(d + 4) = (f32x4){bflo(p0.z), bfhi(p0.z), bflo(p0.w), bfhi(p0.w)};
        *(LAS f32x4*)(d + 8) = (f32x4){bflo(p1.x), bfhi(p1.x), bflo(p1.y), bfhi(p1.y)};
        *(LAS f32x4*)(d + 12) = (f32x4){bflo(p1.z), bfhi(p1.z), bflo(p1.w), bfhi(p1.w)};
        LAS float* d2 = buf + b * BUFF + ls2 * STEPF + (4 + lq2) * 64 + lj2;
        float c8[8] = {bflo(uc.x), bfhi(uc.x), bflo(uc.y), bfhi(uc.y), bflo(uc.z), bfhi(uc.z), bflo(uc.w), bfhi(uc.w)};
        float q8[8] = {bflo(up.x), bfhi(up.x), bflo(up.y), bfhi(up.y), bflo(up.z), bfhi(up.z), bflo(up.w), bfhi(up.w)};
#pragma unroll
        for (int k = 0; k < 8; ++k) c8[k] = c8[k] + (q8[k] - c8[k]) * mu8[k];
        *(LAS f32x4*)(d2) = (f32x4){c8[0], c8[1], c8[2], c8[3]};
        *(LAS f32x4*)(d2 + 4) = (f32x4){c8[4], c8[5], c8[6], c8[7]};
    };
    __syncthreads();
    load_block(0); store_block(0);
    __syncthreads();
    for (int blk = 0; blk < nblk; ++blk) {
        if (blk + 1 < nblk) load_block(blk + 1);
        const LAS float* bb = buf + (blk & 1) * BUFF;
        const int ns = (T - blk * TB) < TB ? (T - blk * TB) : TB;
        bf16* yout = UB + (size_t)(row0 + blk * TB) * BCOLS + 512 + h * 64 + i;
        for (int s = 0; s < ns; ++s) {
            const LAS float* v = bb + s * STEPF;
            const f32x4 w4 = *(const LAS f32x4*)(v + 4 * cg), kk4 = *(const LAS f32x4*)(v + 64 + 4 * cg), ka4 = *(const LAS f32x4*)(v + 128 + 4 * cg),
                        k4 = *(const LAS f32x4*)(v + 192 + 4 * cg), r4 = *(const LAS f32x4*)(v + 256 + 4 * cg);
            const float vi = v[320 + i];
            float sk = (S[0] * kk4[0] + S[1] * kk4[1]) + (S[2] * kk4[2] + S[3] * kk4[3]);
            sk = row_sum16(sk);
            S[0] = S[0] * w4[0] - sk * ka4[0] + vi * k4[0];
            S[1] = S[1] * w4[1] - sk * ka4[1] + vi * k4[1];
            S[2] = S[2] * w4[2] - sk * ka4[2] + vi * k4[2];
            S[3] = S[3] * w4[3] - sk * ka4[3] + vi * k4[3];
            float y = (S[0] * r4[0] + S[1] * r4[1]) + (S[2] * r4[2] + S[3] * r4[3]);
            y = row_sum16(y);
            if (cg == 0) yout[(size_t)s * BCOLS] = (bf16)f2bf(y);
        }
        if (blk + 1 < nblk) store_block((blk + 1) & 1);
        __syncthreads();
    }
    *(f32x4*)(s_out + i * 64 + 4 * cg) = S;
}

typedef short bf16x8_t __attribute__((ext_vector_type(8)));
typedef short bf16x4_t __attribute__((ext_vector_type(4)));
typedef float f32x16 __attribute__((ext_vector_type(16)));
#define MFMA32(a, b, c) __builtin_amdgcn_mfma_f32_32x32x16_bf16((a), (b), (c), 0, 0, 0)
__device__ __forceinline__ int crow(int reg, int hh) { return (reg & 3) + 8 * (reg >> 2) + 4 * hh; }
__device__ __forceinline__ bf16x8_t pack8(float a0, float a1, float a2, float a3, float a4, float a5, float a6, float a7) {
    v4u p; p.x = pk2(a0, a1); p.y = pk2(a2, a3); p.z = pk2(a4, a5); p.w = pk2(a6, a7); return __builtin_bit_cast(bf16x8_t, p);
}
constexpr int HC = 64;
constexpr int H_TP = 72;
constexpr int H_KP = 136;
constexpr int H_OP = 132;
struct HPre { float b[16], kd[16], blast, bmid; };
__device__ __forceinline__ void hgrn_pre(const Frame& F, const bf16* UA, int row0, int h, float lbk, LAS float* segsum, HPre& R) {
    const int k = F.tid & 127, seg = F.tid >> 7;
    const bf16* src = UA + (size_t)(row0 + 16 * seg) * ACOLS + 512 + h * 128 + k;
    float run = 0.f;
#pragma unroll
    for (int j = 0; j < 16; ++j) { const float sg = sigmoidf_(bf2f(src[(size_t)j * ACOLS])); R.kd[j] = (1.0f - lbk) * (1.0f - sg); run += __logf(lbk + (1.0f - lbk) * sg); R.b[j] = run; }
    segsum[seg * 128 + k] = run;
    __syncthreads();
    const float s0 = segsum[k], s1 = segsum[128 + k], s2 = segsum[256 + k], s3 = segsum[384 + k];
    const float pre = seg == 0 ? 0.f : (seg == 1 ? s0 : (seg == 2 ? s0 + s1 : s0 + s1 + s2));
#pragma unroll
    for (int j = 0; j < 16; ++j) R.b[j] += pre;
    R.bmid = s0 + s1; R.blast = (s0 + s1) + (s2 + s3);
}
__device__ __forceinline__ void hgrn_load_vt(const Frame& F, const bf16* UA, int row0, int h, LAS bf16* VT) {
    const int v = F.tid & 127, seg = F.tid >> 7;
    const bf16* src = UA + (size_t)(row0 + 16 * seg) * ACOLS + 1024 + h * 128 + v;
    unsigned w[8];
#pragma unroll
    for (int j = 0; j < 8; ++j) w[j] = (unsigned)src[(size_t)(2 * j) * ACOLS] | ((unsigned)src[(size_t)(2 * j + 1) * ACOLS] << 16);
    LAS v4u* d = (LAS v4u*)(VT + v * H_TP + 16 * seg);
    d[0] = (v4u){w[0], w[1], w[2], w[3]}; d[1] = (v4u){w[4], w[5], w[6], w[7]};
}
__device__ __forceinline__ void h1_unit(const Frame& F, const Args& A, int unit) {
    const bf16* UA = (const bf16*)(A.ws + WS_UA);
    bf16* NS = (bf16*)(A.ws + WS_NS) + (size_t)unit * 16384;
    float* gam = (float*)(A.ws + WS_GAMMA) + (size_t)unit * 128;
    const int bh = unit >> 5, c = unit & 31, b = bh >> 2, h = bh & 3, row0 = b * SEQ + c * HC;
    LAS bf16* KhT = (LAS bf16*)F.lds;
    LAS bf16* VT = KhT + 128 * H_TP;
    LAS float* segsum = (LAS float*)(VT + 128 * H_TP);
    const int k = F.tid & 127, seg = F.tid >> 7;
    const float lbk = 1.0f / (1.0f + __expf(A.in[18][512 + h * 128 + k] - A.in[18][h * 128 + k]));
    HPre R; hgrn_pre(F, UA, row0, h, lbk, segsum, R);
    {   unsigned w[8];
#pragma unroll
        for (int j = 0; j < 8; ++j) w[j] = pk2(R.kd[2 * j] * __expf(R.blast - R.b[2 * j]), R.kd[2 * j + 1] * __expf(R.blast - R.b[2 * j + 1]));
        LAS v4u* d = (LAS v4u*)(KhT + k * H_TP + 16 * seg);
        d[0] = (v4u){w[0], w[1], w[2], w[3]}; d[1] = (v4u){w[4], w[5], w[6], w[7]}; }
    if (seg == 0) gam[k] = __expf(R.blast);
    hgrn_load_vt(F, UA, row0, h, VT);
    __syncthreads();
    const int r = F.lane & 31, hh = F.lane >> 5, vt = F.wave >> 1, kt0 = (F.wave & 1) * 2;
    f32x16 acc0, acc1;
#pragma unroll
    for (int i = 0; i < 16; ++i) { acc0[i] = 0.f; acc1[i] = 0.f; }
#pragma unroll
    for (int s = 0; s < 4; ++s) {
        const bf16x8_t a = *(const LAS bf16x8_t*)(VT + (vt * 32 + r) * H_TP + 16 * s + 8 * hh);
        const bf16x8_t b0 = *(const LAS bf16x8_t*)(KhT + (kt0 * 32 + r) * H_TP + 16 * s + 8 * hh);
        const bf16x8_t b1 = *(const LAS bf16x8_t*)(KhT + ((kt0 + 1) * 32 + r) * H_TP + 16 * s + 8 * hh);
        acc0 = MFMA32(a, b0, acc0); acc1 = MFMA32(a, b1, acc1);
    }
#pragma unroll
    for (int i = 0; i < 16; ++i) { const int v = vt * 32 + crow(i, hh);
        NS[v * 128 + kt0 * 32 + r] = (bf16)f2bf(acc0[i]); NS[v * 128 + (kt0 + 1) * 32 + r] = (bf16)f2bf(acc1[i]); }
    __syncthreads();
}
__device__ __forceinline__ void h2_part(const Frame& F, const Args& A, int part, int nparts) {
    bf16* NS = (bf16*)(A.ws + WS_NS);
    const float* gam = (const float*)(A.ws + WS_GAMMA);
    for (int e = part * 512 + F.tid; e < 32 * 2048; e += nparts * 512) {
        const int bh = e >> 11, vk = e & 2047, v = vk >> 4, k0 = (vk & 15) * 8;
        float S[8];
#pragma unroll
        for (int j = 0; j < 8; ++j) S[j] = 0.f;
        for (int c = 0; c < 32; ++c) {
            v4u* p = (v4u*)(NS + (size_t)(bh * 32 + c) * 16384 + v * 128 + k0);
            const v4u n = *p;
            const f32x4 g0 = *(const f32x4*)(gam + (size_t)(bh * 32 + c) * 128 + k0), g1 = *(const f32x4*)(gam + (size_t)(bh * 32 + c) * 128 + k0 + 4);
            v4u o; o.x = pk2(S[0], S[1]); o.y = pk2(S[2], S[3]); o.z = pk2(S[4], S[5]); o.w = pk2(S[6], S[7]);
            *p = o;
            S[0] = g0[0] * S[0] + bflo(n.x); S[1] = g0[1] * S[1] + bfhi(n.x); S[2] = g0[2] * S[2] + bflo(n.y); S[3] = g0[3] * S[3] + bfhi(n.y);
            S[4] = g1[0] * S[4] + bflo(n.z); S[5] = g1[1] * S[5] + bfhi(n.z); S[6] = g1[2] * S[6] + bflo(n.w); S[7] = g1[3] * S[7] + bfhi(n.w);
        }
        float* so = A.out + O_HGRN_P + (size_t)bh * 16384 + v;
#pragma unroll
        for (int j = 0; j < 8; ++j) so[(size_t)(k0 + j) * 128] = S[j];
    }
}
__device__ __forceinline__ void h3_unit(const Frame& F, const Args& A, int unit) {
    bf16* UA = (bf16*)(A.ws + WS_UA);
    const bf16* NS = (const bf16*)(A.ws + WS_NS) + (size_t)unit * 16384;
    const int bh = unit >> 5, c = unit & 31, b = bh >> 2, h = bh & 3, row0 = b * SEQ + c * HC;
    LAS bf16* Qh = (LAS bf16*)F.lds;
    LAS bf16* Qt = Qh + 64 * H_KP;
    LAS bf16* Kt = Qt + 64 * H_KP;
    LAS bf16* VT = Kt + 64 * H_KP;
    LAS float* segsum = (LAS float*)(VT + 128 * H_TP);
    LAS float* ssq = segsum + 512;
    LAS float* Ost = ssq + 256;
    const int k = F.tid & 127, seg = F.tid >> 7;
    const float lbk = 1.0f / (1.0f + __expf(A.in[18][512 + h * 128 + k] - A.in[18][h * 128 + k]));
    HPre R; hgrn_pre(F, UA, row0, h, lbk, segsum, R);
    {   const bf16* qsrc = UA + (size_t)(row0 + 16 * seg) * ACOLS + h * 128 + k;
#pragma unroll
        for (int j = 0; j < 16; ++j) { const float q = bf2f(qsrc[(size_t)j * ACOLS]); const float qs = q * sigmoidf_(q); const int t = 16 * seg + j;
            Qh[t * H_KP + k] = (bf16)f2bf(qs * __expf(R.b[j]));
            Qt[t * H_KP + k] = (bf16)f2bf(qs * __expf(R.b[j] - R.bmid));
            Kt[t * H_KP + k] = (bf16)f2bf(R.kd[j] * __expf(R.bmid - R.b[j])); } }
    hgrn_load_vt(F, UA, row0, h, VT);
    __syncthreads();
    const int r = F.lane & 31, hh = F.lane >> 5, vt = F.wave >> 1, tt = F.wave & 1;
    f32x16 o;
#pragma unroll
    for (int i = 0; i < 16; ++i) o[i] = 0.f;
#pragma unroll
    for (int st = 0; st < 2; ++st) {
        if (st <= tt) {
            f32x16 at;
#pragma unroll
            for (int i = 0; i < 16; ++i) at[i] = 0.f;
#pragma unroll
            for (int ks = 0; ks < 8; ++ks) {
                const bf16x8_t a = *(const LAS bf16x8_t*)(Kt + (st * 32 + r) * H_KP + 16 * ks + 8 * hh);
                const bf16x8_t bq = *(const LAS bf16x8_t*)(Qt + (tt * 32 + r) * H_KP + 16 * ks + 8 * hh);
                at = MFMA32(a, bq, at);
            }
            if (st == tt) {
#pragma unroll
                for (int i = 0; i < 16; ++i) if (crow(i, hh) > r) at[i] = 0.f;
            }
#pragma unroll
            for (int ks = 0; ks < 2; ++ks) {
                const bf16x4_t lo = *(const LAS bf16x4_t*)(VT + (vt * 32 + r) * H_TP + st * 32 + 16 * ks + 4 * hh);
                const bf16x4_t hi = *(const LAS bf16x4_t*)(VT + (vt * 32 + r) * H_TP + st * 32 + 16 * ks + 8 + 4 * hh);
                const bf16x8_t a = __builtin_shufflevector(lo, hi, 0, 1, 2, 3, 4, 5, 6, 7);
                const bf16x8_t bx = pack8(at[8 * ks], at[8 * ks + 1], at[8 * ks + 2], at[8 * ks + 3], at[8 * ks + 4], at[8 * ks + 5], at[8 * ks + 6], at[8 * ks + 7]);
                o = MFMA32(a, bx, o);
            }
        }
    }
    if (c > 0) {
#pragma unroll
        for (int ks = 0; ks < 8; ++ks) {
            const bf16x8_t a = *(const bf16x8_t*)(NS + (vt * 32 + r) * 128 + 16 * ks + 8 * hh);
            const bf16x8_t bq = *(const LAS bf16x8_t*)(Qh + (tt * 32 + r) * H_KP + 16 * ks + 8 * hh);
            o = MFMA32(a, bq, o);
        }
    }
    {   float s = 0.f;
#pragma unroll
        for (int i = 0; i < 16; ++i) { s += o[i] * o[i]; Ost[(tt * 32 + r) * H_OP + vt * 32 + crow(i, hh)] = o[i]; }
        s += __shfl_xor(s, 32);
        if (hh == 0) ssq[vt * 64 + tt * 32 + r] = s; }
    __syncthreads();
    {   const int t = F.tid >> 3, vg = F.tid & 7, row = row0 + t;
        const float tot = (ssq[t] + ssq[64 + t]) + (ssq[128 + t] + ssq[192 + t]);
        const float rs = rsqrtf(tot * (1.0f / 128.0f) + HGRN_EPS);
        const LAS f32x4* op = (const LAS f32x4*)(Ost + t * H_OP + 16 * vg);
        const v4u* gp = (const v4u*)(UA + (size_t)row * ACOLS + 1536 + h * 128 + 16 * vg);
        const f32x4* nwp = (const f32x4*)(A.in[19] + h * 128 + 16 * vg);
        v4u outw[2];
#pragma unroll
        for (int half = 0; half < 2; ++half) {
            const v4u g = gp[half]; const f32x4 o0 = op[2 * half], o1 = op[2 * half + 1], n0 = nwp[2 * half], n1 = nwp[2 * half + 1];
            const float gg[8] = {bflo(g.x), bfhi(g.x), bflo(g.y), bfhi(g.y), bflo(g.z), bfhi(g.z), bflo(g.w), bfhi(g.w)};
            const float ov[8] = {o0[0] * n0[0], o0[1] * n0[1], o0[2] * n0[2], o0[3] * n0[3], o1[0] * n1[0], o1[1] * n1[1], o1[2] * n1[2], o1[3] * n1[3]};
            float f[8];
#pragma unroll
            for (int e = 0; e < 8; ++e) f[e] = ov[e] * rs * (gg[e] * sigmoidf_(gg[e]));
            outw[half] = (v4u){pk2(f[0], f[1]), pk2(f[2], f[3]), pk2(f[4], f[5]), pk2(f[6], f[7])};
        }
        v4u* dst = (v4u*)(UA + (size_t)row * ACOLS + 1024 + h * 128 + 16 * vg);
        dst[0] = outw[0]; dst[1] = outw[1]; }
    __syncthreads();
}
__device__ __forceinline__ void hgrn_sample_unit(const Frame& F, const Args& A, int bh) {
    bf16* UA = (bf16*)(A.ws + WS_UA);
    const int b = bh >> 2, h = bh & 3, row0 = MP + 4 * b;
    LAS float* vec = (LAS float*)F.lds;
    LAS float* opart = vec + 4 * 384;
    LAS float* red = opart + 2048;
    const int v = F.tid & 127, kq = F.tid >> 7;
    {   const int t = kq, k = v, ch = h * 128 + k;
        const float lbk = 1.0f / (1.0f + __expf(A.in[18][512 + ch] - A.in[18][ch]));
        const float sg = sigmoidf_(bf2f(UA[(size_t)(row0 + t) * ACOLS + 512 + ch])), q = bf2f(UA[(size_t)(row0 + t) * ACOLS + ch]);
        vec[t * 384 + k] = lbk + (1.0f - lbk) * sg; vec[t * 384 + 128 + k] = (1.0f - lbk) * (1.0f - sg); vec[t * 384 + 256 + k] = q * sigmoidf_(q); }
    float iv[4];
#pragma unroll
    for (int t = 0; t < 4; ++t) iv[t] = bf2f(UA[(size_t)(row0 + t) * ACOLS + 1024 + h * 128 + v]);
    const float* sin_ = A.in[2] + (size_t)bh * 16384 + (size_t)(32 * kq) * 128 + v;
    float S[32];
#pragma unroll
    for (int j = 0; j < 32; ++j) S[j] = sin_[(size_t)j * 128];
    __syncthreads();
#pragma unroll
    for (int t = 0; t < 4; ++t) {
        const LAS float* fv = vec + t * 384 + 32 * kq;
        float o = 0.f;
#pragma unroll
        for (int j4 = 0; j4 < 8; ++j4) { const f32x4 f = *(const LAS f32x4*)(fv + 4 * j4), d = *(const LAS f32x4*)(fv + 128 + 4 * j4), q = *(const LAS f32x4*)(fv + 256 + 4 * j4);
#pragma unroll
            for (int e = 0; e < 4; ++e) { S[4 * j4 + e] = f[e] * S[4 * j4 + e] + d[e] * iv[t]; o += S[4 * j4 + e] * q[e]; } }
        opart[(t * 4 + kq) * 128 + v] = o;
    }
    float* sout = A.out + O_HGRN_S + (size_t)bh * 16384 + (size_t)(32 * kq) * 128 + v;
#pragma unroll
    for (int j = 0; j < 32; ++j) sout[(size_t)j * 128] = S[j];
    __syncthreads();
    {   const int t = kq;
        const float o = (opart[(t * 4 + 0) * 128 + v] + opart[(t * 4 + 1) * 128 + v]) + (opart[(t * 4 + 2) * 128 + v] + opart[(t * 4 + 3) * 128 + v]);
        const float ss = wave_sum(o * o);
        if (F.lane == 0) red[F.wave] = ss;
        __syncthreads();
        const float tot = red[F.wave & ~1] + red[F.wave | 1];
        const int ch = h * 128 + v; const size_t row = (size_t)(row0 + t);
        const float g = bf2f(UA[row * ACOLS + 1536 + ch]);
        UA[row * ACOLS + 1024 + ch] = (bf16)f2bf(o * rsqrtf(tot * (1.0f / 128.0f) + HGRN_EPS) * A.in[19][ch] * (g * sigmoidf_(g))); }
    __syncthreads();
}

__device__ __forceinline__ void p3_scans(const Frame& F, const Args& A) {
    for (int u = F.vcu; u < 128; u += F.G) { const int b = u >> 4, h = (u >> 1) & 7, half = u & 1;
        rwkv_scan_unit(F, A, b * SEQ, SEQ, h, half, nullptr, A.out + O_WKV_P + (size_t)(b * 8 + h) * 4096); }
    if (F.G > 128) { if (F.vcu >= 128) h2_part(F, A, F.vcu - 128, F.G - 128); } else h2_part(F, A, F.vcu, F.G);
    for (int u = F.vcu; u < 2048; u += F.G) { const int bh = u >> 1, half = u & 1, b = bh >> 3, h = bh & 7;
        rwkv_scan_unit(F, A, MP + 4 * b, TS, h, half, A.in[3] + (size_t)bh * 4096, A.out + O_WKV_S + (size_t)bh * 4096); }
}

__device__ __forceinline__ void p4_post(const Frame& F, const Args& A) {
    bf16* UB = (bf16*)(A.ws + WS_UB);
    const float* bonus = (const float*)(A.ws + WS_BONUS);
    LAS float* lg = (LAS float*)F.lds;
    const int c = F.tid;
    const float* mu = A.in[7];
    LAS float* gbuf = lg + 32 * 128;
    const float lnw = A.in[16][c], lnb = A.in[17][c], mu_v = mu[1024 + c];
    for (int tile = F.vcu; tile < MT / 32; tile += F.G) {
        const int r0 = tile * 32;
#pragma unroll
        for (int n = 0; n < 8; ++n) { const int idx = F.tid + 512 * n, tok = idx >> 7, k = idx & 127, row = r0 + tok;
            lg[tok * 128 + k] = sigmoidf_(shifted(UB, row, prev_row(row), 1664 + k, mu[1664 + k])); }
        __syncthreads();
        {
            float Wg[64];
            const float* wp = A.in[12] + c; asm volatile("" : "+v"(wp));
#pragma unroll
            for (int k = 0; k < 64; ++k) Wg[k] = wp[k * BW];
#pragma unroll 1
            for (int tok = 0; tok < 32; ++tok) {
                float g = 0.f;
                const LAS f32x4* l4 = (const LAS f32x4*)(lg + tok * 128);
#pragma unroll
                for (int k4 = 0; k4 < 16; ++k4) { const f32x4 t = l4[k4]; g += t[0] * Wg[4 * k4] + t[1] * Wg[4 * k4 + 1] + t[2] * Wg[4 * k4 + 2] + t[3] * Wg[4 * k4 + 3]; }
                gbuf[tok * 512 + c] = g;
            }
        }
        {
            float Wg[64];
            const float* wp = A.in[12] + 64 * BW + c; asm volatile("" : "+v"(wp));
#pragma unroll
            for (int k = 0; k < 64; ++k) Wg[k] = wp[k * BW];
#pragma unroll 1
            for (int tok = 0; tok < 32; ++tok) {
                const int row = r0 + tok, prow = prev_row(row);
                float g = gbuf[tok * 512 + c];
                const LAS f32x4* l4 = (const LAS f32x4*)(lg + tok * 128 + 64);
#pragma unroll
                for (int k4 = 0; k4 < 16; ++k4) { const f32x4 t = l4[k4]; g += t[0] * Wg[4 * k4] + t[1] * Wg[4 * k4 + 1] + t[2] * Wg[4 * k4 + 2] + t[3] * Wg[4 * k4 + 3]; }
                const float y = bf2f(UB[(size_t)row * BCOLS + 512 + c]);
                const float mean = wave_sum(y) * (1.0f / 64.0f), dlt = y - mean;
                const float var = wave_sum(dlt * dlt) * (1.0f / 64.0f);
                const float yn = dlt * rsqrtf(var + GN_EPS) * lnw + lnb;
                const float vv = shifted(UB, row, prow, 1024 + c, mu_v);
                const float ob = (yn + bonus[(size_t)row * 8 + F.wave] * vv) * g;
                UB[(size_t)row * BCOLS + 512 + c] = (bf16)f2bf(ob);
            }
        }
        __syncthreads();
    }
}

__device__ __forceinline__ void p9_final(const Frame& F, const Args& A) {
    const int gw = F.vcu * NWAVES + F.wave, NGW = F.G * NWAVES;
    const float* ssq = (const float*)(A.ws + WS_SSQ2);
    f32x4 gv[4];
#pragma unroll
    for (int j = 0; j < 4; ++j) gv[j] = ((const f32x4*)A.in[26])[F.lane + 64 * j];
    for (int m = gw; m < MT; m += NGW) {
        const f32x4* sp = (const f32x4*)(ssq + (size_t)m * 16); const f32x4 a = sp[0], b = sp[1], c = sp[2], d = sp[3];
        const float tot = ((a[0] + a[1]) + (a[2] + a[3])) + ((b[0] + b[1]) + (b[2] + b[3])) + ((c[0] + c[1]) + (c[2] + c[3])) + ((d[0] + d[1]) + (d[2] + d[3]));
        const float rstd = rsqrtf(tot * (1.0f / D) + NORM_EPS);
        f32x4* xr = (f32x4*)(A.out + (size_t)m * D) + F.lane;
#pragma unroll
        for (int j = 0; j < 4; ++j) xr[64 * j] = xr[64 * j] * rstd * gv[j];
    }
}

__global__ void __launch_bounds__(NWAVES * 64, 2) fwd(Args args) {
    extern __shared__ __attribute__((aligned(16))) unsigned char lds[];
    Frame F;
    F.lds = (LAS unsigned char*)lds;
    F.tid = threadIdx.x; F.lane = F.tid & 63; F.wave = __builtin_amdgcn_readfirstlane(F.tid >> 6);
    F.G = gridDim.x; { const int bx = blockIdx.x; F.vcu = (F.G % 8 == 0) ? (bx % 8) * (F.G / 8) + bx / 8 : bx; }
    unsigned char* ws = args.ws;
    gu32* ctl = (gu32*)(ws + WS_CTL);
    for (int u = F.tid; u < (LDS_BYTES - LDSCTL_OFF) / 4; u += NWAVES * 64) ((LAS unsigned*)(F.lds + LDSCTL_OFF))[u] = 0u;
    __syncthreads();
    volatile LAS unsigned* MISC = (volatile LAS unsigned*)(F.lds + MISC_OFF);
    XcdBarrier bar; bar.bar = (unsigned*)(ctl + CW_BAR); bar.x = 0; bar.st = nullptr;
    if (MK_N_LAUNCHES == 1) bar = xcd_barrier_post((unsigned*)(ctl + CW_BAR), MISC + 8);
    const int lo = args.ph_lo, hi = args.ph_hi;
#ifndef PH_MASK
#define PH_MASK 0x3ff
#endif
#ifndef DUP_MASK
#define DUP_MASK 0
#endif
#define REP(k) for (int rep_ = 0; rep_ < (((DUP_MASK >> (k)) & 1) ? 2 : 1); ++rep_)
#define IN(k) (((PH_MASK >> (k)) & 1) && lo <= (k) && (k) < hi)
#define SEAM(k) do { if (IN(k) && IN((k) + 1)) xcd_barrier(bar); } while (0)
    bf16* UA = (bf16*)(ws + WS_UA); bf16* UB = (bf16*)(ws + WS_UB); bf16* UG = (bf16*)(ws + WS_UG);

    if (IN(0)) REP(0) { p0_prologue(F, args); } SEAM(0);
    if (IN(1)) REP(1) {
        pg8::Gemm g{(const bf16*)args.out, (const bf16*)(ws + WS_WIN), MH, NIN, D, D, D};
        SchedG1 S; S.init(F.G, (int)blockIdx.x);
        EpiG1 E{UA, UB, UG};
        pg8::gemm_phase<EpiG1, SchedG1, true, true>(F.lds, g, S, E);
    } SEAM(1);
    if (IN(2)) { p2_rwkv_prep(F, args); for (int u = F.vcu; u < 1024; u += F.G) h1_unit(F, args, u); } SEAM(2);
    if (IN(3)) { p3_scans(F, args); } SEAM(3);
    if (IN(4)) { p4_post(F, args); for (int u = F.vcu; u < 1024; u += F.G) h3_unit(F, args, u); for (int u = F.vcu; u < 512; u += F.G) hgrn_sample_unit(F, args, u); } SEAM(4);
    if (IN(5)) REP(5) {
        SchedMN S; S.init(MT, D, F.G, (int)blockIdx.x);
        { pg8::Gemm g{UA + 1024, (const bf16*)(ws + WS_WA), MT, D, AW, ACOLS, AW}; EpiMerge<false> E{UA, UG, 0};
          pg8::gemm_phase<EpiMerge<false>, SchedMN, true, true>(F.lds, g, S, E); }
        { pg8::Gemm g{UB + 512, (const bf16*)(ws + WS_WB), MT, D, BW, BCOLS, BW}; EpiMerge<true> E{UA, UG, 1024};
          pg8::gemm_phase<EpiMerge<true>, SchedMN, true, true>(F.lds, g, S, E); }
    } SEAM(5);
    if (IN(6)) REP(6) {
        SchedMN S; S.init(MT, D, F.G, (int)blockIdx.x);
        pg8::Gemm g{UA, (const bf16*)(ws + WS_WO), MT, D, D, ACOLS, D};
        EpiRes<true, true> E{args.in[0], args.in[1], args.out, UB, BCOLS, (float*)(ws + WS_SSQ1)};
        pg8::gemm_phase<EpiRes<true, true>, SchedMN, true, true>(F.lds, g, S, E);
    } SEAM(6);
    if (IN(7)) REP(7) {
        SchedMN S; S.init(MT, DFF, F.G, (int)blockIdx.x);
        pg8::Gemm g{UB, (const bf16*)(ws + WS_WUP), MT, DFF, D, BCOLS, D};
        EpiUp E{UA, (const float*)(ws + WS_SSQ1)};
        pg8::gemm_phase<EpiUp, SchedMN, true, true>(F.lds, g, S, E);
    } SEAM(7);
    if (IN(8)) {
        SchedMN S; S.init(MT, D, F.G, (int)blockIdx.x);
        pg8::Gemm g{UA, (const bf16*)(ws + WS_WDN), MT, D, DFF, DFF, DFF};
        EpiRes<false, false> E{nullptr, nullptr, args.out, nullptr, 0, (float*)(ws + WS_SSQ2)};
        pg8::gemm_phase<EpiRes<false, false>, SchedMN, true, true>(F.lds, g, S, E);
    } SEAM(8);
    if (IN(9)) { p9_final(F, args); }
#undef IN
#undef SEAM
}

extern "C" void kernel_launch(void* const* d_in, const int* in_sizes, int n_in, void* d_out, int out_size, void* d_ws, size_t ws_size, hipStream_t stream) {
    static int grid = 0;
    if (grid == 0) {
        if (n_in != 27 || out_size != (int)O_END || ws_size < WS_END) { fprintf(stderr, "kernel_launch: unexpected shapes (n_in %d, out %d, ws %zu)\n", n_in, out_size, ws_size); grid = -1; return; }
        int dev = 0, cus = 0, per_cu = 0;
        if (hipGetDevice(&dev) != hipSuccess || hipDeviceGetAttribute(&cus, hipDeviceAttributeMultiprocessorCount, dev) != hipSuccess) { grid = -1; return; }
        if (hipFuncSetAttribute((const void*)fwd, hipFuncAttributeMaxDynamicSharedMemorySize, LDS_BYTES) != hipSuccess) { fprintf(stderr, "kernel_launch: hipFuncSetAttribute failed\n"); grid = -1; return; }
        if (hipOccupancyMaxActiveBlocksPerMultiprocessor(&per_cu, (const void*)fwd, NWAVES * 64, LDS_BYTES) != hipSuccess || per_cu < 1) { fprintf(stderr, "kernel_launch: occupancy query says %d\n", per_cu); }
        (void)hipGetLastError();
        grid = cus;
    }
    if (grid < 0) return;
    (void)hipMemsetAsync((char*)d_ws + WS_CTL, 0, CTL_BYTES, stream);
    Args a{};
    for (int i = 0; i < 27; ++i) a.in[i] = (const float*)d_in[i];
    a.out = (float*)d_out; a.ws = (unsigned char*)d_ws;
    if (MK_N_LAUNCHES == 1) { a.ph_lo = 0; a.ph_hi = NPHASE; hipLaunchKernelGGL(fwd, dim3(grid), dim3(NWAVES * 64), LDS_BYTES, stream, a); }
    else for (int p = 0; p < NPHASE; ++p) { a.ph_lo = p; a.ph_hi = p + 1; hipLaunchKernelGGL(fwd, dim3(grid), dim3(NWAVES * 64), LDS_BYTES, stream, a); }
}
```

```cpp
#include <hip/hip_runtime.h>
#include <cstdio>
#include <cstdint>
namespace pg8 {
#define PG8_LAS __attribute__((address_space(3)))
typedef unsigned short bf16_t;
typedef short bf16x8 __attribute__((ext_vector_type(8)));
typedef float f32x4 __attribute__((ext_vector_type(4)));
typedef unsigned u32x4 __attribute__((ext_vector_type(4)));
constexpr int BM = 256, BK = 64, HALF = 128, HTB = HALF * BK * 2  , STAGE_BYTES = 8 * HTB, NXCD = 8, WGM = 8;

__host__ __device__ __forceinline__ int lds_byte(int r, int c) { const int st = (r >> 4) * 2 + (c >> 5), rr = r & 15, cc = c & 31, ob = rr * 64 + cc * 2; return st * 1024 + (ob ^ (((ob >> 9) & 1) << 5)); }
__host__ __device__ __forceinline__ void stage_rc(int b, int& R, int& C) { const int st = b / 1024, sb = b % 1024, swz = sb ^ (((sb >> 9) & 1) << 5); R = (st >> 1) * 16 + swz / 64; C = (st & 1) * 32 + (swz % 64) / 2; }
__host__ __device__ __forceinline__ int perm32(int rho) { const int n = rho >> 4, i = rho & 15; return 8 * (i >> 2) + 4 * n + (i & 3); }

struct Unit { int pm, pn; };
struct Gemm { const bf16_t* A; const bf16_t* Bt; int M, N, K, lda, ldb; };

struct StaticOrder {
    int nM, nN, nwg, G, c;
    __host__ __device__ void init(int M, int N, int G_, int c_) { nM = M / BM; nN = N / BM; nwg = nM * nN; G = G_; c = c_; }
    __host__ __device__ bool next(int i, Unit& u) const {
        const long L = (long)i * G + c; if (L >= nwg) return false;
        int wgid = (int)L; { const int q = nwg / NXCD, r = nwg % NXCD, xcd = wgid % NXCD, off = wgid / NXCD; wgid = (xcd < r ? xcd * (q + 1) : r * (q + 1) + (xcd - r) * q) + off; }
        const int nig = WGM * nN, gid = wgid / nig, fm = gid * WGM, gsz = (nM - fm) < WGM ? (nM - fm) : WGM;
        u.pm = fm + ((wgid % nig) % gsz); u.pn = (wgid % nig) / gsz; return true;
    }
    __device__ __forceinline__ void a_ready(const Unit&) const {}
    __device__ __forceinline__ void done(const Unit&) const {}
};

__device__ __forceinline__ unsigned cvt_pk_bf16(float lo, float hi) { unsigned r; asm volatile("v_cvt_pk_bf16_f32 %0, %1, %2" : "=v"(r) : "v"(lo), "v"(hi)); return r; }
typedef float f32x2 __attribute__((ext_vector_type(2)));
__device__ __forceinline__ f32x2 gelu_pk(f32x2 v) {
    const f32x2 av = __builtin_elementwise_abs(v), d = av * 0.2316418882f + 1.0f;
    f32x2 t; t.x = __builtin_amdgcn_rcpf(d.x); t.y = __builtin_amdgcn_rcpf(d.y);
    f32x2 q = t * 0.5307027145f + (-0.7265760135f); q = q * t + 0.7107068705f; q = q * t + (-0.142248368f); q = q * t + 0.127414796f; q = q * t;
    const f32x2 s = (v * v) * (-0.72134752044f);
    f32x2 e; e.x = __builtin_amdgcn_exp2f(s.x); e.y = __builtin_amdgcn_exp2f(s.y);
    const f32x2 m = v * (q * e), r = v - m;
    f32x2 o; o.x = v.x < 0.f ? m.x : r.x; o.y = v.y < 0.f ? m.y : r.y; return o;
}

template <class Epi, class Sched, bool ALIGN_EPI = false, bool SP2 = false>
__device__ __forceinline__ void gemm_phase(PG8_LAS unsigned char* lds, const Gemm g, const Sched& S, const Epi& E) {
    const int tid = threadIdx.x, wid = __builtin_amdgcn_readfirstlane(tid >> 6), lane = tid & 63, wr = wid >> 2, wc = wid & 3, fr = lane & 15, fq = lane >> 4;
    const int K = g.K, nt = K / BK;
    unsigned voffA[2], voffB[2];
#pragma unroll
    for (int i = 0; i < 2; ++i) { int R, C; stage_rc(tid * 16 + i * 8192, R, C); const int Rb = Epi::PERM ? ((R & ~31) + perm32(R & 31)) : R;
        voffA[i] = (unsigned)(R * g.lda + C) * 2u; voffB[i] = (unsigned)(Rb * g.ldb + C) * 2u; }
    const size_t kstep = (size_t)(BK * 2);
    const size_t hstepA = (size_t)HALF * g.lda * 2, hstepB = (size_t)HALF * g.ldb * 2;
    const size_t tstepA = 2 * hstepA, tstepB = 2 * hstepB;
    const unsigned ldsw = (unsigned)wid * 1024u;
    const int aoff = lds_byte(wr * 64 + fr, fq * 8), boff = lds_byte(wc * 32 + fr, fq * 8);
#define PG8_SA(b, h) (((b) * 2 + (h)) * HTB)
#define PG8_SB(b, h) ((4 + (b) * 2 + (h)) * HTB)
#define PG8_STAGE(bufoff, gbase, voff) do { _Pragma("unroll") for (int _i = 0; _i < 2; ++_i) \
        __builtin_amdgcn_global_load_lds((const unsigned*)((const char*)(gbase) + (voff)[_i]), (PG8_LAS unsigned*)(lds + (bufoff) + ldsw + _i * 8192), 16, 0, 0); } while (0)
#define PG8_LDA(dst, b, h) do { _Pragma("unroll") for (int m = 0; m < 4; ++m) _Pragma("unroll") for (int k = 0; k < 2; ++k) dst[m][k] = *(const PG8_LAS bf16x8*)(lds + PG8_SA(b, h) + aoff + m * 2048 + k * 1024); } while (0)
#define PG8_LDB(dst, b, h) do { _Pragma("unroll") for (int n = 0; n < 2; ++n) _Pragma("unroll") for (int k = 0; k < 2; ++k) dst[n][k] = *(const PG8_LAS bf16x8*)(lds + PG8_SB(b, h) + boff + n * 2048 + k * 1024); } while (0)
#define PG8_MMA(ai, bj, At, Bt) do { __builtin_amdgcn_s_setprio(1); _Pragma("unroll") for (int m = 0; m < 4; ++m) _Pragma("unroll") for (int n = 0; n < 2; ++n) _Pragma("unroll") for (int k = 0; k < 2; ++k) \
        acc[ai][bj][m][n] = __builtin_amdgcn_mfma_f32_16x16x32_bf16(Bt[n][k], At[m][k], acc[ai][bj][m][n], 0, 0, 0); __builtin_amdgcn_s_setprio(0); } while (0)
#define PG8_WAIT_V(n) asm volatile("s_waitcnt vmcnt(" #n ")" ::: "memory")
#define PG8_WAIT_L(n) asm volatile("s_waitcnt lgkmcnt(" #n ")" ::: "memory")
#define PG8_BAR __builtin_amdgcn_s_barrier()
#define PG8_SCHED __builtin_amdgcn_sched_barrier(0)
    Unit cur, nxt; int ui = 0;
    if (!S.next(0, cur)) return;
    f32x4 acc[2][2][4][2];
#pragma unroll
    for (int a = 0; a < 2; ++a)
#pragma unroll
        for (int b = 0; b < 2; ++b)
#pragma unroll
            for (int m = 0; m < 4; ++m)
#pragma unroll
                for (int n = 0; n < 2; ++n) acc[a][b][m][n] = (f32x4){0.f, 0.f, 0.f, 0.f};
    bf16x8 At[4][2], B0[2][2], B1[2][2];
    const char* cA = (const char*)g.A + (size_t)cur.pm * tstepA; const char* cB = (const char*)g.Bt + (size_t)cur.pn * tstepB;
    S.a_ready(cur);
    if constexpr (SP2) {
        PG8_STAGE(PG8_SB(0, 0), cB, voffB); PG8_STAGE(PG8_SB(0, 1), cB + hstepB, voffB); PG8_STAGE(PG8_SA(0, 0), cA, voffA); PG8_STAGE(PG8_SA(0, 1), cA + hstepA, voffA);
        if (wr == 1) PG8_BAR;
        PG8_WAIT_V(2); PG8_BAR;
        PG8_STAGE(PG8_SB(1, 0), cB + kstep, voffB); PG8_STAGE(PG8_SA(1, 0), cA + kstep, voffA); PG8_STAGE(PG8_SB(1, 1), cB + hstepB + kstep, voffB);
        PG8_WAIT_V(6); PG8_BAR;
    } else {
        PG8_STAGE(PG8_SB(0, 0), cB, voffB); PG8_STAGE(PG8_SA(0, 0), cA, voffA); PG8_STAGE(PG8_SB(0, 1), cB + hstepB, voffB); PG8_STAGE(PG8_SA(0, 1), cA + hstepA, voffA);
        if (wr == 1) PG8_BAR;
        PG8_WAIT_V(4); PG8_BAR;
        PG8_STAGE(PG8_SB(1, 0), cB + kstep, voffB); PG8_STAGE(PG8_SA(1, 0), cA + kstep, voffA); PG8_STAGE(PG8_SB(1, 1), cB + hstepB + kstep, voffB);
        PG8_WAIT_V(6); PG8_BAR;
    }
    for (;;) {
        const bool has_next = S.next(ui + 1, nxt);
        const char* nA = has_next ? (const char*)g.A + (size_t)nxt.pm * tstepA : cA; const char* nB = has_next ? (const char*)g.Bt + (size_t)nxt.pn * tstepB : cB;
        for (int t = 0; t < nt; t += 2) {
            const bool last = (t == nt - 2);
            const char* a1 = cA + (size_t)(t + 1) * kstep;
            const char* a2 = last ? nA : cA + (size_t)(t + 2) * kstep; const char* b2 = last ? nB : cB + (size_t)(t + 2) * kstep;
            const char* a3 = a2 + kstep; const char* b3 = b2 + kstep;
            if (last && has_next) S.a_ready(nxt);
            if constexpr (SP2) {
            PG8_LDB(B0, 0, 0); PG8_LDB(B1, 0, 1); PG8_SCHED; PG8_LDA(At, 0, 0); PG8_STAGE(PG8_SA(1, 1), a1 + hstepA, voffA);
            PG8_WAIT_V(8); PG8_WAIT_L(0); PG8_BAR; PG8_MMA(0, 0, At, B0); PG8_MMA(0, 1, At, B1); PG8_BAR; PG8_SCHED;
            PG8_LDA(At, 0, 1); PG8_STAGE(PG8_SB(0, 0), b2, voffB); PG8_STAGE(PG8_SB(0, 1), b2 + hstepB, voffB); PG8_STAGE(PG8_SA(0, 0), a2, voffA);
            PG8_WAIT_V(8); PG8_WAIT_L(0); PG8_BAR; PG8_MMA(1, 0, At, B0); PG8_MMA(1, 1, At, B1); PG8_BAR; PG8_SCHED;
            PG8_LDB(B0, 1, 0); PG8_LDB(B1, 1, 1); PG8_SCHED; PG8_LDA(At, 1, 0); PG8_STAGE(PG8_SA(0, 1), a2 + hstepA, voffA);
            PG8_WAIT_V(8); PG8_WAIT_L(0); PG8_BAR; PG8_MMA(0, 0, At, B0); PG8_MMA(0, 1, At, B1); PG8_BAR; PG8_SCHED;
            PG8_LDA(At, 1, 1); PG8_STAGE(PG8_SB(1, 0), b3, voffB); PG8_STAGE(PG8_SB(1, 1), b3 + hstepB, voffB); PG8_STAGE(PG8_SA(1, 0), a3, voffA);
            PG8_WAIT_V(8); PG8_WAIT_L(0); PG8_BAR; PG8_MMA(1, 0, At, B0); PG8_MMA(1, 1, At, B1); PG8_BAR; PG8_SCHED;
            } else {
            PG8_LDB(B0, 0, 0); PG8_SCHED; PG8_LDA(At, 0, 0); PG8_STAGE(PG8_SA(1, 1), a1 + hstepA, voffA);
            PG8_WAIT_L(8); PG8_BAR; PG8_WAIT_L(0); PG8_MMA(0, 0, At, B0); PG8_BAR; PG8_SCHED;
            PG8_LDB(B1, 0, 1); PG8_STAGE(PG8_SB(0, 0), b2, voffB);
            PG8_BAR; PG8_WAIT_L(0); PG8_MMA(0, 1, At, B1); PG8_BAR;
            PG8_LDA(At, 0, 1); PG8_STAGE(PG8_SA(0, 0), a2, voffA);
            PG8_BAR; PG8_WAIT_L(0); PG8_MMA(1, 0, At, B0); PG8_BAR; PG8_SCHED;
            PG8_STAGE(PG8_SB(0, 1), b2 + hstepB, voffB);
            PG8_WAIT_V(6); PG8_BAR; PG8_MMA(1, 1, At, B1); PG8_BAR;
            PG8_LDB(B0, 1, 0); PG8_SCHED; PG8_LDA(At, 1, 0); PG8_STAGE(PG8_SA(0, 1), a2 + hstepA, voffA);
            PG8_WAIT_L(8); PG8_BAR; PG8_WAIT_L(0); PG8_MMA(0, 0, At, B0); PG8_BAR; PG8_SCHED;
            PG8_LDB(B1, 1, 1); PG8_STAGE(PG8_SB(1, 0), b3, voffB);
            PG8_BAR; PG8_WAIT_L(0); PG8_MMA(0, 1, At, B1); PG8_BAR;
            PG8_LDA(At, 1, 1); PG8_STAGE(PG8_SA(1, 0), a3, voffA);
            PG8_BAR; PG8_WAIT_L(0); PG8_MMA(1, 0, At, B0); PG8_BAR; PG8_SCHED;
            PG8_STAGE(PG8_SB(1, 1), b3 + hstepB, voffB);
            PG8_WAIT_V(6); PG8_BAR; PG8_MMA(1, 1, At, B1); PG8_BAR;
            }
        }
        if constexpr (ALIGN_EPI) { if (wr == 0) PG8_BAR; }
        if constexpr (!Epi::AFTER_DRAIN) { E(acc, cur, wr, wc, fr, fq); S.done(cur); }
        if (!has_next) break;
#pragma unroll
        for (int a = 0; a < 2; ++a)
#pragma unroll
            for (int b = 0; b < 2; ++b)
#pragma unroll
                for (int m = 0; m < 4; ++m)
#pragma unroll
                    for (int n = 0; n < 2; ++n) acc[a][b][m][n] = (f32x4){0.f, 0.f, 0.f, 0.f};
        cur = nxt; cA = nA; cB = nB; ++ui;
        if constexpr (ALIGN_EPI) { if (wr == 1) PG8_BAR; }
    }
    PG8_WAIT_V(0);
    if constexpr (!ALIGN_EPI) { if (wr == 0) PG8_BAR; }
    PG8_BAR;
    if constexpr (Epi::AFTER_DRAIN) { E.fused(acc, cur, wr, wc, fr, fq, lds, wid, lane); S.done(cur); }
#undef PG8_SA
#undef PG8_SB
#undef PG8_STAGE
#undef PG8_LDA
#undef PG8_LDB
#undef PG8_MMA
#undef PG8_WAIT_V
#undef PG8_WAIT_L
#undef PG8_BAR
#undef PG8_SCHED
}
}

#ifndef MK_N_LAUNCHES
#define MK_N_LAUNCHES 1
#endif
constexpr int NPHASE = 10;
constexpr int NWAVES = 8;

constexpr int D = 1024, SEQ = 2048, NBP = 8, NBS = 128, TS = 4;
constexpr int MP = NBP * SEQ;
constexpr int MS = NBS * TS;
constexpr int MT = MP + MS;
constexpr int MH = MT + 256;
constexpr int ACOLS = 2048, BCOLS = 1792, GCOLS = 2048, NIN = ACOLS + BCOLS + GCOLS, DFF = 4096;
constexpr int AW = 512, BW = 512;
constexpr float NORM_EPS = 1e-6f, HGRN_EPS = 1e-5f, GN_EPS = 64e-5f, DECAY_SCALE = 0.6065306597126334f;

constexpr size_t O_Y = 0, O_HGRN_P = (size_t)MT * D, O_WKV_P = O_HGRN_P + (size_t)NBP * 4 * 128 * 128, O_SHIFT_P = O_WKV_P + (size_t)NBP * 8 * 64 * 64,
                 O_HGRN_S = O_SHIFT_P + (size_t)NBP * D, O_WKV_S = O_HGRN_S + (size_t)NBS * 4 * 128 * 128, O_SHIFT_S = O_WKV_S + (size_t)NBS * 8 * 64 * 64,
                 O_END = O_SHIFT_S + (size_t)NBS * D;
static_assert(O_END == 30810112, "d_out size");

constexpr size_t WS_CTL = 0, CTL_BYTES = 65536;
constexpr size_t WS_WIN = WS_CTL + CTL_BYTES;
constexpr size_t WS_WA  = WS_WIN + (size_t)NIN * D * 2;
constexpr size_t WS_WB  = WS_WA + (size_t)D * AW * 2;
constexpr size_t WS_WO  = WS_WB + (size_t)D * BW * 2;
constexpr size_t WS_WUP = WS_WO + (size_t)D * D * 2;
constexpr size_t WS_WDN = WS_WUP + (size_t)DFF * D * 2;
constexpr size_t WS_UB  = WS_WDN + (size_t)D * DFF * 2;
constexpr size_t WS_UA  = WS_UB + (size_t)MH * BCOLS * 2;
constexpr size_t WS_UG  = WS_UA + (size_t)MT * ACOLS * 2;
constexpr size_t WS_BONUS = WS_UG + (size_t)MT * GCOLS * 2;
constexpr size_t WS_NS = WS_BONUS + (size_t)MT * 8 * 4;
constexpr size_t WS_GAMMA = WS_NS + (size_t)1024 * 16384 * 2;
constexpr size_t WS_WDT = WS_GAMMA + (size_t)1024 * 128 * 4;
constexpr size_t WS_WAT = WS_WDT + 512 * 64 * 2;
constexpr size_t WS_WGT = WS_WAT + 512 * 64 * 2;
constexpr size_t WS_END = WS_WGT + 512 * 128 * 2;
constexpr size_t WS_SSQ1 = WS_NS;
constexpr size_t WS_SSQ2 = WS_SSQ1 + (size_t)MT * 16 * 4;
static_assert(WS_END <= 268435456, "d_ws map");
static_assert(WS_UA + (size_t)MT * DFF * 2 == WS_BONUS, "hidden overlays UA|UG exactly");
static_assert((size_t)MT * 2048 * 2 == (size_t)MT * D * 4, "P fits the y region exactly");

constexpr int CW_TMO = 0, CW_BAR = 1024;

constexpr int RING_BYTES = 151552, LDSCTL_OFF = RING_BYTES, MISC_OFF = LDSCTL_OFF + 320, LDS_BYTES = 163840;

#define GAS __attribute__((address_space(1)))
#define LAS __attribute__((address_space(3)))
typedef unsigned short bf16;
typedef unsigned v4u __attribute__((ext_vector_type(4)));
typedef unsigned v2u __attribute__((ext_vector_type(2)));
typedef float f32x4 __attribute__((ext_vector_type(4)));
typedef GAS unsigned gu32;
#define RLX_AGENT __ATOMIC_RELAXED, __HIP_MEMORY_SCOPE_AGENT
#define LDS_WAIT() asm volatile("s_waitcnt lgkmcnt(0)" ::: "memory")
#define VM_WAIT() asm volatile("s_waitcnt vmcnt(0)" ::: "memory")
__device__ __forceinline__ unsigned f2bf(float f) { unsigned u = __builtin_bit_cast(unsigned, f); return (u + 0x7fffu + ((u >> 16) & 1u)) >> 16; }
__device__ __forceinline__ unsigned pk2(float lo, float hi) { return f2bf(lo) | (f2bf(hi) << 16); }
__device__ __forceinline__ float bf2f(unsigned b) { return __builtin_bit_cast(float, b << 16); }
__device__ __forceinline__ float bflo(unsigned w) { return __builtin_bit_cast(float, w << 16); }
__device__ __forceinline__ float bfhi(unsigned w) { return __builtin_bit_cast(float, w & 0xffff0000u); }
__device__ __forceinline__ float sigmoidf_(float x) { return 1.0f / (1.0f + __expf(-x)); }
__device__ __forceinline__ float tanhf_(float x) { return 1.0f - 2.0f / (1.0f + __expf(2.0f * x)); }
__device__ __forceinline__ float wave_sum(float v) {
#pragma unroll
    for (int o = 1; o < 64; o <<= 1) v += __shfl_xor(v, o);
    return v;
}
__device__ __forceinline__ float row_sum16(float x) {
    x += __builtin_bit_cast(float, __builtin_amdgcn_update_dpp(0, __builtin_bit_cast(int, x), 0xB1, 0xF, 0xF, true));
    x += __builtin_bit_cast(float, __builtin_amdgcn_update_dpp(0, __builtin_bit_cast(int, x), 0x4E, 0xF, 0xF, true));
    x += __builtin_bit_cast(float, __builtin_amdgcn_update_dpp(0, __builtin_bit_cast(int, x), 0x141, 0xF, 0xF, true));
    x += __builtin_bit_cast(float, __builtin_amdgcn_update_dpp(0, __builtin_bit_cast(int, x), 0x140, 0xF, 0xF, true));
    return x;
}
#define XB_TMO      128
#define XB_XCNT(j)  (256  + 64 * (j))
#define XB_XSUB(j)  (1280 + 64 * (j))
#define XB_XGEN(j)  (2304 + 64 * (j))
#define XB_TOP      3328
#define XB_TOPGEN   3392
#define XCD_BAR_WORDS 3456
#define XB_SPIN_CAP (1u << 18)

__device__ __forceinline__ unsigned xb_ld(unsigned* p)              { return __hip_atomic_load(p, __ATOMIC_RELAXED, __HIP_MEMORY_SCOPE_AGENT); }
__device__ __forceinline__ unsigned xb_add(unsigned* p, unsigned v) { return __hip_atomic_fetch_add(p, v, __ATOMIC_RELAXED, __HIP_MEMORY_SCOPE_AGENT); }
__device__ __forceinline__ unsigned xb_xcc_id() { return (unsigned)__builtin_amdgcn_s_getreg((3 << 11) | 20) & 0xFu; }
#define XB_SPIN(cond, bar) do { unsigned _sp = 0; while (cond) { __builtin_amdgcn_s_sleep(1); \
    if ((++_sp & 255u) == 0u) { if (xb_ld(&(bar)[XB_TMO])) break; if (_sp > XB_SPIN_CAP) { atomicAdd(&(bar)[XB_TMO], 1u); break; } } } } while (0)

struct XcdBarrier {
    unsigned* bar; unsigned x;
    volatile LAS unsigned* st;
};

__device__ __forceinline__ XcdBarrier xcd_barrier_post(unsigned* bar, volatile LAS unsigned* st) {
    XcdBarrier b; b.bar = bar; b.x = xb_xcc_id(); b.st = st;
    if (threadIdx.x == 0) (void)xb_add(&bar[XB_XCNT(b.x)], 1u);
    return b;
}
__device__ __forceinline__ void xcd_barrier_complete(unsigned* bar, unsigned x, unsigned& nloc, unsigned& nx) {
    const unsigned G = gridDim.x * gridDim.y * gridDim.z;
    unsigned sum, cnt, mine, sp = 0u;
    for (;;) {
        sum = 0u; cnt = 0u; mine = 0u;
#pragma unroll
        for (unsigned j = 0; j < 16; ++j) { const unsigned c = xb_ld(&bar[XB_XCNT(j)]); sum += c; cnt += (c > 0u) ? 1u : 0u; mine = (j == x) ? c : mine; }
        if (sum == G) break;
        __builtin_amdgcn_s_sleep(1);
        if ((++sp & 255u) == 0u) { if (xb_ld(&bar[XB_TMO])) break; if (sp > XB_SPIN_CAP) { atomicAdd(&bar[XB_TMO], 1u); break; } }
    }
    nloc = mine > 0u ? mine : 1u; nx = cnt > 0u ? cnt : 1u;
}

__device__ __forceinline__ void xcd_barrier(const XcdBarrier& b) {
    asm volatile("s_waitcnt vmcnt(0)" ::: "memory");
    __syncthreads();
    if (threadIdx.x == 0) {
        unsigned* bar = b.bar;
        __builtin_amdgcn_s_waitcnt(0);
        unsigned nloc = b.st[0], nx = b.st[1];
        if (nloc == 0u) { xcd_barrier_complete(bar, b.x, nloc, nx); b.st[0] = nloc; b.st[1] = nx; }
        const unsigned old = xb_add(&bar[XB_XSUB(b.x)], 1u);
        const unsigned gen = old / nloc;
        if (old + 1u == (gen + 1u) * nloc) {
            __builtin_amdgcn_fence(__ATOMIC_RELEASE, "agent");
            asm volatile("s_waitcnt vmcnt(0)" ::: "memory");
            const unsigned og = xb_add(&bar[XB_TOP], 1u);
            const unsigned tg = og / nx;
            if (og + 1u == (tg + 1u) * nx) xb_add(&bar[XB_TOPGEN], 1u);
            else XB_SPIN(xb_ld(&bar[XB_TOPGEN]) == tg, bar);
            __builtin_amdgcn_fence(__ATOMIC_ACQUIRE, "agent");
            xb_add(&bar[XB_XGEN(b.x)], 1u);
            asm volatile("s_waitcnt vmcnt(0)" ::: "memory");
        } else {
            XB_SPIN(xb_ld(&bar[XB_XGEN(b.x)]) == gen, bar);
            __builtin_amdgcn_fence(__ATOMIC_ACQUIRE, "agent");
            asm volatile("s_waitcnt vmcnt(0)" ::: "memory");
        }
    }
    __syncthreads();
}


struct Args { const float* in[27]; float* out; unsigned char* ws; int ph_lo, ph_hi; };
struct Frame {
    LAS unsigned char* lds;
    int tid, lane, wave, vcu, G;
};

struct SchedMN {
    pg8::StaticOrder so;
    __device__ void init(int M, int N, int G, int c) { so.init(M, N, G, c); }
    __device__ __forceinline__ bool next(int i, pg8::Unit& u) const { return so.next(i, u); }
    __device__ __forceinline__ void a_ready(const pg8::Unit&) const {}
    __device__ __forceinline__ void done(const pg8::Unit&) const {}
};
struct SchedG1 {
    pg8::StaticOrder so; int G, c;
    __device__ void init(int G_, int c_) { so.init(MT, NIN, G_, c_); G = G_; c = c_; }
    __device__ __forceinline__ bool next(int i, pg8::Unit& u) const {
        const int L = i * G + c;
        if (L < so.nwg) return so.next(i, u);
        if (L < so.nwg + 7) { u.pm = MT / 256; u.pn = 8 + (L - so.nwg); return true; }
        return false;
    }
    __device__ __forceinline__ void a_ready(const pg8::Unit&) const {}
    __device__ __forceinline__ void done(const pg8::Unit&) const {}
};

using pg8::f32x4; using pg8::Unit;
typedef unsigned u32x4 __attribute__((ext_vector_type(4)));
struct EpiG1 {
    static constexpr bool PERM = true, AFTER_DRAIN = false;
    bf16 *UA, *UB, *UG, *BR;
    __device__ __forceinline__ void operator()(const f32x4 (&acc)[2][2][4][2], const Unit& u, int wr, int wc, int fr, int fq) const {
        bf16* base; int ld, colt;
        if (u.pn < 8) { base = UA; ld = ACOLS; colt = u.pn * 256; } else if (u.pn < 15) { base = UB; ld = BCOLS; colt = (u.pn - 8) * 256; } else { base = UG; ld = GCOLS; colt = (u.pn - 15) * 256; }
        const int row0 = u.pm * 256 + wr * 64 + fr, col0 = colt + wc * 32 + 8 * fq;
#pragma unroll
        for (int ai = 0; ai < 2; ++ai)
#pragma unroll
            for (int m = 0; m < 4; ++m) { bf16* rowp = base + (size_t)(row0 + ai * 128 + m * 16) * ld + col0;
#pragma unroll
                for (int bj = 0; bj < 2; ++bj) { const f32x4 v0 = acc[ai][bj][m][0], v1 = acc[ai][bj][m][1];
                    u32x4 w; w.x = pk2(v0[0], v0[1]); w.y = pk2(v0[2], v0[3]); w.z = pk2(v1[0], v1[1]); w.w = pk2(v1[2], v1[3]);
                    *(u32x4*)(rowp + bj * 128) = w;
                    if ((m & 1) && fr == 15 && u.pn >= 8 && u.pn < 14 && u.pm < MP / 256) { const int row = row0 + ai * 128 + m * 16; *(u32x4*)(BR + (size_t)(row >> 5) * 1536 + col0 + bj * 128) = w; } } }
    }
};
template <bool ADD> struct EpiMerge {
    static constexpr bool PERM = true, AFTER_DRAIN = false;
    bf16* Mg; const bf16* UG; int goff;
    __device__ __forceinline__ void operator()(const f32x4 (&acc)[2][2][4][2], const Unit& u, int wr, int wc, int fr, int fq) const {
        const int row0 = u.pm * 256 + wr * 64 + fr, col0 = u.pn * 256 + wc * 32 + 8 * fq;
#pragma unroll
        for (int ai = 0; ai < 2; ++ai)
#pragma unroll
            for (int m = 0; m < 4; ++m) { const size_t row = (size_t)(row0 + ai * 128 + m * 16);
#pragma unroll
                for (int bj = 0; bj < 2; ++bj) { const f32x4 v0 = acc[ai][bj][m][0], v1 = acc[ai][bj][m][1];
                    const u32x4 gq = *(const u32x4*)(UG + row * GCOLS + goff + col0 + bj * 128);
                    float o[8];
                    o[0] = sigmoidf_(bflo(gq.x)) * v0[0]; o[1] = sigmoidf_(bfhi(gq.x)) * v0[1]; o[2] = sigmoidf_(bflo(gq.y)) * v0[2]; o[3] = sigmoidf_(bfhi(gq.y)) * v0[3];
                    o[4] = sigmoidf_(bflo(gq.z)) * v1[0]; o[5] = sigmoidf_(bfhi(gq.z)) * v1[1]; o[6] = sigmoidf_(bflo(gq.w)) * v1[2]; o[7] = sigmoidf_(bfhi(gq.w)) * v1[3];
                    bf16* dst = Mg + row * ACOLS + col0 + bj * 128;
                    if (ADD) { const u32x4 p = *(const u32x4*)dst;
                        o[0] += bflo(p.x); o[1] += bfhi(p.x); o[2] += bflo(p.y); o[3] += bfhi(p.y); o[4] += bflo(p.z); o[5] += bfhi(p.z); o[6] += bflo(p.w); o[7] += bfhi(p.w); }
                    u32x4 w; w.x = pk2(o[0], o[1]); w.y = pk2(o[2], o[3]); w.z = pk2(o[4], o[5]); w.w = pk2(o[6], o[7]);
                    *(u32x4*)dst = w; } }
    }
};
template <bool RES_IS_X, bool WRITE_BF> struct EpiRes {
    static constexpr bool PERM = false, AFTER_DRAIN = false;
    const float* xp; const float* xs; float* out; bf16* xb; int ldb; float* ssq;
    __device__ __forceinline__ void operator()(const f32x4 (&acc)[2][2][4][2], const Unit& u, int wr, int wc, int fr, int fq) const {
        const int row0 = u.pm * 256 + wr * 64 + fr, col0 = u.pn * 256 + wc * 32 + 4 * fq;
#pragma unroll
        for (int ai = 0; ai < 2; ++ai)
#pragma unroll
            for (int m = 0; m < 4; ++m) { const int row = row0 + ai * 128 + m * 16;
                const float* rp = RES_IS_X ? (row < MP ? xp + (size_t)row * D : xs + (size_t)(row - MP) * D) : out + (size_t)row * D;
                float s = 0.f;
#pragma unroll
                for (int bj = 0; bj < 2; ++bj)
#pragma unroll
                    for (int n = 0; n < 2; ++n) { const int col = col0 + bj * 128 + n * 16;
                        const f32x4 r = *(const f32x4*)(rp + col); const f32x4 o = r + acc[ai][bj][m][n];
                        *(f32x4*)(out + (size_t)row * D + col) = o;
                        s += (o[0] * o[0] + o[1] * o[1]) + (o[2] * o[2] + o[3] * o[3]);
                        if (WRITE_BF) { v2u w; w.x = pk2(o[0], o[1]); w.y = pk2(o[2], o[3]); *(v2u*)(xb + (size_t)row * ldb + col) = w; } }
                s += __shfl_xor(s, 16); s += __shfl_xor(s, 32);
                if (fq == 0) ssq[(size_t)row * 16 + u.pn * 4 + wc] = s; }
    }
};
struct EpiUp {
    static constexpr bool PERM = true, AFTER_DRAIN = false;
    bf16* Hd; const float* ssq;
    __device__ __forceinline__ void operator()(const f32x4 (&acc)[2][2][4][2], const Unit& u, int wr, int wc, int fr, int fq) const {
        const int row0 = u.pm * 256 + wr * 64 + fr, col0 = u.pn * 256 + wc * 32 + 8 * fq;
#pragma unroll
        for (int ai = 0; ai < 2; ++ai)
#pragma unroll
            for (int m = 0; m < 4; ++m) { const size_t row = (size_t)(row0 + ai * 128 + m * 16);
                const f32x4* sp = (const f32x4*)(ssq + row * 16); const f32x4 a = sp[0], b = sp[1], c = sp[2], d = sp[3];
                const float tot = ((a[0] + a[1]) + (a[2] + a[3])) + ((b[0] + b[1]) + (b[2] + b[3])) + ((c[0] + c[1]) + (c[2] + c[3])) + ((d[0] + d[1]) + (d[2] + d[3]));
                const float rstd = rsqrtf(tot * (1.0f / D) + NORM_EPS);
#pragma unroll
                for (int bj = 0; bj < 2; ++bj) { const f32x4 v0 = acc[ai][bj][m][0], v1 = acc[ai][bj][m][1];
                    float o[8] = {v0[0], v0[1], v0[2], v0[3], v1[0], v1[1], v1[2], v1[3]};
#pragma unroll
                    for (int e = 0; e < 8; ++e) { const float t = fmaxf(o[e] * rstd, 0.f); o[e] = t * t; }
                    u32x4 w; w.x = pk2(o[0], o[1]); w.y = pk2(o[2], o[3]); w.z = pk2(o[4], o[5]); w.w = pk2(o[6], o[7]);
                    *(u32x4*)(Hd + row * DFF + col0 + bj * 128) = w; } }
    }
};

__device__ __forceinline__ void p0_transpose_item(const float* W, int K, int N, bf16* WT, const float* kscale, LAS float* scr, int item, int lane) {
    const int nblk = N / 32, kb = item / nblk, nb = item % nblk, k0 = 64 * kb, n0 = 32 * nb;
#pragma unroll 8
    for (int i = 0; i < 32; ++i) { const int kk = 2 * i + (lane >> 5); float v = W[(size_t)(k0 + kk) * N + n0 + (lane & 31)]; if (kscale) v *= kscale[k0 + kk]; scr[kk * 33 + (lane & 31)] = v; }
    LDS_WAIT(); asm volatile("" ::: "memory");
    const int c = lane & 7;
#pragma unroll
    for (int j = 0; j < 4; ++j) { const int n = (lane >> 3) + 8 * j; const LAS float* s = scr + (8 * c) * 33 + n;
        v4u o; o.x = pk2(s[0 * 33], s[1 * 33]); o.y = pk2(s[2 * 33], s[3 * 33]); o.z = pk2(s[4 * 33], s[5 * 33]); o.w = pk2(s[6 * 33], s[7 * 33]);
        *(GAS v4u*)(WT + (size_t)(n0 + n) * K + k0 + 8 * c) = o; }
    LDS_WAIT(); asm volatile("" ::: "memory");
}
__device__ __forceinline__ void p0_prologue(const Frame& F, const Args& A) {
    LAS float* scr = (LAS float*)(F.lds + F.wave * 16384);
    const int gw = F.vcu * NWAVES + F.wave, NGW = F.G * NWAVES;
    unsigned char* ws = A.ws;
    constexpr int I_IN = (D / 64) * (NIN / 32), I_A = (AW / 64) * (D / 32), I_O = (D / 64) * (D / 32), I_UP = (D / 64) * (DFF / 32), I_DN = (DFF / 64) * (D / 32);
    constexpr int I_L = 16, I_G = 32;
    constexpr int NITEMS = I_IN + 2 * I_A + I_O + I_UP + I_DN + 2 * I_L + I_G;
    for (int it = gw; it < NITEMS; it += NGW) {
        int r = it;
        if (r < I_IN) { p0_transpose_item(A.in[6], D, NIN, (bf16*)(ws + WS_WIN), nullptr, scr, r, F.lane); continue; } r -= I_IN;
        if (r < I_A) { p0_transpose_item(A.in[20], AW, D, (bf16*)(ws + WS_WA), nullptr, scr, r, F.lane); continue; } r -= I_A;
        if (r < I_A) { p0_transpose_item(A.in[21], BW, D, (bf16*)(ws + WS_WB), nullptr, scr, r, F.lane); continue; } r -= I_A;
        if (r < I_O) { p0_transpose_item(A.in[22], D, D, (bf16*)(ws + WS_WO), nullptr, scr, r, F.lane); continue; } r -= I_O;
        if (r < I_UP) { p0_transpose_item(A.in[24], D, DFF, (bf16*)(ws + WS_WUP), A.in[23], scr, r, F.lane); continue; } r -= I_UP;
        if (r < I_DN) { p0_transpose_item(A.in[25], DFF, D, (bf16*)(ws + WS_WDN), nullptr, scr, r, F.lane); continue; } r -= I_DN;
        if (r < I_L) { p0_transpose_item(A.in[9], 64, BW, (bf16*)(ws + WS_WDT), nullptr, scr, r, F.lane); continue; } r -= I_L;
        if (r < I_L) { p0_transpose_item(A.in[11], 64, BW, (bf16*)(ws + WS_WAT), nullptr, scr, r, F.lane); continue; } r -= I_L;
        p0_transpose_item(A.in[12], 128, BW, (bf16*)(ws + WS_WGT), nullptr, scr, r, F.lane);
    }
    bf16* H = (bf16*)A.out;
    const float* g = A.in[5];
    f32x4 gv[4];
#pragma unroll
    for (int j = 0; j < 4; ++j) gv[j] = ((const f32x4*)g)[F.lane + 64 * j];
    for (int m = gw; m < MH; m += NGW) {
        GAS unsigned long long* o8 = (GAS unsigned long long*)(H + (size_t)m * D) + F.lane;
        if (m < MT) {
            const float* xrow = m < MP ? A.in[0] + (size_t)m * D : A.in[1] + (size_t)(m - MP) * D;
            const f32x4* xr = (const f32x4*)xrow + F.lane;
            f32x4 v[4]; float s = 0.f;
#pragma unroll
            for (int j = 0; j < 4; ++j) { v[j] = xr[64 * j]; s += (v[j][0] * v[j][0] + v[j][1] * v[j][1]) + (v[j][2] * v[j][2] + v[j][3] * v[j][3]); }
            const float rstd = rsqrtf(wave_sum(s) * (1.0f / D) + NORM_EPS);
#pragma unroll
            for (int j = 0; j < 4; ++j) v[j] = v[j] * rstd * gv[j];
#pragma unroll
            for (int j = 0; j < 4; ++j) o8[64 * j] = (unsigned long long)pk2(v[j][0], v[j][1]) | ((unsigned long long)pk2(v[j][2], v[j][3]) << 32);
            float* so = nullptr;
            if (m < MP) { if ((m & (SEQ - 1)) == SEQ - 1) so = A.out + O_SHIFT_P + (size_t)(m >> 11) * D; }
            else { const int s_ = m - MP; if ((s_ & 3) == 3) so = A.out + O_SHIFT_S + (size_t)(s_ >> 2) * D; }
            if (so) {
#pragma unroll
                for (int j = 0; j < 4; ++j) ((f32x4*)so)[F.lane + 64 * j] = v[j];
            }
        } else if (m < MT + NBS) {
            const f32x4* xr = (const f32x4*)(A.in[4] + (size_t)(m - MT) * D) + F.lane;
#pragma unroll
            for (int j = 0; j < 4; ++j) { const f32x4 v = xr[64 * j]; o8[64 * j] = (unsigned long long)pk2(v[0], v[1]) | ((unsigned long long)pk2(v[2], v[3]) << 32); }
        } else {
#pragma unroll
            for (int j = 0; j < 4; ++j) o8[64 * j] = 0ull;
        }
    }
}

__device__ __forceinline__ int prev_row(int row) {
    if (row < MP) return (row & (SEQ - 1)) ? row - 1 : -1;
    const int s = row - MP; return (s & 3) ? row - 1 : MT + (s >> 2);
}
__device__ __forceinline__ float shifted(const bf16* UB, int row, int prow, int col, float mu) {
    const float ub = bf2f(UB[(size_t)row * BCOLS + col]);
    const float up = prow >= 0 ? bf2f(UB[(size_t)prow * BCOLS + col]) : 0.f;
    return ub + (up - ub) * mu;
}

typedef short bf16x8_t __attribute__((ext_vector_type(8)));
typedef short bf16x4_t __attribute__((ext_vector_type(4)));
typedef float f32x16 __attribute__((ext_vector_type(16)));
#define MFMA32(a, b, c) __builtin_amdgcn_mfma_f32_32x32x16_bf16((a), (b), (c), 0, 0, 0)
__device__ __forceinline__ int crow(int reg, int hh) { return (reg & 3) + 8 * (reg >> 2) + 4 * hh; }
__device__ __forceinline__ bf16x8_t pack8(float a0, float a1, float a2, float a3, float a4, float a5, float a6, float a7) {
    v4u p; p.x = pk2(a0, a1); p.y = pk2(a2, a3); p.z = pk2(a4, a5); p.w = pk2(a6, a7); return __builtin_bit_cast(bf16x8_t, p);
}
constexpr int HC = 64;
constexpr int H_TP = 72;
constexpr int H_KP = 136;
constexpr int H_OP = 132;
struct HPre { float b[16], kd[16], blast, bmid; };
__device__ __forceinline__ void hgrn_pre(const Frame& F, const bf16* UA, int row0, int h, float lbk, LAS float* segsum, HPre& R) {
    const int k = F.tid & 127, seg = F.tid >> 7;
    const bf16* src = UA + (size_t)(row0 + 16 * seg) * ACOLS + 512 + h * 128 + k;
    float run = 0.f;
#pragma unroll
    for (int j = 0; j < 16; ++j) { const float sg = sigmoidf_(bf2f(src[(size_t)j * ACOLS])); R.kd[j] = (1.0f - lbk) * (1.0f - sg); run += __logf(lbk + (1.0f - lbk) * sg); R.b[j] = run; }
    segsum[seg * 128 + k] = run;
    __syncthreads();
    const float s0 = segsum[k], s1 = segsum[128 + k], s2 = segsum[256 + k], s3 = segsum[384 + k];
    const float pre = seg == 0 ? 0.f : (seg == 1 ? s0 : (seg == 2 ? s0 + s1 : s0 + s1 + s2));
#pragma unroll
    for (int j = 0; j < 16; ++j) R.b[j] += pre;
    R.bmid = s0 + s1; R.blast = (s0 + s1) + (s2 + s3);
}
__device__ __forceinline__ void hgrn_load_vt(const Frame& F, const bf16* UA, int row0, int h, LAS bf16* VT) {
    const int v = F.tid & 127, seg = F.tid >> 7;
    const bf16* src = UA + (size_t)(row0 + 16 * seg) * ACOLS + 1024 + h * 128 + v;
    unsigned w[8];
#pragma unroll
    for (int j = 0; j < 8; ++j) w[j] = (unsigned)src[(size_t)(2 * j) * ACOLS] | ((unsigned)src[(size_t)(2 * j + 1) * ACOLS] << 16);
    LAS v4u* d = (LAS v4u*)(VT + v * H_TP + 16 * seg);
    d[0] = (v4u){w[0], w[1], w[2], w[3]}; d[1] = (v4u){w[4], w[5], w[6], w[7]};
}
__device__ __forceinline__ void h1_unit(const Frame& F, const Args& A, int unit) {
    const bf16* UA = (const bf16*)(A.ws + WS_UA);
    bf16* NS = (bf16*)(A.ws + WS_NS) + (size_t)unit * 16384;
    float* gam = (float*)(A.ws + WS_GAMMA) + (size_t)unit * 128;
    const int bh = unit >> 5, c = unit & 31, b = bh >> 2, h = bh & 3, row0 = b * SEQ + c * HC;
    LAS bf16* KhT = (LAS bf16*)F.lds;
    LAS bf16* VT = KhT + 128 * H_TP;
    LAS float* segsum = (LAS float*)(VT + 128 * H_TP);
    const int k = F.tid & 127, seg = F.tid >> 7;
    const float lbk = 1.0f / (1.0f + __expf(A.in[18][512 + h * 128 + k] - A.in[18][h * 128 + k]));
    HPre R; hgrn_pre(F, UA, row0, h, lbk, segsum, R);
    {   unsigned w[8];
#pragma unroll
        for (int j = 0; j < 8; ++j) w[j] = pk2(R.kd[2 * j] * __expf(R.blast - R.b[2 * j]), R.kd[2 * j + 1] * __expf(R.blast - R.b[2 * j + 1]));
        LAS v4u* d = (LAS v4u*)(KhT + k * H_TP + 16 * seg);
        d[0] = (v4u){w[0], w[1], w[2], w[3]}; d[1] = (v4u){w[4], w[5], w[6], w[7]}; }
    if (seg == 0) gam[k] = __expf(R.blast);
    hgrn_load_vt(F, UA, row0, h, VT);
    __syncthreads();
    const int r = F.lane & 31, hh = F.lane >> 5, vt = F.wave >> 1, kt0 = (F.wave & 1) * 2;
    f32x16 acc0, acc1;
#pragma unroll
    for (int i = 0; i < 16; ++i) { acc0[i] = 0.f; acc1[i] = 0.f; }
#pragma unroll
    for (int s = 0; s < 4; ++s) {
        const bf16x8_t a = *(const LAS bf16x8_t*)(VT + (vt * 32 + r) * H_TP + 16 * s + 8 * hh);
        const bf16x8_t b0 = *(const LAS bf16x8_t*)(KhT + (kt0 * 32 + r) * H_TP + 16 * s + 8 * hh);
        const bf16x8_t b1 = *(const LAS bf16x8_t*)(KhT + ((kt0 + 1) * 32 + r) * H_TP + 16 * s + 8 * hh);
        acc0 = MFMA32(a, b0, acc0); acc1 = MFMA32(a, b1, acc1);
    }
#pragma unroll
    for (int i = 0; i < 16; ++i) { const int v = vt * 32 + crow(i, hh);
        NS[v * 128 + kt0 * 32 + r] = (bf16)f2bf(acc0[i]); NS[v * 128 + (kt0 + 1) * 32 + r] = (bf16)f2bf(acc1[i]); }
    __syncthreads();
}
__device__ __forceinline__ void h2_part(const Frame& F, const Args& A, int start, int stride) {
    bf16* NS = (bf16*)(A.ws + WS_NS);
    const float* gam = (const float*)(A.ws + WS_GAMMA);
    for (int e = start; e < 32 * 2048; e += stride) {
        const int bh = e >> 11, vk = e & 2047, v = vk >> 4, k0 = (vk & 15) * 8;
        float S[8];
#pragma unroll
        for (int j = 0; j < 8; ++j) S[j] = 0.f;
        for (int c = 0; c < 32; ++c) {
            v4u* p = (v4u*)(NS + (size_t)(bh * 32 + c) * 16384 + v * 128 + k0);
            const v4u n = *p;
            const f32x4 g0 = *(const f32x4*)(gam + (size_t)(bh * 32 + c) * 128 + k0), g1 = *(const f32x4*)(gam + (size_t)(bh * 32 + c) * 128 + k0 + 4);
            v4u o; o.x = pk2(S[0], S[1]); o.y = pk2(S[2], S[3]); o.z = pk2(S[4], S[5]); o.w = pk2(S[6], S[7]);
            *p = o;
            S[0] = g0[0] * S[0] + bflo(n.x); S[1] = g0[1] * S[1] + bfhi(n.x); S[2] = g0[2] * S[2] + bflo(n.y); S[3] = g0[3] * S[3] + bfhi(n.y);
            S[4] = g1[0] * S[4] + bflo(n.z); S[5] = g1[1] * S[5] + bfhi(n.z); S[6] = g1[2] * S[6] + bflo(n.w); S[7] = g1[3] * S[7] + bfhi(n.w);
        }
        float* so = A.out + O_HGRN_P + (size_t)bh * 16384 + v;
#pragma unroll
        for (int j = 0; j < 8; ++j) so[(size_t)(k0 + j) * 128] = S[j];
    }
}
__device__ __forceinline__ void h3_unit(const Frame& F, const Args& A, int unit) {
    bf16* UA = (bf16*)(A.ws + WS_UA);
    const bf16* NS = (const bf16*)(A.ws + WS_NS) + (size_t)unit * 16384;
    const int bh = unit >> 5, c = unit & 31, b = bh >> 2, h = bh & 3, row0 = b * SEQ + c * HC;
    LAS bf16* Qh = (LAS bf16*)F.lds;
    LAS bf16* Qt = Qh + 64 * H_KP;
    LAS bf16* Kt = Qt + 64 * H_KP;
    LAS bf16* VT = Kt + 64 * H_KP;
    LAS float* segsum = (LAS float*)(VT + 128 * H_TP);
    LAS float* ssq = segsum + 512;
    LAS float* Ost = ssq + 256;
    const int k = F.tid & 127, seg = F.tid >> 7;
    const float lbk = 1.0f / (1.0f + __expf(A.in[18][512 + h * 128 + k] - A.in[18][h * 128 + k]));
    HPre R; hgrn_pre(F, UA, row0, h, lbk, segsum, R);
    {   const bf16* qsrc = UA + (size_t)(row0 + 16 * seg) * ACOLS + h * 128 + k;
#pragma unroll
        for (int j = 0; j < 16; ++j) { const float q = bf2f(qsrc[(size_t)j * ACOLS]); const float qs = q * sigmoidf_(q); const int t = 16 * seg + j;
            Qh[t * H_KP + k] = (bf16)f2bf(qs * __expf(R.b[j]));
            Qt[t * H_KP + k] = (bf16)f2bf(qs * __expf(R.b[j] - R.bmid));
            Kt[t * H_KP + k] = (bf16)f2bf(R.kd[j] * __expf(R.bmid - R.b[j])); } }
    hgrn_load_vt(F, UA, row0, h, VT);
    __syncthreads();
    const int r = F.lane & 31, hh = F.lane >> 5, vt = F.wave >> 1, tt = F.wave & 1;
    f32x16 o;
#pragma unroll
    for (int i = 0; i < 16; ++i) o[i] = 0.f;
#pragma unroll
    for (int st = 0; st < 2; ++st) {
        if (st <= tt) {
            f32x16 at;
#pragma unroll
            for (int i = 0; i < 16; ++i) at[i] = 0.f;
#pragma unroll
            for (int ks = 0; ks < 8; ++ks) {
                const bf16x8_t a = *(const LAS bf16x8_t*)(Kt + (st * 32 + r) * H_KP + 16 * ks + 8 * hh);
                const bf16x8_t bq = *(const LAS bf16x8_t*)(Qt + (tt * 32 + r) * H_KP + 16 * ks + 8 * hh);
                at = MFMA32(a, bq, at);
            }
            if (st == tt) {
#pragma unroll
                for (int i = 0; i < 16; ++i) if (crow(i, hh) > r) at[i] = 0.f;
            }
#pragma unroll
            for (int ks = 0; ks < 2; ++ks) {
                const bf16x4_t lo = *(const LAS bf16x4_t*)(VT + (vt * 32 + r) * H_TP + st * 32 + 16 * ks + 4 * hh);
                const bf16x4_t hi = *(const LAS bf16x4_t*)(VT + (vt * 32 + r) * H_TP + st * 32 + 16 * ks + 8 + 4 * hh);
                const bf16x8_t a = __builtin_shufflevector(lo, hi, 0, 1, 2, 3, 4, 5, 6, 7);
                const bf16x8_t bx = pack8(at[8 * ks], at[8 * ks + 1], at[8 * ks + 2], at[8 * ks + 3], at[8 * ks + 4], at[8 * ks + 5], at[8 * ks + 6], at[8 * ks + 7]);
                o = MFMA32(a, bx, o);
            }
        }
    }
    if (c > 0) {
#pragma unroll
        for (int ks = 0; ks < 8; ++ks) {
            const bf16x8_t a = *(const bf16x8_t*)(NS + (vt * 32 + r) * 128 + 16 * ks + 8 * hh);
            const bf16x8_t bq = *(const LAS bf16x8_t*)(Qh + (tt * 32 + r) * H_KP + 16 * ks + 8 * hh);
            o = MFMA32(a, bq, o);
        }
    }
    {   float s = 0.f;
#pragma unroll
        for (int i = 0; i < 16; ++i) { s += o[i] * o[i]; Ost[(tt * 32 + r) * H_OP + vt * 32 + crow(i, hh)] = o[i]; }
        s += __shfl_xor(s, 32);
        if (hh == 0) ssq[vt * 64 + tt * 32 + r] = s; }
    __syncthreads();
    {   const int t = F.tid >> 3, vg = F.tid & 7, row = row0 + t;
        const float tot = (ssq[t] + ssq[64 + t]) + (ssq[128 + t] + ssq[192 + t]);
        const float rs = rsqrtf(tot * (1.0f / 128.0f) + HGRN_EPS);
        const LAS f32x4* op = (const LAS f32x4*)(Ost + t * H_OP + 16 * vg);
        const v4u* gp = (const v4u*)(UA + (size_t)row * ACOLS + 1536 + h * 128 + 16 * vg);
        const f32x4* nwp = (const f32x4*)(A.in[19] + h * 128 + 16 * vg);
        v4u outw[2];
#pragma unroll
        for (int half = 0; half < 2; ++half) {
            const v4u g = gp[half]; const f32x4 o0 = op[2 * half], o1 = op[2 * half + 1], n0 = nwp[2 * half], n1 = nwp[2 * half + 1];
            const float gg[8] = {bflo(g.x), bfhi(g.x), bflo(g.y), bfhi(g.y), bflo(g.z), bfhi(g.z), bflo(g.w), bfhi(g.w)};
            const float ov[8] = {o0[0] * n0[0], o0[1] * n0[1], o0[2] * n0[2], o0[3] * n0[3], o1[0] * n1[0], o1[1] * n1[1], o1[2] * n1[2], o1[3] * n1[3]};
            float f[8];
#pragma unroll
            for (int e = 0; e < 8; ++e) f[e] = ov[e] * rs * (gg[e] * sigmoidf_(gg[e]));
            outw[half] = (v4u){pk2(f[0], f[1]), pk2(f[2], f[3]), pk2(f[4], f[5]), pk2(f[6], f[7])};
        }
        v4u* dst = (v4u*)(UA + (size_t)row * ACOLS + 1024 + h * 128 + 16 * vg);
        dst[0] = outw[0]; dst[1] = outw[1]; }
    __syncthreads();
}
__device__ __forceinline__ void hgrn_sample_unit(const Frame& F, const Args& A, int bh) {
    bf16* UA = (bf16*)(A.ws + WS_UA);
    const int b = bh >> 2, h = bh & 3, row0 = MP + 4 * b;
    LAS float* vec = (LAS float*)F.lds;
    LAS float* opart = vec + 4 * 384;
    LAS float* red = opart + 2048;
    const int v = F.tid & 127, kq = F.tid >> 7;
    {   const int t = kq, k = v, ch = h * 128 + k;
        const float lbk = 1.0f / (1.0f + __expf(A.in[18][512 + ch] - A.in[18][ch]));
        const float sg = sigmoidf_(bf2f(UA[(size_t)(row0 + t) * ACOLS + 512 + ch])), q = bf2f(UA[(size_t)(row0 + t) * ACOLS + ch]);
        vec[t * 384 + k] = lbk + (1.0f - lbk) * sg; vec[t * 384 + 128 + k] = (1.0f - lbk) * (1.0f - sg); vec[t * 384 + 256 + k] = q * sigmoidf_(q); }
    float iv[4];
#pragma unroll
    for (int t = 0; t < 4; ++t) iv[t] = bf2f(UA[(size_t)(row0 + t) * ACOLS + 1024 + h * 128 + v]);
    const float* sin_ = A.in[2] + (size_t)bh * 16384 + (size_t)(32 * kq) * 128 + v;
    float S[32];
#pragma unroll
    for (int j = 0; j < 32; ++j) S[j] = sin_[(size_t)j * 128];
    __syncthreads();
#pragma unroll
    for (int t = 0; t < 4; ++t) {
        const LAS float* fv = vec + t * 384 + 32 * kq;
        float o = 0.f;
#pragma unroll
        for (int j4 = 0; j4 < 8; ++j4) { const f32x4 f = *(const LAS f32x4*)(fv + 4 * j4), d = *(const LAS f32x4*)(fv + 128 + 4 * j4), q = *(const LAS f32x4*)(fv + 256 + 4 * j4);
#pragma unroll
            for (int e = 0; e < 4; ++e) { S[4 * j4 + e] = f[e] * S[4 * j4 + e] + d[e] * iv[t]; o += S[4 * j4 + e] * q[e]; } }
        opart[(t * 4 + kq) * 128 + v] = o;
    }
    float* sout = A.out + O_HGRN_S + (size_t)bh * 16384 + (size_t)(32 * kq) * 128 + v;
#pragma unroll
    for (int j = 0; j < 32; ++j) sout[(size_t)j * 128] = S[j];
    __syncthreads();
    {   const int t = kq;
        const float o = (opart[(t * 4 + 0) * 128 + v] + opart[(t * 4 + 1) * 128 + v]) + (opart[(t * 4 + 2) * 128 + v] + opart[(t * 4 + 3) * 128 + v]);
        const float ss = wave_sum(o * o);
        if (F.lane == 0) red[F.wave] = ss;
        __syncthreads();
        const float tot = red[F.wave & ~1] + red[F.wave | 1];
        const int ch = h * 128 + v; const size_t row = (size_t)(row0 + t);
        const float g = bf2f(UA[row * ACOLS + 1536 + ch]);
        UA[row * ACOLS + 1024 + ch] = (bf16)f2bf(o * rsqrtf(tot * (1.0f / 128.0f) + HGRN_EPS) * A.in[19][ch] * (g * sigmoidf_(g))); }
    __syncthreads();
}


typedef float f32x4_t __attribute__((ext_vector_type(4)));
#define MFMA16(a, b, c) __builtin_amdgcn_mfma_f32_16x16x32_bf16((a), (b), (c), 0, 0, 0)
constexpr int RC = 32;
constexpr int R_TP = 72;
constexpr int R_CP = 40;
constexpr int RL_A = 0;
constexpr int RL_B = RL_A + 9216;
constexpr int RL_C = RL_B + 16384;
constexpr int RL_D = RL_C + 9216;
constexpr int RL_E = RL_D + 18432;
constexpr int RL_F = RL_E + 20480;
constexpr int RL_UNIT = RL_F + 512;
static_assert(2 * RL_UNIT <= RING_BYTES, "two R1 units in LDS");
__device__ __forceinline__ float red8(float x) {
    x += __builtin_bit_cast(float, __builtin_amdgcn_update_dpp(0, __builtin_bit_cast(int, x), 0xB1, 0xF, 0xF, true));
    x += __builtin_bit_cast(float, __builtin_amdgcn_update_dpp(0, __builtin_bit_cast(int, x), 0x4E, 0xF, 0xF, true));
    x += __builtin_bit_cast(float, __builtin_amdgcn_update_dpp(0, __builtin_bit_cast(int, x), 0x141, 0xF, 0xF, true));
    return x;
}
__device__ __forceinline__ void unpack8(const v4u w, float (&o)[8]) { o[0] = bflo(w.x); o[1] = bfhi(w.x); o[2] = bflo(w.y); o[3] = bfhi(w.y); o[4] = bflo(w.z); o[5] = bfhi(w.z); o[6] = bflo(w.w); o[7] = bfhi(w.w); }
__device__ __forceinline__ v4u packw8(const float (&f)[8]) { return (v4u){pk2(f[0], f[1]), pk2(f[2], f[3]), pk2(f[4], f[5]), pk2(f[6], f[7])}; }

__device__ __forceinline__ void r1_pass(const Frame& F, const Args& A, int unit, bool active) {
    bf16* UB = (bf16*)(A.ws + WS_UB);
    const bf16* BR = (const bf16*)(A.out + O_HGRN_S);
    const bf16* Wdt = (const bf16*)(A.ws + WS_WDT); const bf16* Wat = (const bf16*)(A.ws + WS_WAT);
    float* bonus = (float*)(A.ws + WS_BONUS);
    const int sub = F.wave >> 2, w4 = F.wave & 3, tid4 = F.tid & 255, r = F.lane & 31, hh = F.lane >> 5;
    LAS unsigned char* L = F.lds + sub * RL_UNIT;
    LAS bf16* AWs = (LAS bf16*)(L + RL_A); LAS bf16* AAs = AWs + 32 * R_TP;
    LAS bf16* Bm = (LAS bf16*)(L + RL_A); LAS bf16* RAm = Bm + 32 * R_CP; LAS bf16* RKm = RAm + 32 * R_CP;
    LAS float* DEC = (LAS float*)(L + RL_B); LAS float* AAo = DEC + 32 * 64;
    LAS float* BVf = (LAS float*)(L + RL_B); LAS float* Af = BVf + 32 * 64;
    LAS float* CUM = (LAS float*)(L + RL_C); LAS float* SEG = CUM + 32 * 64;
    LAS bf16* Kt = (LAS bf16*)(L + RL_D); LAS bf16* Ah = Kt + 32 * R_TP; LAS bf16* Kh = Ah + 32 * R_TP; LAS bf16* Rt = Kh + 32 * R_TP;
    LAS bf16* KbT = (LAS bf16*)(L + RL_D); LAS bf16* VbT = KbT + 64 * R_CP;
    LAS bf16* KtT = (LAS bf16*)(L + RL_E); LAS bf16* AcT = KtT + 64 * R_CP; LAS bf16* KcT = AcT + 64 * R_CP; LAS bf16* VT = KcT + 64 * R_CP;
    LAS float* GC = (LAS float*)(L + RL_F); LAS float* CL = GC + 64;
    const int b = unit >> 9, h = (unit >> 6) & 7, c = unit & 63, row0 = b * SEQ + c * RC;
    unsigned char* mn = (unsigned char*)A.out + (size_t)unit * 16384;
    const int t = tid4 >> 3, jg = tid4 & 7, row = row0 + t;
    float xr[8], xk[8], xv[8];
    if (active) {
        const float* mu = A.in[7];
        const int cols[5] = {h * 64 + 8 * jg, 512 + h * 64 + 8 * jg, 1024 + h * 64 + 8 * jg, 1536 + 8 * jg, 1600 + 8 * jg};
        float x5[5][8];
#pragma unroll
        for (int q = 0; q < 5; ++q) {
            float cur[8], prv[8];
            unpack8(*(const v4u*)(UB + (size_t)row * BCOLS + cols[q]), cur);
            v4u pw = (v4u){0, 0, 0, 0};
            if (t > 0 || q >= 3) { if (t > 0 || c > 0) pw = *(const v4u*)(UB + (size_t)(row - 1) * BCOLS + cols[q]); }
            else if (c > 0) pw = *(const v4u*)(BR + (size_t)(b * 64 + c - 1) * 1536 + cols[q]);
            unpack8(pw, prv);
            const f32x4 m0 = *(const f32x4*)(mu + cols[q]), m1 = *(const f32x4*)(mu + cols[q] + 4);
#pragma unroll
            for (int e = 0; e < 8; ++e) x5[q][e] = cur[e] + (prv[e] - cur[e]) * (e < 4 ? m0[e] : m1[e - 4]);
        }
#pragma unroll
        for (int e = 0; e < 8; ++e) { xr[e] = x5[0][e]; xk[e] = x5[1][e]; xv[e] = x5[2][e]; x5[3][e] = tanhf_(x5[3][e]); }
        *(LAS v4u*)(AWs + t * R_TP + 8 * jg) = packw8(x5[3]);
        *(LAS v4u*)(AAs + t * R_TP + 8 * jg) = packw8(x5[4]);
    }
    __syncthreads();
    if (active) {
        const int which = w4 >> 1, jt = w4 & 1;
        const LAS bf16* As = which ? AAs : AWs; const bf16* Wt = (which ? Wat : Wdt) + (size_t)(h * 64 + jt * 32 + r) * 64;
        f32x16 acc;
#pragma unroll
        for (int i = 0; i < 16; ++i) acc[i] = 0.f;
#pragma unroll
        for (int s = 0; s < 4; ++s) acc = MFMA32(*(const LAS bf16x8_t*)(As + r * R_TP + 16 * s + 8 * hh), *(const bf16x8_t*)(Wt + 16 * s + 8 * hh), acc);
        LAS float* O = which ? AAo : DEC;
#pragma unroll
        for (int i = 0; i < 16; ++i) O[crow(i, hh) * 64 + jt * 32 + r] = acc[i];
    }
    __syncthreads();
    float lw[8], kk[8], al[8], k2[8];
    if (active) {
        const int ch = h * 64 + 8 * jg;
        float dec[8], aa[8];
        { const f32x4 d0 = *(const LAS f32x4*)(DEC + t * 64 + 8 * jg), d1 = *(const LAS f32x4*)(DEC + t * 64 + 8 * jg + 4), a0 = *(const LAS f32x4*)(AAo + t * 64 + 8 * jg), a1 = *(const LAS f32x4*)(AAo + t * 64 + 8 * jg + 4);
#pragma unroll
          for (int e = 0; e < 4; ++e) { dec[e] = d0[e]; dec[4 + e] = d1[e]; aa[e] = a0[e]; aa[4 + e] = a1[e]; } }
        float n2 = 0.f, bs = 0.f, kp[8], av[8];
#pragma unroll
        for (int e = 0; e < 8; ++e) {
            lw[e] = -DECAY_SCALE * sigmoidf_(A.in[8][ch + e] + dec[e]);
            av[e] = sigmoidf_(A.in[10][ch + e] + aa[e]);
            kp[e] = xk[e] * A.in[13][ch + e]; n2 += kp[e] * kp[e];
            k2[e] = xk[e] * (1.0f + (av[e] - 1.0f) * A.in[14][ch + e]);
            bs += xr[e] * k2[e] * A.in[15][ch + e];
        }
        n2 = red8(n2); bs = red8(bs);
        const float inv = 1.0f / fmaxf(sqrtf(n2), 1e-12f);
#pragma unroll
        for (int e = 0; e < 8; ++e) { kk[e] = kp[e] * inv; al[e] = kk[e] * av[e]; }
        if (jg == 0) bonus[(size_t)row * 8 + h] = bs;
        *(LAS f32x4*)(CUM + t * 64 + 8 * jg) = (f32x4){lw[0], lw[1], lw[2], lw[3]};
        *(LAS f32x4*)(CUM + t * 64 + 8 * jg + 4) = (f32x4){lw[4], lw[5], lw[6], lw[7]};
    }
    __syncthreads();
    {
        const int j = tid4 & 63, seg = tid4 >> 6;
        float v8[8], run = 0.f;
        if (active) {
#pragma unroll
            for (int e = 0; e < 8; ++e) { run += CUM[(8 * seg + e) * 64 + j]; v8[e] = run; }
            SEG[seg * 64 + j] = run;
        }
        __syncthreads();
        if (active) {
            const float s0 = SEG[j], s1 = SEG[64 + j], s2 = SEG[128 + j], s3 = SEG[192 + j];
            const float pre = seg == 0 ? 0.f : (seg == 1 ? s0 : (seg == 2 ? s0 + s1 : s0 + s1 + s2));
#pragma unroll
            for (int e = 0; e < 8; ++e) CUM[(8 * seg + e) * 64 + j] = v8[e] + pre;
            if (seg == 0) { const float tot = (s0 + s1) + (s2 + s3); CL[j] = tot; GC[j] = __expf(tot); }
        }
    }
    __syncthreads();
    if (active) {
        float cum[8], cl[8];
        { const f32x4 c0 = *(const LAS f32x4*)(CUM + t * 64 + 8 * jg), c1 = *(const LAS f32x4*)(CUM + t * 64 + 8 * jg + 4), l0 = *(const LAS f32x4*)(CL + 8 * jg), l1 = *(const LAS f32x4*)(CL + 8 * jg + 4);
#pragma unroll
          for (int e = 0; e < 4; ++e) { cum[e] = c0[e]; cum[4 + e] = c1[e]; cl[e] = l0[e]; cl[4 + e] = l1[e]; } }
        float fKt[8], fAh[8], fKh[8], fRt[8];
#pragma unroll
        for (int e = 0; e < 8; ++e) {
            const float gt = __expf(cum[e]), gm1 = __expf(cum[e] - lw[e]), gi = __expf(-cum[e]), gc = __expf(cl[e] - cum[e]);
            fKt[e] = kk[e] * gm1; fAh[e] = al[e] * gi; fKh[e] = k2[e] * gi; fRt[e] = xr[e] * gt;
            const int j = 8 * jg + e;
            KtT[j * R_CP + t] = (bf16)f2bf(fKt[e]); AcT[j * R_CP + t] = (bf16)f2bf(al[e] * gc); KcT[j * R_CP + t] = (bf16)f2bf(k2[e] * gc); VT[j * R_CP + t] = (bf16)f2bf(xv[e]);
        }
        *(LAS v4u*)(Kt + t * R_TP + 8 * jg) = packw8(fKt); *(LAS v4u*)(Ah + t * R_TP + 8 * jg) = packw8(fAh);
        *(LAS v4u*)(Kh + t * R_TP + 8 * jg) = packw8(fKh); *(LAS v4u*)(Rt + t * R_TP + 8 * jg) = packw8(fRt);
        *(v4u*)(UB + (size_t)row * BCOLS + 1024 + h * 64 + 8 * jg) = packw8(xv);
    }
    __syncthreads();
    f32x16 pre5;
    if (active) {
        const LAS bf16* Ls = (w4 < 2) ? Kt : Rt; const LAS bf16* Rs = (w4 & 1) ? Kh : Ah;
        f32x16 acc;
#pragma unroll
        for (int i = 0; i < 16; ++i) acc[i] = 0.f;
#pragma unroll
        for (int s = 0; s < 4; ++s) acc = MFMA32(*(const LAS bf16x8_t*)(Ls + r * R_TP + 16 * s + 8 * hh), *(const LAS bf16x8_t*)(Rs + r * R_TP + 16 * s + 8 * hh), acc);
#pragma unroll
        for (int i = 0; i < 16; ++i) { const int tt = crow(i, hh); const bool keep = (w4 < 2) ? (r < tt) : (r <= tt); pre5[i] = keep ? acc[i] : 0.f; }
    }
    __syncthreads();
    if (active) {
#pragma unroll
        for (int i = 0; i < 16; ++i) { const int tt = crow(i, hh);
            if (w4 == 0) Af[tt * 32 + r] = pre5[i];
            else { LAS bf16* O = w4 == 1 ? Bm : (w4 == 2 ? RAm : RKm); O[tt * R_CP + r] = (bf16)f2bf(pre5[i]); } }
    }
    __syncthreads();
    if (active && w4 < 2) {
        f32x16 acc;
#pragma unroll
        for (int i = 0; i < 16; ++i) acc[i] = 0.f;
#pragma unroll
        for (int s = 0; s < 2; ++s) acc = MFMA32(*(const LAS bf16x8_t*)(Bm + r * R_CP + 16 * s + 8 * hh), *(const LAS bf16x8_t*)(VT + (w4 * 32 + r) * R_CP + 16 * s + 8 * hh), acc);
#pragma unroll
        for (int i = 0; i < 16; ++i) BVf[crow(i, hh) * 64 + w4 * 32 + r] = acc[i];
    }
    __syncthreads();
    if (active && w4 < 2) {
        float x[32];
        const int col = F.lane;
        if (w4 == 0) {
#pragma unroll
            for (int q = 0; q < 4; ++q) { float f8[8]; unpack8(*(const LAS v4u*)(KtT + col * R_CP + 8 * q), f8);
#pragma unroll
                for (int e = 0; e < 8; ++e) x[8 * q + e] = f8[e]; }
        } else {
#pragma unroll
            for (int tt = 0; tt < 32; ++tt) x[tt] = BVf[tt * 64 + col];
        }
#pragma unroll
        for (int tt = 1; tt < 32; ++tt) {
            float acc = x[tt];
            const LAS float* ap = Af + tt * 32;
            asm volatile("" : "+v"(ap), "+v"(x[tt - 1]));
#pragma unroll
            for (int s = 0; s < tt; ++s) acc = __builtin_fmaf(-ap[s], x[s], acc);
            x[tt] = acc;
        }
        LAS bf16* O = (w4 == 0 ? KbT : VbT) + col * R_CP;
#pragma unroll
        for (int q = 0; q < 4; ++q) { float f8[8];
#pragma unroll
            for (int e = 0; e < 8; ++e) f8[e] = -x[8 * q + e];
            *(LAS v4u*)(O + 8 * q) = packw8(f8); }
    }
    __syncthreads();
    if (active) {
        const int jt = w4 >> 1, ct = w4 & 1;
        f32x16 am, an;
#pragma unroll
        for (int i = 0; i < 16; ++i) { am[i] = 0.f; an[i] = 0.f; }
#pragma unroll
        for (int s = 0; s < 2; ++s) {
            const bf16x8_t a_ac = *(const LAS bf16x8_t*)(AcT + (jt * 32 + r) * R_CP + 16 * s + 8 * hh), a_kc = *(const LAS bf16x8_t*)(KcT + (jt * 32 + r) * R_CP + 16 * s + 8 * hh);
            am = MFMA32(a_ac, *(const LAS bf16x8_t*)(KbT + (ct * 32 + r) * R_CP + 16 * s + 8 * hh), am);
            an = MFMA32(a_kc, *(const LAS bf16x8_t*)(VT + (ct * 32 + r) * R_CP + 16 * s + 8 * hh), an);
            an = MFMA32(a_ac, *(const LAS bf16x8_t*)(VbT + (ct * 32 + r) * R_CP + 16 * s + 8 * hh), an);
        }
        bf16* Mp = (bf16*)mn; bf16* Np = (bf16*)(mn + 8192);
        const int cj = ct * 32 + r;
#pragma unroll
        for (int i = 0; i < 16; ++i) {
            const int j = jt * 32 + crow(i, hh);
            float mv = am[i]; if (j == cj) mv += GC[j];
            const int s2 = cj >> 5, rem = cj & 31, e = 4 * (rem >> 4) + (rem & 3), q = (rem >> 2) & 3;
            Mp[j * 64 + s2 * 32 + q * 8 + e] = (bf16)f2bf(mv);
            Np[cj * 64 + ((j >> 2) & 3) * 16 + (j >> 4) * 4 + (j & 3)] = (bf16)f2bf(an[i]);
        }
        f32x16 ay;
        if (w4 < 2) {
#pragma unroll
            for (int i = 0; i < 16; ++i) ay[i] = bf2f(Rt[crow(i, hh) * R_TP + w4 * 32 + r]);
#pragma unroll
            for (int s = 0; s < 2; ++s) ay = MFMA32(*(const LAS bf16x8_t*)(RAm + r * R_CP + 16 * s + 8 * hh), *(const LAS bf16x8_t*)(KbT + (w4 * 32 + r) * R_CP + 16 * s + 8 * hh), ay);
#pragma unroll
            for (int i = 0; i < 16; ++i) UB[(size_t)(row0 + crow(i, hh)) * BCOLS + h * 64 + w4 * 32 + r] = (bf16)f2bf(ay[i]);
        } else {
            const int it = w4 - 2;
#pragma unroll
            for (int i = 0; i < 16; ++i) ay[i] = 0.f;
#pragma unroll
            for (int s = 0; s < 2; ++s) {
                ay = MFMA32(*(const LAS bf16x8_t*)(RKm + r * R_CP + 16 * s + 8 * hh), *(const LAS bf16x8_t*)(VT + (it * 32 + r) * R_CP + 16 * s + 8 * hh), ay);
                ay = MFMA32(*(const LAS bf16x8_t*)(RAm + r * R_CP + 16 * s + 8 * hh), *(const LAS bf16x8_t*)(VbT + (it * 32 + r) * R_CP + 16 * s + 8 * hh), ay);
            }
#pragma unroll
            for (int i = 0; i < 16; ++i) UB[(size_t)(row0 + crow(i, hh)) * BCOLS + 512 + h * 64 + it * 32 + r] = (bf16)f2bf(ay[i]);
        }
    }
    __syncthreads();
}

__device__ __forceinline__ void r2_wave(const Frame& F, const Args& A, int bh, int wq) {
    const int m = F.lane & 15, q = F.lane >> 4, i = 16 * wq + m;
    f32x4_t acc[4];
#pragma unroll
    for (int jt = 0; jt < 4; ++jt) acc[jt] = (f32x4_t){0.f, 0.f, 0.f, 0.f};
    unsigned char* base = (unsigned char*)A.out + (size_t)bh * 64 * 16384;
    v4u Mf[4][2], Nf[2];
    auto load = [&](int c) {
        const unsigned char* u = base + (size_t)c * 16384;
#pragma unroll
        for (int jt = 0; jt < 4; ++jt)
#pragma unroll
            for (int s2 = 0; s2 < 2; ++s2) Mf[jt][s2] = *(const v4u*)(u + ((16 * jt + m) * 64 + s2 * 32 + q * 8) * 2);
        Nf[0] = *(const v4u*)(u + 8192 + (i * 64 + q * 16) * 2); Nf[1] = *(const v4u*)(u + 8192 + (i * 64 + q * 16 + 8) * 2);
    };
    load(0);
    for (int c = 0; c < 64; ++c) {
        asm volatile("s_waitcnt vmcnt(0)" ::: "memory");
        v4u Mc[4][2]; float nf[16];
#pragma unroll
        for (int jt = 0; jt < 4; ++jt) { Mc[jt][0] = Mf[jt][0]; Mc[jt][1] = Mf[jt][1]; }
        { float t8[8]; unpack8(Nf[0], t8);
#pragma unroll
          for (int e = 0; e < 8; ++e) nf[e] = t8[e];
          unpack8(Nf[1], t8);
#pragma unroll
          for (int e = 0; e < 8; ++e) nf[8 + e] = t8[e]; }
        { unsigned char* u = base + (size_t)c * 16384 + 8192;
#pragma unroll
          for (int jt = 0; jt < 4; ++jt) { v2u w; w.x = pk2(acc[jt][0], acc[jt][1]); w.y = pk2(acc[jt][2], acc[jt][3]); *(v2u*)(u + (i * 64 + 16 * jt + 4 * q) * 2) = w; } }
        if (c + 1 < 64) load(c + 1);
        const bf16x8_t b0 = pack8(acc[0][0], acc[0][1], acc[0][2], acc[0][3], acc[1][0], acc[1][1], acc[1][2], acc[1][3]);
        const bf16x8_t b1 = pack8(acc[2][0], acc[2][1], acc[2][2], acc[2][3], acc[3][0], acc[3][1], acc[3][2], acc[3][3]);
#pragma unroll
        for (int jt = 0; jt < 4; ++jt) {
            f32x4_t n = (f32x4_t){nf[4 * jt], nf[4 * jt + 1], nf[4 * jt + 2], nf[4 * jt + 3]};
            n = MFMA16(__builtin_bit_cast(bf16x8_t, Mc[jt][0]), b0, n);
            n = MFMA16(__builtin_bit_cast(bf16x8_t, Mc[jt][1]), b1, n);
            acc[jt] = n;
        }
    }
    float* so = A.out + O_WKV_P + (size_t)bh * 4096 + i * 64;
#pragma unroll
    for (int jt = 0; jt < 4; ++jt) *(f32x4*)(so + 16 * jt + 4 * q) = (f32x4){acc[jt][0], acc[jt][1], acc[jt][2], acc[jt][3]};
}

__device__ __forceinline__ void r3_unit(const Frame& F, const Args& A, int unit) {
    bf16* UB = (bf16*)(A.ws + WS_UB);
    const bf16* Wgt = (const bf16*)(A.ws + WS_WGT);
    const float* bonus = (const float*)(A.ws + WS_BONUS);
    const int b = unit >> 9, h = (unit >> 6) & 7, c = unit & 63, row0 = b * SEQ + c * RC;
    const bf16* Sc = (const bf16*)((const unsigned char*)A.out + (size_t)unit * 16384 + 8192);
    const int r = F.lane & 31, hh = F.lane >> 5, row = row0 + r;
    f32x16 y0, y1, g0, g1;
#pragma unroll
    for (int i = 0; i < 16; ++i) { y0[i] = 0.f; y1[i] = 0.f; g0[i] = 0.f; g1[i] = 0.f; }
    if (c > 0) {
#pragma unroll
        for (int s = 0; s < 4; ++s) {
            const bf16x8_t bq = *(const bf16x8_t*)(UB + (size_t)row * BCOLS + h * 64 + 16 * s + 8 * hh);
            y0 = MFMA32(*(const bf16x8_t*)(Sc + r * 64 + 16 * s + 8 * hh), bq, y0);
            y1 = MFMA32(*(const bf16x8_t*)(Sc + (32 + r) * 64 + 16 * s + 8 * hh), bq, y1);
        }
    }
    {   const float* mu = A.in[7] + 1664;
        const bool hasprev = (r > 0) || (c > 0);
#pragma unroll
        for (int s = 0; s < 8; ++s) {
            float cur[8], prv[8];
            unpack8(*(const v4u*)(UB + (size_t)row * BCOLS + 1664 + 16 * s + 8 * hh), cur);
            v4u pw = (v4u){0, 0, 0, 0}; if (hasprev) pw = *(const v4u*)(UB + (size_t)(row - 1) * BCOLS + 1664 + 16 * s + 8 * hh);
            unpack8(pw, prv);
            const f32x4 m0 = *(const f32x4*)(mu + 16 * s + 8 * hh), m1 = *(const f32x4*)(mu + 16 * s + 8 * hh + 4);
            float sg[8];
#pragma unroll
            for (int e = 0; e < 8; ++e) sg[e] = sigmoidf_(cur[e] + (prv[e] - cur[e]) * (e < 4 ? m0[e] : m1[e - 4]));
            const bf16x8_t bq = __builtin_bit_cast(bf16x8_t, packw8(sg));
            g0 = MFMA32(*(const bf16x8_t*)(Wgt + (size_t)(h * 64 + r) * 128 + 16 * s + 8 * hh), bq, g0);
            g1 = MFMA32(*(const bf16x8_t*)(Wgt + (size_t)(h * 64 + 32 + r) * 128 + 16 * s + 8 * hh), bq, g1);
        } }
    float yv[32]; float sum = 0.f;
#pragma unroll
    for (int it = 0; it < 2; ++it)
#pragma unroll
        for (int gq = 0; gq < 4; ++gq) {
            const v2u w = *(const v2u*)(UB + (size_t)row * BCOLS + 512 + h * 64 + 32 * it + 8 * gq + 4 * hh);
            const float yb[4] = {bflo(w.x), bfhi(w.x), bflo(w.y), bfhi(w.y)};
#pragma unroll
            for (int e = 0; e < 4; ++e) { const float v = (it ? y1[4 * gq + e] : y0[4 * gq + e]) + yb[e]; yv[16 * it + 4 * gq + e] = v; sum += v; }
        }
    sum += __shfl_xor(sum, 32);
    const float mean = sum * (1.0f / 64.0f);
    float var = 0.f;
#pragma unroll
    for (int x = 0; x < 32; ++x) { yv[x] -= mean; var += yv[x] * yv[x]; }
    var += __shfl_xor(var, 32);
    const float rs = rsqrtf(var * (1.0f / 64.0f) + GN_EPS), bn = bonus[(size_t)row * 8 + h];
#pragma unroll
    for (int it = 0; it < 2; ++it)
#pragma unroll
        for (int gq = 0; gq < 4; ++gq) {
            const int i0 = 32 * it + 8 * gq + 4 * hh, ch = h * 64 + i0;
            const v2u vw = *(const v2u*)(UB + (size_t)row * BCOLS + 1024 + ch);
            const float vv[4] = {bflo(vw.x), bfhi(vw.x), bflo(vw.y), bfhi(vw.y)};
            const f32x4 lw = *(const f32x4*)(A.in[16] + ch), lb = *(const f32x4*)(A.in[17] + ch);
            float o[4];
#pragma unroll
            for (int e = 0; e < 4; ++e) { const float gg = it ? g1[4 * gq + e] : g0[4 * gq + e]; o[e] = (yv[16 * it + 4 * gq + e] * rs * lw[e] + lb[e] + bn * vv[e]) * gg; }
            v2u ow; ow.x = pk2(o[0], o[1]); ow.y = pk2(o[2], o[3]);
            *(v2u*)(UB + (size_t)row * BCOLS + 512 + ch) = ow;
        }
}

__device__ __forceinline__ float rdl(float x, int k) { return __builtin_bit_cast(float, __builtin_amdgcn_readlane(__builtin_bit_cast(int, x), k)); }
__device__ __forceinline__ void rwkv_sample_wave(const Frame& F, const Args& A, int bh, LAS float* wl) {
    bf16* UB = (bf16*)(A.ws + WS_UB);
    const int b = bh >> 3, h = bh & 7, row0 = MP + 4 * b, l = F.lane, ch = h * 64 + l;
    const float* mu = A.in[7];
    float xr[4], xk[4], xv[4], tw[4], ad[4], sg0[4], sg1[4];
#pragma unroll
    for (int t = 0; t < 4; ++t) {
        const int row = row0 + t, prow = t ? row - 1 : MT + b;
        xr[t] = shifted(UB, row, prow, ch, mu[ch]); xk[t] = shifted(UB, row, prow, 512 + ch, mu[512 + ch]); xv[t] = shifted(UB, row, prow, 1024 + ch, mu[1024 + ch]);
        tw[t] = tanhf_(shifted(UB, row, prow, 1536 + l, mu[1536 + l])); ad[t] = shifted(UB, row, prow, 1600 + l, mu[1600 + l]);
        sg0[t] = sigmoidf_(shifted(UB, row, prow, 1664 + l, mu[1664 + l])); sg1[t] = sigmoidf_(shifted(UB, row, prow, 1728 + l, mu[1728 + l]));
    }
    float dec[4] = {0.f, 0.f, 0.f, 0.f}, aa[4] = {0.f, 0.f, 0.f, 0.f}, g[4] = {0.f, 0.f, 0.f, 0.f};
    {   const float* pd = A.in[9] + ch; const float* pa = A.in[11] + ch; const float* pg = A.in[12] + ch;
#pragma unroll 4
        for (int k = 0; k < 64; ++k) {
            const float wd = pd[0], wa = pa[0], wg0 = pg[0], wg1 = pg[64 * BW];
            pd += BW; pa += BW; pg += BW;
#pragma unroll
            for (int t = 0; t < 4; ++t) {
                dec[t] += rdl(tw[t], k) * wd; aa[t] += rdl(ad[t], k) * wa; g[t] += rdl(sg0[t], k) * wg0 + rdl(sg1[t], k) * wg1;
            }
        } }
    const float w0 = A.in[8][ch], a0 = A.in[10][ch], kkc = A.in[13][ch], kac = A.in[14][ch], rkc = A.in[15][ch];
    float bon[4];
#pragma unroll
    for (int t = 0; t < 4; ++t) {
        const float w = __expf(-DECAY_SCALE * sigmoidf_(w0 + dec[t])), a = sigmoidf_(a0 + aa[t]);
        const float kp = xk[t] * kkc, kk = kp / fmaxf(sqrtf(wave_sum(kp * kp)), 1e-12f), k2 = xk[t] * (1.0f + (a - 1.0f) * kac);
        bon[t] = wave_sum(xr[t] * k2 * rkc);
        LAS float* v = wl + t * 384;
        v[l] = w; v[64 + l] = kk; v[128 + l] = kk * a; v[192 + l] = k2; v[256 + l] = xr[t];
    }
    asm volatile("s_waitcnt lgkmcnt(0)" ::: "memory");
    float S[64];
    const float* sin_ = A.in[3] + (size_t)bh * 4096 + l * 64;
#pragma unroll
    for (int j4 = 0; j4 < 16; ++j4) { const f32x4 s = *(const f32x4*)(sin_ + 4 * j4); S[4 * j4] = s[0]; S[4 * j4 + 1] = s[1]; S[4 * j4 + 2] = s[2]; S[4 * j4 + 3] = s[3]; }
#pragma unroll
    for (int t = 0; t < 4; ++t) {
        const LAS float* v = wl + t * 384;
        float sk = 0.f;
#pragma unroll
        for (int j4 = 0; j4 < 16; ++j4) { const f32x4 k4 = *(const LAS f32x4*)(v + 64 + 4 * j4); sk += (S[4 * j4] * k4[0] + S[4 * j4 + 1] * k4[1]) + (S[4 * j4 + 2] * k4[2] + S[4 * j4 + 3] * k4[3]);
            if ((j4 & 3) == 3) asm volatile("" : "+v"(v), "+v"(sk)); }
        float y = 0.f;
#pragma unroll
        for (int j4 = 0; j4 < 16; ++j4) {
            const f32x4 w4 = *(const LAS f32x4*)(v + 4 * j4), ka = *(const LAS f32x4*)(v + 128 + 4 * j4), k4 = *(const LAS f32x4*)(v + 192 + 4 * j4), r4 = *(const LAS f32x4*)(v + 256 + 4 * j4);
#pragma unroll
            for (int e = 0; e < 4; ++e) { const float s = S[4 * j4 + e] * w4[e] - sk * ka[e] + xv[t] * k4[e]; S[4 * j4 + e] = s; y += s * r4[e]; }
            if (j4 & 1) asm volatile("" : "+v"(v), "+v"(y));
        }
        const float mean = wave_sum(y) * (1.0f / 64.0f), d = y - mean, var = wave_sum(d * d) * (1.0f / 64.0f);
        const float yn = d * rsqrtf(var + GN_EPS) * A.in[16][ch] + A.in[17][ch];
        UB[(size_t)(row0 + t) * BCOLS + 512 + ch] = (bf16)f2bf((yn + bon[t] * xv[t]) * g[t]);
    }
    float* so = A.out + O_WKV_S + (size_t)bh * 4096 + l * 64;
#pragma unroll
    for (int j4 = 0; j4 < 16; ++j4) *(f32x4*)(so + 4 * j4) = (f32x4){S[4 * j4], S[4 * j4 + 1], S[4 * j4 + 2], S[4 * j4 + 3]};
    asm volatile("s_waitcnt lgkmcnt(0)" ::: "memory");
}

__device__ __forceinline__ void p3_seq(const Frame& F, const Args& A) {
    if (F.wave == 0) { for (int u = F.vcu; u < 256; u += F.G) r2_wave(F, A, u >> 2, u & 3); }
    else {
        const int wk = F.vcu * 7 + F.wave - 1, NW = F.G * 7;
        h2_part(F, A, wk * 64 + F.lane, NW * 64);
        LAS float* wl = (LAS float*)F.lds + F.wave * 1536;
        for (int bh = wk; bh < 1024; bh += NW) rwkv_sample_wave(F, A, bh, wl);
    }
}

__device__ __forceinline__ void p9_final(const Frame& F, const Args& A) {
    const int gw = F.vcu * NWAVES + F.wave, NGW = F.G * NWAVES;
    const float* ssq = (const float*)(A.ws + WS_SSQ2);
    f32x4 gv[4];
#pragma unroll
    for (int j = 0; j < 4; ++j) gv[j] = ((const f32x4*)A.in[26])[F.lane + 64 * j];
    for (int m = gw; m < MT; m += NGW) {
        const f32x4* sp = (const f32x4*)(ssq + (size_t)m * 16); const f32x4 a = sp[0], b = sp[1], c = sp[2], d = sp[3];
        const float tot = ((a[0] + a[1]) + (a[2] + a[3])) + ((b[0] + b[1]) + (b[2] + b[3])) + ((c[0] + c[1]) + (c[2] + c[3])) + ((d[0] + d[1]) + (d[2] + d[3]));
        const float rstd = rsqrtf(tot * (1.0f / D) + NORM_EPS);
        f32x4* xr = (f32x4*)(A.out + (size_t)m * D) + F.lane;
#pragma unroll
        for (int j = 0; j < 4; ++j) xr[64 * j] = xr[64 * j] * rstd * gv[j];
    }
}

__global__ void __launch_bounds__(NWAVES * 64, 2) fwd(Args args) {
    extern __shared__ __attribute__((aligned(16))) unsigned char lds[];
    Frame F;
    F.lds = (LAS unsigned char*)lds;
    F.tid = threadIdx.x; F.lane = F.tid & 63; F.wave = __builtin_amdgcn_readfirstlane(F.tid >> 6);
    F.G = gridDim.x; { const int bx = blockIdx.x; F.vcu = (F.G % 8 == 0) ? (bx % 8) * (F.G / 8) + bx / 8 : bx; }
    unsigned char* ws = args.ws;
    gu32* ctl = (gu32*)(ws + WS_CTL);
    for (int u = F.tid; u < (LDS_BYTES - LDSCTL_OFF) / 4; u += NWAVES * 64) ((LAS unsigned*)(F.lds + LDSCTL_OFF))[u] = 0u;
    __syncthreads();
    volatile LAS unsigned* MISC = (volatile LAS unsigned*)(F.lds + MISC_OFF);
    XcdBarrier bar; bar.bar = (unsigned*)(ctl + CW_BAR); bar.x = 0; bar.st = nullptr;
    if (MK_N_LAUNCHES == 1) bar = xcd_barrier_post((unsigned*)(ctl + CW_BAR), MISC + 8);
    const int lo = args.ph_lo, hi = args.ph_hi;
#ifndef PH_MASK
#define PH_MASK 0x3ff
#endif
#ifndef DUP_MASK
#define DUP_MASK 0
#endif
#define REP(k) for (int rep_ = 0; rep_ < (((DUP_MASK >> (k)) & 1) ? 2 : 1); ++rep_)
#define IN(k) (((PH_MASK >> (k)) & 1) && lo <= (k) && (k) < hi)
#define SEAM(k) do { if (IN(k) && IN((k) + 1)) xcd_barrier(bar); } while (0)
    bf16* UA = (bf16*)(ws + WS_UA); bf16* UB = (bf16*)(ws + WS_UB); bf16* UG = (bf16*)(ws + WS_UG);

    if (IN(0)) REP(0) { p0_prologue(F, args); } SEAM(0);
    if (IN(1)) REP(1) {
        pg8::Gemm g{(const bf16*)args.out, (const bf16*)(ws + WS_WIN), MH, NIN, D, D, D};
        SchedG1 S; S.init(F.G, (int)blockIdx.x);
        EpiG1 E{UA, UB, UG, (bf16*)(args.out + O_HGRN_S)};
        pg8::gemm_phase<EpiG1, SchedG1, true, true>(F.lds, g, S, E);
    } SEAM(1);
    if (IN(2)) {
        for (int ps = 0; ps * 2 * F.G < 4096; ++ps) { const int unit = (ps * F.G + F.vcu) * 2 + (F.wave >> 2); r1_pass(F, args, unit < 4096 ? unit : 0, unit < 4096); }
        for (int u = F.vcu; u < 1024; u += F.G) h1_unit(F, args, u);
    } SEAM(2);
    if (IN(3)) { p3_seq(F, args); } SEAM(3);
    if (IN(4)) { for (int u = F.vcu * NWAVES + F.wave; u < 4096; u += F.G * NWAVES) r3_unit(F, args, u); for (int u = F.vcu; u < 1024; u += F.G) h3_unit(F, args, u); for (int u = F.vcu; u < 512; u += F.G) hgrn_sample_unit(F, args, u); } SEAM(4);
    if (IN(5)) REP(5) {
        SchedMN S; S.init(MT, D, F.G, (int)blockIdx.x);
        { pg8::Gemm g{UA + 1024, (const bf16*)(ws + WS_WA), MT, D, AW, ACOLS, AW}; EpiMerge<false> E{UA, UG, 0};
          pg8::gemm_phase<EpiMerge<false>, SchedMN, true, true>(F.lds, g, S, E); }
        { pg8::Gemm g{UB + 512, (const bf16*)(ws + WS_WB), MT, D, BW, BCOLS, BW}; EpiMerge<true> E{UA, UG, 1024};
          pg8::gemm_phase<EpiMerge<true>, SchedMN, true, true>(F.lds, g, S, E); }
    } SEAM(5);
    if (IN(6)) REP(6) {
        SchedMN S; S.init(MT, D, F.G, (int)blockIdx.x);
        pg8::Gemm g{UA, (const bf16*)(ws + WS_WO), MT, D, D, ACOLS, D};
        EpiRes<true, true> E{args.in[0], args.in[1], args.out, UB, BCOLS, (float*)(ws + WS_SSQ1)};
        pg8::gemm_phase<EpiRes<true, true>, SchedMN, true, true>(F.lds, g, S, E);
    } SEAM(6);
    if (IN(7)) REP(7) {
        SchedMN S; S.init(MT, DFF, F.G, (int)blockIdx.x);
        pg8::Gemm g{UB, (const bf16*)(ws + WS_WUP), MT, DFF, D, BCOLS, D};
        EpiUp E{UA, (const float*)(ws + WS_SSQ1)};
        pg8::gemm_phase<EpiUp, SchedMN, true, true>(F.lds, g, S, E);
    } SEAM(7);
    if (IN(8)) {
        SchedMN S; S.init(MT, D, F.G, (int)blockIdx.x);
        pg8::Gemm g{UA, (const bf16*)(ws + WS_WDN), MT, D, DFF, DFF, DFF};
        EpiRes<false, false> E{nullptr, nullptr, args.out, nullptr, 0, (float*)(ws + WS_SSQ2)};
        pg8::gemm_phase<EpiRes<false, false>, SchedMN, true, true>(F.lds, g, S, E);
    } SEAM(8);
    if (IN(9)) { p9_final(F, args); }
#undef IN
#undef SEAM
}

extern "C" void kernel_launch(void* const* d_in, const int* in_sizes, int n_in, void* d_out, int out_size, void* d_ws, size_t ws_size, hipStream_t stream) {
    static int grid = 0;
    if (grid == 0) {
        if (n_in != 27 || out_size != (int)O_END || ws_size < WS_END) { fprintf(stderr, "kernel_launch: unexpected shapes (n_in %d, out %d, ws %zu)\n", n_in, out_size, ws_size); grid = -1; return; }
        int dev = 0, cus = 0, per_cu = 0;
        if (hipGetDevice(&dev) != hipSuccess || hipDeviceGetAttribute(&cus, hipDeviceAttributeMultiprocessorCount, dev) != hipSuccess) { grid = -1; return; }
        if (hipFuncSetAttribute((const void*)fwd, hipFuncAttributeMaxDynamicSharedMemorySize, LDS_BYTES) != hipSuccess) { fprintf(stderr, "kernel_launch: hipFuncSetAttribute failed\n"); grid = -1; return; }
        if (hipOccupancyMaxActiveBlocksPerMultiprocessor(&per_cu, (const void*)fwd, NWAVES * 64, LDS_BYTES) != hipSuccess || per_cu < 1) { fprintf(stderr, "kernel_launch: occupancy query says %d\n", per_cu); }
        (void)hipGetLastError();
        grid = cus;
    }
    if (grid < 0) return;
    (void)hipMemsetAsync((char*)d_ws + WS_CTL, 0, CTL_BYTES, stream);
    Args a{};
    for (int i = 0; i < 27; ++i) a.in[i] = (const float*)d_in[i];
    a.out = (float*)d_out; a.ws = (unsigned char*)d_ws;
    if (MK_N_LAUNCHES == 1) { a.ph_lo = 0; a.ph_hi = NPHASE; hipLaunchKernelGGL(fwd, dim3(grid), dim3(NWAVES * 64), LDS_BYTES, stream, a); }
    else for (int p = 0; p < NPHASE; ++p) { a.ph_lo = p; a.ph_hi = p + 1; hipLaunchKernelGGL(fwd, dim3(grid), dim3(NWAVES * 64), LDS_BYTES, stream, a); }
}
```

```cpp
#include <hip/hip_runtime.h>
#include <cstdio>
#include <cstdint>
namespace pg8 {
#define PG8_LAS __attribute__((address_space(3)))
typedef unsigned short bf16_t;
typedef short bf16x8 __attribute__((ext_vector_type(8)));
typedef float f32x4 __attribute__((ext_vector_type(4)));
typedef unsigned u32x4 __attribute__((ext_vector_type(4)));
constexpr int BM = 256, BK = 64, HALF = 128, HTB = HALF * BK * 2  , STAGE_BYTES = 8 * HTB, NXCD = 8, WGM = 8;

__host__ __device__ __forceinline__ int lds_byte(int r, int c) { const int st = (r >> 4) * 2 + (c >> 5), rr = r & 15, cc = c & 31, ob = rr * 64 + cc * 2; return st * 1024 + (ob ^ (((ob >> 9) & 1) << 5)); }
__host__ __device__ __forceinline__ void stage_rc(int b, int& R, int& C) { const int st = b / 1024, sb = b % 1024, swz = sb ^ (((sb >> 9) & 1) << 5); R = (st >> 1) * 16 + swz / 64; C = (st & 1) * 32 + (swz % 64) / 2; }
__host__ __device__ __forceinline__ int perm32(int rho) { const int n = rho >> 4, i = rho & 15; return 8 * (i >> 2) + 4 * n + (i & 3); }

struct Unit { int pm, pn; };
struct Gemm { const bf16_t* A; const bf16_t* Bt; int M, N, K, lda, ldb; };

struct StaticOrder {
    int nM, nN, nwg, G, c;
    __host__ __device__ void init(int M, int N, int G_, int c_) { nM = M / BM; nN = N / BM; nwg = nM * nN; G = G_; c = c_; }
    __host__ __device__ bool next(int i, Unit& u) const {
        const long L = (long)i * G + c; if (L >= nwg) return false;
        int wgid = (int)L; { const int q = nwg / NXCD, r = nwg % NXCD, xcd = wgid % NXCD, off = wgid / NXCD; wgid = (xcd < r ? xcd * (q + 1) : r * (q + 1) + (xcd - r) * q) + off; }
        const int nig = WGM * nN, gid = wgid / nig, fm = gid * WGM, gsz = (nM - fm) < WGM ? (nM - fm) : WGM;
        u.pm = fm + ((wgid % nig) % gsz); u.pn = (wgid % nig) / gsz; return true;
    }
    __device__ __forceinline__ void a_ready(const Unit&) const {}
    __device__ __forceinline__ void done(const Unit&) const {}
};

__device__ __forceinline__ unsigned cvt_pk_bf16(float lo, float hi) { unsigned r; asm volatile("v_cvt_pk_bf16_f32 %0, %1, %2" : "=v"(r) : "v"(lo), "v"(hi)); return r; }
typedef float f32x2 __attribute__((ext_vector_type(2)));
__device__ __forceinline__ f32x2 gelu_pk(f32x2 v) {
    const f32x2 av = __builtin_elementwise_abs(v), d = av * 0.2316418882f + 1.0f;
    f32x2 t; t.x = __builtin_amdgcn_rcpf(d.x); t.y = __builtin_amdgcn_rcpf(d.y);
    f32x2 q = t * 0.5307027145f + (-0.7265760135f); q = q * t + 0.7107068705f; q = q * t + (-0.142248368f); q = q * t + 0.127414796f; q = q * t;
    const f32x2 s = (v * v) * (-0.72134752044f);
    f32x2 e; e.x = __builtin_amdgcn_exp2f(s.x); e.y = __builtin_amdgcn_exp2f(s.y);
    const f32x2 m = v * (q * e), r = v - m;
    f32x2 o; o.x = v.x < 0.f ? m.x : r.x; o.y = v.y < 0.f ? m.y : r.y; return o;
}

template <class Epi, class Sched, bool ALIGN_EPI = false, bool SP2 = false>
__device__ __forceinline__ void gemm_phase(PG8_LAS unsigned char* lds, const Gemm g, const Sched& S, const Epi& E) {
    const int tid = threadIdx.x, wid = __builtin_amdgcn_readfirstlane(tid >> 6), lane = tid & 63, wr = wid >> 2, wc = wid & 3, fr = lane & 15, fq = lane >> 4;
    const int K = g.K, nt = K / BK;
    unsigned voffA[2], voffB[2];
#pragma unroll
    for (int i = 0; i < 2; ++i) { int R, C; stage_rc(tid * 16 + i * 8192, R, C); const int Rb = Epi::PERM ? ((R & ~31) + perm32(R & 31)) : R;
        voffA[i] = (unsigned)(R * g.lda + C) * 2u; voffB[i] = (unsigned)(Rb * g.ldb + C) * 2u; }
    const size_t kstep = (size_t)(BK * 2);
    const size_t hstepA = (size_t)HALF * g.lda * 2, hstepB = (size_t)HALF * g.ldb * 2;
    const size_t tstepA = 2 * hstepA, tstepB = 2 * hstepB;
    const unsigned ldsw = (unsigned)wid * 1024u;
    const int aoff = lds_byte(wr * 64 + fr, fq * 8), boff = lds_byte(wc * 32 + fr, fq * 8);
#define PG8_SA(b, h) (((b) * 2 + (h)) * HTB)
#define PG8_SB(b, h) ((4 + (b) * 2 + (h)) * HTB)
#define PG8_STAGE(bufoff, gbase, voff) do { _Pragma("unroll") for (int _i = 0; _i < 2; ++_i) \
        __builtin_amdgcn_global_load_lds((const unsigned*)((const char*)(gbase) + (voff)[_i]), (PG8_LAS unsigned*)(lds + (bufoff) + ldsw + _i * 8192), 16, 0, 0); } while (0)
#define PG8_LDA(dst, b, h) do { _Pragma("unroll") for (int m = 0; m < 4; ++m) _Pragma("unroll") for (int k = 0; k < 2; ++k) dst[m][k] = *(const PG8_LAS bf16x8*)(lds + PG8_SA(b, h) + aoff + m * 2048 + k * 1024); } while (0)
#define PG8_LDB(dst, b, h) do { _Pragma("unroll") for (int n = 0; n < 2; ++n) _Pragma("unroll") for (int k = 0; k < 2; ++k) dst[n][k] = *(const PG8_LAS bf16x8*)(lds + PG8_SB(b, h) + boff + n * 2048 + k * 1024); } while (0)
#define PG8_MMA(ai, bj, At, Bt) do { __builtin_amdgcn_s_setprio(1); _Pragma("unroll") for (int m = 0; m < 4; ++m) _Pragma("unroll") for (int n = 0; n < 2; ++n) _Pragma("unroll") for (int k = 0; k < 2; ++k) \
        acc[ai][bj][m][n] = __builtin_amdgcn_mfma_f32_16x16x32_bf16(Bt[n][k], At[m][k], acc[ai][bj][m][n], 0, 0, 0); __builtin_amdgcn_s_setprio(0); } while (0)
#define PG8_WAIT_V(n) asm volatile("s_waitcnt vmcnt(" #n ")" ::: "memory")
#define PG8_WAIT_L(n) asm volatile("s_waitcnt lgkmcnt(" #n ")" ::: "memory")
#define PG8_BAR __builtin_amdgcn_s_barrier()
#define PG8_SCHED __builtin_amdgcn_sched_barrier(0)
    Unit cur, nxt; int ui = 0;
    if (!S.next(0, cur)) return;
    f32x4 acc[2][2][4][2];
#pragma unroll
    for (int a = 0; a < 2; ++a)
#pragma unroll
        for (int b = 0; b < 2; ++b)
#pragma unroll
            for (int m = 0; m < 4; ++m)
#pragma unroll
                for (int n = 0; n < 2; ++n) acc[a][b][m][n] = (f32x4){0.f, 0.f, 0.f, 0.f};
    bf16x8 At[4][2], B0[2][2], B1[2][2];
    const char* cA = (const char*)g.A + (size_t)cur.pm * tstepA; const char* cB = (const char*)g.Bt + (size_t)cur.pn * tstepB;
    S.a_ready(cur);
    if constexpr (SP2) {
        PG8_STAGE(PG8_SB(0, 0), cB, voffB); PG8_STAGE(PG8_SB(0, 1), cB + hstepB, voffB); PG8_STAGE(PG8_SA(0, 0), cA, voffA); PG8_STAGE(PG8_SA(0, 1), cA + hstepA, voffA);
        if (wr == 1) PG8_BAR;
        PG8_WAIT_V(2); PG8_BAR;
        PG8_STAGE(PG8_SB(1, 0), cB + kstep, voffB); PG8_STAGE(PG8_SA(1, 0), cA + kstep, voffA); PG8_STAGE(PG8_SB(1, 1), cB + hstepB + kstep, voffB);
        PG8_WAIT_V(6); PG8_BAR;
    } else {
        PG8_STAGE(PG8_SB(0, 0), cB, voffB); PG8_STAGE(PG8_SA(0, 0), cA, voffA); PG8_STAGE(PG8_SB(0, 1), cB + hstepB, voffB); PG8_STAGE(PG8_SA(0, 1), cA + hstepA, voffA);
        if (wr == 1) PG8_BAR;
        PG8_WAIT_V(4); PG8_BAR;
        PG8_STAGE(PG8_SB(1, 0), cB + kstep, voffB); PG8_STAGE(PG8_SA(1, 0), cA + kstep, voffA); PG8_STAGE(PG8_SB(1, 1), cB + hstepB + kstep, voffB);
        PG8_WAIT_V(6); PG8_BAR;
    }
    for (;;) {
        const bool has_next = S.next(ui + 1, nxt);
        const char* nA = has_next ? (const char*)g.A + (size_t)nxt.pm * tstepA : cA; const char* nB = has_next ? (const char*)g.Bt + (size_t)nxt.pn * tstepB : cB;
        for (int t = 0; t < nt; t += 2) {
            const bool last = (t == nt - 2);
            const char* a1 = cA + (size_t)(t + 1) * kstep;
            const char* a2 = last ? nA : cA + (size_t)(t + 2) * kstep; const char* b2 = last ? nB : cB + (size_t)(t + 2) * kstep;
            const char* a3 = a2 + kstep; const char* b3 = b2 + kstep;
            if (last && has_next) S.a_ready(nxt);
            if constexpr (SP2) {
            PG8_LDB(B0, 0, 0); PG8_LDB(B1, 0, 1); PG8_SCHED; PG8_LDA(At, 0, 0); PG8_STAGE(PG8_SA(1, 1), a1 + hstepA, voffA);
            PG8_WAIT_V(8); PG8_WAIT_L(0); PG8_BAR; PG8_MMA(0, 0, At, B0); PG8_MMA(0, 1, At, B1); PG8_BAR; PG8_SCHED;
            PG8_LDA(At, 0, 1); PG8_STAGE(PG8_SB(0, 0), b2, voffB); PG8_STAGE(PG8_SB(0, 1), b2 + hstepB, voffB); PG8_STAGE(PG8_SA(0, 0), a2, voffA);
            PG8_WAIT_V(8); PG8_WAIT_L(0); PG8_BAR; PG8_MMA(1, 0, At, B0); PG8_MMA(1, 1, At, B1); PG8_BAR; PG8_SCHED;
            PG8_LDB(B0, 1, 0); PG8_LDB(B1, 1, 1); PG8_SCHED; PG8_LDA(At, 1, 0); PG8_STAGE(PG8_SA(0, 1), a2 + hstepA, voffA);
            PG8_WAIT_V(8); PG8_WAIT_L(0); PG8_BAR; PG8_MMA(0, 0, At, B0); PG8_MMA(0, 1, At, B1); PG8_BAR; PG8_SCHED;
            PG8_LDA(At, 1, 1); PG8_STAGE(PG8_SB(1, 0), b3, voffB); PG8_STAGE(PG8_SB(1, 1), b3 + hstepB, voffB); PG8_STAGE(PG8_SA(1, 0), a3, voffA);
            PG8_WAIT_V(8); PG8_WAIT_L(0); PG8_BAR; PG8_MMA(1, 0, At, B0); PG8_MMA(1, 1, At, B1); PG8_BAR; PG8_SCHED;
            } else {
            PG8_LDB(B0, 0, 0); PG8_SCHED; PG8_LDA(At, 0, 0); PG8_STAGE(PG8_SA(1, 1), a1 + hstepA, voffA);
            PG8_WAIT_L(8); PG8_BAR; PG8_WAIT_L(0); PG8_MMA(0, 0, At, B0); PG8_BAR; PG8_SCHED;
            PG8_LDB(B1, 0, 1); PG8_STAGE(PG8_SB(0, 0), b2, voffB);
            PG8_BAR; PG8_WAIT_L(0); PG8_MMA(0, 1, At, B1); PG8_BAR;
            PG8_LDA(At, 0, 1); PG8_STAGE(PG8_SA(0, 0), a2, voffA);
            PG8_BAR; PG8_WAIT_L(0); PG8_MMA(1, 0, At, B0); PG8_BAR; PG8_SCHED;
            PG8_STAGE(PG8_SB(0, 1), b2 + hstepB, voffB);
            PG8_WAIT_V(6); PG8_BAR; PG8_MMA(1, 1, At, B1); PG8_BAR;
            PG8_LDB(B0, 1, 0); PG8_SCHED; PG8_LDA(At, 1, 0); PG8_STAGE(PG8_SA(0, 1), a2 + hstepA, voffA);
            PG8_WAIT_L(8); PG8_BAR; PG8_WAIT_L(0); PG8_MMA(0, 0, At, B0); PG8_BAR; PG8_SCHED;
            PG8_LDB(B1, 1, 1); PG8_STAGE(PG8_SB(1, 0), b3, voffB);
            PG8_BAR; PG8_WAIT_L(0); PG8_MMA(0, 1, At, B1); PG8_BAR;
            PG8_LDA(At, 1, 1); PG8_STAGE(PG8_SA(1, 0), a3, voffA);
            PG8_BAR; PG8_WAIT_L(0); PG8_MMA(1, 0, At, B0); PG8_BAR; PG8_SCHED;
            PG8_STAGE(PG8_SB(1, 1), b3 + hstepB, voffB);
            PG8_WAIT_V(6); PG8_BAR; PG8_MMA(1, 1, At, B1); PG8_BAR;
            }
        }
        if constexpr (ALIGN_EPI) { if (wr == 0) PG8_BAR; }
        if constexpr (!Epi::AFTER_DRAIN) { E(acc, cur, wr, wc, fr, fq); S.done(cur); }
        if (!has_next) break;
#pragma unroll
        for (int a = 0; a < 2; ++a)
#pragma unroll
            for (int b = 0; b < 2; ++b)
#pragma unroll
                for (int m = 0; m < 4; ++m)
#pragma unroll
                    for (int n = 0; n < 2; ++n) acc[a][b][m][n] = (f32x4){0.f, 0.f, 0.f, 0.f};
        cur = nxt; cA = nA; cB = nB; ++ui;
        if constexpr (ALIGN_EPI) { if (wr == 1) PG8_BAR; }
    }
    PG8_WAIT_V(0);
    if constexpr (!ALIGN_EPI) { if (wr == 0) PG8_BAR; }
    PG8_BAR;
    if constexpr (Epi::AFTER_DRAIN) { E.fused(acc, cur, wr, wc, fr, fq, lds, wid, lane); S.done(cur); }
#undef PG8_SA
#undef PG8_SB
#undef PG8_STAGE
#undef PG8_LDA
#undef PG8_LDB
#undef PG8_MMA
#undef PG8_WAIT_V
#undef PG8_WAIT_L
#undef PG8_BAR
#undef PG8_SCHED
}
}

#ifndef MK_N_LAUNCHES
#define MK_N_LAUNCHES 1
#endif
constexpr int NPHASE = 10;
constexpr int NWAVES = 8;

constexpr int D = 1024, SEQ = 2048, NBP = 8, NBS = 128, TS = 4;
constexpr int MP = NBP * SEQ;
constexpr int MS = NBS * TS;
constexpr int MT = MP + MS;
constexpr int MH = MT + 256;
constexpr int ACOLS = 2048, BCOLS = 1792, GCOLS = 2048, NIN = ACOLS + BCOLS + GCOLS, DFF = 4096;
constexpr int AW = 512, BW = 512;
constexpr float NORM_EPS = 1e-6f, HGRN_EPS = 1e-5f, GN_EPS = 64e-5f, DECAY_SCALE = 0.6065306597126334f;

constexpr size_t O_Y = 0, O_HGRN_P = (size_t)MT * D, O_WKV_P = O_HGRN_P + (size_t)NBP * 4 * 128 * 128, O_SHIFT_P = O_WKV_P + (size_t)NBP * 8 * 64 * 64,
                 O_HGRN_S = O_SHIFT_P + (size_t)NBP * D, O_WKV_S = O_HGRN_S + (size_t)NBS * 4 * 128 * 128, O_SHIFT_S = O_WKV_S + (size_t)NBS * 8 * 64 * 64,
                 O_END = O_SHIFT_S + (size_t)NBS * D;
static_assert(O_END == 30810112, "d_out size");

constexpr size_t WS_CTL = 0, CTL_BYTES = 65536;
constexpr size_t WS_WIN = WS_CTL + CTL_BYTES;
constexpr size_t WS_WA  = WS_WIN + (size_t)NIN * D * 2;
constexpr size_t WS_WB  = WS_WA + (size_t)D * AW * 2;
constexpr size_t WS_WO  = WS_WB + (size_t)D * BW * 2;
constexpr size_t WS_WUP = WS_WO + (size_t)D * D * 2;
constexpr size_t WS_WDN = WS_WUP + (size_t)DFF * D * 2;
constexpr size_t WS_UB  = WS_WDN + (size_t)D * DFF * 2;
constexpr size_t WS_UA  = WS_UB + (size_t)MH * BCOLS * 2;
constexpr size_t WS_UG  = WS_UA + (size_t)MT * ACOLS * 2;
constexpr size_t WS_BONUS = WS_UG + (size_t)MT * GCOLS * 2;
constexpr size_t WS_NS = WS_BONUS + (size_t)MT * 8 * 4;
constexpr size_t WS_GAMMA = WS_NS + (size_t)1024 * 16384 * 2;
constexpr size_t WS_WDT = WS_GAMMA + (size_t)1024 * 128 * 4;
constexpr size_t WS_WAT = WS_WDT + 512 * 64 * 2;
constexpr size_t WS_WGT = WS_WAT + 512 * 64 * 2;
constexpr size_t WS_END = WS_WGT + 512 * 128 * 2;
constexpr size_t WS_SSQ1 = WS_NS;
constexpr size_t WS_SSQ2 = WS_SSQ1 + (size_t)MT * 16 * 4;
static_assert(WS_END <= 268435456, "d_ws map");
static_assert(WS_UA + (size_t)MT * DFF * 2 == WS_BONUS, "hidden overlays UA|UG exactly");
static_assert((size_t)MT * 2048 * 2 == (size_t)MT * D * 4, "P fits the y region exactly");

constexpr int CW_TMO = 0, CW_BAR = 1024;

constexpr int RING_BYTES = 151552, LDSCTL_OFF = RING_BYTES, MISC_OFF = LDSCTL_OFF + 320, LDS_BYTES = 163840;

#define GAS __attribute__((address_space(1)))
#define LAS __attribute__((address_space(3)))
typedef unsigned short bf16;
typedef unsigned v4u __attribute__((ext_vector_type(4)));
typedef unsigned v2u __attribute__((ext_vector_type(2)));
typedef float f32x4 __attribute__((ext_vector_type(4)));
typedef GAS unsigned gu32;
#define RLX_AGENT __ATOMIC_RELAXED, __HIP_MEMORY_SCOPE_AGENT
#define LDS_WAIT() asm volatile("s_waitcnt lgkmcnt(0)" ::: "memory")
#define VM_WAIT() asm volatile("s_waitcnt vmcnt(0)" ::: "memory")
__device__ __forceinline__ unsigned f2bf(float f) { unsigned u = __builtin_bit_cast(unsigned, f); return (u + 0x7fffu + ((u >> 16) & 1u)) >> 16; }
__device__ __forceinline__ unsigned pk2(float lo, float hi) { return f2bf(lo) | (f2bf(hi) << 16); }
__device__ __forceinline__ float bf2f(unsigned b) { return __builtin_bit_cast(float, b << 16); }
__device__ __forceinline__ float bflo(unsigned w) { return __builtin_bit_cast(float, w << 16); }
__device__ __forceinline__ float bfhi(unsigned w) { return __builtin_bit_cast(float, w & 0xffff0000u); }
__device__ __forceinline__ float sigmoidf_(float x) { return 1.0f / (1.0f + __expf(-x)); }
__device__ __forceinline__ float tanhf_(float x) { return 1.0f - 2.0f / (1.0f + __expf(2.0f * x)); }
__device__ __forceinline__ float wave_sum(float v) {
#pragma unroll
    for (int o = 1; o < 64; o <<= 1) v += __shfl_xor(v, o);
    return v;
}
__device__ __forceinline__ float row_sum16(float x) {
    x += __builtin_bit_cast(float, __builtin_amdgcn_update_dpp(0, __builtin_bit_cast(int, x), 0xB1, 0xF, 0xF, true));
    x += __builtin_bit_cast(float, __builtin_amdgcn_update_dpp(0, __builtin_bit_cast(int, x), 0x4E, 0xF, 0xF, true));
    x += __builtin_bit_cast(float, __builtin_amdgcn_update_dpp(0, __builtin_bit_cast(int, x), 0x141, 0xF, 0xF, true));
    x += __builtin_bit_cast(float, __builtin_amdgcn_update_dpp(0, __builtin_bit_cast(int, x), 0x140, 0xF, 0xF, true));
    return x;
}
#define XB_TMO      128
#define XB_XCNT(j)  (256  + 64 * (j))
#define XB_XSUB(j)  (1280 + 64 * (j))
#define XB_XGEN(j)  (2304 + 64 * (j))
#define XB_TOP      3328
#define XB_TOPGEN   3392
#define XCD_BAR_WORDS 3456
#define XB_SPIN_CAP (1u << 18)

__device__ __forceinline__ unsigned xb_ld(unsigned* p)              { return __hip_atomic_load(p, __ATOMIC_RELAXED, __HIP_MEMORY_SCOPE_AGENT); }
__device__ __forceinline__ unsigned xb_add(unsigned* p, unsigned v) { return __hip_atomic_fetch_add(p, v, __ATOMIC_RELAXED, __HIP_MEMORY_SCOPE_AGENT); }
__device__ __forceinline__ unsigned xb_xcc_id() { return (unsigned)__builtin_amdgcn_s_getreg((3 << 11) | 20) & 0xFu; }
#define XB_SPIN(cond, bar) do { unsigned _sp = 0; while (cond) { __builtin_amdgcn_s_sleep(1); \
    if ((++_sp & 255u) == 0u) { if (xb_ld(&(bar)[XB_TMO])) break; if (_sp > XB_SPIN_CAP) { atomicAdd(&(bar)[XB_TMO], 1u); break; } } } } while (0)

struct XcdBarrier {
    unsigned* bar; unsigned x;
    volatile LAS unsigned* st;
};

__device__ __forceinline__ XcdBarrier xcd_barrier_post(unsigned* bar, volatile LAS unsigned* st) {
    XcdBarrier b; b.bar = bar; b.x = xb_xcc_id(); b.st = st;
    if (threadIdx.x == 0) (void)xb_add(&bar[XB_XCNT(b.x)], 1u);
    return b;
}
__device__ __forceinline__ void xcd_barrier_complete(unsigned* bar, unsigned x, unsigned& nloc, unsigned& nx) {
    const unsigned G = gridDim.x * gridDim.y * gridDim.z;
    unsigned sum, cnt, mine, sp = 0u;
    for (;;) {
        sum = 0u; cnt = 0u; mine = 0u;
#pragma unroll
        for (unsigned j = 0; j < 16; ++j) { const unsigned c = xb_ld(&bar[XB_XCNT(j)]); sum += c; cnt += (c > 0u) ? 1u : 0u; mine = (j == x) ? c : mine; }
        if (sum == G) break;
        __builtin_amdgcn_s_sleep(1);
        if ((++sp & 255u) == 0u) { if (xb_ld(&bar[XB_TMO])) break; if (sp > XB_SPIN_CAP) { atomicAdd(&bar[XB_TMO], 1u); break; } }
    }
    nloc = mine > 0u ? mine : 1u; nx = cnt > 0u ? cnt : 1u;
}

__device__ __forceinline__ void xcd_barrier(const XcdBarrier& b) {
    asm volatile("s_waitcnt vmcnt(0)" ::: "memory");
    __syncthreads();
    if (threadIdx.x == 0) {
        unsigned* bar = b.bar;
        __builtin_amdgcn_s_waitcnt(0);
        unsigned nloc = b.st[0], nx = b.st[1];
        if (nloc == 0u) { xcd_barrier_complete(bar, b.x, nloc, nx); b.st[0] = nloc; b.st[1] = nx; }
        const unsigned old = xb_add(&bar[XB_XSUB(b.x)], 1u);
        const unsigned gen = old / nloc;
        if (old + 1u == (gen + 1u) * nloc) {
            __builtin_amdgcn_fence(__ATOMIC_RELEASE, "agent");
            asm volatile("s_waitcnt vmcnt(0)" ::: "memory");
            const unsigned og = xb_add(&bar[XB_TOP], 1u);
            const unsigned tg = og / nx;
            if (og + 1u == (tg + 1u) * nx) xb_add(&bar[XB_TOPGEN], 1u);
            else XB_SPIN(xb_ld(&bar[XB_TOPGEN]) == tg, bar);
            __builtin_amdgcn_fence(__ATOMIC_ACQUIRE, "agent");
            xb_add(&bar[XB_XGEN(b.x)], 1u);
            asm volatile("s_waitcnt vmcnt(0)" ::: "memory");
        } else {
            XB_SPIN(xb_ld(&bar[XB_XGEN(b.x)]) == gen, bar);
            __builtin_amdgcn_fence(__ATOMIC_ACQUIRE, "agent");
            asm volatile("s_waitcnt vmcnt(0)" ::: "memory");
        }
    }
    __syncthreads();
}


struct Args { const float* in[27]; float* out; unsigned char* ws; int ph_lo, ph_hi; };
struct Frame {
    LAS unsigned char* lds;
    int tid, lane, wave, vcu, G;
};

struct SchedMN {
    pg8::StaticOrder so;
    __device__ void init(int M, int N, int G, int c) { so.init(M, N, G, c); }
    __device__ __forceinline__ bool next(int i, pg8::Unit& u) const { return so.next(i, u); }
    __device__ __forceinline__ void a_ready(const pg8::Unit&) const {}
    __device__ __forceinline__ void done(const pg8::Unit&) const {}
};
struct SchedG1 {
    pg8::StaticOrder so; int G, c;
    __device__ void init(int G_, int c_) { so.init(MT, NIN, G_, c_); G = G_; c = c_; }
    __device__ __forceinline__ bool next(int i, pg8::Unit& u) const {
        const int L = i * G + c;
        if (L < so.nwg) return so.next(i, u);
        if (L < so.nwg + 7) { u.pm = MT / 256; u.pn = 8 + (L - so.nwg); return true; }
        return false;
    }
    __device__ __forceinline__ void a_ready(const pg8::Unit&) const {}
    __device__ __forceinline__ void done(const pg8::Unit&) const {}
};

using pg8::f32x4; using pg8::Unit;
typedef unsigned u32x4 __attribute__((ext_vector_type(4)));
struct EpiG1 {
    static constexpr bool PERM = true, AFTER_DRAIN = false;
    bf16 *UA, *UB, *UG, *BR;
    __device__ __forceinline__ void operator()(const f32x4 (&acc)[2][2][4][2], const Unit& u, int wr, int wc, int fr, int fq) const {
        bf16* base; int ld, colt;
        if (u.pn < 8) { base = UA; ld = ACOLS; colt = u.pn * 256; } else if (u.pn < 15) { base = UB; ld = BCOLS; colt = (u.pn - 8) * 256; } else { base = UG; ld = GCOLS; colt = (u.pn - 15) * 256; }
        const int row0 = u.pm * 256 + wr * 64 + fr, col0 = colt + wc * 32 + 8 * fq;
#pragma unroll
        for (int ai = 0; ai < 2; ++ai)
#pragma unroll
            for (int m = 0; m < 4; ++m) { bf16* rowp = base + (size_t)(row0 + ai * 128 + m * 16) * ld + col0;
#pragma unroll
                for (int bj = 0; bj < 2; ++bj) { const f32x4 v0 = acc[ai][bj][m][0], v1 = acc[ai][bj][m][1];
                    u32x4 w; w.x = pk2(v0[0], v0[1]); w.y = pk2(v0[2], v0[3]); w.z = pk2(v1[0], v1[1]); w.w = pk2(v1[2], v1[3]);
                    *(u32x4*)(rowp + bj * 128) = w;
                    if ((m & 1) && fr == 15 && u.pn >= 8 && u.pn < 14 && u.pm < MP / 256) { const int row = row0 + ai * 128 + m * 16; *(u32x4*)(BR + (size_t)(row >> 5) * 1536 + col0 + bj * 128) = w; } } }
    }
};
template <bool ADD> struct EpiMerge {
    static constexpr bool PERM = true, AFTER_DRAIN = false;
    bf16* Mg; const bf16* UG; int goff;
    __device__ __forceinline__ void operator()(const f32x4 (&acc)[2][2][4][2], const Unit& u, int wr, int wc, int fr, int fq) const {
        const int row0 = u.pm * 256 + wr * 64 + fr, col0 = u.pn * 256 + wc * 32 + 8 * fq;
#pragma unroll
        for (int ai = 0; ai < 2; ++ai)
#pragma unroll
            for (int m = 0; m < 4; ++m) { const size_t row = (size_t)(row0 + ai * 128 + m * 16);
#pragma unroll
                for (int bj = 0; bj < 2; ++bj) { const f32x4 v0 = acc[ai][bj][m][0], v1 = acc[ai][bj][m][1];
                    const u32x4 gq = *(const u32x4*)(UG + row * GCOLS + goff + col0 + bj * 128);
                    float o[8];
                    o[0] = sigmoidf_(bflo(gq.x)) * v0[0]; o[1] = sigmoidf_(bfhi(gq.x)) * v0[1]; o[2] = sigmoidf_(bflo(gq.y)) * v0[2]; o[3] = sigmoidf_(bfhi(gq.y)) * v0[3];
                    o[4] = sigmoidf_(bflo(gq.z)) * v1[0]; o[5] = sigmoidf_(bfhi(gq.z)) * v1[1]; o[6] = sigmoidf_(bflo(gq.w)) * v1[2]; o[7] = sigmoidf_(bfhi(gq.w)) * v1[3];
                    bf16* dst = Mg + row * ACOLS + col0 + bj * 128;
                    if (ADD) { const u32x4 p = *(const u32x4*)dst;
                        o[0] += bflo(p.x); o[1] += bfhi(p.x); o[2] += bflo(p.y); o[3] += bfhi(p.y); o[4] += bflo(p.z); o[5] += bfhi(p.z); o[6] += bflo(p.w); o[7] += bfhi(p.w); }
                    u32x4 w; w.x = pk2(o[0], o[1]); w.y = pk2(o[2], o[3]); w.z = pk2(o[4], o[5]); w.w = pk2(o[6], o[7]);
                    *(u32x4*)dst = w; } }
    }
};
template <bool RES_IS_X, bool WRITE_BF, bool WRITE_SSQ> struct EpiRes {
    static constexpr bool PERM = false, AFTER_DRAIN = false;
    const float* xp; const float* xs; float* out; bf16* xb; int ldb; float* ssq;
    __device__ __forceinline__ void operator()(const f32x4 (&acc)[2][2][4][2], const Unit& u, int wr, int wc, int fr, int fq) const {
        const int row0 = u.pm * 256 + wr * 64 + fr, col0 = u.pn * 256 + wc * 32 + 4 * fq;
#pragma unroll
        for (int ai = 0; ai < 2; ++ai)
#pragma unroll
            for (int m = 0; m < 4; ++m) { const int row = row0 + ai * 128 + m * 16;
                const float* rp = RES_IS_X ? (row < MP ? xp + (size_t)row * D : xs + (size_t)(row - MP) * D) : out + (size_t)row * D;
                float s = 0.f;
#pragma unroll
                for (int bj = 0; bj < 2; ++bj)
#pragma unroll
                    for (int n = 0; n < 2; ++n) { const int col = col0 + bj * 128 + n * 16;
                        const f32x4 r = *(const f32x4*)(rp + col); const f32x4 o = r + acc[ai][bj][m][n];
                        *(f32x4*)(out + (size_t)row * D + col) = o;
                        s += (o[0] * o[0] + o[1] * o[1]) + (o[2] * o[2] + o[3] * o[3]);
                        if (WRITE_BF) { v2u w; w.x = pk2(o[0], o[1]); w.y = pk2(o[2], o[3]); *(v2u*)(xb + (size_t)row * ldb + col) = w; } }
                if (WRITE_SSQ) { s += __shfl_xor(s, 16); s += __shfl_xor(s, 32);
                    if (fq == 0) ssq[(size_t)row * 16 + u.pn * 4 + wc] = s; } }
    }
};
struct EpiUp {
    static constexpr bool PERM = true, AFTER_DRAIN = false;
    bf16* Hd; const float* ssq;
    __device__ __forceinline__ void operator()(const f32x4 (&acc)[2][2][4][2], const Unit& u, int wr, int wc, int fr, int fq) const {
        const int row0 = u.pm * 256 + wr * 64 + fr, col0 = u.pn * 256 + wc * 32 + 8 * fq;
#pragma unroll
        for (int ai = 0; ai < 2; ++ai)
#pragma unroll
            for (int m = 0; m < 4; ++m) { const size_t row = (size_t)(row0 + ai * 128 + m * 16);
                const f32x4* sp = (const f32x4*)(ssq + row * 16); const f32x4 a = sp[0], b = sp[1], c = sp[2], d = sp[3];
                const float tot = ((a[0] + a[1]) + (a[2] + a[3])) + ((b[0] + b[1]) + (b[2] + b[3])) + ((c[0] + c[1]) + (c[2] + c[3])) + ((d[0] + d[1]) + (d[2] + d[3]));
                const float rstd = rsqrtf(tot * (1.0f / D) + NORM_EPS);
#pragma unroll
                for (int bj = 0; bj < 2; ++bj) { const f32x4 v0 = acc[ai][bj][m][0], v1 = acc[ai][bj][m][1];
                    float o[8] = {v0[0], v0[1], v0[2], v0[3], v1[0], v1[1], v1[2], v1[3]};
#pragma unroll
                    for (int e = 0; e < 8; ++e) { const float t = fmaxf(o[e] * rstd, 0.f); o[e] = t * t; }
                    u32x4 w; w.x = pk2(o[0], o[1]); w.y = pk2(o[2], o[3]); w.z = pk2(o[4], o[5]); w.w = pk2(o[6], o[7]);
                    *(u32x4*)(Hd + row * DFF + col0 + bj * 128) = w; } }
    }
};

__device__ __forceinline__ void p0_transpose_item(const float* W, int K, int N, bf16* WT, const float* kscale, LAS float* scr, int item, int lane) {
    const int nblk = N / 32, kb = item / nblk, nb = item % nblk, k0 = 64 * kb, n0 = 32 * nb;
#pragma unroll 8
    for (int i = 0; i < 32; ++i) { const int kk = 2 * i + (lane >> 5); float v = W[(size_t)(k0 + kk) * N + n0 + (lane & 31)]; if (kscale) v *= kscale[k0 + kk]; scr[kk * 33 + (lane & 31)] = v; }
    LDS_WAIT(); asm volatile("" ::: "memory");
    const int c = lane & 7;
#pragma unroll
    for (int j = 0; j < 4; ++j) { const int n = (lane >> 3) + 8 * j; const LAS float* s = scr + (8 * c) * 33 + n;
        v4u o; o.x = pk2(s[0 * 33], s[1 * 33]); o.y = pk2(s[2 * 33], s[3 * 33]); o.z = pk2(s[4 * 33], s[5 * 33]); o.w = pk2(s[6 * 33], s[7 * 33]);
        *(GAS v4u*)(WT + (size_t)(n0 + n) * K + k0 + 8 * c) = o; }
    LDS_WAIT(); asm volatile("" ::: "memory");
}
__device__ __forceinline__ void p0_prologue(const Frame& F, const Args& A) {
    LAS float* scr = (LAS float*)(F.lds + F.wave * 16384);
    const int gw = F.vcu * NWAVES + F.wave, NGW = F.G * NWAVES;
    unsigned char* ws = A.ws;
    constexpr int I_IN = (D / 64) * (NIN / 32), I_A = (AW / 64) * (D / 32), I_O = (D / 64) * (D / 32), I_UP = (D / 64) * (DFF / 32), I_DN = (DFF / 64) * (D / 32);
    constexpr int I_L = 16, I_G = 32;
    constexpr int NITEMS = I_IN + 2 * I_A + I_O + I_UP + I_DN + 2 * I_L + I_G;
    for (int it = gw; it < NITEMS; it += NGW) {
        int r = it;
        if (r < I_IN) { p0_transpose_item(A.in[6], D, NIN, (bf16*)(ws + WS_WIN), nullptr, scr, r, F.lane); continue; } r -= I_IN;
        if (r < I_A) { p0_transpose_item(A.in[20], AW, D, (bf16*)(ws + WS_WA), nullptr, scr, r, F.lane); continue; } r -= I_A;
        if (r < I_A) { p0_transpose_item(A.in[21], BW, D, (bf16*)(ws + WS_WB), nullptr, scr, r, F.lane); continue; } r -= I_A;
        if (r < I_O) { p0_transpose_item(A.in[22], D, D, (bf16*)(ws + WS_WO), nullptr, scr, r, F.lane); continue; } r -= I_O;
        if (r < I_UP) { p0_transpose_item(A.in[24], D, DFF, (bf16*)(ws + WS_WUP), A.in[23], scr, r, F.lane); continue; } r -= I_UP;
        if (r < I_DN) { p0_transpose_item(A.in[25], DFF, D, (bf16*)(ws + WS_WDN), nullptr, scr, r, F.lane); continue; } r -= I_DN;
        if (r < I_L) { p0_transpose_item(A.in[9], 64, BW, (bf16*)(ws + WS_WDT), nullptr, scr, r, F.lane); continue; } r -= I_L;
        if (r < I_L) { p0_transpose_item(A.in[11], 64, BW, (bf16*)(ws + WS_WAT), nullptr, scr, r, F.lane); continue; } r -= I_L;
        p0_transpose_item(A.in[12], 128, BW, (bf16*)(ws + WS_WGT), nullptr, scr, r, F.lane);
    }
    bf16* H = (bf16*)A.out;
    const float* g = A.in[5];
    f32x4 gv[4];
#pragma unroll
    for (int j = 0; j < 4; ++j) gv[j] = ((const f32x4*)g)[F.lane + 64 * j];
    for (int m = gw; m < MH; m += NGW) {
        GAS unsigned long long* o8 = (GAS unsigned long long*)(H + (size_t)m * D) + F.lane;
        if (m < MT) {
            const float* xrow = m < MP ? A.in[0] + (size_t)m * D : A.in[1] + (size_t)(m - MP) * D;
            const f32x4* xr = (const f32x4*)xrow + F.lane;
            f32x4 v[4]; float s = 0.f;
#pragma unroll
            for (int j = 0; j < 4; ++j) { v[j] = xr[64 * j]; s += (v[j][0] * v[j][0] + v[j][1] * v[j][1]) + (v[j][2] * v[j][2] + v[j][3] * v[j][3]); }
            const float rstd = rsqrtf(wave_sum(s) * (1.0f / D) + NORM_EPS);
#pragma unroll
            for (int j = 0; j < 4; ++j) v[j] = v[j] * rstd * gv[j];
#pragma unroll
            for (int j = 0; j < 4; ++j) o8[64 * j] = (unsigned long long)pk2(v[j][0], v[j][1]) | ((unsigned long long)pk2(v[j][2], v[j][3]) << 32);
            float* so = nullptr;
            if (m < MP) { if ((m & (SEQ - 1)) == SEQ - 1) so = A.out + O_SHIFT_P + (size_t)(m >> 11) * D; }
            else { const int s_ = m - MP; if ((s_ & 3) == 3) so = A.out + O_SHIFT_S + (size_t)(s_ >> 2) * D; }
            if (so) {
#pragma unroll
                for (int j = 0; j < 4; ++j) ((f32x4*)so)[F.lane + 64 * j] = v[j];
            }
        } else if (m < MT + NBS) {
            const f32x4* xr = (const f32x4*)(A.in[4] + (size_t)(m - MT) * D) + F.lane;
#pragma unroll
            for (int j = 0; j < 4; ++j) { const f32x4 v = xr[64 * j]; o8[64 * j] = (unsigned long long)pk2(v[0], v[1]) | ((unsigned long long)pk2(v[2], v[3]) << 32); }
        } else {
#pragma unroll
            for (int j = 0; j < 4; ++j) o8[64 * j] = 0ull;
        }
    }
}

__device__ __forceinline__ int prev_row(int row) {
    if (row < MP) return (row & (SEQ - 1)) ? row - 1 : -1;
    const int s = row - MP; return (s & 3) ? row - 1 : MT + (s >> 2);
}
__device__ __forceinline__ float shifted(const bf16* UB, int row, int prow, int col, float mu) {
    const float ub = bf2f(UB[(size_t)row * BCOLS + col]);
    const float up = prow >= 0 ? bf2f(UB[(size_t)prow * BCOLS + col]) : 0.f;
    return ub + (up - ub) * mu;
}

typedef short bf16x8_t __attribute__((ext_vector_type(8)));
typedef short bf16x4_t __attribute__((ext_vector_type(4)));
typedef float f32x16 __attribute__((ext_vector_type(16)));
#define MFMA32(a, b, c) __builtin_amdgcn_mfma_f32_32x32x16_bf16((a), (b), (c), 0, 0, 0)
__device__ __forceinline__ int crow(int reg, int hh) { return (reg & 3) + 8 * (reg >> 2) + 4 * hh; }
__device__ __forceinline__ bf16x8_t pack8(float a0, float a1, float a2, float a3, float a4, float a5, float a6, float a7) {
    v4u p; p.x = pk2(a0, a1); p.y = pk2(a2, a3); p.z = pk2(a4, a5); p.w = pk2(a6, a7); return __builtin_bit_cast(bf16x8_t, p);
}
constexpr int HC = 64;
constexpr int H_TP = 72;
constexpr int H_KP = 136;
constexpr int H_OP = 132;
struct HPre { float b[16], kd[16], blast, bmid; };
__device__ __forceinline__ void hgrn_pre(const Frame& F, const bf16* UA, int row0, int h, float lbk, LAS float* segsum, HPre& R) {
    const int k = F.tid & 127, seg = F.tid >> 7;
    const bf16* src = UA + (size_t)(row0 + 16 * seg) * ACOLS + 512 + h * 128 + k;
    float run = 0.f;
#pragma unroll
    for (int j = 0; j < 16; ++j) { const float sg = sigmoidf_(bf2f(src[(size_t)j * ACOLS])); R.kd[j] = (1.0f - lbk) * (1.0f - sg); run += __logf(lbk + (1.0f - lbk) * sg); R.b[j] = run; }
    segsum[seg * 128 + k] = run;
    __syncthreads();
    const float s0 = segsum[k], s1 = segsum[128 + k], s2 = segsum[256 + k], s3 = segsum[384 + k];
    const float pre = seg == 0 ? 0.f : (seg == 1 ? s0 : (seg == 2 ? s0 + s1 : s0 + s1 + s2));
#pragma unroll
    for (int j = 0; j < 16; ++j) R.b[j] += pre;
    R.bmid = s0 + s1; R.blast = (s0 + s1) + (s2 + s3);
}
__device__ __forceinline__ void hgrn_load_vt(const Frame& F, const bf16* UA, int row0, int h, LAS bf16* VT) {
    const int v = F.tid & 127, seg = F.tid >> 7;
    const bf16* src = UA + (size_t)(row0 + 16 * seg) * ACOLS + 1024 + h * 128 + v;
    unsigned w[8];
#pragma unroll
    for (int j = 0; j < 8; ++j) w[j] = (unsigned)src[(size_t)(2 * j) * ACOLS] | ((unsigned)src[(size_t)(2 * j + 1) * ACOLS] << 16);
    LAS v4u* d = (LAS v4u*)(VT + v * H_TP + 16 * seg);
    d[0] = (v4u){w[0], w[1], w[2], w[3]}; d[1] = (v4u){w[4], w[5], w[6], w[7]};
}
__device__ __forceinline__ void h1_unit(const Frame& F, const Args& A, int unit) {
    const bf16* UA = (const bf16*)(A.ws + WS_UA);
    bf16* NS = (bf16*)(A.ws + WS_NS) + (size_t)unit * 16384;
    float* gam = (float*)(A.ws + WS_GAMMA) + (size_t)unit * 128;
    const int bh = unit >> 5, c = unit & 31, b = bh >> 2, h = bh & 3, row0 = b * SEQ + c * HC;
    LAS bf16* KhT = (LAS bf16*)F.lds;
    LAS bf16* VT = KhT + 128 * H_TP;
    LAS float* segsum = (LAS float*)(VT + 128 * H_TP);
    const int k = F.tid & 127, seg = F.tid >> 7;
    const float lbk = 1.0f / (1.0f + __expf(A.in[18][512 + h * 128 + k] - A.in[18][h * 128 + k]));
    HPre R; hgrn_pre(F, UA, row0, h, lbk, segsum, R);
    {   unsigned w[8];
#pragma unroll
        for (int j = 0; j < 8; ++j) w[j] = pk2(R.kd[2 * j] * __expf(R.blast - R.b[2 * j]), R.kd[2 * j + 1] * __expf(R.blast - R.b[2 * j + 1]));
        LAS v4u* d = (LAS v4u*)(KhT + k * H_TP + 16 * seg);
        d[0] = (v4u){w[0], w[1], w[2], w[3]}; d[1] = (v4u){w[4], w[5], w[6], w[7]}; }
    if (seg == 0) gam[k] = __expf(R.blast);
    hgrn_load_vt(F, UA, row0, h, VT);
    __syncthreads();
    const int r = F.lane & 31, hh = F.lane >> 5, vt = F.wave >> 1, kt0 = (F.wave & 1) * 2;
    f32x16 acc0, acc1;
#pragma unroll
    for (int i = 0; i < 16; ++i) { acc0[i] = 0.f; acc1[i] = 0.f; }
#pragma unroll
    for (int s = 0; s < 4; ++s) {
        const bf16x8_t a = *(const LAS bf16x8_t*)(VT + (vt * 32 + r) * H_TP + 16 * s + 8 * hh);
        const bf16x8_t b0 = *(const LAS bf16x8_t*)(KhT + (kt0 * 32 + r) * H_TP + 16 * s + 8 * hh);
        const bf16x8_t b1 = *(const LAS bf16x8_t*)(KhT + ((kt0 + 1) * 32 + r) * H_TP + 16 * s + 8 * hh);
        acc0 = MFMA32(a, b0, acc0); acc1 = MFMA32(a, b1, acc1);
    }
#pragma unroll
    for (int i = 0; i < 16; ++i) { const int v = vt * 32 + crow(i, hh);
        NS[v * 128 + kt0 * 32 + r] = (bf16)f2bf(acc0[i]); NS[v * 128 + (kt0 + 1) * 32 + r] = (bf16)f2bf(acc1[i]); }
    __syncthreads();
}
__device__ __forceinline__ void h2_part(const Frame& F, const Args& A, int start, int stride) {
    bf16* NS = (bf16*)(A.ws + WS_NS);
    const float* gam = (const float*)(A.ws + WS_GAMMA);
    for (int e = start; e < 32 * 2048; e += stride) {
        const int bh = e >> 11, vk = e & 2047, v = vk >> 4, k0 = (vk & 15) * 8;
        float S[8];
#pragma unroll
        for (int j = 0; j < 8; ++j) S[j] = 0.f;
        for (int c = 0; c < 32; ++c) {
            v4u* p = (v4u*)(NS + (size_t)(bh * 32 + c) * 16384 + v * 128 + k0);
            const v4u n = *p;
            const f32x4 g0 = *(const f32x4*)(gam + (size_t)(bh * 32 + c) * 128 + k0), g1 = *(const f32x4*)(gam + (size_t)(bh * 32 + c) * 128 + k0 + 4);
            v4u o; o.x = pk2(S[0], S[1]); o.y = pk2(S[2], S[3]); o.z = pk2(S[4], S[5]); o.w = pk2(S[6], S[7]);
            *p = o;
            S[0] = g0[0] * S[0] + bflo(n.x); S[1] = g0[1] * S[1] + bfhi(n.x); S[2] = g0[2] * S[2] + bflo(n.y); S[3] = g0[3] * S[3] + bfhi(n.y);
            S[4] = g1[0] * S[4] + bflo(n.z); S[5] = g1[1] * S[5] + bfhi(n.z); S[6] = g1[2] * S[6] + bflo(n.w); S[7] = g1[3] * S[7] + bfhi(n.w);
        }
        float* so = A.out + O_HGRN_P + (size_t)bh * 16384 + v;
#pragma unroll
        for (int j = 0; j < 8; ++j) so[(size_t)(k0 + j) * 128] = S[j];
    }
}
__device__ __forceinline__ void h3_unit(const Frame& F, const Args& A, int unit) {
    bf16* UA = (bf16*)(A.ws + WS_UA);
    const bf16* NS = (const bf16*)(A.ws + WS_NS) + (size_t)unit * 16384;
    const int bh = unit >> 5, c = unit & 31, b = bh >> 2, h = bh & 3, row0 = b * SEQ + c * HC;
    LAS bf16* Qh = (LAS bf16*)F.lds;
    LAS bf16* Qt = Qh + 64 * H_KP;
    LAS bf16* Kt = Qt + 64 * H_KP;
    LAS bf16* VT = Kt + 64 * H_KP;
    LAS float* segsum = (LAS float*)(VT + 128 * H_TP);
    LAS float* ssq = segsum + 512;
    LAS float* Ost = ssq + 256;
    const int k = F.tid & 127, seg = F.tid >> 7;
    const float lbk = 1.0f / (1.0f + __expf(A.in[18][512 + h * 128 + k] - A.in[18][h * 128 + k]));
    HPre R; hgrn_pre(F, UA, row0, h, lbk, segsum, R);
    {   const bf16* qsrc = UA + (size_t)(row0 + 16 * seg) * ACOLS + h * 128 + k;
#pragma unroll
        for (int j = 0; j < 16; ++j) { const float q = bf2f(qsrc[(size_t)j * ACOLS]); const float qs = q * sigmoidf_(q); const int t = 16 * seg + j;
            Qh[t * H_KP + k] = (bf16)f2bf(qs * __expf(R.b[j]));
            Qt[t * H_KP + k] = (bf16)f2bf(qs * __expf(R.b[j] - R.bmid));
            Kt[t * H_KP + k] = (bf16)f2bf(R.kd[j] * __expf(R.bmid - R.b[j])); } }
    hgrn_load_vt(F, UA, row0, h, VT);
    __syncthreads();
    const int r = F.lane & 31, hh = F.lane >> 5, vt = F.wave >> 1, tt = F.wave & 1;
    f32x16 o;
#pragma unroll
    for (int i = 0; i < 16; ++i) o[i] = 0.f;
#pragma unroll
    for (int st = 0; st < 2; ++st) {
        if (st <= tt) {
            f32x16 at;
#pragma unroll
            for (int i = 0; i < 16; ++i) at[i] = 0.f;
#pragma unroll
            for (int ks = 0; ks < 8; ++ks) {
                const bf16x8_t a = *(const LAS bf16x8_t*)(Kt + (st * 32 + r) * H_KP + 16 * ks + 8 * hh);
                const bf16x8_t bq = *(const LAS bf16x8_t*)(Qt + (tt * 32 + r) * H_KP + 16 * ks + 8 * hh);
                at = MFMA32(a, bq, at);
            }
            if (st == tt) {
#pragma unroll
                for (int i = 0; i < 16; ++i) if (crow(i, hh) > r) at[i] = 0.f;
            }
#pragma unroll
            for (int ks = 0; ks < 2; ++ks) {
                const bf16x4_t lo = *(const LAS bf16x4_t*)(VT + (vt * 32 + r) * H_TP + st * 32 + 16 * ks + 4 * hh);
                const bf16x4_t hi = *(const LAS bf16x4_t*)(VT + (vt * 32 + r) * H_TP + st * 32 + 16 * ks + 8 + 4 * hh);
                const bf16x8_t a = __builtin_shufflevector(lo, hi, 0, 1, 2, 3, 4, 5, 6, 7);
                const bf16x8_t bx = pack8(at[8 * ks], at[8 * ks + 1], at[8 * ks + 2], at[8 * ks + 3], at[8 * ks + 4], at[8 * ks + 5], at[8 * ks + 6], at[8 * ks + 7]);
                o = MFMA32(a, bx, o);
            }
        }
    }
    if (c > 0) {
#pragma unroll
        for (int ks = 0; ks < 8; ++ks) {
            const bf16x8_t a = *(const bf16x8_t*)(NS + (vt * 32 + r) * 128 + 16 * ks + 8 * hh);
            const bf16x8_t bq = *(const LAS bf16x8_t*)(Qh + (tt * 32 + r) * H_KP + 16 * ks + 8 * hh);
            o = MFMA32(a, bq, o);
        }
    }
    {   float s = 0.f;
#pragma unroll
        for (int i = 0; i < 16; ++i) { s += o[i] * o[i]; Ost[(tt * 32 + r) * H_OP + vt * 32 + crow(i, hh)] = o[i]; }
        s += __shfl_xor(s, 32);
        if (hh == 0) ssq[vt * 64 + tt * 32 + r] = s; }
    __syncthreads();
    {   const int t = F.tid >> 3, vg = F.tid & 7, row = row0 + t;
        const float tot = (ssq[t] + ssq[64 + t]) + (ssq[128 + t] + ssq[192 + t]);
        const float rs = rsqrtf(tot * (1.0f / 128.0f) + HGRN_EPS);
        const LAS f32x4* op = (const LAS f32x4*)(Ost + t * H_OP + 16 * vg);
        const v4u* gp = (const v4u*)(UA + (size_t)row * ACOLS + 1536 + h * 128 + 16 * vg);
        const f32x4* nwp = (const f32x4*)(A.in[19] + h * 128 + 16 * vg);
        v4u outw[2];
#pragma unroll
        for (int half = 0; half < 2; ++half) {
            const v4u g = gp[half]; const f32x4 o0 = op[2 * half], o1 = op[2 * half + 1], n0 = nwp[2 * half], n1 = nwp[2 * half + 1];
            const float gg[8] = {bflo(g.x), bfhi(g.x), bflo(g.y), bfhi(g.y), bflo(g.z), bfhi(g.z), bflo(g.w), bfhi(g.w)};
            const float ov[8] = {o0[0] * n0[0], o0[1] * n0[1], o0[2] * n0[2], o0[3] * n0[3], o1[0] * n1[0], o1[1] * n1[1], o1[2] * n1[2], o1[3] * n1[3]};
            float f[8];
#pragma unroll
            for (int e = 0; e < 8; ++e) f[e] = ov[e] * rs * (gg[e] * sigmoidf_(gg[e]));
            outw[half] = (v4u){pk2(f[0], f[1]), pk2(f[2], f[3]), pk2(f[4], f[5]), pk2(f[6], f[7])};
        }
        v4u* dst = (v4u*)(UA + (size_t)row * ACOLS + 1024 + h * 128 + 16 * vg);
        dst[0] = outw[0]; dst[1] = outw[1]; }
    __syncthreads();
}
__device__ __forceinline__ void hgrn_sample_unit(const Frame& F, const Args& A, int bh) {
    bf16* UA = (bf16*)(A.ws + WS_UA);
    const int b = bh >> 2, h = bh & 3, row0 = MP + 4 * b;
    LAS float* vec = (LAS float*)F.lds;
    LAS float* opart = vec + 4 * 384;
    LAS float* red = opart + 2048;
    const int v = F.tid & 127, kq = F.tid >> 7;
    {   const int t = kq, k = v, ch = h * 128 + k;
        const float lbk = 1.0f / (1.0f + __expf(A.in[18][512 + ch] - A.in[18][ch]));
        const float sg = sigmoidf_(bf2f(UA[(size_t)(row0 + t) * ACOLS + 512 + ch])), q = bf2f(UA[(size_t)(row0 + t) * ACOLS + ch]);
        vec[t * 384 + k] = lbk + (1.0f - lbk) * sg; vec[t * 384 + 128 + k] = (1.0f - lbk) * (1.0f - sg); vec[t * 384 + 256 + k] = q * sigmoidf_(q); }
    float iv[4];
#pragma unroll
    for (int t = 0; t < 4; ++t) iv[t] = bf2f(UA[(size_t)(row0 + t) * ACOLS + 1024 + h * 128 + v]);
    const float* sin_ = A.in[2] + (size_t)bh * 16384 + (size_t)(32 * kq) * 128 + v;
    float S[32];
#pragma unroll
    for (int j = 0; j < 32; ++j) S[j] = sin_[(size_t)j * 128];
    __syncthreads();
#pragma unroll
    for (int t = 0; t < 4; ++t) {
        const LAS float* fv = vec + t * 384 + 32 * kq;
        float o = 0.f;
#pragma unroll
        for (int j4 = 0; j4 < 8; ++j4) { const f32x4 f = *(const LAS f32x4*)(fv + 4 * j4), d = *(const LAS f32x4*)(fv + 128 + 4 * j4), q = *(const LAS f32x4*)(fv + 256 + 4 * j4);
#pragma unroll
            for (int e = 0; e < 4; ++e) { S[4 * j4 + e] = f[e] * S[4 * j4 + e] + d[e] * iv[t]; o += S[4 * j4 + e] * q[e]; } }
        opart[(t * 4 + kq) * 128 + v] = o;
    }
    float* sout = A.out + O_HGRN_S + (size_t)bh * 16384 + (size_t)(32 * kq) * 128 + v;
#pragma unroll
    for (int j = 0; j < 32; ++j) sout[(size_t)j * 128] = S[j];
    __syncthreads();
    {   const int t = kq;
        const float o = (opart[(t * 4 + 0) * 128 + v] + opart[(t * 4 + 1) * 128 + v]) + (opart[(t * 4 + 2) * 128 + v] + opart[(t * 4 + 3) * 128 + v]);
        const float ss = wave_sum(o * o);
        if (F.lane == 0) red[F.wave] = ss;
        __syncthreads();
        const float tot = red[F.wave & ~1] + red[F.wave | 1];
        const int ch = h * 128 + v; const size_t row = (size_t)(row0 + t);
        const float g = bf2f(UA[row * ACOLS + 1536 + ch]);
        UA[row * ACOLS + 1024 + ch] = (bf16)f2bf(o * rsqrtf(tot * (1.0f / 128.0f) + HGRN_EPS) * A.in[19][ch] * (g * sigmoidf_(g))); }
    __syncthreads();
}


typedef float f32x4_t __attribute__((ext_vector_type(4)));
#define MFMA16(a, b, c) __builtin_amdgcn_mfma_f32_16x16x32_bf16((a), (b), (c), 0, 0, 0)
constexpr int RC = 32;
constexpr int R_TP = 72;
constexpr int R_CP = 40;
constexpr int RL_A = 0;
constexpr int RL_B = RL_A + 9216;
constexpr int RL_C = RL_B + 16384;
constexpr int RL_D = RL_C + 9216;
constexpr int RL_E = RL_D + 18432;
constexpr int RL_F = RL_E + 20480;
constexpr int RL_UNIT = RL_F + 512;
static_assert(2 * RL_UNIT <= RING_BYTES, "two R1 units in LDS");
__device__ __forceinline__ float red8(float x) {
    x += __builtin_bit_cast(float, __builtin_amdgcn_update_dpp(0, __builtin_bit_cast(int, x), 0xB1, 0xF, 0xF, true));
    x += __builtin_bit_cast(float, __builtin_amdgcn_update_dpp(0, __builtin_bit_cast(int, x), 0x4E, 0xF, 0xF, true));
    x += __builtin_bit_cast(float, __builtin_amdgcn_update_dpp(0, __builtin_bit_cast(int, x), 0x141, 0xF, 0xF, true));
    return x;
}
__device__ __forceinline__ void unpack8(const v4u w, float (&o)[8]) { o[0] = bflo(w.x); o[1] = bfhi(w.x); o[2] = bflo(w.y); o[3] = bfhi(w.y); o[4] = bflo(w.z); o[5] = bfhi(w.z); o[6] = bflo(w.w); o[7] = bfhi(w.w); }
__device__ __forceinline__ v4u packw8(const float (&f)[8]) { return (v4u){pk2(f[0], f[1]), pk2(f[2], f[3]), pk2(f[4], f[5]), pk2(f[6], f[7])}; }

__device__ __forceinline__ void r1_pass(const Frame& F, const Args& A, int unit, bool active) {
    bf16* UB = (bf16*)(A.ws + WS_UB);
    const bf16* BR = (const bf16*)(A.out + O_HGRN_S);
    const bf16* Wdt = (const bf16*)(A.ws + WS_WDT); const bf16* Wat = (const bf16*)(A.ws + WS_WAT);
    float* bonus = (float*)(A.ws + WS_BONUS);
    const int sub = F.wave >> 2, w4 = F.wave & 3, tid4 = F.tid & 255, r = F.lane & 31, hh = F.lane >> 5;
    LAS unsigned char* L = F.lds + sub * RL_UNIT;
    LAS bf16* AWs = (LAS bf16*)(L + RL_A); LAS bf16* AAs = AWs + 32 * R_TP;
    LAS bf16* Bm = (LAS bf16*)(L + RL_A); LAS bf16* RAm = Bm + 32 * R_CP; LAS bf16* RKm = RAm + 32 * R_CP;
    LAS float* DEC = (LAS float*)(L + RL_B); LAS float* AAo = DEC + 32 * 64;
    LAS float* BVf = (LAS float*)(L + RL_B); LAS float* Af = BVf + 32 * 64;
    LAS float* CUM = (LAS float*)(L + RL_C); LAS float* SEG = CUM + 32 * 64;
    LAS bf16* Kt = (LAS bf16*)(L + RL_D); LAS bf16* Ah = Kt + 32 * R_TP; LAS bf16* Kh = Ah + 32 * R_TP; LAS bf16* Rt = Kh + 32 * R_TP;
    LAS bf16* KbT = (LAS bf16*)(L + RL_D); LAS bf16* VbT = KbT + 64 * R_CP;
    LAS bf16* KtT = (LAS bf16*)(L + RL_E); LAS bf16* AcT = KtT + 64 * R_CP; LAS bf16* KcT = AcT + 64 * R_CP; LAS bf16* VT = KcT + 64 * R_CP;
    LAS float* GC = (LAS float*)(L + RL_F); LAS float* CL = GC + 64;
    const int b = unit >> 9, h = (unit >> 6) & 7, c = unit & 63, row0 = b * SEQ + c * RC;
    unsigned char* mn = (unsigned char*)A.out + (size_t)unit * 16384;
    const int t = tid4 >> 3, jg = tid4 & 7, row = row0 + t;
    float xr[8], xk[8], xv[8];
    if (active) {
        const float* mu = A.in[7];
        const int cols[5] = {h * 64 + 8 * jg, 512 + h * 64 + 8 * jg, 1024 + h * 64 + 8 * jg, 1536 + 8 * jg, 1600 + 8 * jg};
        float x5[5][8];
#pragma unroll
        for (int q = 0; q < 5; ++q) {
            float cur[8], prv[8];
            unpack8(*(const v4u*)(UB + (size_t)row * BCOLS + cols[q]), cur);
            v4u pw = (v4u){0, 0, 0, 0};
            if (t > 0 || q >= 3) { if (t > 0 || c > 0) pw = *(const v4u*)(UB + (size_t)(row - 1) * BCOLS + cols[q]); }
            else if (c > 0) pw = *(const v4u*)(BR + (size_t)(b * 64 + c - 1) * 1536 + cols[q]);
            unpack8(pw, prv);
            const f32x4 m0 = *(const f32x4*)(mu + cols[q]), m1 = *(const f32x4*)(mu + cols[q] + 4);
#pragma unroll
            for (int e = 0; e < 8; ++e) x5[q][e] = cur[e] + (prv[e] - cur[e]) * (e < 4 ? m0[e] : m1[e - 4]);
        }
#pragma unroll
        for (int e = 0; e < 8; ++e) { xr[e] = x5[0][e]; xk[e] = x5[1][e]; xv[e] = x5[2][e]; x5[3][e] = tanhf_(x5[3][e]); }
        *(LAS v4u*)(AWs + t * R_TP + 8 * jg) = packw8(x5[3]);
        *(LAS v4u*)(AAs + t * R_TP + 8 * jg) = packw8(x5[4]);
    }
    __syncthreads();
    if (active) {
        const int which = w4 >> 1, jt = w4 & 1;
        const LAS bf16* As = which ? AAs : AWs; const bf16* Wt = (which ? Wat : Wdt) + (size_t)(h * 64 + jt * 32 + r) * 64;
        f32x16 acc;
#pragma unroll
        for (int i = 0; i < 16; ++i) acc[i] = 0.f;
#pragma unroll
        for (int s = 0; s < 4; ++s) acc = MFMA32(*(const LAS bf16x8_t*)(As + r * R_TP + 16 * s + 8 * hh), *(const bf16x8_t*)(Wt + 16 * s + 8 * hh), acc);
        LAS float* O = which ? AAo : DEC;
#pragma unroll
        for (int i = 0; i < 16; ++i) O[crow(i, hh) * 64 + jt * 32 + r] = acc[i];
    }
    __syncthreads();
    float lw[8], kk[8], al[8], k2[8];
    if (active) {
        const int ch = h * 64 + 8 * jg;
        float dec[8], aa[8];
        { const f32x4 d0 = *(const LAS f32x4*)(DEC + t * 64 + 8 * jg), d1 = *(const LAS f32x4*)(DEC + t * 64 + 8 * jg + 4), a0 = *(const LAS f32x4*)(AAo + t * 64 + 8 * jg), a1 = *(const LAS f32x4*)(AAo + t * 64 + 8 * jg + 4);
#pragma unroll
          for (int e = 0; e < 4; ++e) { dec[e] = d0[e]; dec[4 + e] = d1[e]; aa[e] = a0[e]; aa[4 + e] = a1[e]; } }
        float n2 = 0.f, bs = 0.f, kp[8], av[8];
#pragma unroll
        for (int e = 0; e < 8; ++e) {
            lw[e] = -DECAY_SCALE * sigmoidf_(A.in[8][ch + e] + dec[e]);
            av[e] = sigmoidf_(A.in[10][ch + e] + aa[e]);
            kp[e] = xk[e] * A.in[13][ch + e]; n2 += kp[e] * kp[e];
            k2[e] = xk[e] * (1.0f + (av[e] - 1.0f) * A.in[14][ch + e]);
            bs += xr[e] * k2[e] * A.in[15][ch + e];
        }
        n2 = red8(n2); bs = red8(bs);
        const float inv = 1.0f / fmaxf(sqrtf(n2), 1e-12f);
#pragma unroll
        for (int e = 0; e < 8; ++e) { kk[e] = kp[e] * inv; al[e] = kk[e] * av[e]; }
        if (jg == 0) bonus[(size_t)row * 8 + h] = bs;
        *(LAS f32x4*)(CUM + t * 64 + 8 * jg) = (f32x4){lw[0], lw[1], lw[2], lw[3]};
        *(LAS f32x4*)(CUM + t * 64 + 8 * jg + 4) = (f32x4){lw[4], lw[5], lw[6], lw[7]};
    }
    __syncthreads();
    {
        const int j = tid4 & 63, seg = tid4 >> 6;
        float v8[8], run = 0.f;
        if (active) {
#pragma unroll
            for (int e = 0; e < 8; ++e) { run += CUM[(8 * seg + e) * 64 + j]; v8[e] = run; }
            SEG[seg * 64 + j] = run;
        }
        __syncthreads();
        if (active) {
            const float s0 = SEG[j], s1 = SEG[64 + j], s2 = SEG[128 + j], s3 = SEG[192 + j];
            const float pre = seg == 0 ? 0.f : (seg == 1 ? s0 : (seg == 2 ? s0 + s1 : s0 + s1 + s2));
#pragma unroll
            for (int e = 0; e < 8; ++e) CUM[(8 * seg + e) * 64 + j] = v8[e] + pre;
            if (seg == 0) { const float tot = (s0 + s1) + (s2 + s3); CL[j] = tot; GC[j] = __expf(tot); }
        }
    }
    __syncthreads();
    if (active) {
        float cum[8], cl[8];
        { const f32x4 c0 = *(const LAS f32x4*)(CUM + t * 64 + 8 * jg), c1 = *(const LAS f32x4*)(CUM + t * 64 + 8 * jg + 4), l0 = *(const LAS f32x4*)(CL + 8 * jg), l1 = *(const LAS f32x4*)(CL + 8 * jg + 4);
#pragma unroll
          for (int e = 0; e < 4; ++e) { cum[e] = c0[e]; cum[4 + e] = c1[e]; cl[e] = l0[e]; cl[4 + e] = l1[e]; } }
        float fKt[8], fAh[8], fKh[8], fRt[8];
#pragma unroll
        for (int e = 0; e < 8; ++e) {
            const float gt = __expf(cum[e]), gm1 = __expf(cum[e] - lw[e]), gi = __expf(-cum[e]), gc = __expf(cl[e] - cum[e]);
            fKt[e] = kk[e] * gm1; fAh[e] = al[e] * gi; fKh[e] = k2[e] * gi; fRt[e] = xr[e] * gt;
            const int j = 8 * jg + e;
            KtT[j * R_CP + t] = (bf16)f2bf(fKt[e]); AcT[j * R_CP + t] = (bf16)f2bf(al[e] * gc); KcT[j * R_CP + t] = (bf16)f2bf(k2[e] * gc); VT[j * R_CP + t] = (bf16)f2bf(xv[e]);
        }
        *(LAS v4u*)(Kt + t * R_TP + 8 * jg) = packw8(fKt); *(LAS v4u*)(Ah + t * R_TP + 8 * jg) = packw8(fAh);
        *(LAS v4u*)(Kh + t * R_TP + 8 * jg) = packw8(fKh); *(LAS v4u*)(Rt + t * R_TP + 8 * jg) = packw8(fRt);
        *(v4u*)(UB + (size_t)row * BCOLS + 1024 + h * 64 + 8 * jg) = packw8(xv);
    }
    __syncthreads();
    f32x16 pre5;
    if (active) {
        const LAS bf16* Ls = (w4 < 2) ? Kt : Rt; const LAS bf16* Rs = (w4 & 1) ? Kh : Ah;
        f32x16 acc;
#pragma unroll
        for (int i = 0; i < 16; ++i) acc[i] = 0.f;
#pragma unroll
        for (int s = 0; s < 4; ++s) acc = MFMA32(*(const LAS bf16x8_t*)(Ls + r * R_TP + 16 * s + 8 * hh), *(const LAS bf16x8_t*)(Rs + r * R_TP + 16 * s + 8 * hh), acc);
#pragma unroll
        for (int i = 0; i < 16; ++i) { const int tt = crow(i, hh); const bool keep = (w4 < 2) ? (r < tt) : (r <= tt); pre5[i] = keep ? acc[i] : 0.f; }
    }
    __syncthreads();
    if (active) {
#pragma unroll
        for (int i = 0; i < 16; ++i) { const int tt = crow(i, hh);
            if (w4 == 0) Af[tt * 32 + r] = pre5[i];
            else { LAS bf16* O = w4 == 1 ? Bm : (w4 == 2 ? RAm : RKm); O[tt * R_CP + r] = (bf16)f2bf(pre5[i]); } }
    }
    __syncthreads();
    if (active && w4 < 2) {
        f32x16 acc;
#pragma unroll
        for (int i = 0; i < 16; ++i) acc[i] = 0.f;
#pragma unroll
        for (int s = 0; s < 2; ++s) acc = MFMA32(*(const LAS bf16x8_t*)(Bm + r * R_CP + 16 * s + 8 * hh), *(const LAS bf16x8_t*)(VT + (w4 * 32 + r) * R_CP + 16 * s + 8 * hh), acc);
#pragma unroll
        for (int i = 0; i < 16; ++i) BVf[crow(i, hh) * 64 + w4 * 32 + r] = acc[i];
    }
    __syncthreads();
    if (active && w4 < 2) {
        float x[32];
        const int col = F.lane;
        if (w4 == 0) {
#pragma unroll
            for (int q = 0; q < 4; ++q) { float f8[8]; unpack8(*(const LAS v4u*)(KtT + col * R_CP + 8 * q), f8);
#pragma unroll
                for (int e = 0; e < 8; ++e) x[8 * q + e] = f8[e]; }
        } else {
#pragma unroll
            for (int tt = 0; tt < 32; ++tt) x[tt] = BVf[tt * 64 + col];
        }
#pragma unroll
        for (int tt = 1; tt < 32; ++tt) {
            float acc = x[tt];
            const LAS float* ap = Af + tt * 32;
            asm volatile("" : "+v"(ap), "+v"(x[tt - 1]));
#pragma unroll
            for (int s = 0; s < tt; ++s) acc = __builtin_fmaf(-ap[s], x[s], acc);
            x[tt] = acc;
        }
        LAS bf16* O = (w4 == 0 ? KbT : VbT) + col * R_CP;
#pragma unroll
        for (int q = 0; q < 4; ++q) { float f8[8];
#pragma unroll
            for (int e = 0; e < 8; ++e) f8[e] = -x[8 * q + e];
            *(LAS v4u*)(O + 8 * q) = packw8(f8); }
    }
    __syncthreads();
    if (active) {
        const int jt = w4 >> 1, ct = w4 & 1;
        f32x16 am, an;
#pragma unroll
        for (int i = 0; i < 16; ++i) { am[i] = 0.f; an[i] = 0.f; }
#pragma unroll
        for (int s = 0; s < 2; ++s) {
            const bf16x8_t a_ac = *(const LAS bf16x8_t*)(AcT + (jt * 32 + r) * R_CP + 16 * s + 8 * hh), a_kc = *(const LAS bf16x8_t*)(KcT + (jt * 32 + r) * R_CP + 16 * s + 8 * hh);
            am = MFMA32(a_ac, *(const LAS bf16x8_t*)(KbT + (ct * 32 + r) * R_CP + 16 * s + 8 * hh), am);
            an = MFMA32(a_kc, *(const LAS bf16x8_t*)(VT + (ct * 32 + r) * R_CP + 16 * s + 8 * hh), an);
            an = MFMA32(a_ac, *(const LAS bf16x8_t*)(VbT + (ct * 32 + r) * R_CP + 16 * s + 8 * hh), an);
        }
        bf16* Mp = (bf16*)mn; bf16* Np = (bf16*)(mn + 8192);
        const int cj = ct * 32 + r;
#pragma unroll
        for (int i = 0; i < 16; ++i) {
            const int j = jt * 32 + crow(i, hh);
            float mv = am[i]; if (j == cj) mv += GC[j];
            const int s2 = cj >> 5, rem = cj & 31, e = 4 * (rem >> 4) + (rem & 3), q = (rem >> 2) & 3;
            Mp[j * 64 + s2 * 32 + q * 8 + e] = (bf16)f2bf(mv);
            Np[cj * 64 + ((j >> 2) & 3) * 16 + (j >> 4) * 4 + (j & 3)] = (bf16)f2bf(an[i]);
        }
        f32x16 ay;
        if (w4 < 2) {
#pragma unroll
            for (int i = 0; i < 16; ++i) ay[i] = bf2f(Rt[crow(i, hh) * R_TP + w4 * 32 + r]);
#pragma unroll
            for (int s = 0; s < 2; ++s) ay = MFMA32(*(const LAS bf16x8_t*)(RAm + r * R_CP + 16 * s + 8 * hh), *(const LAS bf16x8_t*)(KbT + (w4 * 32 + r) * R_CP + 16 * s + 8 * hh), ay);
#pragma unroll
            for (int i = 0; i < 16; ++i) UB[(size_t)(row0 + crow(i, hh)) * BCOLS + h * 64 + w4 * 32 + r] = (bf16)f2bf(ay[i]);
        } else {
            const int it = w4 - 2;
#pragma unroll
            for (int i = 0; i < 16; ++i) ay[i] = 0.f;
#pragma unroll
            for (int s = 0; s < 2; ++s) {
                ay = MFMA32(*(const LAS bf16x8_t*)(RKm + r * R_CP + 16 * s + 8 * hh), *(const LAS bf16x8_t*)(VT + (it * 32 + r) * R_CP + 16 * s + 8 * hh), ay);
                ay = MFMA32(*(const LAS bf16x8_t*)(RAm + r * R_CP + 16 * s + 8 * hh), *(const LAS bf16x8_t*)(VbT + (it * 32 + r) * R_CP + 16 * s + 8 * hh), ay);
            }
#pragma unroll
            for (int i = 0; i < 16; ++i) UB[(size_t)(row0 + crow(i, hh)) * BCOLS + 512 + h * 64 + it * 32 + r] = (bf16)f2bf(ay[i]);
        }
    }
    __syncthreads();
}

__device__ __forceinline__ void r2_wave(const Frame& F, const Args& A, int bh, int wq) {
    const int m = F.lane & 15, q = F.lane >> 4, i = 16 * wq + m;
    f32x4_t acc[4];
#pragma unroll
    for (int jt = 0; jt < 4; ++jt) acc[jt] = (f32x4_t){0.f, 0.f, 0.f, 0.f};
    unsigned char* base = (unsigned char*)A.out + (size_t)bh * 64 * 16384;
    v4u Mf[4][2], Nf[2];
    auto load = [&](int c) {
        const unsigned char* u = base + (size_t)c * 16384;
#pragma unroll
        for (int jt = 0; jt < 4; ++jt)
#pragma unroll
            for (int s2 = 0; s2 < 2; ++s2) Mf[jt][s2] = *(const v4u*)(u + ((16 * jt + m) * 64 + s2 * 32 + q * 8) * 2);
        Nf[0] = *(const v4u*)(u + 8192 + (i * 64 + q * 16) * 2); Nf[1] = *(const v4u*)(u + 8192 + (i * 64 + q * 16 + 8) * 2);
    };
    load(0);
    for (int c = 0; c < 64; ++c) {
        asm volatile("s_waitcnt vmcnt(0)" ::: "memory");
        v4u Mc[4][2]; float nf[16];
#pragma unroll
        for (int jt = 0; jt < 4; ++jt) { Mc[jt][0] = Mf[jt][0]; Mc[jt][1] = Mf[jt][1]; }
        { float t8[8]; unpack8(Nf[0], t8);
#pragma unroll
          for (int e = 0; e < 8; ++e) nf[e] = t8[e];
          unpack8(Nf[1], t8);
#pragma unroll
          for (int e = 0; e < 8; ++e) nf[8 + e] = t8[e]; }
        { unsigned char* u = base + (size_t)c * 16384 + 8192;
#pragma unroll
          for (int jt = 0; jt < 4; ++jt) { v2u w; w.x = pk2(acc[jt][0], acc[jt][1]); w.y = pk2(acc[jt][2], acc[jt][3]); *(v2u*)(u + (i * 64 + 16 * jt + 4 * q) * 2) = w; } }
        if (c + 1 < 64) load(c + 1);
        const bf16x8_t b0 = pack8(acc[0][0], acc[0][1], acc[0][2], acc[0][3], acc[1][0], acc[1][1], acc[1][2], acc[1][3]);
        const bf16x8_t b1 = pack8(acc[2][0], acc[2][1], acc[2][2], acc[2][3], acc[3][0], acc[3][1], acc[3][2], acc[3][3]);
#pragma unroll
        for (int jt = 0; jt < 4; ++jt) {
            f32x4_t n = (f32x4_t){nf[4 * jt], nf[4 * jt + 1], nf[4 * jt + 2], nf[4 * jt + 3]};
            n = MFMA16(__builtin_bit_cast(bf16x8_t, Mc[jt][0]), b0, n);
            n = MFMA16(__builtin_bit_cast(bf16x8_t, Mc[jt][1]), b1, n);
            acc[jt] = n;
        }
    }
    float* so = A.out + O_WKV_P + (size_t)bh * 4096 + i * 64;
#pragma unroll
    for (int jt = 0; jt < 4; ++jt) *(f32x4*)(so + 16 * jt + 4 * q) = (f32x4){acc[jt][0], acc[jt][1], acc[jt][2], acc[jt][3]};
}

__device__ __forceinline__ void r3_unit(const Frame& F, const Args& A, int unit) {
    bf16* UB = (bf16*)(A.ws + WS_UB);
    const bf16* Wgt = (const bf16*)(A.ws + WS_WGT);
    const float* bonus = (const float*)(A.ws + WS_BONUS);
    const int b = unit >> 9, h = (unit >> 6) & 7, c = unit & 63, row0 = b * SEQ + c * RC;
    const bf16* Sc = (const bf16*)((const unsigned char*)A.out + (size_t)unit * 16384 + 8192);
    const int r = F.lane & 31, hh = F.lane >> 5, row = row0 + r;
    f32x16 y0, y1, g0, g1;
#pragma unroll
    for (int i = 0; i < 16; ++i) { y0[i] = 0.f; y1[i] = 0.f; g0[i] = 0.f; g1[i] = 0.f; }
    if (c > 0) {
#pragma unroll
        for (int s = 0; s < 4; ++s) {
            const bf16x8_t bq = *(const bf16x8_t*)(UB + (size_t)row * BCOLS + h * 64 + 16 * s + 8 * hh);
            y0 = MFMA32(*(const bf16x8_t*)(Sc + r * 64 + 16 * s + 8 * hh), bq, y0);
            y1 = MFMA32(*(const bf16x8_t*)(Sc + (32 + r) * 64 + 16 * s + 8 * hh), bq, y1);
        }
    }
    {   const float* mu = A.in[7] + 1664;
        const bool hasprev = (r > 0) || (c > 0);
#pragma unroll
        for (int s = 0; s < 8; ++s) {
            float cur[8], prv[8];
            unpack8(*(const v4u*)(UB + (size_t)row * BCOLS + 1664 + 16 * s + 8 * hh), cur);
            v4u pw = (v4u){0, 0, 0, 0}; if (hasprev) pw = *(const v4u*)(UB + (size_t)(row - 1) * BCOLS + 1664 + 16 * s + 8 * hh);
            unpack8(pw, prv);
            const f32x4 m0 = *(const f32x4*)(mu + 16 * s + 8 * hh), m1 = *(const f32x4*)(mu + 16 * s + 8 * hh + 4);
            float sg[8];
#pragma unroll
            for (int e = 0; e < 8; ++e) sg[e] = sigmoidf_(cur[e] + (prv[e] - cur[e]) * (e < 4 ? m0[e] : m1[e - 4]));
            const bf16x8_t bq = __builtin_bit_cast(bf16x8_t, packw8(sg));
            g0 = MFMA32(*(const bf16x8_t*)(Wgt + (size_t)(h * 64 + r) * 128 + 16 * s + 8 * hh), bq, g0);
            g1 = MFMA32(*(const bf16x8_t*)(Wgt + (size_t)(h * 64 + 32 + r) * 128 + 16 * s + 8 * hh), bq, g1);
        } }
    float yv[32]; float sum = 0.f;
#pragma unroll
    for (int it = 0; it < 2; ++it)
#pragma unroll
        for (int gq = 0; gq < 4; ++gq) {
            const v2u w = *(const v2u*)(UB + (size_t)row * BCOLS + 512 + h * 64 + 32 * it + 8 * gq + 4 * hh);
            const float yb[4] = {bflo(w.x), bfhi(w.x), bflo(w.y), bfhi(w.y)};
#pragma unroll
            for (int e = 0; e < 4; ++e) { const float v = (it ? y1[4 * gq + e] : y0[4 * gq + e]) + yb[e]; yv[16 * it + 4 * gq + e] = v; sum += v; }
        }
    sum += __shfl_xor(sum, 32);
    const float mean = sum * (1.0f / 64.0f);
    float var = 0.f;
#pragma unroll
    for (int x = 0; x < 32; ++x) { yv[x] -= mean; var += yv[x] * yv[x]; }
    var += __shfl_xor(var, 32);
    const float rs = rsqrtf(var * (1.0f / 64.0f) + GN_EPS), bn = bonus[(size_t)row * 8 + h];
#pragma unroll
    for (int it = 0; it < 2; ++it)
#pragma unroll
        for (int gq = 0; gq < 4; ++gq) {
            const int i0 = 32 * it + 8 * gq + 4 * hh, ch = h * 64 + i0;
            const v2u vw = *(const v2u*)(UB + (size_t)row * BCOLS + 1024 + ch);
            const float vv[4] = {bflo(vw.x), bfhi(vw.x), bflo(vw.y), bfhi(vw.y)};
            const f32x4 lw = *(const f32x4*)(A.in[16] + ch), lb = *(const f32x4*)(A.in[17] + ch);
            float o[4];
#pragma unroll
            for (int e = 0; e < 4; ++e) { const float gg = it ? g1[4 * gq + e] : g0[4 * gq + e]; o[e] = (yv[16 * it + 4 * gq + e] * rs * lw[e] + lb[e] + bn * vv[e]) * gg; }
            v2u ow; ow.x = pk2(o[0], o[1]); ow.y = pk2(o[2], o[3]);
            *(v2u*)(UB + (size_t)row * BCOLS + 512 + ch) = ow;
        }
}

__device__ __forceinline__ float rdl(float x, int k) { return __builtin_bit_cast(float, __builtin_amdgcn_readlane(__builtin_bit_cast(int, x), k)); }
__device__ __forceinline__ void rwkv_sample_wave(const Frame& F, const Args& A, int bh, LAS float* wl) {
    bf16* UB = (bf16*)(A.ws + WS_UB);
    const int b = bh >> 3, h = bh & 7, row0 = MP + 4 * b, l = F.lane, ch = h * 64 + l;
    const float* mu = A.in[7];
    float xr[4], xk[4], xv[4], tw[4], ad[4], sg0[4], sg1[4];
#pragma unroll
    for (int t = 0; t < 4; ++t) {
        const int row = row0 + t, prow = t ? row - 1 : MT + b;
        xr[t] = shifted(UB, row, prow, ch, mu[ch]); xk[t] = shifted(UB, row, prow, 512 + ch, mu[512 + ch]); xv[t] = shifted(UB, row, prow, 1024 + ch, mu[1024 + ch]);
        tw[t] = tanhf_(shifted(UB, row, prow, 1536 + l, mu[1536 + l])); ad[t] = shifted(UB, row, prow, 1600 + l, mu[1600 + l]);
        sg0[t] = sigmoidf_(shifted(UB, row, prow, 1664 + l, mu[1664 + l])); sg1[t] = sigmoidf_(shifted(UB, row, prow, 1728 + l, mu[1728 + l]));
    }
    float dec[4] = {0.f, 0.f, 0.f, 0.f}, aa[4] = {0.f, 0.f, 0.f, 0.f}, g[4] = {0.f, 0.f, 0.f, 0.f};
    {   const float* pd = A.in[9] + ch; const float* pa = A.in[11] + ch; const float* pg = A.in[12] + ch;
#pragma unroll 4
        for (int k = 0; k < 64; ++k) {
            const float wd = pd[0], wa = pa[0], wg0 = pg[0], wg1 = pg[64 * BW];
            pd += BW; pa += BW; pg += BW;
#pragma unroll
            for (int t = 0; t < 4; ++t) {
                dec[t] += rdl(tw[t], k) * wd; aa[t] += rdl(ad[t], k) * wa; g[t] += rdl(sg0[t], k) * wg0 + rdl(sg1[t], k) * wg1;
            }
        } }
    const float w0 = A.in[8][ch], a0 = A.in[10][ch], kkc = A.in[13][ch], kac = A.in[14][ch], rkc = A.in[15][ch];
    float bon[4];
#pragma unroll
    for (int t = 0; t < 4; ++t) {
        const float w = __expf(-DECAY_SCALE * sigmoidf_(w0 + dec[t])), a = sigmoidf_(a0 + aa[t]);
        const float kp = xk[t] * kkc, kk = kp / fmaxf(sqrtf(wave_sum(kp * kp)), 1e-12f), k2 = xk[t] * (1.0f + (a - 1.0f) * kac);
        bon[t] = wave_sum(xr[t] * k2 * rkc);
        LAS float* v = wl + t * 384;
        v[l] = w; v[64 + l] = kk; v[128 + l] = kk * a; v[192 + l] = k2; v[256 + l] = xr[t];
    }
    asm volatile("s_waitcnt lgkmcnt(0)" ::: "memory");
    float S[64];
    const float* sin_ = A.in[3] + (size_t)bh * 4096 + l * 64;
#pragma unroll
    for (int j4 = 0; j4 < 16; ++j4) { const f32x4 s = *(const f32x4*)(sin_ + 4 * j4); S[4 * j4] = s[0]; S[4 * j4 + 1] = s[1]; S[4 * j4 + 2] = s[2]; S[4 * j4 + 3] = s[3]; }
#pragma unroll
    for (int t = 0; t < 4; ++t) {
        const LAS float* v = wl + t * 384;
        float sk = 0.f;
#pragma unroll
        for (int j4 = 0; j4 < 16; ++j4) { const f32x4 k4 = *(const LAS f32x4*)(v + 64 + 4 * j4); sk += (S[4 * j4] * k4[0] + S[4 * j4 + 1] * k4[1]) + (S[4 * j4 + 2] * k4[2] + S[4 * j4 + 3] * k4[3]);
            if ((j4 & 3) == 3) asm volatile("" : "+v"(v), "+v"(sk)); }
        float y = 0.f;
#pragma unroll
        for (int j4 = 0; j4 < 16; ++j4) {
            const f32x4 w4 = *(const LAS f32x4*)(v + 4 * j4), ka = *(const LAS f32x4*)(v + 128 + 4 * j4), k4 = *(const LAS f32x4*)(v + 192 + 4 * j4), r4 = *(const LAS f32x4*)(v + 256 + 4 * j4);
#pragma unroll
            for (int e = 0; e < 4; ++e) { const float s = S[4 * j4 + e] * w4[e] - sk * ka[e] + xv[t] * k4[e]; S[4 * j4 + e] = s; y += s * r4[e]; }
            if (j4 & 1) asm volatile("" : "+v"(v), "+v"(y));
        }
        const float mean = wave_sum(y) * (1.0f / 64.0f), d = y - mean, var = wave_sum(d * d) * (1.0f / 64.0f);
        const float yn = d * rsqrtf(var + GN_EPS) * A.in[16][ch] + A.in[17][ch];
        UB[(size_t)(row0 + t) * BCOLS + 512 + ch] = (bf16)f2bf((yn + bon[t] * xv[t]) * g[t]);
    }
    float* so = A.out + O_WKV_S + (size_t)bh * 4096 + l * 64;
#pragma unroll
    for (int j4 = 0; j4 < 16; ++j4) *(f32x4*)(so + 4 * j4) = (f32x4){S[4 * j4], S[4 * j4 + 1], S[4 * j4 + 2], S[4 * j4 + 3]};
    asm volatile("s_waitcnt lgkmcnt(0)" ::: "memory");
}

__device__ __forceinline__ void p3_seq(const Frame& F, const Args& A) {
    if (F.wave == 0) { for (int u = F.vcu; u < 256; u += F.G) r2_wave(F, A, u >> 2, u & 3); }
    else {
        const int wk = F.vcu * 7 + F.wave - 1, NW = F.G * 7;
        h2_part(F, A, wk * 64 + F.lane, NW * 64);
        LAS float* wl = (LAS float*)F.lds + F.wave * 1536;
        for (int bh = wk; bh < 1024; bh += NW) rwkv_sample_wave(F, A, bh, wl);
    }
}


constexpr int SK_P = 72, SK_BUF = (64 + 128) * SK_P;
template <bool SSQ> __device__ __forceinline__ void sk_gemm(const Frame& F, f32x16& acc, const bf16* Ag, int lda, const bf16* Bg, int ldb, int K, float& ssq) {
    LAS bf16* L = (LAS bf16*)F.lds;
    const int prow = F.tid >> 3, c8 = F.tid & 7, r = F.lane & 31, hh = F.lane >> 5, wm = F.wave >> 2, wn = F.wave & 3;
    const bf16* ap = Ag + (size_t)prow * lda + 8 * c8; const bf16* bp0 = Bg + (size_t)prow * ldb + 8 * c8; const bf16* bp1 = bp0 + (size_t)64 * ldb;
    v4u ra = *(const v4u*)ap, rb0 = *(const v4u*)bp0, rb1 = *(const v4u*)bp1;
    const int nk = K / 64;
    __syncthreads();
    for (int it = 0; it < nk; ++it) {
        LAS bf16* B_ = L + (it & 1) * SK_BUF;
        *(LAS v4u*)(B_ + prow * SK_P + 8 * c8) = ra; *(LAS v4u*)(B_ + (64 + prow) * SK_P + 8 * c8) = rb0; *(LAS v4u*)(B_ + (128 + prow) * SK_P + 8 * c8) = rb1;
        if (SSQ) { float f8[8]; unpack8(ra, f8);
#pragma unroll
            for (int e = 0; e < 8; ++e) ssq += f8[e] * f8[e]; }
        __syncthreads();
        if (it + 1 < nk) { const int k = (it + 1) * 64; ra = *(const v4u*)(ap + k); rb0 = *(const v4u*)(bp0 + k); rb1 = *(const v4u*)(bp1 + k); }
#pragma unroll
        for (int s = 0; s < 4; ++s)
            acc = MFMA32(*(const LAS bf16x8_t*)(B_ + (32 * wm + r) * SK_P + 16 * s + 8 * hh), *(const LAS bf16x8_t*)(B_ + (64 + 32 * wn + r) * SK_P + 16 * s + 8 * hh), acc);
    }
}
template <int WHICH> __device__ __forceinline__ void skinny_unit(const Frame& F, const Args& A, int mt, int nt, int ks) {
    unsigned char* ws = A.ws;
    bf16* UA = (bf16*)(ws + WS_UA); bf16* UB = (bf16*)(ws + WS_UB); const bf16* UG = (const bf16*)(ws + WS_UG);
    const int wm = F.wave >> 2, wn = F.wave & 3, r = F.lane & 31, hh = F.lane >> 5;
    const int mb = MP + 64 * mt, m0 = mb + 32 * wm, nb = 128 * nt, n = nb + 32 * wn + r;
    f32x16 acc;
#pragma unroll
    for (int i = 0; i < 16; ++i) acc[i] = 0.f;
    float ssq = 0.f;
    if (WHICH == 0) {
        f32x16 accb;
#pragma unroll
        for (int i = 0; i < 16; ++i) accb[i] = 0.f;
        sk_gemm<false>(F, acc, UA + (size_t)mb * ACOLS + 1024, ACOLS, (const bf16*)(ws + WS_WA) + (size_t)nb * AW, AW, AW, ssq);
        sk_gemm<false>(F, accb, UB + (size_t)mb * BCOLS + 512, BCOLS, (const bf16*)(ws + WS_WB) + (size_t)nb * BW, BW, BW, ssq);
#pragma unroll
        for (int i = 0; i < 16; ++i) { const size_t m = (size_t)(m0 + crow(i, hh));
            const float ga = bf2f(UG[m * GCOLS + n]), gb = bf2f(UG[m * GCOLS + 1024 + n]);
            UA[m * ACOLS + n] = (bf16)f2bf(sigmoidf_(ga) * acc[i] + sigmoidf_(gb) * accb[i]); }
    } else if (WHICH == 1) {
        sk_gemm<false>(F, acc, UA + (size_t)mb * ACOLS, ACOLS, (const bf16*)(ws + WS_WO) + (size_t)nb * D, D, D, ssq);
#pragma unroll
        for (int i = 0; i < 16; ++i) { const size_t m = (size_t)(m0 + crow(i, hh));
            const float o = A.in[1][(m - MP) * D + n] + acc[i];
            A.out[m * D + n] = o; UB[m * BCOLS + n] = (bf16)f2bf(o); }
    } else if (WHICH == 2) {
        sk_gemm<true>(F, acc, UB + (size_t)mb * BCOLS, BCOLS, (const bf16*)(ws + WS_WUP) + (size_t)nb * D, D, D, ssq);
        LAS float* rs = (LAS float*)(F.lds + 2 * SK_BUF * 2);
        ssq = red8(ssq);
        if ((F.tid & 7) == 0) rs[F.tid >> 3] = rsqrtf(ssq * (1.0f / D) + NORM_EPS);
        __syncthreads();
        bf16* Hd = UA;
#pragma unroll
        for (int i = 0; i < 16; ++i) { const int ml = 32 * wm + crow(i, hh); const size_t m = (size_t)(mb + ml);
            const float t = fmaxf(acc[i] * rs[ml], 0.f);
            Hd[m * DFF + n] = (bf16)f2bf(t * t); }
    } else {
        sk_gemm<false>(F, acc, UA + (size_t)mb * DFF + 1024 * ks, DFF, (const bf16*)(ws + WS_WDN) + (size_t)nb * DFF + 1024 * ks, DFF, 1024, ssq);
#pragma unroll
        for (int i = 0; i < 16; ++i) { const size_t m = (size_t)(m0 + crow(i, hh)); atomicAdd(A.out + m * D + n, acc[i]); }
    }
    __syncthreads();
}

__device__ __forceinline__ void p9_final(const Frame& F, const Args& A) {
    const int gw = F.vcu * NWAVES + F.wave, NGW = F.G * NWAVES;
    f32x4 gv[4];
#pragma unroll
    for (int j = 0; j < 4; ++j) gv[j] = ((const f32x4*)A.in[26])[F.lane + 64 * j];
    for (int m = gw; m < MT; m += NGW) {
        f32x4* xr = (f32x4*)(A.out + (size_t)m * D) + F.lane;
        f32x4 v[4]; float s = 0.f;
#pragma unroll
        for (int j = 0; j < 4; ++j) { v[j] = xr[64 * j]; s += (v[j][0] * v[j][0] + v[j][1] * v[j][1]) + (v[j][2] * v[j][2] + v[j][3] * v[j][3]); }
        const float rstd = rsqrtf(wave_sum(s) * (1.0f / D) + NORM_EPS);
#pragma unroll
        for (int j = 0; j < 4; ++j) xr[64 * j] = v[j] * rstd * gv[j];
    }
}

__global__ void __launch_bounds__(NWAVES * 64, 2) fwd(Args args) {
    extern __shared__ __attribute__((aligned(16))) unsigned char lds[];
    Frame F;
    F.lds = (LAS unsigned char*)lds;
    F.tid = threadIdx.x; F.lane = F.tid & 63; F.wave = __builtin_amdgcn_readfirstlane(F.tid >> 6);
    F.G = gridDim.x; { const int bx = blockIdx.x; F.vcu = (F.G % 8 == 0) ? (bx % 8) * (F.G / 8) + bx / 8 : bx; }
    unsigned char* ws = args.ws;
    gu32* ctl = (gu32*)(ws + WS_CTL);
    for (int u = F.tid; u < (LDS_BYTES - LDSCTL_OFF) / 4; u += NWAVES * 64) ((LAS unsigned*)(F.lds + LDSCTL_OFF))[u] = 0u;
    __syncthreads();
    volatile LAS unsigned* MISC = (volatile LAS unsigned*)(F.lds + MISC_OFF);
    XcdBarrier bar; bar.bar = (unsigned*)(ctl + CW_BAR); bar.x = 0; bar.st = nullptr;
    if (MK_N_LAUNCHES == 1) bar = xcd_barrier_post((unsigned*)(ctl + CW_BAR), MISC + 8);
    const int lo = args.ph_lo, hi = args.ph_hi;
#ifndef PH_MASK
#define PH_MASK 0x3ff
#endif
#ifndef DUP_MASK
#define DUP_MASK 0
#endif
#define REP(k) for (int rep_ = 0; rep_ < (((DUP_MASK >> (k)) & 1) ? 2 : 1); ++rep_)
#define IN(k) (((PH_MASK >> (k)) & 1) && lo <= (k) && (k) < hi)
#define SEAM(k) do { if (IN(k) && IN((k) + 1)) xcd_barrier(bar); } while (0)
    bf16* UA = (bf16*)(ws + WS_UA); bf16* UB = (bf16*)(ws + WS_UB); bf16* UG = (bf16*)(ws + WS_UG);

    if (IN(0)) REP(0) { p0_prologue(F, args); } SEAM(0);
    if (IN(1)) REP(1) {
        pg8::Gemm g{(const bf16*)args.out, (const bf16*)(ws + WS_WIN), MH, NIN, D, D, D};
        SchedG1 S; S.init(F.G, (int)blockIdx.x);
        EpiG1 E{UA, UB, UG, (bf16*)(args.out + O_HGRN_S)};
        pg8::gemm_phase<EpiG1, SchedG1, true, true>(F.lds, g, S, E);
    } SEAM(1);
    if (IN(2)) {
        for (int ps = 0; ps * 2 * F.G < 4096; ++ps) { const int unit = (ps * F.G + F.vcu) * 2 + (F.wave >> 2); r1_pass(F, args, unit < 4096 ? unit : 0, unit < 4096); }
        for (int u = F.vcu; u < 1024; u += F.G) h1_unit(F, args, u);
    } SEAM(2);
    if (IN(3)) { p3_seq(F, args); } SEAM(3);
    if (IN(4)) { for (int u = F.vcu * NWAVES + F.wave; u < 4096; u += F.G * NWAVES) r3_unit(F, args, u); for (int u = F.vcu; u < 1024; u += F.G) h3_unit(F, args, u); for (int u = F.vcu; u < 512; u += F.G) hgrn_sample_unit(F, args, u); } SEAM(4);
    if (IN(5)) REP(5) {
        SchedMN S; S.init(MP, D, F.G, (int)blockIdx.x);
        { pg8::Gemm g{UA + 1024, (const bf16*)(ws + WS_WA), MP, D, AW, ACOLS, AW}; EpiMerge<false> E{UA, UG, 0};
          pg8::gemm_phase<EpiMerge<false>, SchedMN, true, true>(F.lds, g, S, E); }
        { pg8::Gemm g{UB + 512, (const bf16*)(ws + WS_WB), MP, D, BW, BCOLS, BW}; EpiMerge<true> E{UA, UG, 1024};
          pg8::gemm_phase<EpiMerge<true>, SchedMN, true, true>(F.lds, g, S, E); }
        for (int u = F.G - 1 - F.vcu; u < 64; u += F.G) skinny_unit<0>(F, args, u >> 3, u & 7, 0);
    } SEAM(5);
    if (IN(6)) REP(6) {
        SchedMN S; S.init(MP, D, F.G, (int)blockIdx.x);
        pg8::Gemm g{UA, (const bf16*)(ws + WS_WO), MP, D, D, ACOLS, D};
        EpiRes<true, true, true> E{args.in[0], args.in[1], args.out, UB, BCOLS, (float*)(ws + WS_SSQ1)};
        pg8::gemm_phase<EpiRes<true, true, true>, SchedMN, true, true>(F.lds, g, S, E);
        for (int u = F.G - 1 - F.vcu; u < 64; u += F.G) skinny_unit<1>(F, args, u >> 3, u & 7, 0);
    } SEAM(6);
    if (IN(7)) REP(7) {
        SchedMN S; S.init(MP, DFF, F.G, (int)blockIdx.x);
        pg8::Gemm g{UB, (const bf16*)(ws + WS_WUP), MP, DFF, D, BCOLS, D};
        EpiUp E{UA, (const float*)(ws + WS_SSQ1)};
        pg8::gemm_phase<EpiUp, SchedMN, true, true>(F.lds, g, S, E);
        for (int u = F.vcu; u < 256; u += F.G) skinny_unit<2>(F, args, u >> 5, u & 31, 0);
    } SEAM(7);
    if (IN(8)) {
        SchedMN S; S.init(MP, D, F.G, (int)blockIdx.x);
        pg8::Gemm g{UA, (const bf16*)(ws + WS_WDN), MP, D, DFF, DFF, DFF};
        EpiRes<false, false, false> E{nullptr, nullptr, args.out, nullptr, 0, nullptr};
        pg8::gemm_phase<EpiRes<false, false, false>, SchedMN, true, true>(F.lds, g, S, E);
        for (int u = F.vcu; u < 256; u += F.G) skinny_unit<3>(F, args, (u >> 3) & 7, u & 7, u >> 6);
    } SEAM(8);
    if (IN(9)) { p9_final(F, args); }
#undef IN
#undef SEAM
}

extern "C" void kernel_launch(void* const* d_in, const int* in_sizes, int n_in, void* d_out, int out_size, void* d_ws, size_t ws_size, hipStream_t stream) {
    static int grid = 0;
    if (grid == 0) {
        if (n_in != 27 || out_size != (int)O_END || ws_size < WS_END) { fprintf(stderr, "kernel_launch: unexpected shapes (n_in %d, out %d, ws %zu)\n", n_in, out_size, ws_size); grid = -1; return; }
        int dev = 0, cus = 0, per_cu = 0;
        if (hipGetDevice(&dev) != hipSuccess || hipDeviceGetAttribute(&cus, hipDeviceAttributeMultiprocessorCount, dev) != hipSuccess) { grid = -1; return; }
        if (hipFuncSetAttribute((const void*)fwd, hipFuncAttributeMaxDynamicSharedMemorySize, LDS_BYTES) != hipSuccess) { fprintf(stderr, "kernel_launch: hipFuncSetAttribute failed\n"); grid = -1; return; }
        if (hipOccupancyMaxActiveBlocksPerMultiprocessor(&per_cu, (const void*)fwd, NWAVES * 64, LDS_BYTES) != hipSuccess || per_cu < 1) { fprintf(stderr, "kernel_launch: occupancy query says %d\n", per_cu); }
        (void)hipGetLastError();
        grid = cus;
    }
    if (grid < 0) return;
    (void)hipMemsetAsync((char*)d_ws + WS_CTL, 0, CTL_BYTES, stream);
    Args a{};
    for (int i = 0; i < 27; ++i) a.in[i] = (const float*)d_in[i];
    a.out = (float*)d_out; a.ws = (unsigned char*)d_ws;
    if (MK_N_LAUNCHES == 1) { a.ph_lo = 0; a.ph_hi = NPHASE; hipLaunchKernelGGL(fwd, dim3(grid), dim3(NWAVES * 64), LDS_BYTES, stream, a); }
    else for (int p = 0; p < NPHASE; ++p) { a.ph_lo = p; a.ph_hi = p + 1; hipLaunchKernelGGL(fwd, dim3(grid), dim3(NWAVES * 64), LDS_BYTES, stream, a); }
}
```

```cpp
#include <hip/hip_runtime.h>
#include <cstdio>
#include <cstdint>
namespace pg8 {
#define PG8_LAS __attribute__((address_space(3)))
typedef unsigned short bf16_t;
typedef short bf16x8 __attribute__((ext_vector_type(8)));
typedef float f32x4 __attribute__((ext_vector_type(4)));
typedef unsigned u32x4 __attribute__((ext_vector_type(4)));
constexpr int BM = 256, BK = 64, HALF = 128, HTB = HALF * BK * 2  , STAGE_BYTES = 8 * HTB, NXCD = 8, WGM = 8;

__host__ __device__ __forceinline__ int lds_byte(int r, int c) { const int st = (r >> 4) * 2 + (c >> 5), rr = r & 15, cc = c & 31, ob = rr * 64 + cc * 2; return st * 1024 + (ob ^ (((ob >> 9) & 1) << 5)); }
__host__ __device__ __forceinline__ void stage_rc(int b, int& R, int& C) { const int st = b / 1024, sb = b % 1024, swz = sb ^ (((sb >> 9) & 1) << 5); R = (st >> 1) * 16 + swz / 64; C = (st & 1) * 32 + (swz % 64) / 2; }
__host__ __device__ __forceinline__ int perm32(int rho) { const int n = rho >> 4, i = rho & 15; return 8 * (i >> 2) + 4 * n + (i & 3); }

struct Unit { int pm, pn; };
struct Gemm { const bf16_t* A; const bf16_t* Bt; int M, N, K, lda, ldb; };

struct StaticOrder {
    int nM, nN, nwg, G, c;
    __host__ __device__ void init(int M, int N, int G_, int c_) { nM = M / BM; nN = N / BM; nwg = nM * nN; G = G_; c = c_; }
    __host__ __device__ bool next(int i, Unit& u) const {
        const long L = (long)i * G + c; if (L >= nwg) return false;
        int wgid = (int)L; { const int q = nwg / NXCD, r = nwg % NXCD, xcd = wgid % NXCD, off = wgid / NXCD; wgid = (xcd < r ? xcd * (q + 1) : r * (q + 1) + (xcd - r) * q) + off; }
        const int nig = WGM * nN, gid = wgid / nig, fm = gid * WGM, gsz = (nM - fm) < WGM ? (nM - fm) : WGM;
        u.pm = fm + ((wgid % nig) % gsz); u.pn = (wgid % nig) / gsz; return true;
    }
    __device__ __forceinline__ void a_ready(const Unit&) const {}
    __device__ __forceinline__ void done(const Unit&) const {}
};

__device__ __forceinline__ unsigned cvt_pk_bf16(float lo, float hi) { unsigned r; asm volatile("v_cvt_pk_bf16_f32 %0, %1, %2" : "=v"(r) : "v"(lo), "v"(hi)); return r; }
typedef float f32x2 __attribute__((ext_vector_type(2)));
__device__ __forceinline__ f32x2 gelu_pk(f32x2 v) {
    const f32x2 av = __builtin_elementwise_abs(v), d = av * 0.2316418882f + 1.0f;
    f32x2 t; t.x = __builtin_amdgcn_rcpf(d.x); t.y = __builtin_amdgcn_rcpf(d.y);
    f32x2 q = t * 0.5307027145f + (-0.7265760135f); q = q * t + 0.7107068705f; q = q * t + (-0.142248368f); q = q * t + 0.127414796f; q = q * t;
    const f32x2 s = (v * v) * (-0.72134752044f);
    f32x2 e; e.x = __builtin_amdgcn_exp2f(s.x); e.y = __builtin_amdgcn_exp2f(s.y);
    const f32x2 m = v * (q * e), r = v - m;
    f32x2 o; o.x = v.x < 0.f ? m.x : r.x; o.y = v.y < 0.f ? m.y : r.y; return o;
}

template <class Epi, class Sched, bool ALIGN_EPI = false, bool SP2 = false>
__device__ __forceinline__ void gemm_phase(PG8_LAS unsigned char* lds, const Gemm g, const Sched& S, const Epi& E) {
    const int tid = threadIdx.x, wid = __builtin_amdgcn_readfirstlane(tid >> 6), lane = tid & 63, wr = wid >> 2, wc = wid & 3, fr = lane & 15, fq = lane >> 4;
    const int K = g.K, nt = K / BK;
    unsigned voffA[2], voffB[2];
#pragma unroll
    for (int i = 0; i < 2; ++i) { int R, C; stage_rc(tid * 16 + i * 8192, R, C); const int Rb = Epi::PERM ? ((R & ~31) + perm32(R & 31)) : R;
        voffA[i] = (unsigned)(R * g.lda + C) * 2u; voffB[i] = (unsigned)(Rb * g.ldb + C) * 2u; }
    const size_t kstep = (size_t)(BK * 2);
    const size_t hstepA = (size_t)HALF * g.lda * 2, hstepB = (size_t)HALF * g.ldb * 2;
    const size_t tstepA = 2 * hstepA, tstepB = 2 * hstepB;
    const unsigned ldsw = (unsigned)wid * 1024u;
    const int aoff = lds_byte(wr * 64 + fr, fq * 8), boff = lds_byte(wc * 32 + fr, fq * 8);
#define PG8_SA(b, h) (((b) * 2 + (h)) * HTB)
#define PG8_SB(b, h) ((4 + (b) * 2 + (h)) * HTB)
#define PG8_STAGE(bufoff, gbase, voff) do { _Pragma("unroll") for (int _i = 0; _i < 2; ++_i) \
        __builtin_amdgcn_global_load_lds((const unsigned*)((const char*)(gbase) + (voff)[_i]), (PG8_LAS unsigned*)(lds + (bufoff) + ldsw + _i * 8192), 16, 0, 0); } while (0)
#define PG8_LDA(dst, b, h) do { _Pragma("unroll") for (int m = 0; m < 4; ++m) _Pragma("unroll") for (int k = 0; k < 2; ++k) dst[m][k] = *(const PG8_LAS bf16x8*)(lds + PG8_SA(b, h) + aoff + m * 2048 + k * 1024); } while (0)
#define PG8_LDB(dst, b, h) do { _Pragma("unroll") for (int n = 0; n < 2; ++n) _Pragma("unroll") for (int k = 0; k < 2; ++k) dst[n][k] = *(const PG8_LAS bf16x8*)(lds + PG8_SB(b, h) + boff + n * 2048 + k * 1024); } while (0)
#define PG8_MMA(ai, bj, At, Bt) do { __builtin_amdgcn_s_setprio(1); _Pragma("unroll") for (int m = 0; m < 4; ++m) _Pragma("unroll") for (int n = 0; n < 2; ++n) _Pragma("unroll") for (int k = 0; k < 2; ++k) \
        acc[ai][bj][m][n] = __builtin_amdgcn_mfma_f32_16x16x32_bf16(Bt[n][k], At[m][k], acc[ai][bj][m][n], 0, 0, 0); __builtin_amdgcn_s_setprio(0); } while (0)
#define PG8_WAIT_V(n) asm volatile("s_waitcnt vmcnt(" #n ")" ::: "memory")
#define PG8_WAIT_L(n) asm volatile("s_waitcnt lgkmcnt(" #n ")" ::: "memory")
#define PG8_BAR __builtin_amdgcn_s_barrier()
#define PG8_SCHED __builtin_amdgcn_sched_barrier(0)
    Unit cur, nxt; int ui = 0;
    if (!S.next(0, cur)) return;
    f32x4 acc[2][2][4][2];
#pragma unroll
    for (int a = 0; a < 2; ++a)
#pragma unroll
        for (int b = 0; b < 2; ++b)
#pragma unroll
            for (int m = 0; m < 4; ++m)
#pragma unroll
                for (int n = 0; n < 2; ++n) acc[a][b][m][n] = (f32x4){0.f, 0.f, 0.f, 0.f};
    bf16x8 At[4][2], B0[2][2], B1[2][2];
    const char* cA = (const char*)g.A + (size_t)cur.pm * tstepA; const char* cB = (const char*)g.Bt + (size_t)cur.pn * tstepB;
    S.a_ready(cur);
    if constexpr (SP2) {
        PG8_STAGE(PG8_SB(0, 0), cB, voffB); PG8_STAGE(PG8_SB(0, 1), cB + hstepB, voffB); PG8_STAGE(PG8_SA(0, 0), cA, voffA); PG8_STAGE(PG8_SA(0, 1), cA + hstepA, voffA);
        if (wr == 1) PG8_BAR;
        PG8_WAIT_V(2); PG8_BAR;
        PG8_STAGE(PG8_SB(1, 0), cB + kstep, voffB); PG8_STAGE(PG8_SA(1, 0), cA + kstep, voffA); PG8_STAGE(PG8_SB(1, 1), cB + hstepB + kstep, voffB);
        PG8_WAIT_V(6); PG8_BAR;
    } else {
        PG8_STAGE(PG8_SB(0, 0), cB, voffB); PG8_STAGE(PG8_SA(0, 0), cA, voffA); PG8_STAGE(PG8_SB(0, 1), cB + hstepB, voffB); PG8_STAGE(PG8_SA(0, 1), cA + hstepA, voffA);
        if (wr == 1) PG8_BAR;
        PG8_WAIT_V(4); PG8_BAR;
        PG8_STAGE(PG8_SB(1, 0), cB + kstep, voffB); PG8_STAGE(PG8_SA(1, 0), cA + kstep, voffA); PG8_STAGE(PG8_SB(1, 1), cB + hstepB + kstep, voffB);
        PG8_WAIT_V(6); PG8_BAR;
    }
    for (;;) {
        const bool has_next = S.next(ui + 1, nxt);
        const char* nA = has_next ? (const char*)g.A + (size_t)nxt.pm * tstepA : cA; const char* nB = has_next ? (const char*)g.Bt + (size_t)nxt.pn * tstepB : cB;
        for (int t = 0; t < nt; t += 2) {
            const bool last = (t == nt - 2);
            const char* a1 = cA + (size_t)(t + 1) * kstep;
            const char* a2 = last ? nA : cA + (size_t)(t + 2) * kstep; const char* b2 = last ? nB : cB + (size_t)(t + 2) * kstep;
            const char* a3 = a2 + kstep; const char* b3 = b2 + kstep;
            if (last && has_next) S.a_ready(nxt);
            if constexpr (SP2) {
            PG8_LDB(B0, 0, 0); PG8_LDB(B1, 0, 1); PG8_SCHED; PG8_LDA(At, 0, 0); PG8_STAGE(PG8_SA(1, 1), a1 + hstepA, voffA);
            PG8_WAIT_V(8); PG8_WAIT_L(0); PG8_BAR; PG8_MMA(0, 0, At, B0); PG8_MMA(0, 1, At, B1); PG8_BAR; PG8_SCHED;
            PG8_LDA(At, 0, 1); PG8_STAGE(PG8_SB(0, 0), b2, voffB); PG8_STAGE(PG8_SB(0, 1), b2 + hstepB, voffB); PG8_STAGE(PG8_SA(0, 0), a2, voffA);
            PG8_WAIT_V(8); PG8_WAIT_L(0); PG8_BAR; PG8_MMA(1, 0, At, B0); PG8_MMA(1, 1, At, B1); PG8_BAR; PG8_SCHED;
            PG8_LDB(B0, 1, 0); PG8_LDB(B1, 1, 1); PG8_SCHED; PG8_LDA(At, 1, 0); PG8_STAGE(PG8_SA(0, 1), a2 + hstepA, voffA);
            PG8_WAIT_V(8); PG8_WAIT_L(0); PG8_BAR; PG8_MMA(0, 0, At, B0); PG8_MMA(0, 1, At, B1); PG8_BAR; PG8_SCHED;
            PG8_LDA(At, 1, 1); PG8_STAGE(PG8_SB(1, 0), b3, voffB); PG8_STAGE(PG8_SB(1, 1), b3 + hstepB, voffB); PG8_STAGE(PG8_SA(1, 0), a3, voffA);
            PG8_WAIT_V(8); PG8_WAIT_L(0); PG8_BAR; PG8_MMA(1, 0, At, B0); PG8_MMA(1, 1, At, B1); PG8_BAR; PG8_SCHED;
            } else {
            PG8_LDB(B0, 0, 0); PG8_SCHED; PG8_LDA(At, 0, 0); PG8_STAGE(PG8_SA(1, 1), a1 + hstepA, voffA);
            PG8_WAIT_L(8); PG8_BAR; PG8_WAIT_L(0); PG8_MMA(0, 0, At, B0); PG8_BAR; PG8_SCHED;
            PG8_LDB(B1, 0, 1); PG8_STAGE(PG8_SB(0, 0), b2, voffB);
            PG8_BAR; PG8_WAIT_L(0); PG8_MMA(0, 1, At, B1); PG8_BAR;
            PG8_LDA(At, 0, 1); PG8_STAGE(PG8_SA(0, 0), a2, voffA);
            PG8_BAR; PG8_WAIT_L(0); PG8_MMA(1, 0, At, B0); PG8_BAR; PG8_SCHED;
            PG8_STAGE(PG8_SB(0, 1), b2 + hstepB, voffB);
            PG8_WAIT_V(6); PG8_BAR; PG8_MMA(1, 1, At, B1); PG8_BAR;
            PG8_LDB(B0, 1, 0); PG8_SCHED; PG8_LDA(At, 1, 0); PG8_STAGE(PG8_SA(0, 1), a2 + hstepA, voffA);
            PG8_WAIT_L(8); PG8_BAR; PG8_WAIT_L(0); PG8_MMA(0, 0, At, B0); PG8_BAR; PG8_SCHED;
            PG8_LDB(B1, 1, 1); PG8_STAGE(PG8_SB(1, 0), b3, voffB);
            PG8_BAR; PG8_WAIT_L(0); PG8_MMA(0, 1, At, B1); PG8_BAR;
            PG8_LDA(At, 1, 1); PG8_STAGE(PG8_SA(1, 0), a3, voffA);
            PG8_BAR; PG8_WAIT_L(0); PG8_MMA(1, 0, At, B0); PG8_BAR; PG8_SCHED;
            PG8_STAGE(PG8_SB(1, 1), b3 + hstepB, voffB);
            PG8_WAIT_V(6); PG8_BAR; PG8_MMA(1, 1, At, B1); PG8_BAR;
            }
        }
        if constexpr (ALIGN_EPI) { if (wr == 0) PG8_BAR; }
        if constexpr (!Epi::AFTER_DRAIN) { E(acc, cur, wr, wc, fr, fq); S.done(cur); }
        if (!has_next) break;
#pragma unroll
        for (int a = 0; a < 2; ++a)
#pragma unroll
            for (int b = 0; b < 2; ++b)
#pragma unroll
                for (int m = 0; m < 4; ++m)
#pragma unroll
                    for (int n = 0; n < 2; ++n) acc[a][b][m][n] = (f32x4){0.f, 0.f, 0.f, 0.f};
        cur = nxt; cA = nA; cB = nB; ++ui;
        if constexpr (ALIGN_EPI) { if (wr == 1) PG8_BAR; }
    }
    PG8_WAIT_V(0);
    if constexpr (!ALIGN_EPI) { if (wr == 0) PG8_BAR; }
    PG8_BAR;
    if constexpr (Epi::AFTER_DRAIN) { E.fused(acc, cur, wr, wc, fr, fq, lds, wid, lane); S.done(cur); }
#undef PG8_SA
#undef PG8_SB
#undef PG8_STAGE
#undef PG8_LDA
#undef PG8_LDB
#undef PG8_MMA
#undef PG8_WAIT_V
#undef PG8_WAIT_L
#undef PG8_BAR
#undef PG8_SCHED
}
}

#ifndef MK_N_LAUNCHES
#define MK_N_LAUNCHES 1
#endif
constexpr int NPHASE = 10;
constexpr int NWAVES = 8;

constexpr int D = 1024, SEQ = 2048, NBP = 8, NBS = 128, TS = 4;
constexpr int MP = NBP * SEQ;
constexpr int MS = NBS * TS;
constexpr int MT = MP + MS;
constexpr int MH = MT + 256;
constexpr int ACOLS = 2048, BCOLS = 1792, GCOLS = 2048, NIN = ACOLS + BCOLS + GCOLS, DFF = 4096;
constexpr int AW = 512, BW = 512;
constexpr float NORM_EPS = 1e-6f, HGRN_EPS = 1e-5f, GN_EPS = 64e-5f, DECAY_SCALE = 0.6065306597126334f;

constexpr size_t O_Y = 0, O_HGRN_P = (size_t)MT * D, O_WKV_P = O_HGRN_P + (size_t)NBP * 4 * 128 * 128, O_SHIFT_P = O_WKV_P + (size_t)NBP * 8 * 64 * 64,
                 O_HGRN_S = O_SHIFT_P + (size_t)NBP * D, O_WKV_S = O_HGRN_S + (size_t)NBS * 4 * 128 * 128, O_SHIFT_S = O_WKV_S + (size_t)NBS * 8 * 64 * 64,
                 O_END = O_SHIFT_S + (size_t)NBS * D;
static_assert(O_END == 30810112, "d_out size");

constexpr size_t WS_CTL = 0, CTL_BYTES = 65536;
constexpr size_t WS_WIN = WS_CTL + CTL_BYTES;
constexpr size_t WS_WA  = WS_WIN + (size_t)NIN * D * 2;
constexpr size_t WS_WB  = WS_WA + (size_t)D * AW * 2;
constexpr size_t WS_WO  = WS_WB + (size_t)D * BW * 2;
constexpr size_t WS_WUP = WS_WO + (size_t)D * D * 2;
constexpr size_t WS_WDN = WS_WUP + (size_t)DFF * D * 2;
constexpr size_t WS_UB  = WS_WDN + (size_t)D * DFF * 2;
constexpr size_t WS_UA  = WS_UB + (size_t)MH * BCOLS * 2;
constexpr size_t WS_UG  = WS_UA + (size_t)MT * ACOLS * 2;
constexpr size_t WS_BONUS = WS_UG + (size_t)MT * GCOLS * 2;
constexpr size_t WS_NS = WS_BONUS + (size_t)MT * 8 * 4;
constexpr size_t WS_GAMMA = WS_NS + (size_t)1024 * 16384 * 2;
constexpr size_t WS_WDT = WS_GAMMA + (size_t)1024 * 128 * 4;
constexpr size_t WS_WAT = WS_WDT + 512 * 64 * 2;
constexpr size_t WS_WGT = WS_WAT + 512 * 64 * 2;
constexpr size_t WS_END = WS_WGT + 512 * 128 * 2;
constexpr size_t WS_SSQ1 = WS_NS;
constexpr size_t WS_SSQ2 = WS_SSQ1 + (size_t)MT * 16 * 4;
static_assert(WS_END <= 268435456, "d_ws map");
static_assert(WS_UA + (size_t)MT * DFF * 2 == WS_BONUS, "hidden overlays UA|UG exactly");
static_assert((size_t)MT * 2048 * 2 == (size_t)MT * D * 4, "P fits the y region exactly");

constexpr int CW_TMO = 0, CW_BAR = 1024;

constexpr int RING_BYTES = 159744, LDSCTL_OFF = RING_BYTES, MISC_OFF = LDSCTL_OFF + 320, LDS_BYTES = 163840;

#define GAS __attribute__((address_space(1)))
#define LAS __attribute__((address_space(3)))
typedef unsigned short bf16;
typedef unsigned v4u __attribute__((ext_vector_type(4)));
typedef unsigned v2u __attribute__((ext_vector_type(2)));
typedef float f32x4 __attribute__((ext_vector_type(4)));
typedef GAS unsigned gu32;
#define RLX_AGENT __ATOMIC_RELAXED, __HIP_MEMORY_SCOPE_AGENT
#define LDS_WAIT() asm volatile("s_waitcnt lgkmcnt(0)" ::: "memory")
#define VM_WAIT() asm volatile("s_waitcnt vmcnt(0)" ::: "memory")
__device__ __forceinline__ unsigned f2bf(float f) { unsigned u = __builtin_bit_cast(unsigned, f); return (u + 0x7fffu + ((u >> 16) & 1u)) >> 16; }
__device__ __forceinline__ unsigned pk2(float lo, float hi) { return f2bf(lo) | (f2bf(hi) << 16); }
__device__ __forceinline__ float bf2f(unsigned b) { return __builtin_bit_cast(float, b << 16); }
__device__ __forceinline__ float bflo(unsigned w) { return __builtin_bit_cast(float, w << 16); }
__device__ __forceinline__ float bfhi(unsigned w) { return __builtin_bit_cast(float, w & 0xffff0000u); }
__device__ __forceinline__ float sigmoidf_(float x) { return 1.0f / (1.0f + __expf(-x)); }
__device__ __forceinline__ float tanhf_(float x) { return 1.0f - 2.0f / (1.0f + __expf(2.0f * x)); }
__device__ __forceinline__ float wave_sum(float v) {
#pragma unroll
    for (int o = 1; o < 64; o <<= 1) v += __shfl_xor(v, o);
    return v;
}
__device__ __forceinline__ float row_sum16(float x) {
    x += __builtin_bit_cast(float, __builtin_amdgcn_update_dpp(0, __builtin_bit_cast(int, x), 0xB1, 0xF, 0xF, true));
    x += __builtin_bit_cast(float, __builtin_amdgcn_update_dpp(0, __builtin_bit_cast(int, x), 0x4E, 0xF, 0xF, true));
    x += __builtin_bit_cast(float, __builtin_amdgcn_update_dpp(0, __builtin_bit_cast(int, x), 0x141, 0xF, 0xF, true));
    x += __builtin_bit_cast(float, __builtin_amdgcn_update_dpp(0, __builtin_bit_cast(int, x), 0x140, 0xF, 0xF, true));
    return x;
}
#define XB_TMO      128
#define XB_XCNT(j)  (256  + 64 * (j))
#define XB_XSUB(j)  (1280 + 64 * (j))
#define XB_XGEN(j)  (2304 + 64 * (j))
#define XB_TOP      3328
#define XB_TOPGEN   3392
#define XCD_BAR_WORDS 3456
#define XB_SPIN_CAP (1u << 18)

__device__ __forceinline__ unsigned xb_ld(unsigned* p)              { return __hip_atomic_load(p, __ATOMIC_RELAXED, __HIP_MEMORY_SCOPE_AGENT); }
__device__ __forceinline__ unsigned xb_add(unsigned* p, unsigned v) { return __hip_atomic_fetch_add(p, v, __ATOMIC_RELAXED, __HIP_MEMORY_SCOPE_AGENT); }
__device__ __forceinline__ unsigned xb_xcc_id() { return (unsigned)__builtin_amdgcn_s_getreg((3 << 11) | 20) & 0xFu; }
#define XB_SPIN(cond, bar) do { unsigned _sp = 0; while (cond) { __builtin_amdgcn_s_sleep(1); \
    if ((++_sp & 255u) == 0u) { if (xb_ld(&(bar)[XB_TMO])) break; if (_sp > XB_SPIN_CAP) { atomicAdd(&(bar)[XB_TMO], 1u); break; } } } } while (0)

struct XcdBarrier {
    unsigned* bar; unsigned x;
    volatile LAS unsigned* st;
};

__device__ __forceinline__ XcdBarrier xcd_barrier_post(unsigned* bar, volatile LAS unsigned* st) {
    XcdBarrier b; b.bar = bar; b.x = xb_xcc_id(); b.st = st;
    if (threadIdx.x == 0) (void)xb_add(&bar[XB_XCNT(b.x)], 1u);
    return b;
}
__device__ __forceinline__ void xcd_barrier_complete(unsigned* bar, unsigned x, unsigned& nloc, unsigned& nx) {
    const unsigned G = gridDim.x * gridDim.y * gridDim.z;
    unsigned sum, cnt, mine, sp = 0u;
    for (;;) {
        sum = 0u; cnt = 0u; mine = 0u;
#pragma unroll
        for (unsigned j = 0; j < 16; ++j) { const unsigned c = xb_ld(&bar[XB_XCNT(j)]); sum += c; cnt += (c > 0u) ? 1u : 0u; mine = (j == x) ? c : mine; }
        if (sum == G) break;
        __builtin_amdgcn_s_sleep(1);
        if ((++sp & 255u) == 0u) { if (xb_ld(&bar[XB_TMO])) break; if (sp > XB_SPIN_CAP) { atomicAdd(&bar[XB_TMO], 1u); break; } }
    }
    nloc = mine > 0u ? mine : 1u; nx = cnt > 0u ? cnt : 1u;
}

__device__ __forceinline__ void xcd_barrier(const XcdBarrier& b) {
    asm volatile("s_waitcnt vmcnt(0)" ::: "memory");
    __syncthreads();
    if (threadIdx.x == 0) {
        unsigned* bar = b.bar;
        __builtin_amdgcn_s_waitcnt(0);
        unsigned nloc = b.st[0], nx = b.st[1];
        if (nloc == 0u) { xcd_barrier_complete(bar, b.x, nloc, nx); b.st[0] = nloc; b.st[1] = nx; }
        const unsigned old = xb_add(&bar[XB_XSUB(b.x)], 1u);
        const unsigned gen = old / nloc;
        if (old + 1u == (gen + 1u) * nloc) {
            __builtin_amdgcn_fence(__ATOMIC_RELEASE, "agent");
            asm volatile("s_waitcnt vmcnt(0)" ::: "memory");
            const unsigned og = xb_add(&bar[XB_TOP], 1u);
            const unsigned tg = og / nx;
            if (og + 1u == (tg + 1u) * nx) xb_add(&bar[XB_TOPGEN], 1u);
            else XB_SPIN(xb_ld(&bar[XB_TOPGEN]) == tg, bar);
            __builtin_amdgcn_fence(__ATOMIC_ACQUIRE, "agent");
            xb_add(&bar[XB_XGEN(b.x)], 1u);
            asm volatile("s_waitcnt vmcnt(0)" ::: "memory");
        } else {
            XB_SPIN(xb_ld(&bar[XB_XGEN(b.x)]) == gen, bar);
            __builtin_amdgcn_fence(__ATOMIC_ACQUIRE, "agent");
            asm volatile("s_waitcnt vmcnt(0)" ::: "memory");
        }
    }
    __syncthreads();
}


struct Args { const float* in[27]; float* out; unsigned char* ws; int ph_lo, ph_hi; };
struct Frame {
    LAS unsigned char* lds;
    int tid, lane, wave, vcu, G;
};

struct SchedMN {
    pg8::StaticOrder so;
    __device__ void init(int M, int N, int G, int c) { so.init(M, N, G, c); }
    __device__ __forceinline__ bool next(int i, pg8::Unit& u) const { return so.next(i, u); }
    __device__ __forceinline__ void a_ready(const pg8::Unit&) const {}
    __device__ __forceinline__ void done(const pg8::Unit&) const {}
};
struct SchedG1 {
    pg8::StaticOrder so; int G, c;
    __device__ void init(int G_, int c_) { so.init(MT, NIN, G_, c_); G = G_; c = c_; }
    __device__ __forceinline__ bool next(int i, pg8::Unit& u) const {
        const int L = i * G + c;
        if (L < so.nwg) return so.next(i, u);
        if (L < so.nwg + 7) { u.pm = MT / 256; u.pn = 8 + (L - so.nwg); return true; }
        return false;
    }
    __device__ __forceinline__ void a_ready(const pg8::Unit&) const {}
    __device__ __forceinline__ void done(const pg8::Unit&) const {}
};

using pg8::f32x4; using pg8::Unit;
typedef unsigned u32x4 __attribute__((ext_vector_type(4)));
struct EpiG1 {
    static constexpr bool PERM = true, AFTER_DRAIN = false;
    bf16 *UA, *UB, *UG, *BR;
    __device__ __forceinline__ void operator()(const f32x4 (&acc)[2][2][4][2], const Unit& u, int wr, int wc, int fr, int fq) const {
        bf16* base; int ld, colt;
        if (u.pn < 8) { base = UA; ld = ACOLS; colt = u.pn * 256; } else if (u.pn < 15) { base = UB; ld = BCOLS; colt = (u.pn - 8) * 256; } else { base = UG; ld = GCOLS; colt = (u.pn - 15) * 256; }
        const int row0 = u.pm * 256 + wr * 64 + fr, col0 = colt + wc * 32 + 8 * fq;
#pragma unroll
        for (int ai = 0; ai < 2; ++ai)
#pragma unroll
            for (int m = 0; m < 4; ++m) { bf16* rowp = base + (size_t)(row0 + ai * 128 + m * 16) * ld + col0;
#pragma unroll
                for (int bj = 0; bj < 2; ++bj) { const f32x4 v0 = acc[ai][bj][m][0], v1 = acc[ai][bj][m][1];
                    u32x4 w; w.x = pk2(v0[0], v0[1]); w.y = pk2(v0[2], v0[3]); w.z = pk2(v1[0], v1[1]); w.w = pk2(v1[2], v1[3]);
                    *(u32x4*)(rowp + bj * 128) = w;
                    if ((m & 1) && fr == 15 && u.pn >= 8 && u.pn < 14 && u.pm < MP / 256) { const int row = row0 + ai * 128 + m * 16; *(u32x4*)(BR + (size_t)(row >> 5) * 1536 + col0 + bj * 128) = w; } } }
    }
};
template <bool ADD> struct EpiMerge {
    static constexpr bool PERM = true, AFTER_DRAIN = false;
    bf16* Mg; const bf16* UG; int goff;
    __device__ __forceinline__ void operator()(const f32x4 (&acc)[2][2][4][2], const Unit& u, int wr, int wc, int fr, int fq) const {
        const int row0 = u.pm * 256 + wr * 64 + fr, col0 = u.pn * 256 + wc * 32 + 8 * fq;
#pragma unroll
        for (int ai = 0; ai < 2; ++ai)
#pragma unroll
            for (int m = 0; m < 4; ++m) { const size_t row = (size_t)(row0 + ai * 128 + m * 16);
#pragma unroll
                for (int bj = 0; bj < 2; ++bj) { const f32x4 v0 = acc[ai][bj][m][0], v1 = acc[ai][bj][m][1];
                    const u32x4 gq = *(const u32x4*)(UG + row * GCOLS + goff + col0 + bj * 128);
                    float o[8];
                    o[0] = sigmoidf_(bflo(gq.x)) * v0[0]; o[1] = sigmoidf_(bfhi(gq.x)) * v0[1]; o[2] = sigmoidf_(bflo(gq.y)) * v0[2]; o[3] = sigmoidf_(bfhi(gq.y)) * v0[3];
                    o[4] = sigmoidf_(bflo(gq.z)) * v1[0]; o[5] = sigmoidf_(bfhi(gq.z)) * v1[1]; o[6] = sigmoidf_(bflo(gq.w)) * v1[2]; o[7] = sigmoidf_(bfhi(gq.w)) * v1[3];
                    bf16* dst = Mg + row * ACOLS + col0 + bj * 128;
                    if (ADD) { const u32x4 p = *(const u32x4*)dst;
                        o[0] += bflo(p.x); o[1] += bfhi(p.x); o[2] += bflo(p.y); o[3] += bfhi(p.y); o[4] += bflo(p.z); o[5] += bfhi(p.z); o[6] += bflo(p.w); o[7] += bfhi(p.w); }
                    u32x4 w; w.x = pk2(o[0], o[1]); w.y = pk2(o[2], o[3]); w.z = pk2(o[4], o[5]); w.w = pk2(o[6], o[7]);
                    *(u32x4*)dst = w; } }
    }
};
template <bool RES_IS_X, bool WRITE_BF, bool WRITE_SSQ> struct EpiRes {
    static constexpr bool PERM = false, AFTER_DRAIN = false;
    const float* xp; const float* xs; float* out; bf16* xb; int ldb; float* ssq;
    __device__ __forceinline__ void operator()(const f32x4 (&acc)[2][2][4][2], const Unit& u, int wr, int wc, int fr, int fq) const {
        const int row0 = u.pm * 256 + wr * 64 + fr, col0 = u.pn * 256 + wc * 32 + 4 * fq;
#pragma unroll
        for (int ai = 0; ai < 2; ++ai)
#pragma unroll
            for (int m = 0; m < 4; ++m) { const int row = row0 + ai * 128 + m * 16;
                const float* rp = RES_IS_X ? (row < MP ? xp + (size_t)row * D : xs + (size_t)(row - MP) * D) : out + (size_t)row * D;
                float s = 0.f;
#pragma unroll
                for (int bj = 0; bj < 2; ++bj)
#pragma unroll
                    for (int n = 0; n < 2; ++n) { const int col = col0 + bj * 128 + n * 16;
                        const f32x4 r = *(const f32x4*)(rp + col); const f32x4 o = r + acc[ai][bj][m][n];
                        *(f32x4*)(out + (size_t)row * D + col) = o;
                        s += (o[0] * o[0] + o[1] * o[1]) + (o[2] * o[2] + o[3] * o[3]);
                        if (WRITE_BF) { v2u w; w.x = pk2(o[0], o[1]); w.y = pk2(o[2], o[3]); *(v2u*)(xb + (size_t)row * ldb + col) = w; } }
                if (WRITE_SSQ) { s += __shfl_xor(s, 16); s += __shfl_xor(s, 32);
                    if (fq == 0) ssq[(size_t)row * 16 + u.pn * 4 + wc] = s; } }
    }
};
struct EpiUp {
    static constexpr bool PERM = true, AFTER_DRAIN = false;
    bf16* Hd; const float* ssq;
    __device__ __forceinline__ void operator()(const f32x4 (&acc)[2][2][4][2], const Unit& u, int wr, int wc, int fr, int fq) const {
        const int row0 = u.pm * 256 + wr * 64 + fr, col0 = u.pn * 256 + wc * 32 + 8 * fq;
#pragma unroll
        for (int ai = 0; ai < 2; ++ai)
#pragma unroll
            for (int m = 0; m < 4; ++m) { const size_t row = (size_t)(row0 + ai * 128 + m * 16);
                const f32x4* sp = (const f32x4*)(ssq + row * 16); const f32x4 a = sp[0], b = sp[1], c = sp[2], d = sp[3];
                const float tot = ((a[0] + a[1]) + (a[2] + a[3])) + ((b[0] + b[1]) + (b[2] + b[3])) + ((c[0] + c[1]) + (c[2] + c[3])) + ((d[0] + d[1]) + (d[2] + d[3]));
                const float rstd = rsqrtf(tot * (1.0f / D) + NORM_EPS);
#pragma unroll
                for (int bj = 0; bj < 2; ++bj) { const f32x4 v0 = acc[ai][bj][m][0], v1 = acc[ai][bj][m][1];
                    float o[8] = {v0[0], v0[1], v0[2], v0[3], v1[0], v1[1], v1[2], v1[3]};
#pragma unroll
                    for (int e = 0; e < 8; ++e) { const float t = fmaxf(o[e] * rstd, 0.f); o[e] = t * t; }
                    u32x4 w; w.x = pk2(o[0], o[1]); w.y = pk2(o[2], o[3]); w.z = pk2(o[4], o[5]); w.w = pk2(o[6], o[7]);
                    *(u32x4*)(Hd + row * DFF + col0 + bj * 128) = w; } }
    }
};

__device__ __forceinline__ void p0_transpose_item(const float* W, int K, int N, bf16* WT, const float* kscale, LAS float* scr, int item, int lane) {
    const int nblk = N / 32, kb = item / nblk, nb = item % nblk, k0 = 64 * kb, n0 = 32 * nb;
#pragma unroll 8
    for (int i = 0; i < 32; ++i) { const int kk = 2 * i + (lane >> 5); float v = W[(size_t)(k0 + kk) * N + n0 + (lane & 31)]; if (kscale) v *= kscale[k0 + kk]; scr[kk * 33 + (lane & 31)] = v; }
    LDS_WAIT(); asm volatile("" ::: "memory");
    const int c = lane & 7;
#pragma unroll
    for (int j = 0; j < 4; ++j) { const int n = (lane >> 3) + 8 * j; const LAS float* s = scr + (8 * c) * 33 + n;
        v4u o; o.x = pk2(s[0 * 33], s[1 * 33]); o.y = pk2(s[2 * 33], s[3 * 33]); o.z = pk2(s[4 * 33], s[5 * 33]); o.w = pk2(s[6 * 33], s[7 * 33]);
        *(GAS v4u*)(WT + (size_t)(n0 + n) * K + k0 + 8 * c) = o; }
    LDS_WAIT(); asm volatile("" ::: "memory");
}
__device__ __forceinline__ void p0_prologue(const Frame& F, const Args& A) {
    LAS float* scr = (LAS float*)(F.lds + F.wave * 16384);
    const int gw = F.vcu * NWAVES + F.wave, NGW = F.G * NWAVES;
    unsigned char* ws = A.ws;
    constexpr int I_IN = (D / 64) * (NIN / 32), I_A = (AW / 64) * (D / 32), I_O = (D / 64) * (D / 32), I_UP = (D / 64) * (DFF / 32), I_DN = (DFF / 64) * (D / 32);
    constexpr int I_L = 16, I_G = 32;
    constexpr int NITEMS = I_IN + 2 * I_A + I_O + I_UP + I_DN + 2 * I_L + I_G;
    for (int it = gw; it < NITEMS; it += NGW) {
        int r = it;
        if (r < I_IN) { p0_transpose_item(A.in[6], D, NIN, (bf16*)(ws + WS_WIN), nullptr, scr, r, F.lane); continue; } r -= I_IN;
        if (r < I_A) { p0_transpose_item(A.in[20], AW, D, (bf16*)(ws + WS_WA), nullptr, scr, r, F.lane); continue; } r -= I_A;
        if (r < I_A) { p0_transpose_item(A.in[21], BW, D, (bf16*)(ws + WS_WB), nullptr, scr, r, F.lane); continue; } r -= I_A;
        if (r < I_O) { p0_transpose_item(A.in[22], D, D, (bf16*)(ws + WS_WO), nullptr, scr, r, F.lane); continue; } r -= I_O;
        if (r < I_UP) { p0_transpose_item(A.in[24], D, DFF, (bf16*)(ws + WS_WUP), A.in[23], scr, r, F.lane); continue; } r -= I_UP;
        if (r < I_DN) { p0_transpose_item(A.in[25], DFF, D, (bf16*)(ws + WS_WDN), nullptr, scr, r, F.lane); continue; } r -= I_DN;
        if (r < I_L) { p0_transpose_item(A.in[9], 64, BW, (bf16*)(ws + WS_WDT), nullptr, scr, r, F.lane); continue; } r -= I_L;
        if (r < I_L) { p0_transpose_item(A.in[11], 64, BW, (bf16*)(ws + WS_WAT), nullptr, scr, r, F.lane); continue; } r -= I_L;
        p0_transpose_item(A.in[12], 128, BW, (bf16*)(ws + WS_WGT), nullptr, scr, r, F.lane);
    }
    bf16* H = (bf16*)A.out;
    const float* g = A.in[5];
    f32x4 gv[4];
#pragma unroll
    for (int j = 0; j < 4; ++j) gv[j] = ((const f32x4*)g)[F.lane + 64 * j];
    for (int m = gw; m < MH; m += NGW) {
        GAS unsigned long long* o8 = (GAS unsigned long long*)(H + (size_t)m * D) + F.lane;
        if (m < MT) {
            const float* xrow = m < MP ? A.in[0] + (size_t)m * D : A.in[1] + (size_t)(m - MP) * D;
            const f32x4* xr = (const f32x4*)xrow + F.lane;
            f32x4 v[4]; float s = 0.f;
#pragma unroll
            for (int j = 0; j < 4; ++j) { v[j] = xr[64 * j]; s += (v[j][0] * v[j][0] + v[j][1] * v[j][1]) + (v[j][2] * v[j][2] + v[j][3] * v[j][3]); }
            const float rstd = rsqrtf(wave_sum(s) * (1.0f / D) + NORM_EPS);
#pragma unroll
            for (int j = 0; j < 4; ++j) v[j] = v[j] * rstd * gv[j];
#pragma unroll
            for (int j = 0; j < 4; ++j) o8[64 * j] = (unsigned long long)pk2(v[j][0], v[j][1]) | ((unsigned long long)pk2(v[j][2], v[j][3]) << 32);
            float* so = nullptr;
            if (m < MP) { if ((m & (SEQ - 1)) == SEQ - 1) so = A.out + O_SHIFT_P + (size_t)(m >> 11) * D; }
            else { const int s_ = m - MP; if ((s_ & 3) == 3) so = A.out + O_SHIFT_S + (size_t)(s_ >> 2) * D; }
            if (so) {
#pragma unroll
                for (int j = 0; j < 4; ++j) ((f32x4*)so)[F.lane + 64 * j] = v[j];
            }
        } else if (m < MT + NBS) {
            const f32x4* xr = (const f32x4*)(A.in[4] + (size_t)(m - MT) * D) + F.lane;
#pragma unroll
            for (int j = 0; j < 4; ++j) { const f32x4 v = xr[64 * j]; o8[64 * j] = (unsigned long long)pk2(v[0], v[1]) | ((unsigned long long)pk2(v[2], v[3]) << 32); }
        } else {
#pragma unroll
            for (int j = 0; j < 4; ++j) o8[64 * j] = 0ull;
        }
    }
}

__device__ __forceinline__ int prev_row(int row) {
    if (row < MP) return (row & (SEQ - 1)) ? row - 1 : -1;
    const int s = row - MP; return (s & 3) ? row - 1 : MT + (s >> 2);
}
__device__ __forceinline__ float shifted(const bf16* UB, int row, int prow, int col, float mu) {
    const float ub = bf2f(UB[(size_t)row * BCOLS + col]);
    const float up = prow >= 0 ? bf2f(UB[(size_t)prow * BCOLS + col]) : 0.f;
    return ub + (up - ub) * mu;
}

typedef short bf16x8_t __attribute__((ext_vector_type(8)));
typedef short bf16x4_t __attribute__((ext_vector_type(4)));
typedef float f32x16 __attribute__((ext_vector_type(16)));
#define MFMA32(a, b, c) __builtin_amdgcn_mfma_f32_32x32x16_bf16((a), (b), (c), 0, 0, 0)
__device__ __forceinline__ int crow(int reg, int hh) { return (reg & 3) + 8 * (reg >> 2) + 4 * hh; }
__device__ __forceinline__ bf16x8_t pack8(float a0, float a1, float a2, float a3, float a4, float a5, float a6, float a7) {
    v4u p; p.x = pk2(a0, a1); p.y = pk2(a2, a3); p.z = pk2(a4, a5); p.w = pk2(a6, a7); return __builtin_bit_cast(bf16x8_t, p);
}
constexpr int HC = 64;
constexpr int H_TP = 72;
constexpr int H_KP = 136;
constexpr int H_OP = 132;
struct HPre { float b[16], kd[16], blast, bmid; };
__device__ __forceinline__ void hgrn_pre(const Frame& F, const bf16* UA, int row0, int h, float lbk, LAS float* segsum, HPre& R) {
    const int k = F.tid & 127, seg = F.tid >> 7;
    const bf16* src = UA + (size_t)(row0 + 16 * seg) * ACOLS + 512 + h * 128 + k;
    float run = 0.f;
#pragma unroll
    for (int j = 0; j < 16; ++j) { const float sg = sigmoidf_(bf2f(src[(size_t)j * ACOLS])); R.kd[j] = (1.0f - lbk) * (1.0f - sg); run += __logf(lbk + (1.0f - lbk) * sg); R.b[j] = run; }
    segsum[seg * 128 + k] = run;
    __syncthreads();
    const float s0 = segsum[k], s1 = segsum[128 + k], s2 = segsum[256 + k], s3 = segsum[384 + k];
    const float pre = seg == 0 ? 0.f : (seg == 1 ? s0 : (seg == 2 ? s0 + s1 : s0 + s1 + s2));
#pragma unroll
    for (int j = 0; j < 16; ++j) R.b[j] += pre;
    R.bmid = s0 + s1; R.blast = (s0 + s1) + (s2 + s3);
}
__device__ __forceinline__ void hgrn_load_vt(const Frame& F, const bf16* UA, int row0, int h, LAS bf16* VT) {
    const int v = F.tid & 127, seg = F.tid >> 7;
    const bf16* src = UA + (size_t)(row0 + 16 * seg) * ACOLS + 1024 + h * 128 + v;
    unsigned w[8];
#pragma unroll
    for (int j = 0; j < 8; ++j) w[j] = (unsigned)src[(size_t)(2 * j) * ACOLS] | ((unsigned)src[(size_t)(2 * j + 1) * ACOLS] << 16);
    LAS v4u* d = (LAS v4u*)(VT + v * H_TP + 16 * seg);
    d[0] = (v4u){w[0], w[1], w[2], w[3]}; d[1] = (v4u){w[4], w[5], w[6], w[7]};
}
__device__ __forceinline__ void h1_unit(const Frame& F, const Args& A, int unit) {
    const bf16* UA = (const bf16*)(A.ws + WS_UA);
    bf16* NS = (bf16*)(A.ws + WS_NS) + (size_t)unit * 16384;
    float* gam = (float*)(A.ws + WS_GAMMA) + (size_t)unit * 128;
    const int bh = unit >> 5, c = unit & 31, b = bh >> 2, h = bh & 3, row0 = b * SEQ + c * HC;
    LAS bf16* KhT = (LAS bf16*)F.lds;
    LAS bf16* VT = KhT + 128 * H_TP;
    LAS float* segsum = (LAS float*)(VT + 128 * H_TP);
    const int k = F.tid & 127, seg = F.tid >> 7;
    const float lbk = 1.0f / (1.0f + __expf(A.in[18][512 + h * 128 + k] - A.in[18][h * 128 + k]));
    HPre R; hgrn_pre(F, UA, row0, h, lbk, segsum, R);
    {   unsigned w[8];
#pragma unroll
        for (int j = 0; j < 8; ++j) w[j] = pk2(R.kd[2 * j] * __expf(R.blast - R.b[2 * j]), R.kd[2 * j + 1] * __expf(R.blast - R.b[2 * j + 1]));
        LAS v4u* d = (LAS v4u*)(KhT + k * H_TP + 16 * seg);
        d[0] = (v4u){w[0], w[1], w[2], w[3]}; d[1] = (v4u){w[4], w[5], w[6], w[7]}; }
    if (seg == 0) gam[k] = __expf(R.blast);
    hgrn_load_vt(F, UA, row0, h, VT);
    __syncthreads();
    const int r = F.lane & 31, hh = F.lane >> 5, vt = F.wave >> 1, kt0 = (F.wave & 1) * 2;
    f32x16 acc0, acc1;
#pragma unroll
    for (int i = 0; i < 16; ++i) { acc0[i] = 0.f; acc1[i] = 0.f; }
#pragma unroll
    for (int s = 0; s < 4; ++s) {
        const bf16x8_t a = *(const LAS bf16x8_t*)(VT + (vt * 32 + r) * H_TP + 16 * s + 8 * hh);
        const bf16x8_t b0 = *(const LAS bf16x8_t*)(KhT + (kt0 * 32 + r) * H_TP + 16 * s + 8 * hh);
        const bf16x8_t b1 = *(const LAS bf16x8_t*)(KhT + ((kt0 + 1) * 32 + r) * H_TP + 16 * s + 8 * hh);
        acc0 = MFMA32(a, b0, acc0); acc1 = MFMA32(a, b1, acc1);
    }
#pragma unroll
    for (int i = 0; i < 16; ++i) { const int v = vt * 32 + crow(i, hh);
        NS[v * 128 + kt0 * 32 + r] = (bf16)f2bf(acc0[i]); NS[v * 128 + (kt0 + 1) * 32 + r] = (bf16)f2bf(acc1[i]); }
    __syncthreads();
}
__device__ __forceinline__ void h2_part(const Frame& F, const Args& A, int start, int stride) {
    bf16* NS = (bf16*)(A.ws + WS_NS);
    const float* gam = (const float*)(A.ws + WS_GAMMA);
    for (int e = start; e < 32 * 2048; e += stride) {
        const int bh = e >> 11, vk = e & 2047, v = vk >> 4, k0 = (vk & 15) * 8;
        float S[8];
#pragma unroll
        for (int j = 0; j < 8; ++j) S[j] = 0.f;
        for (int c = 0; c < 32; ++c) {
            v4u* p = (v4u*)(NS + (size_t)(bh * 32 + c) * 16384 + v * 128 + k0);
            const v4u n = *p;
            const f32x4 g0 = *(const f32x4*)(gam + (size_t)(bh * 32 + c) * 128 + k0), g1 = *(const f32x4*)(gam + (size_t)(bh * 32 + c) * 128 + k0 + 4);
            v4u o; o.x = pk2(S[0], S[1]); o.y = pk2(S[2], S[3]); o.z = pk2(S[4], S[5]); o.w = pk2(S[6], S[7]);
            *p = o;
            S[0] = g0[0] * S[0] + bflo(n.x); S[1] = g0[1] * S[1] + bfhi(n.x); S[2] = g0[2] * S[2] + bflo(n.y); S[3] = g0[3] * S[3] + bfhi(n.y);
            S[4] = g1[0] * S[4] + bflo(n.z); S[5] = g1[1] * S[5] + bfhi(n.z); S[6] = g1[2] * S[6] + bflo(n.w); S[7] = g1[3] * S[7] + bfhi(n.w);
        }
        float* so = A.out + O_HGRN_P + (size_t)bh * 16384 + v;
#pragma unroll
        for (int j = 0; j < 8; ++j) so[(size_t)(k0 + j) * 128] = S[j];
    }
}
__device__ __forceinline__ void h3_unit(const Frame& F, const Args& A, int unit) {
    bf16* UA = (bf16*)(A.ws + WS_UA);
    const bf16* NS = (const bf16*)(A.ws + WS_NS) + (size_t)unit * 16384;
    const int bh = unit >> 5, c = unit & 31, b = bh >> 2, h = bh & 3, row0 = b * SEQ + c * HC;
    LAS bf16* Qh = (LAS bf16*)F.lds;
    LAS bf16* Qt = Qh + 64 * H_KP;
    LAS bf16* Kt = Qt + 64 * H_KP;
    LAS bf16* VT = Kt + 64 * H_KP;
    LAS float* segsum = (LAS float*)(VT + 128 * H_TP);
    LAS float* ssq = segsum + 512;
    LAS float* Ost = ssq + 256;
    const int k = F.tid & 127, seg = F.tid >> 7;
    const float lbk = 1.0f / (1.0f + __expf(A.in[18][512 + h * 128 + k] - A.in[18][h * 128 + k]));
    HPre R; hgrn_pre(F, UA, row0, h, lbk, segsum, R);
    {   const bf16* qsrc = UA + (size_t)(row0 + 16 * seg) * ACOLS + h * 128 + k;
#pragma unroll
        for (int j = 0; j < 16; ++j) { const float q = bf2f(qsrc[(size_t)j * ACOLS]); const float qs = q * sigmoidf_(q); const int t = 16 * seg + j;
            Qh[t * H_KP + k] = (bf16)f2bf(qs * __expf(R.b[j]));
            Qt[t * H_KP + k] = (bf16)f2bf(qs * __expf(R.b[j] - R.bmid));
            Kt[t * H_KP + k] = (bf16)f2bf(R.kd[j] * __expf(R.bmid - R.b[j])); } }
    hgrn_load_vt(F, UA, row0, h, VT);
    __syncthreads();
    const int r = F.lane & 31, hh = F.lane >> 5, vt = F.wave >> 1, tt = F.wave & 1;
    f32x16 o;
#pragma unroll
    for (int i = 0; i < 16; ++i) o[i] = 0.f;
#pragma unroll
    for (int st = 0; st < 2; ++st) {
        if (st <= tt) {
            f32x16 at;
#pragma unroll
            for (int i = 0; i < 16; ++i) at[i] = 0.f;
#pragma unroll
            for (int ks = 0; ks < 8; ++ks) {
                const bf16x8_t a = *(const LAS bf16x8_t*)(Kt + (st * 32 + r) * H_KP + 16 * ks + 8 * hh);
                const bf16x8_t bq = *(const LAS bf16x8_t*)(Qt + (tt * 32 + r) * H_KP + 16 * ks + 8 * hh);
                at = MFMA32(a, bq, at);
            }
            if (st == tt) {
#pragma unroll
                for (int i = 0; i < 16; ++i) if (crow(i, hh) > r) at[i] = 0.f;
            }
#pragma unroll
            for (int ks = 0; ks < 2; ++ks) {
                const bf16x4_t lo = *(const LAS bf16x4_t*)(VT + (vt * 32 + r) * H_TP + st * 32 + 16 * ks + 4 * hh);
                const bf16x4_t hi = *(const LAS bf16x4_t*)(VT + (vt * 32 + r) * H_TP + st * 32 + 16 * ks + 8 + 4 * hh);
                const bf16x8_t a = __builtin_shufflevector(lo, hi, 0, 1, 2, 3, 4, 5, 6, 7);
                const bf16x8_t bx = pack8(at[8 * ks], at[8 * ks + 1], at[8 * ks + 2], at[8 * ks + 3], at[8 * ks + 4], at[8 * ks + 5], at[8 * ks + 6], at[8 * ks + 7]);
                o = MFMA32(a, bx, o);
            }
        }
    }
    if (c > 0) {
#pragma unroll
        for (int ks = 0; ks < 8; ++ks) {
            const bf16x8_t a = *(const bf16x8_t*)(NS + (vt * 32 + r) * 128 + 16 * ks + 8 * hh);
            const bf16x8_t bq = *(const LAS bf16x8_t*)(Qh + (tt * 32 + r) * H_KP + 16 * ks + 8 * hh);
            o = MFMA32(a, bq, o);
        }
    }
    {   float s = 0.f;
#pragma unroll
        for (int i = 0; i < 16; ++i) { s += o[i] * o[i]; Ost[(tt * 32 + r) * H_OP + vt * 32 + crow(i, hh)] = o[i]; }
        s += __shfl_xor(s, 32);
        if (hh == 0) ssq[vt * 64 + tt * 32 + r] = s; }
    __syncthreads();
    {   const int t = F.tid >> 3, vg = F.tid & 7, row = row0 + t;
        const float tot = (ssq[t] + ssq[64 + t]) + (ssq[128 + t] + ssq[192 + t]);
        const float rs = rsqrtf(tot * (1.0f / 128.0f) + HGRN_EPS);
        const LAS f32x4* op = (const LAS f32x4*)(Ost + t * H_OP + 16 * vg);
        const v4u* gp = (const v4u*)(UA + (size_t)row * ACOLS + 1536 + h * 128 + 16 * vg);
        const f32x4* nwp = (const f32x4*)(A.in[19] + h * 128 + 16 * vg);
        v4u outw[2];
#pragma unroll
        for (int half = 0; half < 2; ++half) {
            const v4u g = gp[half]; const f32x4 o0 = op[2 * half], o1 = op[2 * half + 1], n0 = nwp[2 * half], n1 = nwp[2 * half + 1];
            const float gg[8] = {bflo(g.x), bfhi(g.x), bflo(g.y), bfhi(g.y), bflo(g.z), bfhi(g.z), bflo(g.w), bfhi(g.w)};
            const float ov[8] = {o0[0] * n0[0], o0[1] * n0[1], o0[2] * n0[2], o0[3] * n0[3], o1[0] * n1[0], o1[1] * n1[1], o1[2] * n1[2], o1[3] * n1[3]};
            float f[8];
#pragma unroll
            for (int e = 0; e < 8; ++e) f[e] = ov[e] * rs * (gg[e] * sigmoidf_(gg[e]));
            outw[half] = (v4u){pk2(f[0], f[1]), pk2(f[2], f[3]), pk2(f[4], f[5]), pk2(f[6], f[7])};
        }
        v4u* dst = (v4u*)(UA + (size_t)row * ACOLS + 1024 + h * 128 + 16 * vg);
        dst[0] = outw[0]; dst[1] = outw[1]; }
    __syncthreads();
}
__device__ __forceinline__ void hgrn_sample_unit(const Frame& F, const Args& A, int bh) {
    bf16* UA = (bf16*)(A.ws + WS_UA);
    const int b = bh >> 2, h = bh & 3, row0 = MP + 4 * b;
    LAS float* vec = (LAS float*)F.lds;
    LAS float* opart = vec + 4 * 384;
    LAS float* red = opart + 2048;
    const int v = F.tid & 127, kq = F.tid >> 7;
    {   const int t = kq, k = v, ch = h * 128 + k;
        const float lbk = 1.0f / (1.0f + __expf(A.in[18][512 + ch] - A.in[18][ch]));
        const float sg = sigmoidf_(bf2f(UA[(size_t)(row0 + t) * ACOLS + 512 + ch])), q = bf2f(UA[(size_t)(row0 + t) * ACOLS + ch]);
        vec[t * 384 + k] = lbk + (1.0f - lbk) * sg; vec[t * 384 + 128 + k] = (1.0f - lbk) * (1.0f - sg); vec[t * 384 + 256 + k] = q * sigmoidf_(q); }
    float iv[4];
#pragma unroll
    for (int t = 0; t < 4; ++t) iv[t] = bf2f(UA[(size_t)(row0 + t) * ACOLS + 1024 + h * 128 + v]);
    const float* sin_ = A.in[2] + (size_t)bh * 16384 + (size_t)(32 * kq) * 128 + v;
    float S[32];
#pragma unroll
    for (int j = 0; j < 32; ++j) S[j] = sin_[(size_t)j * 128];
    __syncthreads();
#pragma unroll
    for (int t = 0; t < 4; ++t) {
        const LAS float* fv = vec + t * 384 + 32 * kq;
        float o = 0.f;
#pragma unroll
        for (int j4 = 0; j4 < 8; ++j4) { const f32x4 f = *(const LAS f32x4*)(fv + 4 * j4), d = *(const LAS f32x4*)(fv + 128 + 4 * j4), q = *(const LAS f32x4*)(fv + 256 + 4 * j4);
#pragma unroll
            for (int e = 0; e < 4; ++e) { S[4 * j4 + e] = f[e] * S[4 * j4 + e] + d[e] * iv[t]; o += S[4 * j4 + e] * q[e]; } }
        opart[(t * 4 + kq) * 128 + v] = o;
    }
    float* sout = A.out + O_HGRN_S + (size_t)bh * 16384 + (size_t)(32 * kq) * 128 + v;
#pragma unroll
    for (int j = 0; j < 32; ++j) sout[(size_t)j * 128] = S[j];
    __syncthreads();
    {   const int t = kq;
        const float o = (opart[(t * 4 + 0) * 128 + v] + opart[(t * 4 + 1) * 128 + v]) + (opart[(t * 4 + 2) * 128 + v] + opart[(t * 4 + 3) * 128 + v]);
        const float ss = wave_sum(o * o);
        if (F.lane == 0) red[F.wave] = ss;
        __syncthreads();
        const float tot = red[F.wave & ~1] + red[F.wave | 1];
        const int ch = h * 128 + v; const size_t row = (size_t)(row0 + t);
        const float g = bf2f(UA[row * ACOLS + 1536 + ch]);
        UA[row * ACOLS + 1024 + ch] = (bf16)f2bf(o * rsqrtf(tot * (1.0f / 128.0f) + HGRN_EPS) * A.in[19][ch] * (g * sigmoidf_(g))); }
    __syncthreads();
}


typedef float f32x4_t __attribute__((ext_vector_type(4)));
#define MFMA16(a, b, c) __builtin_amdgcn_mfma_f32_16x16x32_bf16((a), (b), (c), 0, 0, 0)
constexpr int RC = 32;
constexpr int R_TP = 72;
constexpr int R_CP = 40;
constexpr int RL_A = 0;
constexpr int RL_B = RL_A + 9216;
constexpr int RL_C = RL_B + 16384;
constexpr int RL_D = RL_C + 9216;
constexpr int RL_E = RL_D + 18432;
constexpr int RL_F = RL_E + 20480;
constexpr int RL_UNIT = RL_F + 512;
constexpr int RL_PAR = 2 * RL_UNIT;
static_assert(RL_PAR + 5 * 512 * 4 <= RING_BYTES, "two R1 units + parameters in LDS");
__device__ __forceinline__ float red8(float x) {
    x += __builtin_bit_cast(float, __builtin_amdgcn_update_dpp(0, __builtin_bit_cast(int, x), 0xB1, 0xF, 0xF, true));
    x += __builtin_bit_cast(float, __builtin_amdgcn_update_dpp(0, __builtin_bit_cast(int, x), 0x4E, 0xF, 0xF, true));
    x += __builtin_bit_cast(float, __builtin_amdgcn_update_dpp(0, __builtin_bit_cast(int, x), 0x141, 0xF, 0xF, true));
    return x;
}
__device__ __forceinline__ void unpack8(const v4u w, float (&o)[8]) { o[0] = bflo(w.x); o[1] = bfhi(w.x); o[2] = bflo(w.y); o[3] = bfhi(w.y); o[4] = bflo(w.z); o[5] = bfhi(w.z); o[6] = bflo(w.w); o[7] = bfhi(w.w); }
__device__ __forceinline__ v4u packw8(const float (&f)[8]) { return (v4u){pk2(f[0], f[1]), pk2(f[2], f[3]), pk2(f[4], f[5]), pk2(f[6], f[7])}; }

__device__ __forceinline__ void r1_pass(const Frame& F, const Args& A, int unit, bool active) {
    bf16* UB = (bf16*)(A.ws + WS_UB);
    const bf16* BR = (const bf16*)(A.out + O_HGRN_S);
    const bf16* Wdt = (const bf16*)(A.ws + WS_WDT); const bf16* Wat = (const bf16*)(A.ws + WS_WAT);
    float* bonus = (float*)(A.ws + WS_BONUS);
    const int sub = F.wave >> 2, w4 = F.wave & 3, tid4 = F.tid & 255, r = F.lane & 31, hh = F.lane >> 5;
    LAS unsigned char* L = F.lds + sub * RL_UNIT;
    LAS bf16* AWs = (LAS bf16*)(L + RL_A); LAS bf16* AAs = AWs + 32 * R_TP;
    LAS bf16* Bm = (LAS bf16*)(L + RL_A); LAS bf16* RAm = Bm + 32 * R_CP; LAS bf16* RKm = RAm + 32 * R_CP;
    LAS float* DEC = (LAS float*)(L + RL_B); LAS float* AAo = DEC + 32 * 64;
    LAS float* BVf = (LAS float*)(L + RL_B); LAS float* Af = BVf + 32 * 64;
    LAS float* CUM = (LAS float*)(L + RL_C); LAS float* SEG = CUM + 32 * 64;
    LAS bf16* Kt = (LAS bf16*)(L + RL_D); LAS bf16* Ah = Kt + 32 * R_TP; LAS bf16* Kh = Ah + 32 * R_TP; LAS bf16* Rt = Kh + 32 * R_TP;
    LAS bf16* KbT = (LAS bf16*)(L + RL_D); LAS bf16* VbT = KbT + 64 * R_CP;
    LAS bf16* KtT = (LAS bf16*)(L + RL_E); LAS bf16* AcT = KtT + 64 * R_CP; LAS bf16* KcT = AcT + 64 * R_CP; LAS bf16* VT = KcT + 64 * R_CP;
    LAS float* GC = (LAS float*)(L + RL_F); LAS float* CL = GC + 64;
    const LAS float* PAR = (const LAS float*)(F.lds + RL_PAR);
    const int b = unit >> 9, h = (unit >> 6) & 7, c = unit & 63, row0 = b * SEQ + c * RC;
    unsigned char* mn = (unsigned char*)A.out + (size_t)unit * 16384;
    const int t = tid4 >> 3, jg = tid4 & 7, row = row0 + t;
    float xr[8], xk[8], xv[8];
    if (active) {
        const float* mu = A.in[7];
        const int cols[5] = {h * 64 + 8 * jg, 512 + h * 64 + 8 * jg, 1024 + h * 64 + 8 * jg, 1536 + 8 * jg, 1600 + 8 * jg};
        float x5[5][8];
#pragma unroll
        for (int q = 0; q < 5; ++q) {
            float cur[8], prv[8];
            unpack8(*(const v4u*)(UB + (size_t)row * BCOLS + cols[q]), cur);
            v4u pw = (v4u){0, 0, 0, 0};
            if (t > 0 || q >= 3) { if (t > 0 || c > 0) pw = *(const v4u*)(UB + (size_t)(row - 1) * BCOLS + cols[q]); }
            else if (c > 0) pw = *(const v4u*)(BR + (size_t)(b * 64 + c - 1) * 1536 + cols[q]);
            unpack8(pw, prv);
            const f32x4 m0 = *(const f32x4*)(mu + cols[q]), m1 = *(const f32x4*)(mu + cols[q] + 4);
#pragma unroll
            for (int e = 0; e < 8; ++e) x5[q][e] = cur[e] + (prv[e] - cur[e]) * (e < 4 ? m0[e] : m1[e - 4]);
        }
#pragma unroll
        for (int e = 0; e < 8; ++e) { xr[e] = x5[0][e]; xk[e] = x5[1][e]; xv[e] = x5[2][e]; x5[3][e] = tanhf_(x5[3][e]); }
        *(LAS v4u*)(AWs + t * R_TP + 8 * jg) = packw8(x5[3]);
        *(LAS v4u*)(AAs + t * R_TP + 8 * jg) = packw8(x5[4]);
    }
    __syncthreads();
    if (active) {
        const int which = w4 >> 1, jt = w4 & 1;
        const LAS bf16* As = which ? AAs : AWs; const bf16* Wt = (which ? Wat : Wdt) + (size_t)(h * 64 + jt * 32 + r) * 64;
        f32x16 acc;
#pragma unroll
        for (int i = 0; i < 16; ++i) acc[i] = 0.f;
#pragma unroll
        for (int s = 0; s < 4; ++s) acc = MFMA32(*(const LAS bf16x8_t*)(As + r * R_TP + 16 * s + 8 * hh), *(const bf16x8_t*)(Wt + 16 * s + 8 * hh), acc);
        LAS float* O = which ? AAo : DEC;
#pragma unroll
        for (int i = 0; i < 16; ++i) O[crow(i, hh) * 64 + jt * 32 + r] = acc[i];
    }
    __syncthreads();
    float lw[8], kk[8], al[8], k2[8];
    if (active) {
        const int ch = h * 64 + 8 * jg;
        float dec[8], aa[8];
        { const f32x4 d0 = *(const LAS f32x4*)(DEC + t * 64 + 8 * jg), d1 = *(const LAS f32x4*)(DEC + t * 64 + 8 * jg + 4), a0 = *(const LAS f32x4*)(AAo + t * 64 + 8 * jg), a1 = *(const LAS f32x4*)(AAo + t * 64 + 8 * jg + 4);
#pragma unroll
          for (int e = 0; e < 4; ++e) { dec[e] = d0[e]; dec[4 + e] = d1[e]; aa[e] = a0[e]; aa[4 + e] = a1[e]; } }
        float n2 = 0.f, bs = 0.f, kp[8], av[8];
#pragma unroll
        for (int e = 0; e < 8; ++e) {
            lw[e] = -DECAY_SCALE * sigmoidf_(PAR[ch + e] + dec[e]);
            av[e] = sigmoidf_(PAR[512 + ch + e] + aa[e]);
            kp[e] = xk[e] * PAR[1024 + ch + e]; n2 += kp[e] * kp[e];
            k2[e] = xk[e] * (1.0f + (av[e] - 1.0f) * PAR[1536 + ch + e]);
            bs += xr[e] * k2[e] * PAR[2048 + ch + e];
        }
        n2 = red8(n2); bs = red8(bs);
        const float inv = 1.0f / fmaxf(sqrtf(n2), 1e-12f);
#pragma unroll
        for (int e = 0; e < 8; ++e) { kk[e] = kp[e] * inv; al[e] = kk[e] * av[e]; }
        if (jg == 0) bonus[(size_t)row * 8 + h] = bs;
        *(LAS f32x4*)(CUM + t * 64 + 8 * jg) = (f32x4){lw[0], lw[1], lw[2], lw[3]};
        *(LAS f32x4*)(CUM + t * 64 + 8 * jg + 4) = (f32x4){lw[4], lw[5], lw[6], lw[7]};
    }
    __syncthreads();
    {
        const int j = tid4 & 63, seg = tid4 >> 6;
        float v8[8], run = 0.f;
        if (active) {
#pragma unroll
            for (int e = 0; e < 8; ++e) { run += CUM[(8 * seg + e) * 64 + j]; v8[e] = run; }
            SEG[seg * 64 + j] = run;
        }
        __syncthreads();
        if (active) {
            const float s0 = SEG[j], s1 = SEG[64 + j], s2 = SEG[128 + j], s3 = SEG[192 + j];
            const float pre = seg == 0 ? 0.f : (seg == 1 ? s0 : (seg == 2 ? s0 + s1 : s0 + s1 + s2));
#pragma unroll
            for (int e = 0; e < 8; ++e) CUM[(8 * seg + e) * 64 + j] = v8[e] + pre;
            if (seg == 0) { const float tot = (s0 + s1) + (s2 + s3); CL[j] = tot; GC[j] = __expf(tot); }
        }
    }
    __syncthreads();
    if (active) {
        float cum[8], cl[8];
        { const f32x4 c0 = *(const LAS f32x4*)(CUM + t * 64 + 8 * jg), c1 = *(const LAS f32x4*)(CUM + t * 64 + 8 * jg + 4), l0 = *(const LAS f32x4*)(CL + 8 * jg), l1 = *(const LAS f32x4*)(CL + 8 * jg + 4);
#pragma unroll
          for (int e = 0; e < 4; ++e) { cum[e] = c0[e]; cum[4 + e] = c1[e]; cl[e] = l0[e]; cl[4 + e] = l1[e]; } }
        float fKt[8], fAh[8], fKh[8], fRt[8];
#pragma unroll
        for (int e = 0; e < 8; ++e) {
            const float gt = __expf(cum[e]), gm1 = __expf(cum[e] - lw[e]), gi = __expf(-cum[e]), gc = __expf(cl[e] - cum[e]);
            fKt[e] = kk[e] * gm1; fAh[e] = al[e] * gi; fKh[e] = k2[e] * gi; fRt[e] = xr[e] * gt;
            const int j = 8 * jg + e;
            KtT[j * R_CP + t] = (bf16)f2bf(fKt[e]); AcT[j * R_CP + t] = (bf16)f2bf(al[e] * gc); KcT[j * R_CP + t] = (bf16)f2bf(k2[e] * gc); VT[j * R_CP + t] = (bf16)f2bf(xv[e]);
        }
        *(LAS v4u*)(Kt + t * R_TP + 8 * jg) = packw8(fKt); *(LAS v4u*)(Ah + t * R_TP + 8 * jg) = packw8(fAh);
        *(LAS v4u*)(Kh + t * R_TP + 8 * jg) = packw8(fKh); *(LAS v4u*)(Rt + t * R_TP + 8 * jg) = packw8(fRt);
        *(v4u*)(UB + (size_t)row * BCOLS + 1024 + h * 64 + 8 * jg) = packw8(xv);
    }
    __syncthreads();
    LAS bf16* BVT = (LAS bf16*)(L + RL_B);
    LAS bf16* QA = BVT + 64 * R_CP; LAS bf16* QT = QA + 32 * R_CP; LAS bf16* PP = QT + 32 * R_CP; LAS bf16* TT = PP + 32 * R_CP;
    f32x16 pacc;
    if (active) {
        const LAS bf16* Ls = (w4 < 2) ? Kt : Rt; const LAS bf16* Rs = (w4 & 1) ? Kh : Ah;
        f32x16 acc;
#pragma unroll
        for (int i = 0; i < 16; ++i) acc[i] = 0.f;
#pragma unroll
        for (int s = 0; s < 4; ++s) acc = MFMA32(*(const LAS bf16x8_t*)(Ls + r * R_TP + 16 * s + 8 * hh), *(const LAS bf16x8_t*)(Rs + r * R_TP + 16 * s + 8 * hh), acc);
#pragma unroll
        for (int i = 0; i < 16; ++i) { const int tt = crow(i, hh); const bool keep = (w4 < 2) ? (r < tt) : (r <= tt); acc[i] = keep ? acc[i] : 0.f; }
        if (w4 == 0) {
#pragma unroll
            for (int i = 0; i < 16; ++i) { const int tt = crow(i, hh); pacc[i] = (tt == r ? 1.0f : 0.0f) - acc[i]; QA[tt * R_CP + r] = (bf16)f2bf(acc[i]); PP[tt * R_CP + r] = (bf16)f2bf(pacc[i]); }
#pragma unroll
            for (int g = 0; g < 4; ++g) { v2u w; w.x = pk2(acc[4 * g], acc[4 * g + 1]); w.y = pk2(acc[4 * g + 2], acc[4 * g + 3]); *(LAS v2u*)(QT + r * R_CP + 8 * g + 4 * hh) = w; }
        } else {
            LAS bf16* O = w4 == 1 ? Bm : (w4 == 2 ? RAm : RKm);
#pragma unroll
            for (int i = 0; i < 16; ++i) O[crow(i, hh) * R_CP + r] = (bf16)f2bf(acc[i]);
        }
    }
    __syncthreads();
    if (active && w4 == 0) {
#pragma unroll
        for (int st = 0; st < 5; ++st) {
            asm volatile("s_waitcnt lgkmcnt(0)" ::: "memory");
            const bf16x8_t qt0 = *(const LAS bf16x8_t*)(QT + r * R_CP + 8 * hh), qt1 = *(const LAS bf16x8_t*)(QT + r * R_CP + 16 + 8 * hh);
            if (st > 0) { const bf16x8_t p0 = *(const LAS bf16x8_t*)(PP + r * R_CP + 8 * hh), p1 = *(const LAS bf16x8_t*)(PP + r * R_CP + 16 + 8 * hh);
                pacc = MFMA32(p0, qt0, pacc); pacc = MFMA32(p1, qt1, pacc); }
            if (st < 4) {
                const bf16x8_t q0 = *(const LAS bf16x8_t*)(QA + r * R_CP + 8 * hh), q1 = *(const LAS bf16x8_t*)(QA + r * R_CP + 16 + 8 * hh);
                f32x16 qacc;
#pragma unroll
                for (int i = 0; i < 16; ++i) qacc[i] = 0.f;
                qacc = MFMA32(q0, qt0, qacc); qacc = MFMA32(q1, qt1, qacc);
#pragma unroll
                for (int i = 0; i < 16; ++i) QA[crow(i, hh) * R_CP + r] = (bf16)f2bf(qacc[i]);
#pragma unroll
                for (int g = 0; g < 4; ++g) { v2u w; w.x = pk2(qacc[4 * g], qacc[4 * g + 1]); w.y = pk2(qacc[4 * g + 2], qacc[4 * g + 3]); *(LAS v2u*)(QT + r * R_CP + 8 * g + 4 * hh) = w; }
            }
            if (st > 0 && st < 4) {
#pragma unroll
                for (int i = 0; i < 16; ++i) PP[crow(i, hh) * R_CP + r] = (bf16)f2bf(pacc[i]);
            }
        }
#pragma unroll
        for (int i = 0; i < 16; ++i) TT[crow(i, hh) * R_CP + r] = (bf16)f2bf(pacc[i]);
    }
    if (active && (w4 == 1 || w4 == 2)) {
        const int it = w4 - 1;
        f32x16 acc;
#pragma unroll
        for (int i = 0; i < 16; ++i) acc[i] = 0.f;
#pragma unroll
        for (int s = 0; s < 2; ++s) acc = MFMA32(*(const LAS bf16x8_t*)(Bm + r * R_CP + 16 * s + 8 * hh), *(const LAS bf16x8_t*)(VT + (it * 32 + r) * R_CP + 16 * s + 8 * hh), acc);
#pragma unroll
        for (int g = 0; g < 4; ++g) { v2u w; w.x = pk2(acc[4 * g], acc[4 * g + 1]); w.y = pk2(acc[4 * g + 2], acc[4 * g + 3]); *(LAS v2u*)(BVT + (it * 32 + r) * R_CP + 8 * g + 4 * hh) = w; }
    }
    __syncthreads();
    if (active) {
        const LAS bf16* Asrc = (w4 < 2 ? KtT : BVT) + ((w4 & 1) * 32 + r) * R_CP;
        f32x16 acc;
#pragma unroll
        for (int i = 0; i < 16; ++i) acc[i] = 0.f;
#pragma unroll
        for (int s = 0; s < 2; ++s) acc = MFMA32(*(const LAS bf16x8_t*)(Asrc + 16 * s + 8 * hh), *(const LAS bf16x8_t*)(TT + r * R_CP + 16 * s + 8 * hh), acc);
        LAS bf16* O = (w4 < 2 ? KbT : VbT) + (w4 & 1) * 32 * R_CP;
#pragma unroll
        for (int i = 0; i < 16; ++i) O[crow(i, hh) * R_CP + r] = (bf16)f2bf(-acc[i]);
    }
    __syncthreads();
    if (active) {
        const int jt = w4 >> 1, ct = w4 & 1;
        f32x16 am, an;
#pragma unroll
        for (int i = 0; i < 16; ++i) { am[i] = 0.f; an[i] = 0.f; }
#pragma unroll
        for (int s = 0; s < 2; ++s) {
            const bf16x8_t a_ac = *(const LAS bf16x8_t*)(AcT + (jt * 32 + r) * R_CP + 16 * s + 8 * hh), a_kc = *(const LAS bf16x8_t*)(KcT + (jt * 32 + r) * R_CP + 16 * s + 8 * hh);
            am = MFMA32(a_ac, *(const LAS bf16x8_t*)(KbT + (ct * 32 + r) * R_CP + 16 * s + 8 * hh), am);
            an = MFMA32(a_kc, *(const LAS bf16x8_t*)(VT + (ct * 32 + r) * R_CP + 16 * s + 8 * hh), an);
            an = MFMA32(a_ac, *(const LAS bf16x8_t*)(VbT + (ct * 32 + r) * R_CP + 16 * s + 8 * hh), an);
        }
        LAS bf16* Mp = (LAS bf16*)(L + RL_B); LAS bf16* Np = Mp + 4096;
        LAS bf16* RYs = (LAS bf16*)(L + RL_C);
        const int cj = ct * 32 + r;
#pragma unroll
        for (int i = 0; i < 16; ++i) {
            const int j = jt * 32 + crow(i, hh);
            float mv = am[i]; if (j == cj) mv += GC[j];
            const int s2 = cj >> 5, rem = cj & 31, e = 4 * (rem >> 4) + (rem & 3), q = (rem >> 2) & 3;
            Mp[j * 64 + s2 * 32 + q * 8 + e] = (bf16)f2bf(mv);
            Np[cj * 64 + ((j >> 2) & 3) * 16 + (j >> 4) * 4 + (j & 3)] = (bf16)f2bf(an[i]);
        }
        f32x16 ay;
        if (w4 < 2) {
#pragma unroll
            for (int i = 0; i < 16; ++i) ay[i] = bf2f(Rt[crow(i, hh) * R_TP + w4 * 32 + r]);
#pragma unroll
            for (int s = 0; s < 2; ++s) ay = MFMA32(*(const LAS bf16x8_t*)(RAm + r * R_CP + 16 * s + 8 * hh), *(const LAS bf16x8_t*)(KbT + (w4 * 32 + r) * R_CP + 16 * s + 8 * hh), ay);
#pragma unroll
            for (int i = 0; i < 16; ++i) RYs[crow(i, hh) * 64 + w4 * 32 + r] = (bf16)f2bf(ay[i]);
        } else {
            const int it = w4 - 2;
#pragma unroll
            for (int i = 0; i < 16; ++i) ay[i] = 0.f;
#pragma unroll
            for (int s = 0; s < 2; ++s) {
                ay = MFMA32(*(const LAS bf16x8_t*)(RKm + r * R_CP + 16 * s + 8 * hh), *(const LAS bf16x8_t*)(VT + (it * 32 + r) * R_CP + 16 * s + 8 * hh), ay);
                ay = MFMA32(*(const LAS bf16x8_t*)(RAm + r * R_CP + 16 * s + 8 * hh), *(const LAS bf16x8_t*)(VbT + (it * 32 + r) * R_CP + 16 * s + 8 * hh), ay);
            }
#pragma unroll
            for (int i = 0; i < 16; ++i) RYs[2048 + crow(i, hh) * 64 + it * 32 + r] = (bf16)f2bf(ay[i]);
        }
    }
    __syncthreads();
    if (active) {
        const LAS v4u* src = (const LAS v4u*)(L + RL_B);
#pragma unroll
        for (int q = 0; q < 4; ++q) ((v4u*)mn)[tid4 + 256 * q] = src[tid4 + 256 * q];
        const LAS v4u* ry = (const LAS v4u*)(L + RL_C);
        const int tr = tid4 >> 3, pc = tid4 & 7;
        *(v4u*)(UB + (size_t)(row0 + tr) * BCOLS + h * 64 + 8 * pc) = ry[tr * 8 + pc];
        *(v4u*)(UB + (size_t)(row0 + tr) * BCOLS + 512 + h * 64 + 8 * pc) = ry[256 + tr * 8 + pc];
    }
    __syncthreads();
}

__device__ __forceinline__ void r2_wave(const Frame& F, const Args& A, int bh, int wq) {
    const int m = F.lane & 15, q = F.lane >> 4, i = 16 * wq + m;
    f32x4_t acc[4];
#pragma unroll
    for (int jt = 0; jt < 4; ++jt) acc[jt] = (f32x4_t){0.f, 0.f, 0.f, 0.f};
    unsigned char* base = (unsigned char*)A.out + (size_t)bh * 64 * 16384;
    v4u Mf[4][2], Nf[2];
    auto load = [&](int c) {
        const unsigned char* u = base + (size_t)c * 16384;
#pragma unroll
        for (int jt = 0; jt < 4; ++jt)
#pragma unroll
            for (int s2 = 0; s2 < 2; ++s2) Mf[jt][s2] = *(const v4u*)(u + ((16 * jt + m) * 64 + s2 * 32 + q * 8) * 2);
        Nf[0] = *(const v4u*)(u + 8192 + (i * 64 + q * 16) * 2); Nf[1] = *(const v4u*)(u + 8192 + (i * 64 + q * 16 + 8) * 2);
    };
    load(0);
    for (int c = 0; c < 64; ++c) {
        asm volatile("s_waitcnt vmcnt(0)" ::: "memory");
        v4u Mc[4][2]; float nf[16];
#pragma unroll
        for (int jt = 0; jt < 4; ++jt) { Mc[jt][0] = Mf[jt][0]; Mc[jt][1] = Mf[jt][1]; }
        { float t8[8]; unpack8(Nf[0], t8);
#pragma unroll
          for (int e = 0; e < 8; ++e) nf[e] = t8[e];
          unpack8(Nf[1], t8);
#pragma unroll
          for (int e = 0; e < 8; ++e) nf[8 + e] = t8[e]; }
        { unsigned char* u = base + (size_t)c * 16384 + 8192;
#pragma unroll
          for (int jt = 0; jt < 4; ++jt) { v2u w; w.x = pk2(acc[jt][0], acc[jt][1]); w.y = pk2(acc[jt][2], acc[jt][3]); *(v2u*)(u + (i * 64 + 16 * jt + 4 * q) * 2) = w; } }
        if (c + 1 < 64) load(c + 1);
        const bf16x8_t b0 = pack8(acc[0][0], acc[0][1], acc[0][2], acc[0][3], acc[1][0], acc[1][1], acc[1][2], acc[1][3]);
        const bf16x8_t b1 = pack8(acc[2][0], acc[2][1], acc[2][2], acc[2][3], acc[3][0], acc[3][1], acc[3][2], acc[3][3]);
#pragma unroll
        for (int jt = 0; jt < 4; ++jt) {
            f32x4_t n = (f32x4_t){nf[4 * jt], nf[4 * jt + 1], nf[4 * jt + 2], nf[4 * jt + 3]};
            n = MFMA16(__builtin_bit_cast(bf16x8_t, Mc[jt][0]), b0, n);
            n = MFMA16(__builtin_bit_cast(bf16x8_t, Mc[jt][1]), b1, n);
            acc[jt] = n;
        }
    }
    float* so = A.out + O_WKV_P + (size_t)bh * 4096 + i * 64;
#pragma unroll
    for (int jt = 0; jt < 4; ++jt) *(f32x4*)(so + 16 * jt + 4 * q) = (f32x4){acc[jt][0], acc[jt][1], acc[jt][2], acc[jt][3]};
}

__device__ __forceinline__ void r3_unit(const Frame& F, const Args& A, int unit) {
    bf16* UB = (bf16*)(A.ws + WS_UB);
    const bf16* Wgt = (const bf16*)(A.ws + WS_WGT);
    const float* bonus = (const float*)(A.ws + WS_BONUS);
    const int b = unit >> 9, h = (unit >> 6) & 7, c = unit & 63, row0 = b * SEQ + c * RC;
    const bf16* Sc = (const bf16*)((const unsigned char*)A.out + (size_t)unit * 16384 + 8192);
    const int r = F.lane & 31, hh = F.lane >> 5, row = row0 + r;
    f32x16 y0, y1, g0, g1;
#pragma unroll
    for (int i = 0; i < 16; ++i) { y0[i] = 0.f; y1[i] = 0.f; g0[i] = 0.f; g1[i] = 0.f; }
    if (c > 0) {
#pragma unroll
        for (int s = 0; s < 4; ++s) {
            const bf16x8_t bq = *(const bf16x8_t*)(UB + (size_t)row * BCOLS + h * 64 + 16 * s + 8 * hh);
            y0 = MFMA32(*(const bf16x8_t*)(Sc + r * 64 + 16 * s + 8 * hh), bq, y0);
            y1 = MFMA32(*(const bf16x8_t*)(Sc + (32 + r) * 64 + 16 * s + 8 * hh), bq, y1);
        }
    }
    {   const float* mu = A.in[7] + 1664;
        const bool hasprev = (r > 0) || (c > 0);
#pragma unroll
        for (int s = 0; s < 8; ++s) {
            float cur[8], prv[8];
            unpack8(*(const v4u*)(UB + (size_t)row * BCOLS + 1664 + 16 * s + 8 * hh), cur);
            v4u pw = (v4u){0, 0, 0, 0}; if (hasprev) pw = *(const v4u*)(UB + (size_t)(row - 1) * BCOLS + 1664 + 16 * s + 8 * hh);
            unpack8(pw, prv);
            const f32x4 m0 = *(const f32x4*)(mu + 16 * s + 8 * hh), m1 = *(const f32x4*)(mu + 16 * s + 8 * hh + 4);
            float sg[8];
#pragma unroll
            for (int e = 0; e < 8; ++e) sg[e] = sigmoidf_(cur[e] + (prv[e] - cur[e]) * (e < 4 ? m0[e] : m1[e - 4]));
            const bf16x8_t bq = __builtin_bit_cast(bf16x8_t, packw8(sg));
            g0 = MFMA32(*(const bf16x8_t*)(Wgt + (size_t)(h * 64 + r) * 128 + 16 * s + 8 * hh), bq, g0);
            g1 = MFMA32(*(const bf16x8_t*)(Wgt + (size_t)(h * 64 + 32 + r) * 128 + 16 * s + 8 * hh), bq, g1);
        } }
    float yv[32]; float sum = 0.f;
#pragma unroll
    for (int it = 0; it < 2; ++it)
#pragma unroll
        for (int gq = 0; gq < 4; ++gq) {
            const v2u w = *(const v2u*)(UB + (size_t)row * BCOLS + 512 + h * 64 + 32 * it + 8 * gq + 4 * hh);
            const float yb[4] = {bflo(w.x), bfhi(w.x), bflo(w.y), bfhi(w.y)};
#pragma unroll
            for (int e = 0; e < 4; ++e) { const float v = (it ? y1[4 * gq + e] : y0[4 * gq + e]) + yb[e]; yv[16 * it + 4 * gq + e] = v; sum += v; }
        }
    sum += __shfl_xor(sum, 32);
    const float mean = sum * (1.0f / 64.0f);
    float var = 0.f;
#pragma unroll
    for (int x = 0; x < 32; ++x) { yv[x] -= mean; var += yv[x] * yv[x]; }
    var += __shfl_xor(var, 32);
    const float rs = rsqrtf(var * (1.0f / 64.0f) + GN_EPS), bn = bonus[(size_t)row * 8 + h];
#pragma unroll
    for (int it = 0; it < 2; ++it)
#pragma unroll
        for (int gq = 0; gq < 4; ++gq) {
            const int i0 = 32 * it + 8 * gq + 4 * hh, ch = h * 64 + i0;
            const v2u vw = *(const v2u*)(UB + (size_t)row * BCOLS + 1024 + ch);
            const float vv[4] = {bflo(vw.x), bfhi(vw.x), bflo(vw.y), bfhi(vw.y)};
            const f32x4 lw = *(const f32x4*)(A.in[16] + ch), lb = *(const f32x4*)(A.in[17] + ch);
            float o[4];
#pragma unroll
            for (int e = 0; e < 4; ++e) { const float gg = it ? g1[4 * gq + e] : g0[4 * gq + e]; o[e] = (yv[16 * it + 4 * gq + e] * rs * lw[e] + lb[e] + bn * vv[e]) * gg; }
            v2u ow; ow.x = pk2(o[0], o[1]); ow.y = pk2(o[2], o[3]);
            *(v2u*)(UB + (size_t)row * BCOLS + 512 + ch) = ow;
        }
}

__device__ __forceinline__ float rdl(float x, int k) { return __builtin_bit_cast(float, __builtin_amdgcn_readlane(__builtin_bit_cast(int, x), k)); }
__device__ __forceinline__ void rwkv_sample_wave(const Frame& F, const Args& A, int bh, LAS float* wl) {
    bf16* UB = (bf16*)(A.ws + WS_UB);
    const int b = bh >> 3, h = bh & 7, row0 = MP + 4 * b, l = F.lane, ch = h * 64 + l;
    const float* mu = A.in[7];
    float xr[4], xk[4], xv[4], tw[4], ad[4], sg0[4], sg1[4];
#pragma unroll
    for (int t = 0; t < 4; ++t) {
        const int row = row0 + t, prow = t ? row - 1 : MT + b;
        xr[t] = shifted(UB, row, prow, ch, mu[ch]); xk[t] = shifted(UB, row, prow, 512 + ch, mu[512 + ch]); xv[t] = shifted(UB, row, prow, 1024 + ch, mu[1024 + ch]);
        tw[t] = tanhf_(shifted(UB, row, prow, 1536 + l, mu[1536 + l])); ad[t] = shifted(UB, row, prow, 1600 + l, mu[1600 + l]);
        sg0[t] = sigmoidf_(shifted(UB, row, prow, 1664 + l, mu[1664 + l])); sg1[t] = sigmoidf_(shifted(UB, row, prow, 1728 + l, mu[1728 + l]));
    }
    float dec[4] = {0.f, 0.f, 0.f, 0.f}, aa[4] = {0.f, 0.f, 0.f, 0.f}, g[4] = {0.f, 0.f, 0.f, 0.f};
    {   const float* pd = A.in[9] + ch; const float* pa = A.in[11] + ch; const float* pg = A.in[12] + ch;
#pragma unroll 4
        for (int k = 0; k < 64; ++k) {
            const float wd = pd[0], wa = pa[0], wg0 = pg[0], wg1 = pg[64 * BW];
            pd += BW; pa += BW; pg += BW;
#pragma unroll
            for (int t = 0; t < 4; ++t) {
                dec[t] += rdl(tw[t], k) * wd; aa[t] += rdl(ad[t], k) * wa; g[t] += rdl(sg0[t], k) * wg0 + rdl(sg1[t], k) * wg1;
            }
        } }
    const float w0 = A.in[8][ch], a0 = A.in[10][ch], kkc = A.in[13][ch], kac = A.in[14][ch], rkc = A.in[15][ch];
    float bon[4];
#pragma unroll
    for (int t = 0; t < 4; ++t) {
        const float w = __expf(-DECAY_SCALE * sigmoidf_(w0 + dec[t])), a = sigmoidf_(a0 + aa[t]);
        const float kp = xk[t] * kkc, kk = kp / fmaxf(sqrtf(wave_sum(kp * kp)), 1e-12f), k2 = xk[t] * (1.0f + (a - 1.0f) * kac);
        bon[t] = wave_sum(xr[t] * k2 * rkc);
        LAS float* v = wl + t * 384;
        v[l] = w; v[64 + l] = kk; v[128 + l] = kk * a; v[192 + l] = k2; v[256 + l] = xr[t];
    }
    asm volatile("s_waitcnt lgkmcnt(0)" ::: "memory");
    float S[64];
    const float* sin_ = A.in[3] + (size_t)bh * 4096 + l * 64;
#pragma unroll
    for (int j4 = 0; j4 < 16; ++j4) { const f32x4 s = *(const f32x4*)(sin_ + 4 * j4); S[4 * j4] = s[0]; S[4 * j4 + 1] = s[1]; S[4 * j4 + 2] = s[2]; S[4 * j4 + 3] = s[3]; }
#pragma unroll
    for (int t = 0; t < 4; ++t) {
        const LAS float* v = wl + t * 384;
        float sk = 0.f;
#pragma unroll
        for (int j4 = 0; j4 < 16; ++j4) { const f32x4 k4 = *(const LAS f32x4*)(v + 64 + 4 * j4); sk += (S[4 * j4] * k4[0] + S[4 * j4 + 1] * k4[1]) + (S[4 * j4 + 2] * k4[2] + S[4 * j4 + 3] * k4[3]);
            if ((j4 & 3) == 3) asm volatile("" : "+v"(v), "+v"(sk)); }
        float y = 0.f;
#pragma unroll
        for (int j4 = 0; j4 < 16; ++j4) {
            const f32x4 w4 = *(const LAS f32x4*)(v + 4 * j4), ka = *(const LAS f32x4*)(v + 128 + 4 * j4), k4 = *(const LAS f32x4*)(v + 192 + 4 * j4), r4 = *(const LAS f32x4*)(v + 256 + 4 * j4);
#pragma unroll
            for (int e = 0; e < 4; ++e) { const float s = S[4 * j4 + e] * w4[e] - sk * ka[e] + xv[t] * k4[e]; S[4 * j4 + e] = s; y += s * r4[e]; }
            if (j4 & 1) asm volatile("" : "+v"(v), "+v"(y));
        }
        const float mean = wave_sum(y) * (1.0f / 64.0f), d = y - mean, var = wave_sum(d * d) * (1.0f / 64.0f);
        const float yn = d * rsqrtf(var + GN_EPS) * A.in[16][ch] + A.in[17][ch];
        UB[(size_t)(row0 + t) * BCOLS + 512 + ch] = (bf16)f2bf((yn + bon[t] * xv[t]) * g[t]);
    }
    float* so = A.out + O_WKV_S + (size_t)bh * 4096 + l * 64;
#pragma unroll
    for (int j4 = 0; j4 < 16; ++j4) *(f32x4*)(so + 4 * j4) = (f32x4){S[4 * j4], S[4 * j4 + 1], S[4 * j4 + 2], S[4 * j4 + 3]};
    asm volatile("s_waitcnt lgkmcnt(0)" ::: "memory");
}

__device__ __forceinline__ void p3_seq(const Frame& F, const Args& A) {
    if (F.wave == 0) { for (int u = F.vcu; u < 256; u += F.G) r2_wave(F, A, u >> 2, u & 3); }
    else {
        const int wk = F.vcu * 7 + F.wave - 1, NW = F.G * 7;
        h2_part(F, A, wk * 64 + F.lane, NW * 64);
        LAS float* wl = (LAS float*)F.lds + F.wave * 1536;
        for (int bh = wk; bh < 1024; bh += NW) rwkv_sample_wave(F, A, bh, wl);
    }
}


constexpr int SK_P = 72, SK_BUF = (64 + 128) * SK_P;
template <bool SSQ> __device__ __forceinline__ void sk_gemm(const Frame& F, f32x16& acc, const bf16* Ag, int lda, const bf16* Bg, int ldb, int K, float& ssq) {
    LAS bf16* L = (LAS bf16*)F.lds;
    const int prow = F.tid >> 3, c8 = F.tid & 7, r = F.lane & 31, hh = F.lane >> 5, wm = F.wave >> 2, wn = F.wave & 3;
    const bf16* ap = Ag + (size_t)prow * lda + 8 * c8; const bf16* bp0 = Bg + (size_t)prow * ldb + 8 * c8; const bf16* bp1 = bp0 + (size_t)64 * ldb;
    v4u ra = *(const v4u*)ap, rb0 = *(const v4u*)bp0, rb1 = *(const v4u*)bp1;
    const int nk = K / 64;
    __syncthreads();
    for (int it = 0; it < nk; ++it) {
        LAS bf16* B_ = L + (it & 1) * SK_BUF;
        *(LAS v4u*)(B_ + prow * SK_P + 8 * c8) = ra; *(LAS v4u*)(B_ + (64 + prow) * SK_P + 8 * c8) = rb0; *(LAS v4u*)(B_ + (128 + prow) * SK_P + 8 * c8) = rb1;
        if (SSQ) { float f8[8]; unpack8(ra, f8);
#pragma unroll
            for (int e = 0; e < 8; ++e) ssq += f8[e] * f8[e]; }
        __syncthreads();
        if (it + 1 < nk) { const int k = (it + 1) * 64; ra = *(const v4u*)(ap + k); rb0 = *(const v4u*)(bp0 + k); rb1 = *(const v4u*)(bp1 + k); }
#pragma unroll
        for (int s = 0; s < 4; ++s)
            acc = MFMA32(*(const LAS bf16x8_t*)(B_ + (32 * wm + r) * SK_P + 16 * s + 8 * hh), *(const LAS bf16x8_t*)(B_ + (64 + 32 * wn + r) * SK_P + 16 * s + 8 * hh), acc);
    }
}
template <int WHICH> __device__ __forceinline__ void skinny_unit(const Frame& F, const Args& A, int mt, int nt, int ks) {
    unsigned char* ws = A.ws;
    bf16* UA = (bf16*)(ws + WS_UA); bf16* UB = (bf16*)(ws + WS_UB); const bf16* UG = (const bf16*)(ws + WS_UG);
    const int wm = F.wave >> 2, wn = F.wave & 3, r = F.lane & 31, hh = F.lane >> 5;
    const int mb = MP + 64 * mt, m0 = mb + 32 * wm, nb = 128 * nt, n = nb + 32 * wn + r;
    f32x16 acc;
#pragma unroll
    for (int i = 0; i < 16; ++i) acc[i] = 0.f;
    float ssq = 0.f;
    if (WHICH == 0) {
        f32x16 accb;
#pragma unroll
        for (int i = 0; i < 16; ++i) accb[i] = 0.f;
        sk_gemm<false>(F, acc, UA + (size_t)mb * ACOLS + 1024, ACOLS, (const bf16*)(ws + WS_WA) + (size_t)nb * AW, AW, AW, ssq);
        sk_gemm<false>(F, accb, UB + (size_t)mb * BCOLS + 512, BCOLS, (const bf16*)(ws + WS_WB) + (size_t)nb * BW, BW, BW, ssq);
#pragma unroll
        for (int i = 0; i < 16; ++i) { const size_t m = (size_t)(m0 + crow(i, hh));
            const float ga = bf2f(UG[m * GCOLS + n]), gb = bf2f(UG[m * GCOLS + 1024 + n]);
            UA[m * ACOLS + n] = (bf16)f2bf(sigmoidf_(ga) * acc[i] + sigmoidf_(gb) * accb[i]); }
    } else if (WHICH == 1) {
        sk_gemm<false>(F, acc, UA + (size_t)mb * ACOLS, ACOLS, (const bf16*)(ws + WS_WO) + (size_t)nb * D, D, D, ssq);
#pragma unroll
        for (int i = 0; i < 16; ++i) { const size_t m = (size_t)(m0 + crow(i, hh));
            const float o = A.in[1][(m - MP) * D + n] + acc[i];
            A.out[m * D + n] = o; UB[m * BCOLS + n] = (bf16)f2bf(o); }
    } else if (WHICH == 2) {
        sk_gemm<true>(F, acc, UB + (size_t)mb * BCOLS, BCOLS, (const bf16*)(ws + WS_WUP) + (size_t)nb * D, D, D, ssq);
        LAS float* rs = (LAS float*)(F.lds + 2 * SK_BUF * 2);
        ssq = red8(ssq);
        if ((F.tid & 7) == 0) rs[F.tid >> 3] = rsqrtf(ssq * (1.0f / D) + NORM_EPS);
        __syncthreads();
        bf16* Hd = UA;
#pragma unroll
        for (int i = 0; i < 16; ++i) { const int ml = 32 * wm + crow(i, hh); const size_t m = (size_t)(mb + ml);
            const float t = fmaxf(acc[i] * rs[ml], 0.f);
            Hd[m * DFF + n] = (bf16)f2bf(t * t); }
    } else {
        sk_gemm<false>(F, acc, UA + (size_t)mb * DFF + 1024 * ks, DFF, (const bf16*)(ws + WS_WDN) + (size_t)nb * DFF + 1024 * ks, DFF, 1024, ssq);
#pragma unroll
        for (int i = 0; i < 16; ++i) { const size_t m = (size_t)(m0 + crow(i, hh)); atomicAdd(A.out + m * D + n, acc[i]); }
    }
    __syncthreads();
}

__device__ __forceinline__ void p9_final(const Frame& F, const Args& A) {
    const int gw = F.vcu * NWAVES + F.wave, NGW = F.G * NWAVES;
    f32x4 gv[4];
#pragma unroll
    for (int j = 0; j < 4; ++j) gv[j] = ((const f32x4*)A.in[26])[F.lane + 64 * j];
    for (int m = gw; m < MT; m += NGW) {
        f32x4* xr = (f32x4*)(A.out + (size_t)m * D) + F.lane;
        f32x4 v[4]; float s = 0.f;
#pragma unroll
        for (int j = 0; j < 4; ++j) { v[j] = xr[64 * j]; s += (v[j][0] * v[j][0] + v[j][1] * v[j][1]) + (v[j][2] * v[j][2] + v[j][3] * v[j][3]); }
        const float rstd = rsqrtf(wave_sum(s) * (1.0f / D) + NORM_EPS);
#pragma unroll
        for (int j = 0; j < 4; ++j) xr[64 * j] = v[j] * rstd * gv[j];
    }
}

__global__ void __launch_bounds__(NWAVES * 64, 2) fwd(Args args) {
    extern __shared__ __attribute__((aligned(16))) unsigned char lds[];
    Frame F;
    F.lds = (LAS unsigned char*)lds;
    F.tid = threadIdx.x; F.lane = F.tid & 63; F.wave = __builtin_amdgcn_readfirstlane(F.tid >> 6);
    F.G = gridDim.x; { const int bx = blockIdx.x; F.vcu = (F.G % 8 == 0) ? (bx % 8) * (F.G / 8) + bx / 8 : bx; }
    unsigned char* ws = args.ws;
    gu32* ctl = (gu32*)(ws + WS_CTL);
    for (int u = F.tid; u < (LDS_BYTES - LDSCTL_OFF) / 4; u += NWAVES * 64) ((LAS unsigned*)(F.lds + LDSCTL_OFF))[u] = 0u;
    __syncthreads();
    volatile LAS unsigned* MISC = (volatile LAS unsigned*)(F.lds + MISC_OFF);
    XcdBarrier bar; bar.bar = (unsigned*)(ctl + CW_BAR); bar.x = 0; bar.st = nullptr;
    if (MK_N_LAUNCHES == 1) bar = xcd_barrier_post((unsigned*)(ctl + CW_BAR), MISC + 8);
    const int lo = args.ph_lo, hi = args.ph_hi;
#ifndef PH_MASK
#define PH_MASK 0x3ff
#endif
#ifndef DUP_MASK
#define DUP_MASK 0
#endif
#define REP(k) for (int rep_ = 0; rep_ < (((DUP_MASK >> (k)) & 1) ? 2 : 1); ++rep_)
#define IN(k) (((PH_MASK >> (k)) & 1) && lo <= (k) && (k) < hi)
#define SEAM(k) do { if (IN(k) && IN((k) + 1)) xcd_barrier(bar); } while (0)
    bf16* UA = (bf16*)(ws + WS_UA); bf16* UB = (bf16*)(ws + WS_UB); bf16* UG = (bf16*)(ws + WS_UG);

    if (IN(0)) REP(0) { p0_prologue(F, args); } SEAM(0);
    if (IN(1)) REP(1) {
        pg8::Gemm g{(const bf16*)args.out, (const bf16*)(ws + WS_WIN), MH, NIN, D, D, D};
        SchedG1 S; S.init(F.G, (int)blockIdx.x);
        EpiG1 E{UA, UB, UG, (bf16*)(args.out + O_HGRN_S)};
        pg8::gemm_phase<EpiG1, SchedG1, true, true>(F.lds, g, S, E);
    } SEAM(1);
    if (IN(2)) {
        { LAS float* PAR = (LAS float*)(F.lds + RL_PAR); const int c_ = F.tid;
          PAR[c_] = args.in[8][c_]; PAR[512 + c_] = args.in[10][c_]; PAR[1024 + c_] = args.in[13][c_]; PAR[1536 + c_] = args.in[14][c_]; PAR[2048 + c_] = args.in[15][c_]; }
        for (int ps = 0; ps * 2 * F.G < 4096; ++ps) { const int unit = (ps * F.G + F.vcu) * 2 + (F.wave >> 2); r1_pass(F, args, unit < 4096 ? unit : 0, unit < 4096); }
        for (int u = F.vcu; u < 1024; u += F.G) h1_unit(F, args, u);
    } SEAM(2);
    if (IN(3)) { p3_seq(F, args); } SEAM(3);
    if (IN(4)) { for (int u = F.vcu * NWAVES + F.wave; u < 4096; u += F.G * NWAVES) r3_unit(F, args, u); for (int u = F.vcu; u < 1024; u += F.G) h3_unit(F, args, u); for (int u = F.vcu; u < 512; u += F.G) hgrn_sample_unit(F, args, u); } SEAM(4);
    if (IN(5)) REP(5) {
        SchedMN S; S.init(MP, D, F.G, (int)blockIdx.x);
        { pg8::Gemm g{UA + 1024, (const bf16*)(ws + WS_WA), MP, D, AW, ACOLS, AW}; EpiMerge<false> E{UA, UG, 0};
          pg8::gemm_phase<EpiMerge<false>, SchedMN, true, true>(F.lds, g, S, E); }
        { pg8::Gemm g{UB + 512, (const bf16*)(ws + WS_WB), MP, D, BW, BCOLS, BW}; EpiMerge<true> E{UA, UG, 1024};
          pg8::gemm_phase<EpiMerge<true>, SchedMN, true, true>(F.lds, g, S, E); }
        for (int u = F.G - 1 - F.vcu; u < 64; u += F.G) skinny_unit<0>(F, args, u >> 3, u & 7, 0);
    } SEAM(5);
    if (IN(6)) REP(6) {
        SchedMN S; S.init(MP, D, F.G, (int)blockIdx.x);
        pg8::Gemm g{UA, (const bf16*)(ws + WS_WO), MP, D, D, ACOLS, D};
        EpiRes<true, true, true> E{args.in[0], args.in[1], args.out, UB, BCOLS, (float*)(ws + WS_SSQ1)};
        pg8::gemm_phase<EpiRes<true, true, true>, SchedMN, true, true>(F.lds, g, S, E);
        for (int u = F.G - 1 - F.vcu; u < 64; u += F.G) skinny_unit<1>(F, args, u >> 3, u & 7, 0);
    } SEAM(6);
    if (IN(7)) REP(7) {
        SchedMN S; S.init(MP, DFF, F.G, (int)blockIdx.x);
        pg8::Gemm g{UB, (const bf16*)(ws + WS_WUP), MP, DFF, D, BCOLS, D};
        EpiUp E{UA, (const float*)(ws + WS_SSQ1)};
        pg8::gemm_phase<EpiUp, SchedMN, true, true>(F.lds, g, S, E);
        for (int u = F.vcu; u < 256; u += F.G) skinny_unit<2>(F, args, u >> 5, u & 31, 0);
    } SEAM(7);
    if (IN(8)) {
        SchedMN S; S.init(MP, D, F.G, (int)blockIdx.x);
        pg8::Gemm g{UA, (const bf16*)(ws + WS_WDN), MP, D, DFF, DFF, DFF};
        EpiRes<false, false, false> E{nullptr, nullptr, args.out, nullptr, 0, nullptr};
        pg8::gemm_phase<EpiRes<false, false, false>, SchedMN, true, true>(F.lds, g, S, E);
        for (int u = F.vcu; u < 256; u += F.G) skinny_unit<3>(F, args, (u >> 3) & 7, u & 7, u >> 6);
    } SEAM(8);
    if (IN(9)) { p9_final(F, args); }
#undef IN
#undef SEAM
}

extern "C" void kernel_launch(void* const* d_in, const int* in_sizes, int n_in, void* d_out, int out_size, void* d_ws, size_t ws_size, hipStream_t stream) {
    static int grid = 0;
    if (grid == 0) {
        if (n_in != 27 || out_size != (int)O_END || ws_size < WS_END) { fprintf(stderr, "kernel_launch: unexpected shapes (n_in %d, out %d, ws %zu)\n", n_in, out_size, ws_size); grid = -1; return; }
        int dev = 0, cus = 0, per_cu = 0;
        if (hipGetDevice(&dev) != hipSuccess || hipDeviceGetAttribute(&cus, hipDeviceAttributeMultiprocessorCount, dev) != hipSuccess) { grid = -1; return; }
        if (hipFuncSetAttribute((const void*)fwd, hipFuncAttributeMaxDynamicSharedMemorySize, LDS_BYTES) != hipSuccess) { fprintf(stderr, "kernel_launch: hipFuncSetAttribute failed\n"); grid = -1; return; }
        if (hipOccupancyMaxActiveBlocksPerMultiprocessor(&per_cu, (const void*)fwd, NWAVES * 64, LDS_BYTES) != hipSuccess || per_cu < 1) { fprintf(stderr, "kernel_launch: occupancy query says %d\n", per_cu); }
        (void)hipGetLastError();
        grid = cus;
    }
    if (grid < 0) return;
    (void)hipMemsetAsync((char*)d_ws + WS_CTL, 0, CTL_BYTES, stream);
    Args a{};
    for (int i = 0; i < 27; ++i) a.in[i] = (const float*)d_in[i];
    a.out = (float*)d_out; a.ws = (unsigned char*)d_ws;
    if (MK_N_LAUNCHES == 1) { a.ph_lo = 0; a.ph_hi = NPHASE; hipLaunchKernelGGL(fwd, dim3(grid), dim3(NWAVES * 64), LDS_BYTES, stream, a); }
    else for (int p = 0; p < NPHASE; ++p) { a.ph_lo = p; a.ph_hi = p + 1; hipLaunchKernelGGL(fwd, dim3(grid), dim3(NWAVES * 64), LDS_BYTES, stream, a); }
}
```

```cpp
#include <hip/hip_runtime.h>
#include <cstdio>
#include <cstdint>
namespace pg8 {
#define PG8_LAS __attribute__((address_space(3)))
typedef unsigned short bf16_t;
typedef short bf16x8 __attribute__((ext_vector_type(8)));
typedef float f32x4 __attribute__((ext_vector_type(4)));
typedef unsigned u32x4 __attribute__((ext_vector_type(4)));
constexpr int BM = 256, BK = 64, HALF = 128, HTB = HALF * BK * 2  , STAGE_BYTES = 8 * HTB, NXCD = 8, WGM = 8;

__host__ __device__ __forceinline__ int lds_byte(int r, int c) { const int st = (r >> 4) * 2 + (c >> 5), rr = r & 15, cc = c & 31, ob = rr * 64 + cc * 2; return st * 1024 + (ob ^ (((ob >> 9) & 1) << 5)); }
__host__ __device__ __forceinline__ void stage_rc(int b, int& R, int& C) { const int st = b / 1024, sb = b % 1024, swz = sb ^ (((sb >> 9) & 1) << 5); R = (st >> 1) * 16 + swz / 64; C = (st & 1) * 32 + (swz % 64) / 2; }
__host__ __device__ __forceinline__ int perm32(int rho) { const int n = rho >> 4, i = rho & 15; return 8 * (i >> 2) + 4 * n + (i & 3); }

struct Unit { int pm, pn; };
struct Gemm { const bf16_t* A; const bf16_t* Bt; int M, N, K, lda, ldb; };

struct StaticOrder {
    int nM, nN, nwg, G, c;
    __host__ __device__ void init(int M, int N, int G_, int c_) { nM = M / BM; nN = N / BM; nwg = nM * nN; G = G_; c = c_; }
    __host__ __device__ bool next(int i, Unit& u) const {
        const long L = (long)i * G + c; if (L >= nwg) return false;
        int wgid = (int)L; { const int q = nwg / NXCD, r = nwg % NXCD, xcd = wgid % NXCD, off = wgid / NXCD; wgid = (xcd < r ? xcd * (q + 1) : r * (q + 1) + (xcd - r) * q) + off; }
        const int nig = WGM * nN, gid = wgid / nig, fm = gid * WGM, gsz = (nM - fm) < WGM ? (nM - fm) : WGM;
        u.pm = fm + ((wgid % nig) % gsz); u.pn = (wgid % nig) / gsz; return true;
    }
    __device__ __forceinline__ void a_ready(const Unit&) const {}
    __device__ __forceinline__ void done(const Unit&) const {}
};

__device__ __forceinline__ unsigned cvt_pk_bf16(float lo, float hi) { unsigned r; asm volatile("v_cvt_pk_bf16_f32 %0, %1, %2" : "=v"(r) : "v"(lo), "v"(hi)); return r; }
typedef float f32x2 __attribute__((ext_vector_type(2)));
__device__ __forceinline__ f32x2 gelu_pk(f32x2 v) {
    const f32x2 av = __builtin_elementwise_abs(v), d = av * 0.2316418882f + 1.0f;
    f32x2 t; t.x = __builtin_amdgcn_rcpf(d.x); t.y = __builtin_amdgcn_rcpf(d.y);
    f32x2 q = t * 0.5307027145f + (-0.7265760135f); q = q * t + 0.7107068705f; q = q * t + (-0.142248368f); q = q * t + 0.127414796f; q = q * t;
    const f32x2 s = (v * v) * (-0.72134752044f);
    f32x2 e; e.x = __builtin_amdgcn_exp2f(s.x); e.y = __builtin_amdgcn_exp2f(s.y);
    const f32x2 m = v * (q * e), r = v - m;
    f32x2 o; o.x = v.x < 0.f ? m.x : r.x; o.y = v.y < 0.f ? m.y : r.y; return o;
}

template <class Epi, class Sched, bool ALIGN_EPI = false, bool SP2 = false>
__device__ __forceinline__ void gemm_phase(PG8_LAS unsigned char* lds, const Gemm g, const Sched& S, const Epi& E) {
    const int tid = threadIdx.x, wid = __builtin_amdgcn_readfirstlane(tid >> 6), lane = tid & 63, wr = wid >> 2, wc = wid & 3, fr = lane & 15, fq = lane >> 4;
    const int K = g.K, nt = K / BK;
    unsigned voffA[2], voffB[2];
#pragma unroll
    for (int i = 0; i < 2; ++i) { int R, C; stage_rc(tid * 16 + i * 8192, R, C); const int Rb = Epi::PERM ? ((R & ~31) + perm32(R & 31)) : R;
        voffA[i] = (unsigned)(R * g.lda + C) * 2u; voffB[i] = (unsigned)(Rb * g.ldb + C) * 2u; }
    const size_t kstep = (size_t)(BK * 2);
    const size_t hstepA = (size_t)HALF * g.lda * 2, hstepB = (size_t)HALF * g.ldb * 2;
    const size_t tstepA = 2 * hstepA, tstepB = 2 * hstepB;
    const unsigned ldsw = (unsigned)wid * 1024u;
    const int aoff = lds_byte(wr * 64 + fr, fq * 8), boff = lds_byte(wc * 32 + fr, fq * 8);
#define PG8_SA(b, h) (((b) * 2 + (h)) * HTB)
#define PG8_SB(b, h) ((4 + (b) * 2 + (h)) * HTB)
#define PG8_STAGE(bufoff, gbase, voff) do { _Pragma("unroll") for (int _i = 0; _i < 2; ++_i) \
        __builtin_amdgcn_global_load_lds((const unsigned*)((const char*)(gbase) + (voff)[_i]), (PG8_LAS unsigned*)(lds + (bufoff) + ldsw + _i * 8192), 16, 0, 0); } while (0)
#define PG8_LDA(dst, b, h) do { _Pragma("unroll") for (int m = 0; m < 4; ++m) _Pragma("unroll") for (int k = 0; k < 2; ++k) dst[m][k] = *(const PG8_LAS bf16x8*)(lds + PG8_SA(b, h) + aoff + m * 2048 + k * 1024); } while (0)
#define PG8_LDB(dst, b, h) do { _Pragma("unroll") for (int n = 0; n < 2; ++n) _Pragma("unroll") for (int k = 0; k < 2; ++k) dst[n][k] = *(const PG8_LAS bf16x8*)(lds + PG8_SB(b, h) + boff + n * 2048 + k * 1024); } while (0)
#define PG8_MMA(ai, bj, At, Bt) do { __builtin_amdgcn_s_setprio(1); _Pragma("unroll") for (int m = 0; m < 4; ++m) _Pragma("unroll") for (int n = 0; n < 2; ++n) _Pragma("unroll") for (int k = 0; k < 2; ++k) \
        acc[ai][bj][m][n] = __builtin_amdgcn_mfma_f32_16x16x32_bf16(Bt[n][k], At[m][k], acc[ai][bj][m][n], 0, 0, 0); __builtin_amdgcn_s_setprio(0); } while (0)
#define PG8_WAIT_V(n) asm volatile("s_waitcnt vmcnt(" #n ")" ::: "memory")
#define PG8_WAIT_L(n) asm volatile("s_waitcnt lgkmcnt(" #n ")" ::: "memory")
#define PG8_BAR __builtin_amdgcn_s_barrier()
#define PG8_SCHED __builtin_amdgcn_sched_barrier(0)
    Unit cur, nxt; int ui = 0;
    if (!S.next(0, cur)) return;
    f32x4 acc[2][2][4][2];
#pragma unroll
    for (int a = 0; a < 2; ++a)
#pragma unroll
        for (int b = 0; b < 2; ++b)
#pragma unroll
            for (int m = 0; m < 4; ++m)
#pragma unroll
                for (int n = 0; n < 2; ++n) acc[a][b][m][n] = (f32x4){0.f, 0.f, 0.f, 0.f};
    bf16x8 At[4][2], B0[2][2], B1[2][2];
    const char* cA = (const char*)g.A + (size_t)cur.pm * tstepA; const char* cB = (const char*)g.Bt + (size_t)cur.pn * tstepB;
    S.a_ready(cur);
    if constexpr (SP2) {
        PG8_STAGE(PG8_SB(0, 0), cB, voffB); PG8_STAGE(PG8_SB(0, 1), cB + hstepB, voffB); PG8_STAGE(PG8_SA(0, 0), cA, voffA); PG8_STAGE(PG8_SA(0, 1), cA + hstepA, voffA);
        if (wr == 1) PG8_BAR;
        PG8_WAIT_V(2); PG8_BAR;
        PG8_STAGE(PG8_SB(1, 0), cB + kstep, voffB); PG8_STAGE(PG8_SA(1, 0), cA + kstep, voffA); PG8_STAGE(PG8_SB(1, 1), cB + hstepB + kstep, voffB);
        PG8_WAIT_V(6); PG8_BAR;
    } else {
        PG8_STAGE(PG8_SB(0, 0), cB, voffB); PG8_STAGE(PG8_SA(0, 0), cA, voffA); PG8_STAGE(PG8_SB(0, 1), cB + hstepB, voffB); PG8_STAGE(PG8_SA(0, 1), cA + hstepA, voffA);
        if (wr == 1) PG8_BAR;
        PG8_WAIT_V(4); PG8_BAR;
        PG8_STAGE(PG8_SB(1, 0), cB + kstep, voffB); PG8_STAGE(PG8_SA(1, 0), cA + kstep, voffA); PG8_STAGE(PG8_SB(1, 1), cB + hstepB + kstep, voffB);
        PG8_WAIT_V(6); PG8_BAR;
    }
    for (;;) {
        const bool has_next = S.next(ui + 1, nxt);
        const char* nA = has_next ? (const char*)g.A + (size_t)nxt.pm * tstepA : cA; const char* nB = has_next ? (const char*)g.Bt + (size_t)nxt.pn * tstepB : cB;
        for (int t = 0; t < nt; t += 2) {
            const bool last = (t == nt - 2);
            const char* a1 = cA + (size_t)(t + 1) * kstep;
            const char* a2 = last ? nA : cA + (size_t)(t + 2) * kstep; const char* b2 = last ? nB : cB + (size_t)(t + 2) * kstep;
            const char* a3 = a2 + kstep; const char* b3 = b2 + kstep;
            if (last && has_next) S.a_ready(nxt);
            if constexpr (SP2) {
            PG8_LDB(B0, 0, 0); PG8_LDB(B1, 0, 1); PG8_SCHED; PG8_LDA(At, 0, 0); PG8_STAGE(PG8_SA(1, 1), a1 + hstepA, voffA);
            PG8_WAIT_V(8); PG8_WAIT_L(0); PG8_BAR; PG8_MMA(0, 0, At, B0); PG8_MMA(0, 1, At, B1); PG8_BAR; PG8_SCHED;
            PG8_LDA(At, 0, 1); PG8_STAGE(PG8_SB(0, 0), b2, voffB); PG8_STAGE(PG8_SB(0, 1), b2 + hstepB, voffB); PG8_STAGE(PG8_SA(0, 0), a2, voffA);
            PG8_WAIT_V(8); PG8_WAIT_L(0); PG8_BAR; PG8_MMA(1, 0, At, B0); PG8_MMA(1, 1, At, B1); PG8_BAR; PG8_SCHED;
            PG8_LDB(B0, 1, 0); PG8_LDB(B1, 1, 1); PG8_SCHED; PG8_LDA(At, 1, 0); PG8_STAGE(PG8_SA(0, 1), a2 + hstepA, voffA);
            PG8_WAIT_V(8); PG8_WAIT_L(0); PG8_BAR; PG8_MMA(0, 0, At, B0); PG8_MMA(0, 1, At, B1); PG8_BAR; PG8_SCHED;
            PG8_LDA(At, 1, 1); PG8_STAGE(PG8_SB(1, 0), b3, voffB); PG8_STAGE(PG8_SB(1, 1), b3 + hstepB, voffB); PG8_STAGE(PG8_SA(1, 0), a3, voffA);
            PG8_WAIT_V(8); PG8_WAIT_L(0); PG8_BAR; PG8_MMA(1, 0, At, B0); PG8_MMA(1, 1, At, B1); PG8_BAR; PG8_SCHED;
            } else {
            PG8_LDB(B0, 0, 0); PG8_SCHED; PG8_LDA(At, 0, 0); PG8_STAGE(PG8_SA(1, 1), a1 + hstepA, voffA);
            PG8_WAIT_L(8); PG8_BAR; PG8_WAIT_L(0); PG8_MMA(0, 0, At, B0); PG8_BAR; PG8_SCHED;
            PG8_LDB(B1, 0, 1); PG8_STAGE(PG8_SB(0, 0), b2, voffB);
            PG8_BAR; PG8_WAIT_L(0); PG8_MMA(0, 1, At, B1); PG8_BAR;
            PG8_LDA(At, 0, 1); PG8_STAGE(PG8_SA(0, 0), a2, voffA);
            PG8_BAR; PG8_WAIT_L(0); PG8_MMA(1, 0, At, B0); PG8_BAR; PG8_SCHED;
            PG8_STAGE(PG8_SB(0, 1), b2 + hstepB, voffB);
            PG8_WAIT_V(6); PG8_BAR; PG8_MMA(1, 1, At, B1); PG8_BAR;
            PG8_LDB(B0, 1, 0); PG8_SCHED; PG8_LDA(At, 1, 0); PG8_STAGE(PG8_SA(0, 1), a2 + hstepA, voffA);
            PG8_WAIT_L(8); PG8_BAR; PG8_WAIT_L(0); PG8_MMA(0, 0, At, B0); PG8_BAR; PG8_SCHED;
            PG8_LDB(B1, 1, 1); PG8_STAGE(PG8_SB(1, 0), b3, voffB);
            PG8_BAR; PG8_WAIT_L(0); PG8_MMA(0, 1, At, B1); PG8_BAR;
            PG8_LDA(At, 1, 1); PG8_STAGE(PG8_SA(1, 0), a3, voffA);
            PG8_BAR; PG8_WAIT_L(0); PG8_MMA(1, 0, At, B0); PG8_BAR; PG8_SCHED;
            PG8_STAGE(PG8_SB(1, 1), b3 + hstepB, voffB);
            PG8_WAIT_V(6); PG8_BAR; PG8_MMA(1, 1, At, B1); PG8_BAR;
            }
        }
        if constexpr (ALIGN_EPI) { if (wr == 0) PG8_BAR; }
        if constexpr (!Epi::AFTER_DRAIN) { E(acc, cur, wr, wc, fr, fq); S.done(cur); }
        if (!has_next) break;
#pragma unroll
        for (int a = 0; a < 2; ++a)
#pragma unroll
            for (int b = 0; b < 2; ++b)
#pragma unroll
                for (int m = 0; m < 4; ++m)
#pragma unroll
                    for (int n = 0; n < 2; ++n) acc[a][b][m][n] = (f32x4){0.f, 0.f, 0.f, 0.f};
        cur = nxt; cA = nA; cB = nB; ++ui;
        if constexpr (ALIGN_EPI) { if (wr == 1) PG8_BAR; }
    }
    PG8_WAIT_V(0);
    if constexpr (!ALIGN_EPI) { if (wr == 0) PG8_BAR; }
    PG8_BAR;
    if constexpr (Epi::AFTER_DRAIN) { E.fused(acc, cur, wr, wc, fr, fq, lds, wid, lane); S.done(cur); }
#undef PG8_SA
#undef PG8_SB
#undef PG8_STAGE
#undef PG8_LDA
#undef PG8_LDB
#undef PG8_MMA
#undef PG8_WAIT_V
#undef PG8_WAIT_L
#undef PG8_BAR
#undef PG8_SCHED
}
}

#ifndef MK_N_LAUNCHES
#define MK_N_LAUNCHES 1
#endif
constexpr int NPHASE = 10;
constexpr int NWAVES = 8;

constexpr int D = 1024, SEQ = 2048, NBP = 8, NBS = 128, TS = 4;
constexpr int MP = NBP * SEQ;
constexpr int MS = NBS * TS;
constexpr int MT = MP + MS;
constexpr int MH = MT + 256;
constexpr int ACOLS = 2048, BCOLS = 1792, GCOLS = 2048, NIN = ACOLS + BCOLS + GCOLS, DFF = 4096;
constexpr int AW = 512, BW = 512;
constexpr float NORM_EPS = 1e-6f, HGRN_EPS = 1e-5f, GN_EPS = 64e-5f, DECAY_SCALE = 0.6065306597126334f;

constexpr size_t O_Y = 0, O_HGRN_P = (size_t)MT * D, O_WKV_P = O_HGRN_P + (size_t)NBP * 4 * 128 * 128, O_SHIFT_P = O_WKV_P + (size_t)NBP * 8 * 64 * 64,
                 O_HGRN_S = O_SHIFT_P + (size_t)NBP * D, O_WKV_S = O_HGRN_S + (size_t)NBS * 4 * 128 * 128, O_SHIFT_S = O_WKV_S + (size_t)NBS * 8 * 64 * 64,
                 O_END = O_SHIFT_S + (size_t)NBS * D;
static_assert(O_END == 30810112, "d_out size");

constexpr size_t WS_CTL = 0, CTL_BYTES = 65536;
constexpr size_t WS_WIN = WS_CTL + CTL_BYTES;
constexpr size_t WS_WA  = WS_WIN + (size_t)NIN * D * 2;
constexpr size_t WS_WB  = WS_WA + (size_t)D * AW * 2;
constexpr size_t WS_WO  = WS_WB + (size_t)D * BW * 2;
constexpr size_t WS_WUP = WS_WO + (size_t)D * D * 2;
constexpr size_t WS_WDN = WS_WUP + (size_t)DFF * D * 2;
constexpr size_t WS_UB  = WS_WDN + (size_t)D * DFF * 2;
constexpr size_t WS_UA  = WS_UB + (size_t)MH * BCOLS * 2;
constexpr size_t WS_UG  = WS_UA + (size_t)MT * ACOLS * 2;
constexpr size_t WS_BONUS = WS_UG + (size_t)MT * GCOLS * 2;
constexpr size_t WS_NS = WS_BONUS + (size_t)MT * 8 * 4;
constexpr size_t WS_GAMMA = WS_NS + (size_t)1024 * 16384 * 2;
constexpr size_t WS_WDT = WS_GAMMA + (size_t)1024 * 128 * 4;
constexpr size_t WS_WAT = WS_WDT + 512 * 64 * 2;
constexpr size_t WS_WGT = WS_WAT + 512 * 64 * 2;
constexpr size_t WS_END = WS_WGT + 512 * 128 * 2;
constexpr size_t WS_SSQ1 = WS_NS;
constexpr size_t WS_SSQ2 = WS_SSQ1 + (size_t)MT * 16 * 4;
static_assert(WS_END <= 268435456, "d_ws map");
static_assert(WS_UA + (size_t)MT * DFF * 2 == WS_BONUS, "hidden overlays UA|UG exactly");
static_assert((size_t)MT * 2048 * 2 == (size_t)MT * D * 4, "P fits the y region exactly");

constexpr int CW_TMO = 0, CW_BAR = 1024;

constexpr int RING_BYTES = 159744, LDSCTL_OFF = RING_BYTES, MISC_OFF = LDSCTL_OFF + 320, LDS_BYTES = 163840;

#define GAS __attribute__((address_space(1)))
#define LAS __attribute__((address_space(3)))
typedef unsigned short bf16;
typedef unsigned v4u __attribute__((ext_vector_type(4)));
typedef unsigned v2u __attribute__((ext_vector_type(2)));
typedef float f32x4 __attribute__((ext_vector_type(4)));
typedef GAS unsigned gu32;
#define RLX_AGENT __ATOMIC_RELAXED, __HIP_MEMORY_SCOPE_AGENT
#define LDS_WAIT() asm volatile("s_waitcnt lgkmcnt(0)" ::: "memory")
#define VM_WAIT() asm volatile("s_waitcnt vmcnt(0)" ::: "memory")
__device__ __forceinline__ unsigned f2bf(float f) { unsigned u = __builtin_bit_cast(unsigned, f); return (u + 0x7fffu + ((u >> 16) & 1u)) >> 16; }
__device__ __forceinline__ unsigned pk2(float lo, float hi) { return f2bf(lo) | (f2bf(hi) << 16); }
__device__ __forceinline__ float bf2f(unsigned b) { return __builtin_bit_cast(float, b << 16); }
__device__ __forceinline__ float bflo(unsigned w) { return __builtin_bit_cast(float, w << 16); }
__device__ __forceinline__ float bfhi(unsigned w) { return __builtin_bit_cast(float, w & 0xffff0000u); }
__device__ __forceinline__ float sigmoidf_(float x) { return 1.0f / (1.0f + __expf(-x)); }
__device__ __forceinline__ float tanhf_(float x) { return 1.0f - 2.0f / (1.0f + __expf(2.0f * x)); }
__device__ __forceinline__ float wave_sum(float v) {
#pragma unroll
    for (int o = 1; o < 64; o <<= 1) v += __shfl_xor(v, o);
    return v;
}
__device__ __forceinline__ float row_sum16(float x) {
    x += __builtin_bit_cast(float, __builtin_amdgcn_update_dpp(0, __builtin_bit_cast(int, x), 0xB1, 0xF, 0xF, true));
    x += __builtin_bit_cast(float, __builtin_amdgcn_update_dpp(0, __builtin_bit_cast(int, x), 0x4E, 0xF, 0xF, true));
    x += __builtin_bit_cast(float, __builtin_amdgcn_update_dpp(0, __builtin_bit_cast(int, x), 0x141, 0xF, 0xF, true));
    x += __builtin_bit_cast(float, __builtin_amdgcn_update_dpp(0, __builtin_bit_cast(int, x), 0x140, 0xF, 0xF, true));
    return x;
}
#define XB_TMO      128
#define XB_XCNT(j)  (256  + 64 * (j))
#define XB_XSUB(j)  (1280 + 64 * (j))
#define XB_XGEN(j)  (2304 + 64 * (j))
#define XB_TOP      3328
#define XB_TOPGEN   3392
#define XCD_BAR_WORDS 3456
#define XB_SPIN_CAP (1u << 18)

__device__ __forceinline__ unsigned xb_ld(unsigned* p)              { return __hip_atomic_load(p, __ATOMIC_RELAXED, __HIP_MEMORY_SCOPE_AGENT); }
__device__ __forceinline__ unsigned xb_add(unsigned* p, unsigned v) { return __hip_atomic_fetch_add(p, v, __ATOMIC_RELAXED, __HIP_MEMORY_SCOPE_AGENT); }
__device__ __forceinline__ unsigned xb_xcc_id() { return (unsigned)__builtin_amdgcn_s_getreg((3 << 11) | 20) & 0xFu; }
#define XB_SPIN(cond, bar) do { unsigned _sp = 0; while (cond) { __builtin_amdgcn_s_sleep(1); \
    if ((++_sp & 255u) == 0u) { if (xb_ld(&(bar)[XB_TMO])) break; if (_sp > XB_SPIN_CAP) { atomicAdd(&(bar)[XB_TMO], 1u); break; } } } } while (0)

struct XcdBarrier {
    unsigned* bar; unsigned x;
    volatile LAS unsigned* st;
};

__device__ __forceinline__ XcdBarrier xcd_barrier_post(unsigned* bar, volatile LAS unsigned* st) {
    XcdBarrier b; b.bar = bar; b.x = xb_xcc_id(); b.st = st;
    if (threadIdx.x == 0) (void)xb_add(&bar[XB_XCNT(b.x)], 1u);
    return b;
}
__device__ __forceinline__ void xcd_barrier_complete(unsigned* bar, unsigned x, unsigned& nloc, unsigned& nx) {
    const unsigned G = gridDim.x * gridDim.y * gridDim.z;
    unsigned sum, cnt, mine, sp = 0u;
    for (;;) {
        sum = 0u; cnt = 0u; mine = 0u;
#pragma unroll
        for (unsigned j = 0; j < 16; ++j) { const unsigned c = xb_ld(&bar[XB_XCNT(j)]); sum += c; cnt += (c > 0u) ? 1u : 0u; mine = (j == x) ? c : mine; }
        if (sum == G) break;
        __builtin_amdgcn_s_sleep(1);
        if ((++sp & 255u) == 0u) { if (xb_ld(&bar[XB_TMO])) break; if (sp > XB_SPIN_CAP) { atomicAdd(&bar[XB_TMO], 1u); break; } }
    }
    nloc = mine > 0u ? mine : 1u; nx = cnt > 0u ? cnt : 1u;
}

__device__ __forceinline__ void xcd_barrier(const XcdBarrier& b) {
    asm volatile("s_waitcnt vmcnt(0)" ::: "memory");
    __syncthreads();
    if (threadIdx.x == 0) {
        unsigned* bar = b.bar;
        __builtin_amdgcn_s_waitcnt(0);
        unsigned nloc = b.st[0], nx = b.st[1];
        if (nloc == 0u) { xcd_barrier_complete(bar, b.x, nloc, nx); b.st[0] = nloc; b.st[1] = nx; }
        const unsigned old = xb_add(&bar[XB_XSUB(b.x)], 1u);
        const unsigned gen = old / nloc;
        if (old + 1u == (gen + 1u) * nloc) {
            __builtin_amdgcn_fence(__ATOMIC_RELEASE, "agent");
            asm volatile("s_waitcnt vmcnt(0)" ::: "memory");
            const unsigned og = xb_add(&bar[XB_TOP], 1u);
            const unsigned tg = og / nx;
            if (og + 1u == (tg + 1u) * nx) xb_add(&bar[XB_TOPGEN], 1u);
            else XB_SPIN(xb_ld(&bar[XB_TOPGEN]) == tg, bar);
            __builtin_amdgcn_fence(__ATOMIC_ACQUIRE, "agent");
            xb_add(&bar[XB_XGEN(b.x)], 1u);
            asm volatile("s_waitcnt vmcnt(0)" ::: "memory");
        } else {
            XB_SPIN(xb_ld(&bar[XB_XGEN(b.x)]) == gen, bar);
            __builtin_amdgcn_fence(__ATOMIC_ACQUIRE, "agent");
            asm volatile("s_waitcnt vmcnt(0)" ::: "memory");
        }
    }
    __syncthreads();
}


struct Args { const float* in[27]; float* out; unsigned char* ws; int ph_lo, ph_hi; };
struct Frame {
    LAS unsigned char* lds;
    int tid, lane, wave, vcu, G;
};

struct SchedMN {
    pg8::StaticOrder so;
    __device__ void init(int M, int N, int G, int c) { so.init(M, N, G, c); }
    __device__ __forceinline__ bool next(int i, pg8::Unit& u) const { return so.next(i, u); }
    __device__ __forceinline__ void a_ready(const pg8::Unit&) const {}
    __device__ __forceinline__ void done(const pg8::Unit&) const {}
};
struct SchedG1 {
    pg8::StaticOrder so; int G, c;
    __device__ void init(int G_, int c_) { so.init(MT, NIN, G_, c_); G = G_; c = c_; }
    __device__ __forceinline__ bool next(int i, pg8::Unit& u) const {
        const int L = i * G + c;
        if (L < so.nwg) return so.next(i, u);
        if (L < so.nwg + 7) { u.pm = MT / 256; u.pn = 8 + (L - so.nwg); return true; }
        return false;
    }
    __device__ __forceinline__ void a_ready(const pg8::Unit&) const {}
    __device__ __forceinline__ void done(const pg8::Unit&) const {}
};

using pg8::f32x4; using pg8::Unit;
typedef unsigned u32x4 __attribute__((ext_vector_type(4)));
struct EpiG1 {
    static constexpr bool PERM = true, AFTER_DRAIN = false;
    bf16 *UA, *UB, *UG, *BR;
    __device__ __forceinline__ void operator()(const f32x4 (&acc)[2][2][4][2], const Unit& u, int wr, int wc, int fr, int fq) const {
        bf16* base; int ld, colt;
        if (u.pn < 8) { base = UA; ld = ACOLS; colt = u.pn * 256; } else if (u.pn < 15) { base = UB; ld = BCOLS; colt = (u.pn - 8) * 256; } else { base = UG; ld = GCOLS; colt = (u.pn - 15) * 256; }
        const int row0 = u.pm * 256 + wr * 64 + fr, col0 = colt + wc * 32 + 8 * fq;
#pragma unroll
        for (int ai = 0; ai < 2; ++ai)
#pragma unroll
            for (int m = 0; m < 4; ++m) { bf16* rowp = base + (size_t)(row0 + ai * 128 + m * 16) * ld + col0;
#pragma unroll
                for (int bj = 0; bj < 2; ++bj) { const f32x4 v0 = acc[ai][bj][m][0], v1 = acc[ai][bj][m][1];
                    u32x4 w; w.x = pk2(v0[0], v0[1]); w.y = pk2(v0[2], v0[3]); w.z = pk2(v1[0], v1[1]); w.w = pk2(v1[2], v1[3]);
                    *(u32x4*)(rowp + bj * 128) = w;
                    if ((m & 1) && fr == 15 && u.pn >= 8 && u.pn < 14 && u.pm < MP / 256) { const int row = row0 + ai * 128 + m * 16; *(u32x4*)(BR + (size_t)(row >> 5) * 1536 + col0 + bj * 128) = w; } } }
    }
};
template <bool ADD> struct EpiMerge {
    static constexpr bool PERM = true, AFTER_DRAIN = false;
    bf16* Mg; const bf16* UG; int goff;
    __device__ __forceinline__ void operator()(const f32x4 (&acc)[2][2][4][2], const Unit& u, int wr, int wc, int fr, int fq) const {
        const int row0 = u.pm * 256 + wr * 64 + fr, col0 = u.pn * 256 + wc * 32 + 8 * fq;
#pragma unroll
        for (int ai = 0; ai < 2; ++ai)
#pragma unroll
            for (int m = 0; m < 4; ++m) { const size_t row = (size_t)(row0 + ai * 128 + m * 16);
#pragma unroll
                for (int bj = 0; bj < 2; ++bj) { const f32x4 v0 = acc[ai][bj][m][0], v1 = acc[ai][bj][m][1];
                    const u32x4 gq = *(const u32x4*)(UG + row * GCOLS + goff + col0 + bj * 128);
                    float o[8];
                    o[0] = sigmoidf_(bflo(gq.x)) * v0[0]; o[1] = sigmoidf_(bfhi(gq.x)) * v0[1]; o[2] = sigmoidf_(bflo(gq.y)) * v0[2]; o[3] = sigmoidf_(bfhi(gq.y)) * v0[3];
                    o[4] = sigmoidf_(bflo(gq.z)) * v1[0]; o[5] = sigmoidf_(bfhi(gq.z)) * v1[1]; o[6] = sigmoidf_(bflo(gq.w)) * v1[2]; o[7] = sigmoidf_(bfhi(gq.w)) * v1[3];
                    bf16* dst = Mg + row * ACOLS + col0 + bj * 128;
                    if (ADD) { const u32x4 p = *(const u32x4*)dst;
                        o[0] += bflo(p.x); o[1] += bfhi(p.x); o[2] += bflo(p.y); o[3] += bfhi(p.y); o[4] += bflo(p.z); o[5] += bfhi(p.z); o[6] += bflo(p.w); o[7] += bfhi(p.w); }
                    u32x4 w; w.x = pk2(o[0], o[1]); w.y = pk2(o[2], o[3]); w.z = pk2(o[4], o[5]); w.w = pk2(o[6], o[7]);
                    *(u32x4*)dst = w; } }
    }
};
template <bool RES_IS_X, bool WRITE_BF, bool WRITE_SSQ> struct EpiRes {
    static constexpr bool PERM = false, AFTER_DRAIN = false;
    const float* xp; const float* xs; float* out; bf16* xb; int ldb; float* ssq;
    __device__ __forceinline__ void operator()(const f32x4 (&acc)[2][2][4][2], const Unit& u, int wr, int wc, int fr, int fq) const {
        const int row0 = u.pm * 256 + wr * 64 + fr, col0 = u.pn * 256 + wc * 32 + 4 * fq;
#pragma unroll
        for (int ai = 0; ai < 2; ++ai)
#pragma unroll
            for (int m = 0; m < 4; ++m) { const int row = row0 + ai * 128 + m * 16;
                const float* rp = RES_IS_X ? (row < MP ? xp + (size_t)row * D : xs + (size_t)(row - MP) * D) : out + (size_t)row * D;
                float s = 0.f;
#pragma unroll
                for (int bj = 0; bj < 2; ++bj)
#pragma unroll
                    for (int n = 0; n < 2; ++n) { const int col = col0 + bj * 128 + n * 16;
                        const f32x4 r = *(const f32x4*)(rp + col); const f32x4 o = r + acc[ai][bj][m][n];
                        *(f32x4*)(out + (size_t)row * D + col) = o;
                        s += (o[0] * o[0] + o[1] * o[1]) + (o[2] * o[2] + o[3] * o[3]);
                        if (WRITE_BF) { v2u w; w.x = pk2(o[0], o[1]); w.y = pk2(o[2], o[3]); *(v2u*)(xb + (size_t)row * ldb + col) = w; } }
                if (WRITE_SSQ) { s += __shfl_xor(s, 16); s += __shfl_xor(s, 32);
                    if (fq == 0) ssq[(size_t)row * 16 + u.pn * 4 + wc] = s; } }
    }
};
struct EpiUp {
    static constexpr bool PERM = true, AFTER_DRAIN = false;
    bf16* Hd; const float* ssq;
    __device__ __forceinline__ void operator()(const f32x4 (&acc)[2][2][4][2], const Unit& u, int wr, int wc, int fr, int fq) const {
        const int row0 = u.pm * 256 + wr * 64 + fr, col0 = u.pn * 256 + wc * 32 + 8 * fq;
#pragma unroll
        for (int ai = 0; ai < 2; ++ai)
#pragma unroll
            for (int m = 0; m < 4; ++m) { const size_t row = (size_t)(row0 + ai * 128 + m * 16);
                const f32x4* sp = (const f32x4*)(ssq + row * 16); const f32x4 a = sp[0], b = sp[1], c = sp[2], d = sp[3];
                const float tot = ((a[0] + a[1]) + (a[2] + a[3])) + ((b[0] + b[1]) + (b[2] + b[3])) + ((c[0] + c[1]) + (c[2] + c[3])) + ((d[0] + d[1]) + (d[2] + d[3]));
                const float rstd = rsqrtf(tot * (1.0f / D) + NORM_EPS);
#pragma unroll
                for (int bj = 0; bj < 2; ++bj) { const f32x4 v0 = acc[ai][bj][m][0], v1 = acc[ai][bj][m][1];
                    float o[8] = {v0[0], v0[1], v0[2], v0[3], v1[0], v1[1], v1[2], v1[3]};
#pragma unroll
                    for (int e = 0; e < 8; ++e) { const float t = fmaxf(o[e] * rstd, 0.f); o[e] = t * t; }
                    u32x4 w; w.x = pk2(o[0], o[1]); w.y = pk2(o[2], o[3]); w.z = pk2(o[4], o[5]); w.w = pk2(o[6], o[7]);
                    *(u32x4*)(Hd + row * DFF + col0 + bj * 128) = w; } }
    }
};

__device__ __forceinline__ void p0_transpose_item(const float* W, int K, int N, bf16* WT, const float* kscale, LAS float* scr, int item, int lane) {
    const int nblk = N / 32, kb = item / nblk, nb = item % nblk, k0 = 64 * kb, n0 = 32 * nb;
#pragma unroll 8
    for (int i = 0; i < 32; ++i) { const int kk = 2 * i + (lane >> 5); float v = W[(size_t)(k0 + kk) * N + n0 + (lane & 31)]; if (kscale) v *= kscale[k0 + kk]; scr[kk * 33 + (lane & 31)] = v; }
    LDS_WAIT(); asm volatile("" ::: "memory");
    const int c = lane & 7;
#pragma unroll
    for (int j = 0; j < 4; ++j) { const int n = (lane >> 3) + 8 * j; const LAS float* s = scr + (8 * c) * 33 + n;
        v4u o; o.x = pk2(s[0 * 33], s[1 * 33]); o.y = pk2(s[2 * 33], s[3 * 33]); o.z = pk2(s[4 * 33], s[5 * 33]); o.w = pk2(s[6 * 33], s[7 * 33]);
        *(GAS v4u*)(WT + (size_t)(n0 + n) * K + k0 + 8 * c) = o; }
    LDS_WAIT(); asm volatile("" ::: "memory");
}
__device__ __forceinline__ void p0_prologue(const Frame& F, const Args& A) {
    LAS float* scr = (LAS float*)(F.lds + F.wave * 16384);
    const int gw = F.vcu * NWAVES + F.wave, NGW = F.G * NWAVES;
    unsigned char* ws = A.ws;
    constexpr int I_IN = (D / 64) * (NIN / 32), I_A = (AW / 64) * (D / 32), I_O = (D / 64) * (D / 32), I_UP = (D / 64) * (DFF / 32), I_DN = (DFF / 64) * (D / 32);
    constexpr int I_L = 16, I_G = 32;
    constexpr int NITEMS = I_IN + 2 * I_A + I_O + I_UP + I_DN + 2 * I_L + I_G;
    for (int it = gw; it < NITEMS; it += NGW) {
        int r = it;
        if (r < I_IN) { p0_transpose_item(A.in[6], D, NIN, (bf16*)(ws + WS_WIN), nullptr, scr, r, F.lane); continue; } r -= I_IN;
        if (r < I_A) { p0_transpose_item(A.in[20], AW, D, (bf16*)(ws + WS_WA), nullptr, scr, r, F.lane); continue; } r -= I_A;
        if (r < I_A) { p0_transpose_item(A.in[21], BW, D, (bf16*)(ws + WS_WB), nullptr, scr, r, F.lane); continue; } r -= I_A;
        if (r < I_O) { p0_transpose_item(A.in[22], D, D, (bf16*)(ws + WS_WO), nullptr, scr, r, F.lane); continue; } r -= I_O;
        if (r < I_UP) { p0_transpose_item(A.in[24], D, DFF, (bf16*)(ws + WS_WUP), A.in[23], scr, r, F.lane); continue; } r -= I_UP;
        if (r < I_DN) { p0_transpose_item(A.in[25], DFF, D, (bf16*)(ws + WS_WDN), nullptr, scr, r, F.lane); continue; } r -= I_DN;
        if (r < I_L) { p0_transpose_item(A.in[9], 64, BW, (bf16*)(ws + WS_WDT), nullptr, scr, r, F.lane); continue; } r -= I_L;
        if (r < I_L) { p0_transpose_item(A.in[11], 64, BW, (bf16*)(ws + WS_WAT), nullptr, scr, r, F.lane); continue; } r -= I_L;
        p0_transpose_item(A.in[12], 128, BW, (bf16*)(ws + WS_WGT), nullptr, scr, r, F.lane);
    }
    bf16* H = (bf16*)A.out;
    const float* g = A.in[5];
    f32x4 gv[4];
#pragma unroll
    for (int j = 0; j < 4; ++j) gv[j] = ((const f32x4*)g)[F.lane + 64 * j];
    for (int m = gw; m < MH; m += NGW) {
        GAS unsigned long long* o8 = (GAS unsigned long long*)(H + (size_t)m * D) + F.lane;
        if (m < MT) {
            const float* xrow = m < MP ? A.in[0] + (size_t)m * D : A.in[1] + (size_t)(m - MP) * D;
            const f32x4* xr = (const f32x4*)xrow + F.lane;
            f32x4 v[4]; float s = 0.f;
#pragma unroll
            for (int j = 0; j < 4; ++j) { v[j] = xr[64 * j]; s += (v[j][0] * v[j][0] + v[j][1] * v[j][1]) + (v[j][2] * v[j][2] + v[j][3] * v[j][3]); }
            const float rstd = rsqrtf(wave_sum(s) * (1.0f / D) + NORM_EPS);
#pragma unroll
            for (int j = 0; j < 4; ++j) v[j] = v[j] * rstd * gv[j];
#pragma unroll
            for (int j = 0; j < 4; ++j) o8[64 * j] = (unsigned long long)pk2(v[j][0], v[j][1]) | ((unsigned long long)pk2(v[j][2], v[j][3]) << 32);
            float* so = nullptr;
            if (m < MP) { if ((m & (SEQ - 1)) == SEQ - 1) so = A.out + O_SHIFT_P + (size_t)(m >> 11) * D; }
            else { const int s_ = m - MP; if ((s_ & 3) == 3) so = A.out + O_SHIFT_S + (size_t)(s_ >> 2) * D; }
            if (so) {
#pragma unroll
                for (int j = 0; j < 4; ++j) ((f32x4*)so)[F.lane + 64 * j] = v[j];
            }
        } else if (m < MT + NBS) {
            const f32x4* xr = (const f32x4*)(A.in[4] + (size_t)(m - MT) * D) + F.lane;
#pragma unroll
            for (int j = 0; j < 4; ++j) { const f32x4 v = xr[64 * j]; o8[64 * j] = (unsigned long long)pk2(v[0], v[1]) | ((unsigned long long)pk2(v[2], v[3]) << 32); }
        } else {
#pragma unroll
            for (int j = 0; j < 4; ++j) o8[64 * j] = 0ull;
        }
    }
}

__device__ __forceinline__ int prev_row(int row) {
    if (row < MP) return (row & (SEQ - 1)) ? row - 1 : -1;
    const int s = row - MP; return (s & 3) ? row - 1 : MT + (s >> 2);
}
__device__ __forceinline__ float shifted(const bf16* UB, int row, int prow, int col, float mu) {
    const float ub = bf2f(UB[(size_t)row * BCOLS + col]);
    const float up = prow >= 0 ? bf2f(UB[(size_t)prow * BCOLS + col]) : 0.f;
    return ub + (up - ub) * mu;
}

typedef short bf16x8_t __attribute__((ext_vector_type(8)));
typedef short bf16x4_t __attribute__((ext_vector_type(4)));
typedef float f32x16 __attribute__((ext_vector_type(16)));
#define MFMA32(a, b, c) __builtin_amdgcn_mfma_f32_32x32x16_bf16((a), (b), (c), 0, 0, 0)
__device__ __forceinline__ int crow(int reg, int hh) { return (reg & 3) + 8 * (reg >> 2) + 4 * hh; }
__device__ __forceinline__ bf16x8_t pack8(float a0, float a1, float a2, float a3, float a4, float a5, float a6, float a7) {
    v4u p; p.x = pk2(a0, a1); p.y = pk2(a2, a3); p.z = pk2(a4, a5); p.w = pk2(a6, a7); return __builtin_bit_cast(bf16x8_t, p);
}
constexpr int HC = 64;
constexpr int H_TP = 72;
constexpr int H_KP = 136;
constexpr int H_OP = 132;
struct HPre { float b[16], kd[16], blast, bmid; };
__device__ __forceinline__ void hgrn_ld16(const bf16* src, unsigned short (&raw)[16]) {
#pragma unroll
    for (int j = 0; j < 16; ++j) raw[j] = src[(size_t)j * ACOLS];
}
__device__ __forceinline__ void hgrn_pre(const Frame& F, const unsigned short (&fzr)[16], float lbk, LAS float* segsum, HPre& R) {
    const int k = F.tid & 127, seg = F.tid >> 7;
    float run = 0.f;
#pragma unroll
    for (int j = 0; j < 16; ++j) { const float sg = sigmoidf_(bf2f(fzr[j])); R.kd[j] = (1.0f - lbk) * (1.0f - sg); run += __logf(lbk + (1.0f - lbk) * sg); R.b[j] = run; }
    segsum[seg * 128 + k] = run;
    __syncthreads();
    const float s0 = segsum[k], s1 = segsum[128 + k], s2 = segsum[256 + k], s3 = segsum[384 + k];
    const float pre = seg == 0 ? 0.f : (seg == 1 ? s0 : (seg == 2 ? s0 + s1 : s0 + s1 + s2));
#pragma unroll
    for (int j = 0; j < 16; ++j) R.b[j] += pre;
    R.bmid = s0 + s1; R.blast = (s0 + s1) + (s2 + s3);
}
__device__ __forceinline__ void hgrn_store_vt(const Frame& F, const unsigned short (&vr)[16], LAS bf16* VT) {
    const int v = F.tid & 127, seg = F.tid >> 7;
    LAS v4u* d = (LAS v4u*)(VT + v * H_TP + 16 * seg);
    d[0] = (v4u){(unsigned)vr[0] | ((unsigned)vr[1] << 16), (unsigned)vr[2] | ((unsigned)vr[3] << 16), (unsigned)vr[4] | ((unsigned)vr[5] << 16), (unsigned)vr[6] | ((unsigned)vr[7] << 16)};
    d[1] = (v4u){(unsigned)vr[8] | ((unsigned)vr[9] << 16), (unsigned)vr[10] | ((unsigned)vr[11] << 16), (unsigned)vr[12] | ((unsigned)vr[13] << 16), (unsigned)vr[14] | ((unsigned)vr[15] << 16)};
}
__device__ __forceinline__ void h1_unit(const Frame& F, const Args& A, int unit) {
    const bf16* UA = (const bf16*)(A.ws + WS_UA);
    bf16* NS = (bf16*)(A.ws + WS_NS) + (size_t)unit * 16384;
    float* gam = (float*)(A.ws + WS_GAMMA) + (size_t)unit * 128;
    const int bh = unit >> 5, c = unit & 31, b = bh >> 2, h = bh & 3, row0 = b * SEQ + c * HC;
    LAS bf16* KhT = (LAS bf16*)F.lds;
    LAS bf16* VT = KhT + 128 * H_TP;
    LAS float* segsum = (LAS float*)(VT + 128 * H_TP);
    const int k = F.tid & 127, seg = F.tid >> 7;
    const float lbk = 1.0f / (1.0f + __expf(A.in[18][512 + h * 128 + k] - A.in[18][h * 128 + k]));
    unsigned short fzr[16], vr[16];
    { const bf16* rb = UA + (size_t)(row0 + 16 * seg) * ACOLS + h * 128 + k; hgrn_ld16(rb + 512, fzr); hgrn_ld16(rb + 1024, vr); }
    asm volatile("" ::: "memory");
    HPre R; hgrn_pre(F, fzr, lbk, segsum, R);
    {   unsigned w[8];
#pragma unroll
        for (int j = 0; j < 8; ++j) w[j] = pk2(R.kd[2 * j] * __expf(R.blast - R.b[2 * j]), R.kd[2 * j + 1] * __expf(R.blast - R.b[2 * j + 1]));
        LAS v4u* d = (LAS v4u*)(KhT + k * H_TP + 16 * seg);
        d[0] = (v4u){w[0], w[1], w[2], w[3]}; d[1] = (v4u){w[4], w[5], w[6], w[7]}; }
    if (seg == 0) gam[k] = __expf(R.blast);
    hgrn_store_vt(F, vr, VT);
    __syncthreads();
    const int r = F.lane & 31, hh = F.lane >> 5, vt = F.wave >> 1, kt0 = (F.wave & 1) * 2;
    f32x16 acc0, acc1;
#pragma unroll
    for (int i = 0; i < 16; ++i) { acc0[i] = 0.f; acc1[i] = 0.f; }
#pragma unroll
    for (int s = 0; s < 4; ++s) {
        const bf16x8_t a = *(const LAS bf16x8_t*)(VT + (vt * 32 + r) * H_TP + 16 * s + 8 * hh);
        const bf16x8_t b0 = *(const LAS bf16x8_t*)(KhT + (kt0 * 32 + r) * H_TP + 16 * s + 8 * hh);
        const bf16x8_t b1 = *(const LAS bf16x8_t*)(KhT + ((kt0 + 1) * 32 + r) * H_TP + 16 * s + 8 * hh);
        acc0 = MFMA32(a, b0, acc0); acc1 = MFMA32(a, b1, acc1);
    }
#pragma unroll
    for (int i = 0; i < 16; ++i) { const int v = vt * 32 + crow(i, hh);
        NS[v * 128 + kt0 * 32 + r] = (bf16)f2bf(acc0[i]); NS[v * 128 + (kt0 + 1) * 32 + r] = (bf16)f2bf(acc1[i]); }
    __syncthreads();
}
__device__ __forceinline__ void h2_part(const Frame& F, const Args& A, int start, int stride) {
    bf16* NS = (bf16*)(A.ws + WS_NS);
    const float* gam = (const float*)(A.ws + WS_GAMMA);
    for (int e = start; e < 32 * 2048; e += stride) {
        const int bh = e >> 11, vk = e & 2047, v = vk >> 4, k0 = (vk & 15) * 8;
        float S[8];
#pragma unroll
        for (int j = 0; j < 8; ++j) S[j] = 0.f;
        for (int c0 = 0; c0 < 32; c0 += 8) {
            v4u n[8]; f32x4 g0[8], g1[8];
#pragma unroll
            for (int u = 0; u < 8; ++u) { const size_t un = (size_t)(bh * 32 + c0 + u);
                n[u] = *(const v4u*)(NS + un * 16384 + v * 128 + k0); g0[u] = *(const f32x4*)(gam + un * 128 + k0); g1[u] = *(const f32x4*)(gam + un * 128 + k0 + 4); }
#pragma unroll
            for (int u = 0; u < 8; ++u) {
                v4u o; o.x = pk2(S[0], S[1]); o.y = pk2(S[2], S[3]); o.z = pk2(S[4], S[5]); o.w = pk2(S[6], S[7]);
                *(v4u*)(NS + (size_t)(bh * 32 + c0 + u) * 16384 + v * 128 + k0) = o;
                S[0] = g0[u][0] * S[0] + bflo(n[u].x); S[1] = g0[u][1] * S[1] + bfhi(n[u].x); S[2] = g0[u][2] * S[2] + bflo(n[u].y); S[3] = g0[u][3] * S[3] + bfhi(n[u].y);
                S[4] = g1[u][0] * S[4] + bflo(n[u].z); S[5] = g1[u][1] * S[5] + bfhi(n[u].z); S[6] = g1[u][2] * S[6] + bflo(n[u].w); S[7] = g1[u][3] * S[7] + bfhi(n[u].w);
            }
        }
        float* so = A.out + O_HGRN_P + (size_t)bh * 16384 + v;
#pragma unroll
        for (int j = 0; j < 8; ++j) so[(size_t)(k0 + j) * 128] = S[j];
    }
}
__device__ __forceinline__ void h3_unit(const Frame& F, const Args& A, int unit) {
    bf16* UA = (bf16*)(A.ws + WS_UA);
    const bf16* NS = (const bf16*)(A.ws + WS_NS) + (size_t)unit * 16384;
    const int bh = unit >> 5, c = unit & 31, b = bh >> 2, h = bh & 3, row0 = b * SEQ + c * HC;
    LAS bf16* Qh = (LAS bf16*)F.lds;
    LAS bf16* Qt = Qh + 64 * H_KP;
    LAS bf16* Kt = Qt + 64 * H_KP;
    LAS bf16* VT = Kt + 64 * H_KP;
    LAS float* segsum = (LAS float*)(VT + 128 * H_TP);
    LAS float* ssq = segsum + 512;
    LAS float* Ost = ssq + 256;
    const int k = F.tid & 127, seg = F.tid >> 7;
    const float lbk = 1.0f / (1.0f + __expf(A.in[18][512 + h * 128 + k] - A.in[18][h * 128 + k]));
    unsigned short fzr[16], qr[16], vr[16];
    { const bf16* rb = UA + (size_t)(row0 + 16 * seg) * ACOLS + h * 128 + k; hgrn_ld16(rb + 512, fzr); hgrn_ld16(rb, qr); hgrn_ld16(rb + 1024, vr); }
    asm volatile("" ::: "memory");
    HPre R; hgrn_pre(F, fzr, lbk, segsum, R);
    {
#pragma unroll
        for (int j = 0; j < 16; ++j) { const float q = bf2f(qr[j]); const float qs = q * sigmoidf_(q); const int t = 16 * seg + j;
            Qh[t * H_KP + k] = (bf16)f2bf(qs * __expf(R.b[j]));
            Qt[t * H_KP + k] = (bf16)f2bf(qs * __expf(R.b[j] - R.bmid));
            Kt[t * H_KP + k] = (bf16)f2bf(R.kd[j] * __expf(R.bmid - R.b[j])); } }
    hgrn_store_vt(F, vr, VT);
    __syncthreads();
    const int r = F.lane & 31, hh = F.lane >> 5, vt = F.wave >> 1, tt = F.wave & 1;
    f32x16 o;
#pragma unroll
    for (int i = 0; i < 16; ++i) o[i] = 0.f;
#pragma unroll
    for (int st = 0; st < 2; ++st) {
        if (st <= tt) {
            f32x16 at;
#pragma unroll
            for (int i = 0; i < 16; ++i) at[i] = 0.f;
#pragma unroll
            for (int ks = 0; ks < 8; ++ks) {
                const bf16x8_t a = *(const LAS bf16x8_t*)(Kt + (st * 32 + r) * H_KP + 16 * ks + 8 * hh);
                const bf16x8_t bq = *(const LAS bf16x8_t*)(Qt + (tt * 32 + r) * H_KP + 16 * ks + 8 * hh);
                at = MFMA32(a, bq, at);
            }
            if (st == tt) {
#pragma unroll
                for (int i = 0; i < 16; ++i) if (crow(i, hh) > r) at[i] = 0.f;
            }
#pragma unroll
            for (int ks = 0; ks < 2; ++ks) {
                const bf16x4_t lo = *(const LAS bf16x4_t*)(VT + (vt * 32 + r) * H_TP + st * 32 + 16 * ks + 4 * hh);
                const bf16x4_t hi = *(const LAS bf16x4_t*)(VT + (vt * 32 + r) * H_TP + st * 32 + 16 * ks + 8 + 4 * hh);
                const bf16x8_t a = __builtin_shufflevector(lo, hi, 0, 1, 2, 3, 4, 5, 6, 7);
                const bf16x8_t bx = pack8(at[8 * ks], at[8 * ks + 1], at[8 * ks + 2], at[8 * ks + 3], at[8 * ks + 4], at[8 * ks + 5], at[8 * ks + 6], at[8 * ks + 7]);
                o = MFMA32(a, bx, o);
            }
        }
    }
    if (c > 0) {
#pragma unroll
        for (int ks = 0; ks < 8; ++ks) {
            const bf16x8_t a = *(const bf16x8_t*)(NS + (vt * 32 + r) * 128 + 16 * ks + 8 * hh);
            const bf16x8_t bq = *(const LAS bf16x8_t*)(Qh + (tt * 32 + r) * H_KP + 16 * ks + 8 * hh);
            o = MFMA32(a, bq, o);
        }
    }
    {   float s = 0.f;
#pragma unroll
        for (int i = 0; i < 16; ++i) { s += o[i] * o[i]; Ost[(tt * 32 + r) * H_OP + vt * 32 + crow(i, hh)] = o[i]; }
        s += __shfl_xor(s, 32);
        if (hh == 0) ssq[vt * 64 + tt * 32 + r] = s; }
    __syncthreads();
    {   const int t = F.tid >> 3, vg = F.tid & 7, row = row0 + t;
        const float tot = (ssq[t] + ssq[64 + t]) + (ssq[128 + t] + ssq[192 + t]);
        const float rs = rsqrtf(tot * (1.0f / 128.0f) + HGRN_EPS);
        const LAS f32x4* op = (const LAS f32x4*)(Ost + t * H_OP + 16 * vg);
        const v4u* gp = (const v4u*)(UA + (size_t)row * ACOLS + 1536 + h * 128 + 16 * vg);
        const f32x4* nwp = (const f32x4*)(A.in[19] + h * 128 + 16 * vg);
        v4u outw[2];
#pragma unroll
        for (int half = 0; half < 2; ++half) {
            const v4u g = gp[half]; const f32x4 o0 = op[2 * half], o1 = op[2 * half + 1], n0 = nwp[2 * half], n1 = nwp[2 * half + 1];
            const float gg[8] = {bflo(g.x), bfhi(g.x), bflo(g.y), bfhi(g.y), bflo(g.z), bfhi(g.z), bflo(g.w), bfhi(g.w)};
            const float ov[8] = {o0[0] * n0[0], o0[1] * n0[1], o0[2] * n0[2], o0[3] * n0[3], o1[0] * n1[0], o1[1] * n1[1], o1[2] * n1[2], o1[3] * n1[3]};
            float f[8];
#pragma unroll
            for (int e = 0; e < 8; ++e) f[e] = ov[e] * rs * (gg[e] * sigmoidf_(gg[e]));
            outw[half] = (v4u){pk2(f[0], f[1]), pk2(f[2], f[3]), pk2(f[4], f[5]), pk2(f[6], f[7])};
        }
        v4u* dst = (v4u*)(UA + (size_t)row * ACOLS + 1024 + h * 128 + 16 * vg);
        dst[0] = outw[0]; dst[1] = outw[1]; }
    __syncthreads();
}
__device__ __forceinline__ void hgrn_sample_unit(const Frame& F, const Args& A, int bh) {
    bf16* UA = (bf16*)(A.ws + WS_UA);
    const int b = bh >> 2, h = bh & 3, row0 = MP + 4 * b;
    LAS float* vec = (LAS float*)F.lds;
    LAS float* opart = vec + 4 * 384;
    LAS float* red = opart + 2048;
    const int v = F.tid & 127, kq = F.tid >> 7;
    {   const int t = kq, k = v, ch = h * 128 + k;
        const float lbk = 1.0f / (1.0f + __expf(A.in[18][512 + ch] - A.in[18][ch]));
        const float sg = sigmoidf_(bf2f(UA[(size_t)(row0 + t) * ACOLS + 512 + ch])), q = bf2f(UA[(size_t)(row0 + t) * ACOLS + ch]);
        vec[t * 384 + k] = lbk + (1.0f - lbk) * sg; vec[t * 384 + 128 + k] = (1.0f - lbk) * (1.0f - sg); vec[t * 384 + 256 + k] = q * sigmoidf_(q); }
    float iv[4];
#pragma unroll
    for (int t = 0; t < 4; ++t) iv[t] = bf2f(UA[(size_t)(row0 + t) * ACOLS + 1024 + h * 128 + v]);
    const float* sin_ = A.in[2] + (size_t)bh * 16384 + (size_t)(32 * kq) * 128 + v;
    float S[32];
#pragma unroll
    for (int j = 0; j < 32; ++j) S[j] = sin_[(size_t)j * 128];
    __syncthreads();
#pragma unroll
    for (int t = 0; t < 4; ++t) {
        const LAS float* fv = vec + t * 384 + 32 * kq;
        float o = 0.f;
#pragma unroll
        for (int j4 = 0; j4 < 8; ++j4) { const f32x4 f = *(const LAS f32x4*)(fv + 4 * j4), d = *(const LAS f32x4*)(fv + 128 + 4 * j4), q = *(const LAS f32x4*)(fv + 256 + 4 * j4);
#pragma unroll
            for (int e = 0; e < 4; ++e) { S[4 * j4 + e] = f[e] * S[4 * j4 + e] + d[e] * iv[t]; o += S[4 * j4 + e] * q[e]; } }
        opart[(t * 4 + kq) * 128 + v] = o;
    }
    float* sout = A.out + O_HGRN_S + (size_t)bh * 16384 + (size_t)(32 * kq) * 128 + v;
#pragma unroll
    for (int j = 0; j < 32; ++j) sout[(size_t)j * 128] = S[j];
    __syncthreads();
    {   const int t = kq;
        const float o = (opart[(t * 4 + 0) * 128 + v] + opart[(t * 4 + 1) * 128 + v]) + (opart[(t * 4 + 2) * 128 + v] + opart[(t * 4 + 3) * 128 + v]);
        const float ss = wave_sum(o * o);
        if (F.lane == 0) red[F.wave] = ss;
        __syncthreads();
        const float tot = red[F.wave & ~1] + red[F.wave | 1];
        const int ch = h * 128 + v; const size_t row = (size_t)(row0 + t);
        const float g = bf2f(UA[row * ACOLS + 1536 + ch]);
        UA[row * ACOLS + 1024 + ch] = (bf16)f2bf(o * rsqrtf(tot * (1.0f / 128.0f) + HGRN_EPS) * A.in[19][ch] * (g * sigmoidf_(g))); }
    __syncthreads();
}


typedef float f32x4_t __attribute__((ext_vector_type(4)));
#define MFMA16(a, b, c) __builtin_amdgcn_mfma_f32_16x16x32_bf16((a), (b), (c), 0, 0, 0)
constexpr int RC = 32;
constexpr int R_TP = 72;
constexpr int R_CP = 40;
constexpr int RL_A = 0;
constexpr int RL_B = RL_A + 9216;
constexpr int RL_C = RL_B + 16384;
constexpr int RL_D = RL_C + 9216;
constexpr int RL_E = RL_D + 18432;
constexpr int RL_F = RL_E + 20480;
constexpr int RL_UNIT = RL_F + 512;
constexpr int RL_PAR = 2 * RL_UNIT;
static_assert(RL_PAR + 5 * 512 * 4 <= RING_BYTES, "two R1 units + parameters in LDS");
__device__ __forceinline__ float red8(float x) {
    x += __builtin_bit_cast(float, __builtin_amdgcn_update_dpp(0, __builtin_bit_cast(int, x), 0xB1, 0xF, 0xF, true));
    x += __builtin_bit_cast(float, __builtin_amdgcn_update_dpp(0, __builtin_bit_cast(int, x), 0x4E, 0xF, 0xF, true));
    x += __builtin_bit_cast(float, __builtin_amdgcn_update_dpp(0, __builtin_bit_cast(int, x), 0x141, 0xF, 0xF, true));
    return x;
}
__device__ __forceinline__ void unpack8(const v4u w, float (&o)[8]) { o[0] = bflo(w.x); o[1] = bfhi(w.x); o[2] = bflo(w.y); o[3] = bfhi(w.y); o[4] = bflo(w.z); o[5] = bfhi(w.z); o[6] = bflo(w.w); o[7] = bfhi(w.w); }
__device__ __forceinline__ v4u packw8(const float (&f)[8]) { return (v4u){pk2(f[0], f[1]), pk2(f[2], f[3]), pk2(f[4], f[5]), pk2(f[6], f[7])}; }

__device__ __forceinline__ void r1_pass(const Frame& F, const Args& A, int unit, bool active) {
    bf16* UB = (bf16*)(A.ws + WS_UB);
    const bf16* BR = (const bf16*)(A.out + O_HGRN_S);
    const bf16* Wdt = (const bf16*)(A.ws + WS_WDT); const bf16* Wat = (const bf16*)(A.ws + WS_WAT);
    float* bonus = (float*)(A.ws + WS_BONUS);
    const int sub = F.wave >> 2, w4 = F.wave & 3, tid4 = F.tid & 255, r = F.lane & 31, hh = F.lane >> 5;
    LAS unsigned char* L = F.lds + sub * RL_UNIT;
    LAS bf16* AWs = (LAS bf16*)(L + RL_A); LAS bf16* AAs = AWs + 32 * R_TP;
    LAS bf16* Bm = (LAS bf16*)(L + RL_A); LAS bf16* RAm = Bm + 32 * R_CP; LAS bf16* RKm = RAm + 32 * R_CP;
    LAS float* DEC = (LAS float*)(L + RL_B); LAS float* AAo = DEC + 32 * 64;
    LAS float* BVf = (LAS float*)(L + RL_B); LAS float* Af = BVf + 32 * 64;
    LAS float* CUM = (LAS float*)(L + RL_C); LAS float* SEG = CUM + 32 * 64;
    LAS bf16* Kt = (LAS bf16*)(L + RL_D); LAS bf16* Ah = Kt + 32 * R_TP; LAS bf16* Kh = Ah + 32 * R_TP; LAS bf16* Rt = Kh + 32 * R_TP;
    LAS bf16* KbT = (LAS bf16*)(L + RL_D); LAS bf16* VbT = KbT + 64 * R_CP;
    LAS bf16* KtT = (LAS bf16*)(L + RL_E); LAS bf16* AcT = KtT + 64 * R_CP; LAS bf16* KcT = AcT + 64 * R_CP; LAS bf16* VT = KcT + 64 * R_CP;
    LAS float* GC = (LAS float*)(L + RL_F); LAS float* CL = GC + 64;
    const LAS float* PAR = (const LAS float*)(F.lds + RL_PAR);
    const int b = unit >> 9, h = (unit >> 6) & 7, c = unit & 63, row0 = b * SEQ + c * RC;
    unsigned char* mn = (unsigned char*)A.out + (size_t)unit * 16384;
    const int t = tid4 >> 3, jg = tid4 & 7, row = row0 + t;
    float xr[8], xk[8], xv[8];
    if (active) {
        const float* mu = A.in[7];
        const int cols[5] = {h * 64 + 8 * jg, 512 + h * 64 + 8 * jg, 1024 + h * 64 + 8 * jg, 1536 + 8 * jg, 1600 + 8 * jg};
        float x5[5][8];
#pragma unroll
        for (int q = 0; q < 5; ++q) {
            float cur[8], prv[8];
            unpack8(*(const v4u*)(UB + (size_t)row * BCOLS + cols[q]), cur);
            v4u pw = (v4u){0, 0, 0, 0};
            if (t > 0 || q >= 3) { if (t > 0 || c > 0) pw = *(const v4u*)(UB + (size_t)(row - 1) * BCOLS + cols[q]); }
            else if (c > 0) pw = *(const v4u*)(BR + (size_t)(b * 64 + c - 1) * 1536 + cols[q]);
            unpack8(pw, prv);
            const f32x4 m0 = *(const f32x4*)(mu + cols[q]), m1 = *(const f32x4*)(mu + cols[q] + 4);
#pragma unroll
            for (int e = 0; e < 8; ++e) x5[q][e] = cur[e] + (prv[e] - cur[e]) * (e < 4 ? m0[e] : m1[e - 4]);
        }
#pragma unroll
        for (int e = 0; e < 8; ++e) { xr[e] = x5[0][e]; xk[e] = x5[1][e]; xv[e] = x5[2][e]; x5[3][e] = tanhf_(x5[3][e]); }
        *(LAS v4u*)(AWs + t * R_TP + 8 * jg) = packw8(x5[3]);
        *(LAS v4u*)(AAs + t * R_TP + 8 * jg) = packw8(x5[4]);
    }
    __syncthreads();
    if (active) {
        const int which = w4 >> 1, jt = w4 & 1;
        const LAS bf16* As = which ? AAs : AWs; const bf16* Wt = (which ? Wat : Wdt) + (size_t)(h * 64 + jt * 32 + r) * 64;
        f32x16 acc;
#pragma unroll
        for (int i = 0; i < 16; ++i) acc[i] = 0.f;
#pragma unroll
        for (int s = 0; s < 4; ++s) acc = MFMA32(*(const LAS bf16x8_t*)(As + r * R_TP + 16 * s + 8 * hh), *(const bf16x8_t*)(Wt + 16 * s + 8 * hh), acc);
        LAS float* O = which ? AAo : DEC;
#pragma unroll
        for (int i = 0; i < 16; ++i) O[crow(i, hh) * 64 + jt * 32 + r] = acc[i];
    }
    __syncthreads();
    float lw[8], kk[8], al[8], k2[8];
    if (active) {
        const int ch = h * 64 + 8 * jg;
        float dec[8], aa[8];
        { const f32x4 d0 = *(const LAS f32x4*)(DEC + t * 64 + 8 * jg), d1 = *(const LAS f32x4*)(DEC + t * 64 + 8 * jg + 4), a0 = *(const LAS f32x4*)(AAo + t * 64 + 8 * jg), a1 = *(const LAS f32x4*)(AAo + t * 64 + 8 * jg + 4);
#pragma unroll
          for (int e = 0; e < 4; ++e) { dec[e] = d0[e]; dec[4 + e] = d1[e]; aa[e] = a0[e]; aa[4 + e] = a1[e]; } }
        float n2 = 0.f, bs = 0.f, kp[8], av[8];
#pragma unroll
        for (int e = 0; e < 8; ++e) {
            lw[e] = -DECAY_SCALE * sigmoidf_(PAR[ch + e] + dec[e]);
            av[e] = sigmoidf_(PAR[512 + ch + e] + aa[e]);
            kp[e] = xk[e] * PAR[1024 + ch + e]; n2 += kp[e] * kp[e];
            k2[e] = xk[e] * (1.0f + (av[e] - 1.0f) * PAR[1536 + ch + e]);
            bs += xr[e] * k2[e] * PAR[2048 + ch + e];
        }
        n2 = red8(n2); bs = red8(bs);
        const float inv = 1.0f / fmaxf(sqrtf(n2), 1e-12f);
#pragma unroll
        for (int e = 0; e < 8; ++e) { kk[e] = kp[e] * inv; al[e] = kk[e] * av[e]; }
        if (jg == 0) bonus[(size_t)row * 8 + h] = bs;
        *(LAS f32x4*)(CUM + t * 64 + 8 * jg) = (f32x4){lw[0], lw[1], lw[2], lw[3]};
        *(LAS f32x4*)(CUM + t * 64 + 8 * jg + 4) = (f32x4){lw[4], lw[5], lw[6], lw[7]};
    }
    __syncthreads();
    {
        const int j = tid4 & 63, seg = tid4 >> 6;
        float v8[8], run = 0.f;
        if (active) {
#pragma unroll
            for (int e = 0; e < 8; ++e) { run += CUM[(8 * seg + e) * 64 + j]; v8[e] = run; }
            SEG[seg * 64 + j] = run;
        }
        __syncthreads();
        if (active) {
            const float s0 = SEG[j], s1 = SEG[64 + j], s2 = SEG[128 + j], s3 = SEG[192 + j];
            const float pre = seg == 0 ? 0.f : (seg == 1 ? s0 : (seg == 2 ? s0 + s1 : s0 + s1 + s2));
#pragma unroll
            for (int e = 0; e < 8; ++e) CUM[(8 * seg + e) * 64 + j] = v8[e] + pre;
            if (seg == 0) { const float tot = (s0 + s1) + (s2 + s3); CL[j] = tot; GC[j] = __expf(tot); }
        }
    }
    __syncthreads();
    if (active) {
        float cum[8], cl[8];
        { const f32x4 c0 = *(const LAS f32x4*)(CUM + t * 64 + 8 * jg), c1 = *(const LAS f32x4*)(CUM + t * 64 + 8 * jg + 4), l0 = *(const LAS f32x4*)(CL + 8 * jg), l1 = *(const LAS f32x4*)(CL + 8 * jg + 4);
#pragma unroll
          for (int e = 0; e < 4; ++e) { cum[e] = c0[e]; cum[4 + e] = c1[e]; cl[e] = l0[e]; cl[4 + e] = l1[e]; } }
        float fKt[8], fAh[8], fKh[8], fRt[8];
#pragma unroll
        for (int e = 0; e < 8; ++e) {
            const float gt = __expf(cum[e]), gm1 = __expf(cum[e] - lw[e]), gi = __expf(-cum[e]), gc = __expf(cl[e] - cum[e]);
            fKt[e] = kk[e] * gm1; fAh[e] = al[e] * gi; fKh[e] = k2[e] * gi; fRt[e] = xr[e] * gt;
            const int j = 8 * jg + e;
            KtT[j * R_CP + t] = (bf16)f2bf(fKt[e]); AcT[j * R_CP + t] = (bf16)f2bf(al[e] * gc); KcT[j * R_CP + t] = (bf16)f2bf(k2[e] * gc); VT[j * R_CP + t] = (bf16)f2bf(xv[e]);
        }
        *(LAS v4u*)(Kt + t * R_TP + 8 * jg) = packw8(fKt); *(LAS v4u*)(Ah + t * R_TP + 8 * jg) = packw8(fAh);
        *(LAS v4u*)(Kh + t * R_TP + 8 * jg) = packw8(fKh); *(LAS v4u*)(Rt + t * R_TP + 8 * jg) = packw8(fRt);
        *(v4u*)(UB + (size_t)row * BCOLS + 1024 + h * 64 + 8 * jg) = packw8(xv);
    }
    __syncthreads();
    LAS bf16* BVT = (LAS bf16*)(L + RL_B);
    LAS bf16* QA = BVT + 64 * R_CP; LAS bf16* QT = QA + 32 * R_CP; LAS bf16* PP = QT + 32 * R_CP; LAS bf16* TT = PP + 32 * R_CP;
    f32x16 pacc;
    if (active) {
        const LAS bf16* Ls = (w4 < 2) ? Kt : Rt; const LAS bf16* Rs = (w4 & 1) ? Kh : Ah;
        f32x16 acc;
#pragma unroll
        for (int i = 0; i < 16; ++i) acc[i] = 0.f;
#pragma unroll
        for (int s = 0; s < 4; ++s) acc = MFMA32(*(const LAS bf16x8_t*)(Ls + r * R_TP + 16 * s + 8 * hh), *(const LAS bf16x8_t*)(Rs + r * R_TP + 16 * s + 8 * hh), acc);
#pragma unroll
        for (int i = 0; i < 16; ++i) { const int tt = crow(i, hh); const bool keep = (w4 < 2) ? (r < tt) : (r <= tt); acc[i] = keep ? acc[i] : 0.f; }
        if (w4 == 0) {
#pragma unroll
            for (int i = 0; i < 16; ++i) { const int tt = crow(i, hh); pacc[i] = (tt == r ? 1.0f : 0.0f) - acc[i]; QA[tt * R_CP + r] = (bf16)f2bf(acc[i]); PP[tt * R_CP + r] = (bf16)f2bf(pacc[i]); }
#pragma unroll
            for (int g = 0; g < 4; ++g) { v2u w; w.x = pk2(acc[4 * g], acc[4 * g + 1]); w.y = pk2(acc[4 * g + 2], acc[4 * g + 3]); *(LAS v2u*)(QT + r * R_CP + 8 * g + 4 * hh) = w; }
        } else {
            LAS bf16* O = w4 == 1 ? Bm : (w4 == 2 ? RAm : RKm);
#pragma unroll
            for (int i = 0; i < 16; ++i) O[crow(i, hh) * R_CP + r] = (bf16)f2bf(acc[i]);
        }
    }
    __syncthreads();
    if (active && w4 == 0) {
#pragma unroll
        for (int st = 0; st < 5; ++st) {
            asm volatile("s_waitcnt lgkmcnt(0)" ::: "memory");
            const bf16x8_t qt0 = *(const LAS bf16x8_t*)(QT + r * R_CP + 8 * hh), qt1 = *(const LAS bf16x8_t*)(QT + r * R_CP + 16 + 8 * hh);
            if (st > 0) { const bf16x8_t p0 = *(const LAS bf16x8_t*)(PP + r * R_CP + 8 * hh), p1 = *(const LAS bf16x8_t*)(PP + r * R_CP + 16 + 8 * hh);
                pacc = MFMA32(p0, qt0, pacc); pacc = MFMA32(p1, qt1, pacc); }
            if (st < 4) {
                const bf16x8_t q0 = *(const LAS bf16x8_t*)(QA + r * R_CP + 8 * hh), q1 = *(const LAS bf16x8_t*)(QA + r * R_CP + 16 + 8 * hh);
                f32x16 qacc;
#pragma unroll
                for (int i = 0; i < 16; ++i) qacc[i] = 0.f;
                qacc = MFMA32(q0, qt0, qacc); qacc = MFMA32(q1, qt1, qacc);
#pragma unroll
                for (int i = 0; i < 16; ++i) QA[crow(i, hh) * R_CP + r] = (bf16)f2bf(qacc[i]);
#pragma unroll
                for (int g = 0; g < 4; ++g) { v2u w; w.x = pk2(qacc[4 * g], qacc[4 * g + 1]); w.y = pk2(qacc[4 * g + 2], qacc[4 * g + 3]); *(LAS v2u*)(QT + r * R_CP + 8 * g + 4 * hh) = w; }
            }
            if (st > 0 && st < 4) {
#pragma unroll
                for (int i = 0; i < 16; ++i) PP[crow(i, hh) * R_CP + r] = (bf16)f2bf(pacc[i]);
            }
        }
#pragma unroll
        for (int i = 0; i < 16; ++i) TT[crow(i, hh) * R_CP + r] = (bf16)f2bf(pacc[i]);
    }
    if (active && (w4 == 1 || w4 == 2)) {
        const int it = w4 - 1;
        f32x16 acc;
#pragma unroll
        for (int i = 0; i < 16; ++i) acc[i] = 0.f;
#pragma unroll
        for (int s = 0; s < 2; ++s) acc = MFMA32(*(const LAS bf16x8_t*)(Bm + r * R_CP + 16 * s + 8 * hh), *(const LAS bf16x8_t*)(VT + (it * 32 + r) * R_CP + 16 * s + 8 * hh), acc);
#pragma unroll
        for (int g = 0; g < 4; ++g) { v2u w; w.x = pk2(acc[4 * g], acc[4 * g + 1]); w.y = pk2(acc[4 * g + 2], acc[4 * g + 3]); *(LAS v2u*)(BVT + (it * 32 + r) * R_CP + 8 * g + 4 * hh) = w; }
    }
    __syncthreads();
    if (active) {
        const LAS bf16* Asrc = (w4 < 2 ? KtT : BVT) + ((w4 & 1) * 32 + r) * R_CP;
        f32x16 acc;
#pragma unroll
        for (int i = 0; i < 16; ++i) acc[i] = 0.f;
#pragma unroll
        for (int s = 0; s < 2; ++s) acc = MFMA32(*(const LAS bf16x8_t*)(Asrc + 16 * s + 8 * hh), *(const LAS bf16x8_t*)(TT + r * R_CP + 16 * s + 8 * hh), acc);
        LAS bf16* O = (w4 < 2 ? KbT : VbT) + (w4 & 1) * 32 * R_CP;
#pragma unroll
        for (int i = 0; i < 16; ++i) O[crow(i, hh) * R_CP + r] = (bf16)f2bf(-acc[i]);
    }
    __syncthreads();
    if (active) {
        const int jt = w4 >> 1, ct = w4 & 1;
        f32x16 am, an;
#pragma unroll
        for (int i = 0; i < 16; ++i) { am[i] = 0.f; an[i] = 0.f; }
#pragma unroll
        for (int s = 0; s < 2; ++s) {
            const bf16x8_t a_ac = *(const LAS bf16x8_t*)(AcT + (jt * 32 + r) * R_CP + 16 * s + 8 * hh), a_kc = *(const LAS bf16x8_t*)(KcT + (jt * 32 + r) * R_CP + 16 * s + 8 * hh);
            am = MFMA32(a_ac, *(const LAS bf16x8_t*)(KbT + (ct * 32 + r) * R_CP + 16 * s + 8 * hh), am);
            an = MFMA32(a_kc, *(const LAS bf16x8_t*)(VT + (ct * 32 + r) * R_CP + 16 * s + 8 * hh), an);
            an = MFMA32(a_ac, *(const LAS bf16x8_t*)(VbT + (ct * 32 + r) * R_CP + 16 * s + 8 * hh), an);
        }
        LAS bf16* Mp = (LAS bf16*)(L + RL_B); LAS bf16* Np = Mp + 4096;
        LAS bf16* RYs = (LAS bf16*)(L + RL_C);
        const int cj = ct * 32 + r;
#pragma unroll
        for (int i = 0; i < 16; ++i) {
            const int j = jt * 32 + crow(i, hh);
            float mv = am[i]; if (j == cj) mv += GC[j];
            const int s2 = cj >> 5, rem = cj & 31, e = 4 * (rem >> 4) + (rem & 3), q = (rem >> 2) & 3;
            Mp[j * 64 + s2 * 32 + q * 8 + e] = (bf16)f2bf(mv);
            Np[cj * 64 + ((j >> 2) & 3) * 16 + (j >> 4) * 4 + (j & 3)] = (bf16)f2bf(an[i]);
        }
        f32x16 ay;
        if (w4 < 2) {
#pragma unroll
            for (int i = 0; i < 16; ++i) ay[i] = bf2f(Rt[crow(i, hh) * R_TP + w4 * 32 + r]);
#pragma unroll
            for (int s = 0; s < 2; ++s) ay = MFMA32(*(const LAS bf16x8_t*)(RAm + r * R_CP + 16 * s + 8 * hh), *(const LAS bf16x8_t*)(KbT + (w4 * 32 + r) * R_CP + 16 * s + 8 * hh), ay);
#pragma unroll
            for (int i = 0; i < 16; ++i) RYs[crow(i, hh) * 64 + w4 * 32 + r] = (bf16)f2bf(ay[i]);
        } else {
            const int it = w4 - 2;
#pragma unroll
            for (int i = 0; i < 16; ++i) ay[i] = 0.f;
#pragma unroll
            for (int s = 0; s < 2; ++s) {
                ay = MFMA32(*(const LAS bf16x8_t*)(RKm + r * R_CP + 16 * s + 8 * hh), *(const LAS bf16x8_t*)(VT + (it * 32 + r) * R_CP + 16 * s + 8 * hh), ay);
                ay = MFMA32(*(const LAS bf16x8_t*)(RAm + r * R_CP + 16 * s + 8 * hh), *(const LAS bf16x8_t*)(VbT + (it * 32 + r) * R_CP + 16 * s + 8 * hh), ay);
            }
#pragma unroll
            for (int i = 0; i < 16; ++i) RYs[2048 + crow(i, hh) * 64 + it * 32 + r] = (bf16)f2bf(ay[i]);
        }
    }
    __syncthreads();
    if (active) {
        const LAS v4u* src = (const LAS v4u*)(L + RL_B);
#pragma unroll
        for (int q = 0; q < 4; ++q) ((v4u*)mn)[tid4 + 256 * q] = src[tid4 + 256 * q];
        const LAS v4u* ry = (const LAS v4u*)(L + RL_C);
        const int tr = tid4 >> 3, pc = tid4 & 7;
        *(v4u*)(UB + (size_t)(row0 + tr) * BCOLS + h * 64 + 8 * pc) = ry[tr * 8 + pc];
        *(v4u*)(UB + (size_t)(row0 + tr) * BCOLS + 512 + h * 64 + 8 * pc) = ry[256 + tr * 8 + pc];
    }
    __syncthreads();
}

__device__ __forceinline__ void r2_wave(const Frame& F, const Args& A, int bh, int wq) {
    const int m = F.lane & 15, q = F.lane >> 4, i = 16 * wq + m;
    f32x4_t acc[4];
#pragma unroll
    for (int jt = 0; jt < 4; ++jt) acc[jt] = (f32x4_t){0.f, 0.f, 0.f, 0.f};
    unsigned char* base = (unsigned char*)A.out + (size_t)bh * 64 * 16384;
    v4u Mf[3][8], Nf[3][2];
#define R2_LOAD(buf, c) do { const unsigned char* u_ = base + (size_t)(c) * 16384; \
        _Pragma("unroll") for (int jt = 0; jt < 4; ++jt) _Pragma("unroll") for (int s2 = 0; s2 < 2; ++s2) Mf[buf][2 * jt + s2] = *(const v4u*)(u_ + ((16 * jt + m) * 64 + s2 * 32 + q * 8) * 2); \
        Nf[buf][0] = *(const v4u*)(u_ + 8192 + (i * 64 + q * 16) * 2); Nf[buf][1] = *(const v4u*)(u_ + 8192 + (i * 64 + q * 16 + 8) * 2); } while (0)
#define R2_STEP(u, c) do { \
            const bf16x8_t b0 = pack8(acc[0][0], acc[0][1], acc[0][2], acc[0][3], acc[1][0], acc[1][1], acc[1][2], acc[1][3]); \
            const bf16x8_t b1 = pack8(acc[2][0], acc[2][1], acc[2][2], acc[2][3], acc[3][0], acc[3][1], acc[3][2], acc[3][3]); \
            float nf[16]; \
            { float t8[8]; unpack8(Nf[u][0], t8); _Pragma("unroll") for (int e = 0; e < 8; ++e) nf[e] = t8[e]; \
              unpack8(Nf[u][1], t8); _Pragma("unroll") for (int e = 0; e < 8; ++e) nf[8 + e] = t8[e]; } \
            _Pragma("unroll") for (int jt = 0; jt < 4; ++jt) { \
                f32x4_t n = (f32x4_t){nf[4 * jt], nf[4 * jt + 1], nf[4 * jt + 2], nf[4 * jt + 3]}; \
                n = MFMA16(__builtin_bit_cast(bf16x8_t, Mf[u][2 * jt]), b0, n); \
                n = MFMA16(__builtin_bit_cast(bf16x8_t, Mf[u][2 * jt + 1]), b1, n); \
                acc[jt] = n; } \
              \
            { unsigned char* us = base + (size_t)(c) * 16384 + 8192; const v4u w0 = __builtin_bit_cast(v4u, b0), w1 = __builtin_bit_cast(v4u, b1); \
              *(v2u*)(us + (i * 64 + 0 + 4 * q) * 2) = (v2u){w0.x, w0.y}; *(v2u*)(us + (i * 64 + 16 + 4 * q) * 2) = (v2u){w0.z, w0.w}; \
              *(v2u*)(us + (i * 64 + 32 + 4 * q) * 2) = (v2u){w1.x, w1.y}; *(v2u*)(us + (i * 64 + 48 + 4 * q) * 2) = (v2u){w1.z, w1.w}; } \
            if ((c) + 3 < 64) R2_LOAD(u, (c) + 3); } while (0)
    R2_LOAD(0, 0); R2_LOAD(1, 1); R2_LOAD(2, 2);
    for (int c3 = 0; c3 < 21; ++c3) { R2_STEP(0, 3 * c3); R2_STEP(1, 3 * c3 + 1); R2_STEP(2, 3 * c3 + 2); }
    R2_STEP(0, 63);
#undef R2_STEP
#undef R2_LOAD
    float* so = A.out + O_WKV_P + (size_t)bh * 4096 + i * 64;
#pragma unroll
    for (int jt = 0; jt < 4; ++jt) *(f32x4*)(so + 16 * jt + 4 * q) = (f32x4){acc[jt][0], acc[jt][1], acc[jt][2], acc[jt][3]};
}

constexpr int R3_PAR_OFF = 122880;
__device__ __forceinline__ void r3_unit(const Frame& F, const Args& A, int unit) {
    bf16* UB = (bf16*)(A.ws + WS_UB);
    const bf16* Wgt = (const bf16*)(A.ws + WS_WGT);
    const float* bonus = (const float*)(A.ws + WS_BONUS);
    const LAS float* mug = (const LAS float*)(F.lds + R3_PAR_OFF); const LAS float* lnw = mug + 128; const LAS float* lnb = lnw + 512;
    const int b = unit >> 9, h = (unit >> 6) & 7, c = unit & 63, row0 = b * SEQ + c * RC;
    const bf16* Sc = (const bf16*)((const unsigned char*)A.out + (size_t)unit * 16384 + 8192);
    const int r = F.lane & 31, hh = F.lane >> 5, row = row0 + r;
    const bool hasprev = (r > 0) || (c > 0);
    f32x16 y0, y1, g0, g1;
#pragma unroll
    for (int i = 0; i < 16; ++i) { y0[i] = 0.f; y1[i] = 0.f; g0[i] = 0.f; g1[i] = 0.f; }
    {
        v4u gc[8], gp[8], wa[8], wb[8];
#pragma unroll
        for (int s = 0; s < 8; ++s) { gc[s] = *(const v4u*)(UB + (size_t)row * BCOLS + 1664 + 16 * s + 8 * hh);
            gp[s] = (v4u){0, 0, 0, 0}; if (hasprev) gp[s] = *(const v4u*)(UB + (size_t)(row - 1) * BCOLS + 1664 + 16 * s + 8 * hh);
            wa[s] = *(const v4u*)(Wgt + (size_t)(h * 64 + r) * 128 + 16 * s + 8 * hh); wb[s] = *(const v4u*)(Wgt + (size_t)(h * 64 + 32 + r) * 128 + 16 * s + 8 * hh); }
        asm volatile("" ::: "memory");
#pragma unroll
        for (int s = 0; s < 8; ++s) {
            float cur[8], prv[8]; unpack8(gc[s], cur); unpack8(gp[s], prv);
            const f32x4 m0 = *(const LAS f32x4*)(mug + 16 * s + 8 * hh), m1 = *(const LAS f32x4*)(mug + 16 * s + 8 * hh + 4);
            float sg[8];
#pragma unroll
            for (int e = 0; e < 8; ++e) sg[e] = sigmoidf_(cur[e] + (prv[e] - cur[e]) * (e < 4 ? m0[e] : m1[e - 4]));
            const bf16x8_t sgp = __builtin_bit_cast(bf16x8_t, packw8(sg));
            g0 = MFMA32(__builtin_bit_cast(bf16x8_t, wa[s]), sgp, g0); g1 = MFMA32(__builtin_bit_cast(bf16x8_t, wb[s]), sgp, g1);
        }
    }
    const bf16* ub2 = UB + (size_t)row * BCOLS + h * 64;
    asm volatile("" : "+v"(ub2), "+v"(g0[0]), "+v"(g1[0]));
    v4u sa0[4], sa1[4], rb[4]; v2u yb[8], vb[8];
#pragma unroll
    for (int s = 0; s < 4; ++s) { rb[s] = *(const v4u*)(ub2 + 16 * s + 8 * hh);
        sa0[s] = (v4u){0, 0, 0, 0}; sa1[s] = (v4u){0, 0, 0, 0};
        if (c > 0) { sa0[s] = *(const v4u*)(Sc + r * 64 + 16 * s + 8 * hh); sa1[s] = *(const v4u*)(Sc + (32 + r) * 64 + 16 * s + 8 * hh); } }
#pragma unroll
    for (int x = 0; x < 8; ++x) { const int i0 = 32 * (x >> 2) + 8 * (x & 3) + 4 * hh; yb[x] = *(const v2u*)(ub2 + 512 + i0); vb[x] = *(const v2u*)(ub2 + 1024 + i0); }
    const float bn = bonus[(size_t)row * 8 + h];
    asm volatile("" ::: "memory");
#pragma unroll
    for (int s = 0; s < 4; ++s) { y0 = MFMA32(__builtin_bit_cast(bf16x8_t, sa0[s]), __builtin_bit_cast(bf16x8_t, rb[s]), y0); y1 = MFMA32(__builtin_bit_cast(bf16x8_t, sa1[s]), __builtin_bit_cast(bf16x8_t, rb[s]), y1); }
    float yv[32]; float sum = 0.f;
#pragma unroll
    for (int x = 0; x < 8; ++x) { const int it = x >> 2, gq = x & 3;
        const float ybf[4] = {bflo(yb[x].x), bfhi(yb[x].x), bflo(yb[x].y), bfhi(yb[x].y)};
#pragma unroll
        for (int e = 0; e < 4; ++e) { const float v = (it ? y1[4 * gq + e] : y0[4 * gq + e]) + ybf[e]; yv[16 * it + 4 * gq + e] = v; sum += v; } }
    sum += __shfl_xor(sum, 32);
    const float mean = sum * (1.0f / 64.0f);
    float var = 0.f;
#pragma unroll
    for (int x = 0; x < 32; ++x) { yv[x] -= mean; var += yv[x] * yv[x]; }
    var += __shfl_xor(var, 32);
    const float rs = rsqrtf(var * (1.0f / 64.0f) + GN_EPS);
#pragma unroll
    for (int x = 0; x < 8; ++x) { const int it = x >> 2, gq = x & 3, i0 = 32 * it + 8 * gq + 4 * hh, ch = h * 64 + i0;
        const float vv[4] = {bflo(vb[x].x), bfhi(vb[x].x), bflo(vb[x].y), bfhi(vb[x].y)};
        const f32x4 lw = *(const LAS f32x4*)(lnw + ch), lb = *(const LAS f32x4*)(lnb + ch);
        float o[4];
#pragma unroll
        for (int e = 0; e < 4; ++e) { const float gg = it ? g1[4 * gq + e] : g0[4 * gq + e]; o[e] = (yv[16 * it + 4 * gq + e] * rs * lw[e] + lb[e] + bn * vv[e]) * gg; }
        v2u ow; ow.x = pk2(o[0], o[1]); ow.y = pk2(o[2], o[3]);
        *(v2u*)(UB + (size_t)row * BCOLS + 512 + ch) = ow; }
}

__device__ __forceinline__ float rdl(float x, int k) { return __builtin_bit_cast(float, __builtin_amdgcn_readlane(__builtin_bit_cast(int, x), k)); }
__device__ __forceinline__ void rwkv_sample_wave(const Frame& F, const Args& A, int bh, LAS float* wl) {
    bf16* UB = (bf16*)(A.ws + WS_UB);
    const int b = bh >> 3, h = bh & 7, row0 = MP + 4 * b, l = F.lane, ch = h * 64 + l;
    const float* mu = A.in[7];
    float xr[4], xk[4], xv[4], tw[4], ad[4], sg0[4], sg1[4];
#pragma unroll
    for (int t = 0; t < 4; ++t) {
        const int row = row0 + t, prow = t ? row - 1 : MT + b;
        xr[t] = shifted(UB, row, prow, ch, mu[ch]); xk[t] = shifted(UB, row, prow, 512 + ch, mu[512 + ch]); xv[t] = shifted(UB, row, prow, 1024 + ch, mu[1024 + ch]);
        tw[t] = tanhf_(shifted(UB, row, prow, 1536 + l, mu[1536 + l])); ad[t] = shifted(UB, row, prow, 1600 + l, mu[1600 + l]);
        sg0[t] = sigmoidf_(shifted(UB, row, prow, 1664 + l, mu[1664 + l])); sg1[t] = sigmoidf_(shifted(UB, row, prow, 1728 + l, mu[1728 + l]));
    }
    float dec[4] = {0.f, 0.f, 0.f, 0.f}, aa[4] = {0.f, 0.f, 0.f, 0.f}, g[4] = {0.f, 0.f, 0.f, 0.f};
    {   const float* pd = A.in[9] + ch; const float* pa = A.in[11] + ch; const float* pg = A.in[12] + ch;
#pragma unroll 1
        for (int k0 = 0; k0 < 64; k0 += 8) {
            float wd[8], wa[8], wg0[8], wg1[8];
#pragma unroll
            for (int u = 0; u < 8; ++u) { wd[u] = pd[(k0 + u) * BW]; wa[u] = pa[(k0 + u) * BW]; wg0[u] = pg[(k0 + u) * BW]; wg1[u] = pg[(64 + k0 + u) * BW]; }
            asm volatile("" ::: "memory");
#pragma unroll
            for (int u = 0; u < 8; ++u) {
#pragma unroll
                for (int t = 0; t < 4; ++t) {
                    dec[t] += rdl(tw[t], k0 + u) * wd[u]; aa[t] += rdl(ad[t], k0 + u) * wa[u]; g[t] += rdl(sg0[t], k0 + u) * wg0[u] + rdl(sg1[t], k0 + u) * wg1[u];
                }
            }
        } }
    const float w0 = A.in[8][ch], a0 = A.in[10][ch], kkc = A.in[13][ch], kac = A.in[14][ch], rkc = A.in[15][ch];
    float bon[4];
#pragma unroll
    for (int t = 0; t < 4; ++t) {
        const float w = __expf(-DECAY_SCALE * sigmoidf_(w0 + dec[t])), a = sigmoidf_(a0 + aa[t]);
        const float kp = xk[t] * kkc, kk = kp / fmaxf(sqrtf(wave_sum(kp * kp)), 1e-12f), k2 = xk[t] * (1.0f + (a - 1.0f) * kac);
        bon[t] = wave_sum(xr[t] * k2 * rkc);
        LAS float* v = wl + t * 384;
        v[l] = w; v[64 + l] = kk; v[128 + l] = kk * a; v[192 + l] = k2; v[256 + l] = xr[t];
    }
    asm volatile("s_waitcnt lgkmcnt(0)" ::: "memory");
    float S[64];
    const float* sin_ = A.in[3] + (size_t)bh * 4096 + l * 64;
#pragma unroll
    for (int j4 = 0; j4 < 16; ++j4) { const f32x4 s = *(const f32x4*)(sin_ + 4 * j4); S[4 * j4] = s[0]; S[4 * j4 + 1] = s[1]; S[4 * j4 + 2] = s[2]; S[4 * j4 + 3] = s[3]; }
#pragma unroll
    for (int t = 0; t < 4; ++t) {
        const LAS float* v = wl + t * 384;
        float sk = 0.f;
#pragma unroll
        for (int j4 = 0; j4 < 16; ++j4) { const f32x4 k4 = *(const LAS f32x4*)(v + 64 + 4 * j4); sk += (S[4 * j4] * k4[0] + S[4 * j4 + 1] * k4[1]) + (S[4 * j4 + 2] * k4[2] + S[4 * j4 + 3] * k4[3]);
            if ((j4 & 3) == 3) asm volatile("" : "+v"(v), "+v"(sk)); }
        float y = 0.f;
#pragma unroll
        for (int j4 = 0; j4 < 16; ++j4) {
            const f32x4 w4 = *(const LAS f32x4*)(v + 4 * j4), ka = *(const LAS f32x4*)(v + 128 + 4 * j4), k4 = *(const LAS f32x4*)(v + 192 + 4 * j4), r4 = *(const LAS f32x4*)(v + 256 + 4 * j4);
#pragma unroll
            for (int e = 0; e < 4; ++e) { const float s = S[4 * j4 + e] * w4[e] - sk * ka[e] + xv[t] * k4[e]; S[4 * j4 + e] = s; y += s * r4[e]; }
            if (j4 & 1) asm volatile("" : "+v"(v), "+v"(y));
        }
        const float mean = wave_sum(y) * (1.0f / 64.0f), d = y - mean, var = wave_sum(d * d) * (1.0f / 64.0f);
        const float yn = d * rsqrtf(var + GN_EPS) * A.in[16][ch] + A.in[17][ch];
        UB[(size_t)(row0 + t) * BCOLS + 512 + ch] = (bf16)f2bf((yn + bon[t] * xv[t]) * g[t]);
    }
    float* so = A.out + O_WKV_S + (size_t)bh * 4096 + l * 64;
#pragma unroll
    for (int j4 = 0; j4 < 16; ++j4) *(f32x4*)(so + 4 * j4) = (f32x4){S[4 * j4], S[4 * j4 + 1], S[4 * j4 + 2], S[4 * j4 + 3]};
    asm volatile("s_waitcnt lgkmcnt(0)" ::: "memory");
}

__device__ __forceinline__ void p3_seq(const Frame& F, const Args& A) {
    if (F.wave == 0) { for (int u = F.vcu; u < 256; u += F.G) r2_wave(F, A, u >> 2, u & 3); }
    else {
        const int wk = F.vcu * 7 + F.wave - 1, NW = F.G * 7;
        h2_part(F, A, wk * 64 + F.lane, NW * 64);
        LAS float* wl = (LAS float*)F.lds + F.wave * 1536;
        for (int bh = wk; bh < 1024; bh += NW) rwkv_sample_wave(F, A, bh, wl);
    }
}


constexpr int SK_P = 72, SK_BUF = (64 + 128) * SK_P;
template <bool SSQ> __device__ __forceinline__ void sk_gemm(const Frame& F, f32x16& acc, const bf16* Ag, int lda, const bf16* Bg, int ldb, int K, float& ssq) {
    LAS bf16* L = (LAS bf16*)F.lds;
    const int prow = F.tid >> 3, c8 = F.tid & 7, r = F.lane & 31, hh = F.lane >> 5, wm = F.wave >> 2, wn = F.wave & 3;
    const bf16* ap = Ag + (size_t)prow * lda + 8 * c8; const bf16* bp0 = Bg + (size_t)prow * ldb + 8 * c8; const bf16* bp1 = bp0 + (size_t)64 * ldb;
    v4u ra = *(const v4u*)ap, rb0 = *(const v4u*)bp0, rb1 = *(const v4u*)bp1;
    const int nk = K / 64;
    __syncthreads();
    for (int it = 0; it < nk; ++it) {
        LAS bf16* B_ = L + (it & 1) * SK_BUF;
        *(LAS v4u*)(B_ + prow * SK_P + 8 * c8) = ra; *(LAS v4u*)(B_ + (64 + prow) * SK_P + 8 * c8) = rb0; *(LAS v4u*)(B_ + (128 + prow) * SK_P + 8 * c8) = rb1;
        if (SSQ) { float f8[8]; unpack8(ra, f8);
#pragma unroll
            for (int e = 0; e < 8; ++e) ssq += f8[e] * f8[e]; }
        __syncthreads();
        if (it + 1 < nk) { const int k = (it + 1) * 64; ra = *(const v4u*)(ap + k); rb0 = *(const v4u*)(bp0 + k); rb1 = *(const v4u*)(bp1 + k); }
#pragma unroll
        for (int s = 0; s < 4; ++s)
            acc = MFMA32(*(const LAS bf16x8_t*)(B_ + (32 * wm + r) * SK_P + 16 * s + 8 * hh), *(const LAS bf16x8_t*)(B_ + (64 + 32 * wn + r) * SK_P + 16 * s + 8 * hh), acc);
    }
}
template <int WHICH> __device__ __forceinline__ void skinny_unit(const Frame& F, const Args& A, int mt, int nt, int ks) {
    unsigned char* ws = A.ws;
    bf16* UA = (bf16*)(ws + WS_UA); bf16* UB = (bf16*)(ws + WS_UB); const bf16* UG = (const bf16*)(ws + WS_UG);
    const int wm = F.wave >> 2, wn = F.wave & 3, r = F.lane & 31, hh = F.lane >> 5;
    const int mb = MP + 64 * mt, m0 = mb + 32 * wm, nb = 128 * nt, n = nb + 32 * wn + r;
    f32x16 acc;
#pragma unroll
    for (int i = 0; i < 16; ++i) acc[i] = 0.f;
    float ssq = 0.f;
    if (WHICH == 0) {
        f32x16 accb;
#pragma unroll
        for (int i = 0; i < 16; ++i) accb[i] = 0.f;
        sk_gemm<false>(F, acc, UA + (size_t)mb * ACOLS + 1024, ACOLS, (const bf16*)(ws + WS_WA) + (size_t)nb * AW, AW, AW, ssq);
        sk_gemm<false>(F, accb, UB + (size_t)mb * BCOLS + 512, BCOLS, (const bf16*)(ws + WS_WB) + (size_t)nb * BW, BW, BW, ssq);
#pragma unroll
        for (int i = 0; i < 16; ++i) { const size_t m = (size_t)(m0 + crow(i, hh));
            const float ga = bf2f(UG[m * GCOLS + n]), gb = bf2f(UG[m * GCOLS + 1024 + n]);
            UA[m * ACOLS + n] = (bf16)f2bf(sigmoidf_(ga) * acc[i] + sigmoidf_(gb) * accb[i]); }
    } else if (WHICH == 1) {
        sk_gemm<false>(F, acc, UA + (size_t)mb * ACOLS, ACOLS, (const bf16*)(ws + WS_WO) + (size_t)nb * D, D, D, ssq);
#pragma unroll
        for (int i = 0; i < 16; ++i) { const size_t m = (size_t)(m0 + crow(i, hh));
            const float o = A.in[1][(m - MP) * D + n] + acc[i];
            A.out[m * D + n] = o; UB[m * BCOLS + n] = (bf16)f2bf(o); }
    } else if (WHICH == 2) {
        sk_gemm<true>(F, acc, UB + (size_t)mb * BCOLS, BCOLS, (const bf16*)(ws + WS_WUP) + (size_t)nb * D, D, D, ssq);
        LAS float* rs = (LAS float*)(F.lds + 2 * SK_BUF * 2);
        ssq = red8(ssq);
        if ((F.tid & 7) == 0) rs[F.tid >> 3] = rsqrtf(ssq * (1.0f / D) + NORM_EPS);
        __syncthreads();
        bf16* Hd = UA;
#pragma unroll
        for (int i = 0; i < 16; ++i) { const int ml = 32 * wm + crow(i, hh); const size_t m = (size_t)(mb + ml);
            const float t = fmaxf(acc[i] * rs[ml], 0.f);
            Hd[m * DFF + n] = (bf16)f2bf(t * t); }
    } else {
        sk_gemm<false>(F, acc, UA + (size_t)mb * DFF + 1024 * ks, DFF, (const bf16*)(ws + WS_WDN) + (size_t)nb * DFF + 1024 * ks, DFF, 1024, ssq);
#pragma unroll
        for (int i = 0; i < 16; ++i) { const size_t m = (size_t)(m0 + crow(i, hh)); atomicAdd(A.out + m * D + n, acc[i]); }
    }
    __syncthreads();
}

__device__ __forceinline__ void p9_final(const Frame& F, const Args& A) {
    const int gw = F.vcu * NWAVES + F.wave, NGW = F.G * NWAVES;
    f32x4 gv[4];
#pragma unroll
    for (int j = 0; j < 4; ++j) gv[j] = ((const f32x4*)A.in[26])[F.lane + 64 * j];
    for (int m = gw; m < MT; m += NGW) {
        f32x4* xr = (f32x4*)(A.out + (size_t)m * D) + F.lane;
        f32x4 v[4]; float s = 0.f;
#pragma unroll
        for (int j = 0; j < 4; ++j) { v[j] = xr[64 * j]; s += (v[j][0] * v[j][0] + v[j][1] * v[j][1]) + (v[j][2] * v[j][2] + v[j][3] * v[j][3]); }
        const float rstd = rsqrtf(wave_sum(s) * (1.0f / D) + NORM_EPS);
#pragma unroll
        for (int j = 0; j < 4; ++j) xr[64 * j] = v[j] * rstd * gv[j];
    }
}

__global__ void __launch_bounds__(NWAVES * 64, 2) fwd(Args args) {
    extern __shared__ __attribute__((aligned(16))) unsigned char lds[];
    Frame F;
    F.lds = (LAS unsigned char*)lds;
    F.tid = threadIdx.x; F.lane = F.tid & 63; F.wave = __builtin_amdgcn_readfirstlane(F.tid >> 6);
    F.G = gridDim.x; { const int bx = blockIdx.x; F.vcu = (F.G % 8 == 0) ? (bx % 8) * (F.G / 8) + bx / 8 : bx; }
    unsigned char* ws = args.ws;
    gu32* ctl = (gu32*)(ws + WS_CTL);
    for (int u = F.tid; u < (LDS_BYTES - LDSCTL_OFF) / 4; u += NWAVES * 64) ((LAS unsigned*)(F.lds + LDSCTL_OFF))[u] = 0u;
    __syncthreads();
    volatile LAS unsigned* MISC = (volatile LAS unsigned*)(F.lds + MISC_OFF);
    XcdBarrier bar; bar.bar = (unsigned*)(ctl + CW_BAR); bar.x = 0; bar.st = nullptr;
    if (MK_N_LAUNCHES == 1) bar = xcd_barrier_post((unsigned*)(ctl + CW_BAR), MISC + 8);
    const int lo = args.ph_lo, hi = args.ph_hi;
#ifndef PH_MASK
#define PH_MASK 0x3ff
#endif
#ifndef DUP_MASK
#define DUP_MASK 0
#endif
#define REP(k) for (int rep_ = 0; rep_ < (((DUP_MASK >> (k)) & 1) ? 2 : 1); ++rep_)
#define IN(k) (((PH_MASK >> (k)) & 1) && lo <= (k) && (k) < hi)
#define SEAM(k) do { if (IN(k) && IN((k) + 1)) xcd_barrier(bar); } while (0)
    bf16* UA = (bf16*)(ws + WS_UA); bf16* UB = (bf16*)(ws + WS_UB); bf16* UG = (bf16*)(ws + WS_UG);

    if (IN(0)) REP(0) { p0_prologue(F, args); } SEAM(0);
    if (IN(1)) REP(1) {
        pg8::Gemm g{(const bf16*)args.out, (const bf16*)(ws + WS_WIN), MH, NIN, D, D, D};
        SchedG1 S; S.init(F.G, (int)blockIdx.x);
        EpiG1 E{UA, UB, UG, (bf16*)(args.out + O_HGRN_S)};
        pg8::gemm_phase<EpiG1, SchedG1, true, true>(F.lds, g, S, E);
    } SEAM(1);
    if (IN(2)) {
        { LAS float* PAR = (LAS float*)(F.lds + RL_PAR); const int c_ = F.tid;
          PAR[c_] = args.in[8][c_]; PAR[512 + c_] = args.in[10][c_]; PAR[1024 + c_] = args.in[13][c_]; PAR[1536 + c_] = args.in[14][c_]; PAR[2048 + c_] = args.in[15][c_]; }
        for (int ps = 0; ps * 2 * F.G < 4096; ++ps) { const int unit = (ps * F.G + F.vcu) * 2 + (F.wave >> 2); r1_pass(F, args, unit < 4096 ? unit : 0, unit < 4096); }
        for (int u = F.vcu; u < 1024; u += F.G) h1_unit(F, args, u);
    } SEAM(2);
    if (IN(3)) { p3_seq(F, args); } SEAM(3);
    if (IN(4)) { { LAS float* pr_ = (LAS float*)(F.lds + R3_PAR_OFF); if (F.tid < 128) pr_[F.tid] = args.in[7][1664 + F.tid]; pr_[128 + F.tid] = args.in[16][F.tid]; pr_[640 + F.tid] = args.in[17][F.tid]; __syncthreads(); }
        for (int u = F.vcu * NWAVES + F.wave; u < 4096; u += F.G * NWAVES) r3_unit(F, args, u); __syncthreads(); for (int u = F.vcu; u < 1024; u += F.G) h3_unit(F, args, u); for (int u = F.vcu; u < 512; u += F.G) hgrn_sample_unit(F, args, u); } SEAM(4);
    if (IN(5)) REP(5) {
        SchedMN S; S.init(MP, D, F.G, (int)blockIdx.x);
        { pg8::Gemm g{UA + 1024, (const bf16*)(ws + WS_WA), MP, D, AW, ACOLS, AW}; EpiMerge<false> E{UA, UG, 0};
          pg8::gemm_phase<EpiMerge<false>, SchedMN, true, true>(F.lds, g, S, E); }
        { pg8::Gemm g{UB + 512, (const bf16*)(ws + WS_WB), MP, D, BW, BCOLS, BW}; EpiMerge<true> E{UA, UG, 1024};
          pg8::gemm_phase<EpiMerge<true>, SchedMN, true, true>(F.lds, g, S, E); }
        for (int u = F.G - 1 - F.vcu; u < 64; u += F.G) skinny_unit<0>(F, args, u >> 3, u & 7, 0);
    } SEAM(5);
    if (IN(6)) REP(6) {
        SchedMN S; S.init(MP, D, F.G, (int)blockIdx.x);
        pg8::Gemm g{UA, (const bf16*)(ws + WS_WO), MP, D, D, ACOLS, D};
        EpiRes<true, true, true> E{args.in[0], args.in[1], args.out, UB, BCOLS, (float*)(ws + WS_SSQ1)};
        pg8::gemm_phase<EpiRes<true, true, true>, SchedMN, true, true>(F.lds, g, S, E);
        for (int u = F.G - 1 - F.vcu; u < 64; u += F.G) skinny_unit<1>(F, args, u >> 3, u & 7, 0);
    } SEAM(6);
    if (IN(7)) REP(7) {
        SchedMN S; S.init(MP, DFF, F.G, (int)blockIdx.x);
        pg8::Gemm g{UB, (const bf16*)(ws + WS_WUP), MP, DFF, D, BCOLS, D};
        EpiUp E{UA, (const float*)(ws + WS_SSQ1)};
        pg8::gemm_phase<EpiUp, SchedMN, true, true>(F.lds, g, S, E);
        for (int u = F.vcu; u < 256; u += F.G) skinny_unit<2>(F, args, u >> 5, u & 31, 0);
    } SEAM(7);
    if (IN(8)) {
        SchedMN S; S.init(MP, D, F.G, (int)blockIdx.x);
        pg8::Gemm g{UA, (const bf16*)(ws + WS_WDN), MP, D, DFF, DFF, DFF};
        EpiRes<false, false, false> E{nullptr, nullptr, args.out, nullptr, 0, nullptr};
        pg8::gemm_phase<EpiRes<false, false, false>, SchedMN, true, true>(F.lds, g, S, E);
        for (int u = F.vcu; u < 256; u += F.G) skinny_unit<3>(F, args, (u >> 3) & 7, u & 7, u >> 6);
    } SEAM(8);
    if (IN(9)) { p9_final(F, args); }
#undef IN
#undef SEAM
}

extern "C" void kernel_launch(void* const* d_in, const int* in_sizes, int n_in, void* d_out, int out_size, void* d_ws, size_t ws_size, hipStream_t stream) {
    static int grid = 0;
    if (grid == 0) {
        if (n_in != 27 || out_size != (int)O_END || ws_size < WS_END) { fprintf(stderr, "kernel_launch: unexpected shapes (n_in %d, out %d, ws %zu)\n", n_in, out_size, ws_size); grid = -1; return; }
        int dev = 0, cus = 0, per_cu = 0;
        if (hipGetDevice(&dev) != hipSuccess || hipDeviceGetAttribute(&cus, hipDeviceAttributeMultiprocessorCount, dev) != hipSuccess) { grid = -1; return; }
        if (hipFuncSetAttribute((const void*)fwd, hipFuncAttributeMaxDynamicSharedMemorySize, LDS_BYTES) != hipSuccess) { fprintf(stderr, "kernel_launch: hipFuncSetAttribute failed\n"); grid = -1; return; }
        if (hipOccupancyMaxActiveBlocksPerMultiprocessor(&per_cu, (const void*)fwd, NWAVES * 64, LDS_BYTES) != hipSuccess || per_cu < 1) { fprintf(stderr, "kernel_launch: occupancy query says %d\n", per_cu); }
        (void)hipGetLastError();
        grid = cus;
    }
    if (grid < 0) return;
    (void)hipMemsetAsync((char*)d_ws + WS_CTL, 0, CTL_BYTES, stream);
    Args a{};
    for (int i = 0; i < 27; ++i) a.in[i] = (const float*)d_in[i];
    a.out = (float*)d_out; a.ws = (unsigned char*)d_ws;
    if (MK_N_LAUNCHES == 1) { a.ph_lo = 0; a.ph_hi = NPHASE; hipLaunchKernelGGL(fwd, dim3(grid), dim3(NWAVES * 64), LDS_BYTES, stream, a); }
    else for (int p = 0; p < NPHASE; ++p) { a.ph_lo = p; a.ph_hi = p + 1; hipLaunchKernelGGL(fwd, dim3(grid), dim3(NWAVES * 64), LDS_BYTES, stream, a); }
}
```

```cpp
#include <hip/hip_runtime.h>
#include <cstdio>
#include <cstdint>
namespace pg8 {
#define PG8_LAS __attribute__((address_space(3)))
typedef unsigned short bf16_t;
typedef short bf16x8 __attribute__((ext_vector_type(8)));
typedef float f32x4 __attribute__((ext_vector_type(4)));
typedef unsigned u32x4 __attribute__((ext_vector_type(4)));
constexpr int BM = 256, BK = 64, HALF = 128, HTB = HALF * BK * 2  , STAGE_BYTES = 8 * HTB, NXCD = 8, WGM = 8;

__host__ __device__ __forceinline__ int lds_byte(int r, int c) { const int st = (r >> 4) * 2 + (c >> 5), rr = r & 15, cc = c & 31, ob = rr * 64 + cc * 2; return st * 1024 + (ob ^ (((ob >> 9) & 1) << 5)); }
__host__ __device__ __forceinline__ void stage_rc(int b, int& R, int& C) { const int st = b / 1024, sb = b % 1024, swz = sb ^ (((sb >> 9) & 1) << 5); R = (st >> 1) * 16 + swz / 64; C = (st & 1) * 32 + (swz % 64) / 2; }
__host__ __device__ __forceinline__ int perm32(int rho) { const int n = rho >> 4, i = rho & 15; return 8 * (i >> 2) + 4 * n + (i & 3); }

struct Unit { int pm, pn; };
struct Gemm { const bf16_t* A; const bf16_t* Bt; int M, N, K, lda, ldb; };

struct StaticOrder {
    int nM, nN, nwg, G, c;
    __host__ __device__ void init(int M, int N, int G_, int c_) { nM = M / BM; nN = N / BM; nwg = nM * nN; G = G_; c = c_; }
    __host__ __device__ bool next(int i, Unit& u) const {
        const long L = (long)i * G + c; if (L >= nwg) return false;
        int wgid = (int)L; { const int q = nwg / NXCD, r = nwg % NXCD, xcd = wgid % NXCD, off = wgid / NXCD; wgid = (xcd < r ? xcd * (q + 1) : r * (q + 1) + (xcd - r) * q) + off; }
        const int nig = WGM * nN, gid = wgid / nig, fm = gid * WGM, gsz = (nM - fm) < WGM ? (nM - fm) : WGM;
        u.pm = fm + ((wgid % nig) % gsz); u.pn = (wgid % nig) / gsz; return true;
    }
    __device__ __forceinline__ void a_ready(const Unit&) const {}
    __device__ __forceinline__ void done(const Unit&) const {}
};

__device__ __forceinline__ unsigned cvt_pk_bf16(float lo, float hi) { unsigned r; asm volatile("v_cvt_pk_bf16_f32 %0, %1, %2" : "=v"(r) : "v"(lo), "v"(hi)); return r; }
typedef float f32x2 __attribute__((ext_vector_type(2)));
__device__ __forceinline__ f32x2 gelu_pk(f32x2 v) {
    const f32x2 av = __builtin_elementwise_abs(v), d = av * 0.2316418882f + 1.0f;
    f32x2 t; t.x = __builtin_amdgcn_rcpf(d.x); t.y = __builtin_amdgcn_rcpf(d.y);
    f32x2 q = t * 0.5307027145f + (-0.7265760135f); q = q * t + 0.7107068705f; q = q * t + (-0.142248368f); q = q * t + 0.127414796f; q = q * t;
    const f32x2 s = (v * v) * (-0.72134752044f);
    f32x2 e; e.x = __builtin_amdgcn_exp2f(s.x); e.y = __builtin_amdgcn_exp2f(s.y);
    const f32x2 m = v * (q * e), r = v - m;
    f32x2 o; o.x = v.x < 0.f ? m.x : r.x; o.y = v.y < 0.f ? m.y : r.y; return o;
}

template <class Epi, class Sched, bool ALIGN_EPI = false, bool SP2 = false>
__device__ __forceinline__ void gemm_phase(PG8_LAS unsigned char* lds, const Gemm g, const Sched& S, const Epi& E) {
    const int tid = threadIdx.x, wid = __builtin_amdgcn_readfirstlane(tid >> 6), lane = tid & 63, wr = wid >> 2, wc = wid & 3, fr = lane & 15, fq = lane >> 4;
    const int K = g.K, nt = K / BK;
    unsigned voffA[2], voffB[2];
#pragma unroll
    for (int i = 0; i < 2; ++i) { int R, C; stage_rc(tid * 16 + i * 8192, R, C); const int Rb = Epi::PERM ? ((R & ~31) + perm32(R & 31)) : R;
        voffA[i] = (unsigned)(R * g.lda + C) * 2u; voffB[i] = (unsigned)(Rb * g.ldb + C) * 2u; }
    const size_t kstep = (size_t)(BK * 2);
    const size_t hstepA = (size_t)HALF * g.lda * 2, hstepB = (size_t)HALF * g.ldb * 2;
    const size_t tstepA = 2 * hstepA, tstepB = 2 * hstepB;
    const unsigned ldsw = (unsigned)wid * 1024u;
    const int aoff = lds_byte(wr * 64 + fr, fq * 8), boff = lds_byte(wc * 32 + fr, fq * 8);
#define PG8_SA(b, h) (((b) * 2 + (h)) * HTB)
#define PG8_SB(b, h) ((4 + (b) * 2 + (h)) * HTB)
#define PG8_STAGE(bufoff, gbase, voff) do { _Pragma("unroll") for (int _i = 0; _i < 2; ++_i) \
        __builtin_amdgcn_global_load_lds((const unsigned*)((const char*)(gbase) + (voff)[_i]), (PG8_LAS unsigned*)(lds + (bufoff) + ldsw + _i * 8192), 16, 0, 0); } while (0)
#define PG8_LDA(dst, b, h) do { _Pragma("unroll") for (int m = 0; m < 4; ++m) _Pragma("unroll") for (int k = 0; k < 2; ++k) dst[m][k] = *(const PG8_LAS bf16x8*)(lds + PG8_SA(b, h) + aoff + m * 2048 + k * 1024); } while (0)
#define PG8_LDB(dst, b, h) do { _Pragma("unroll") for (int n = 0; n < 2; ++n) _Pragma("unroll") for (int k = 0; k < 2; ++k) dst[n][k] = *(const PG8_LAS bf16x8*)(lds + PG8_SB(b, h) + boff + n * 2048 + k * 1024); } while (0)
#define PG8_MMA(ai, bj, At, Bt) do { __builtin_amdgcn_s_setprio(1); _Pragma("unroll") for (int m = 0; m < 4; ++m) _Pragma("unroll") for (int n = 0; n < 2; ++n) _Pragma("unroll") for (int k = 0; k < 2; ++k) \
        acc[ai][bj][m][n] = __builtin_amdgcn_mfma_f32_16x16x32_bf16(Bt[n][k], At[m][k], acc[ai][bj][m][n], 0, 0, 0); __builtin_amdgcn_s_setprio(0); } while (0)
#define PG8_WAIT_V(n) asm volatile("s_waitcnt vmcnt(" #n ")" ::: "memory")
#define PG8_WAIT_L(n) asm volatile("s_waitcnt lgkmcnt(" #n ")" ::: "memory")
#define PG8_BAR __builtin_amdgcn_s_barrier()
#define PG8_SCHED __builtin_amdgcn_sched_barrier(0)
    Unit cur, nxt; int ui = 0;
    if (!S.next(0, cur)) return;
    f32x4 acc[2][2][4][2];
#pragma unroll
    for (int a = 0; a < 2; ++a)
#pragma unroll
        for (int b = 0; b < 2; ++b)
#pragma unroll
            for (int m = 0; m < 4; ++m)
#pragma unroll
                for (int n = 0; n < 2; ++n) acc[a][b][m][n] = (f32x4){0.f, 0.f, 0.f, 0.f};
    bf16x8 At[4][2], B0[2][2], B1[2][2];
    const char* cA = (const char*)g.A + (size_t)cur.pm * tstepA; const char* cB = (const char*)g.Bt + (size_t)cur.pn * tstepB;
    S.a_ready(cur);
    if constexpr (SP2) {
        PG8_STAGE(PG8_SB(0, 0), cB, voffB); PG8_STAGE(PG8_SB(0, 1), cB + hstepB, voffB); PG8_STAGE(PG8_SA(0, 0), cA, voffA); PG8_STAGE(PG8_SA(0, 1), cA + hstepA, voffA);
        if (wr == 1) PG8_BAR;
        PG8_WAIT_V(2); PG8_BAR;
        PG8_STAGE(PG8_SB(1, 0), cB + kstep, voffB); PG8_STAGE(PG8_SA(1, 0), cA + kstep, voffA); PG8_STAGE(PG8_SB(1, 1), cB + hstepB + kstep, voffB);
        PG8_WAIT_V(6); PG8_BAR;
    } else {
        PG8_STAGE(PG8_SB(0, 0), cB, voffB); PG8_STAGE(PG8_SA(0, 0), cA, voffA); PG8_STAGE(PG8_SB(0, 1), cB + hstepB, voffB); PG8_STAGE(PG8_SA(0, 1), cA + hstepA, voffA);
        if (wr == 1) PG8_BAR;
        PG8_WAIT_V(4); PG8_BAR;
        PG8_STAGE(PG8_SB(1, 0), cB + kstep, voffB); PG8_STAGE(PG8_SA(1, 0), cA + kstep, voffA); PG8_STAGE(PG8_SB(1, 1), cB + hstepB + kstep, voffB);
        PG8_WAIT_V(6); PG8_BAR;
    }
    for (;;) {
        const bool has_next = S.next(ui + 1, nxt);
        const char* nA = has_next ? (const char*)g.A + (size_t)nxt.pm * tstepA : cA; const char* nB = has_next ? (const char*)g.Bt + (size_t)nxt.pn * tstepB : cB;
        for (int t = 0; t < nt; t += 2) {
            const bool last = (t == nt - 2);
            const char* a1 = cA + (size_t)(t + 1) * kstep;
            const char* a2 = last ? nA : cA + (size_t)(t + 2) * kstep; const char* b2 = last ? nB : cB + (size_t)(t + 2) * kstep;
            const char* a3 = a2 + kstep; const char* b3 = b2 + kstep;
            if (last && has_next) S.a_ready(nxt);
            if constexpr (SP2) {
            PG8_LDB(B0, 0, 0); PG8_LDB(B1, 0, 1); PG8_SCHED; PG8_LDA(At, 0, 0); PG8_STAGE(PG8_SA(1, 1), a1 + hstepA, voffA);
            PG8_WAIT_V(8); PG8_WAIT_L(0); PG8_BAR; PG8_MMA(0, 0, At, B0); PG8_MMA(0, 1, At, B1); PG8_BAR; PG8_SCHED;
            PG8_LDA(At, 0, 1); PG8_STAGE(PG8_SB(0, 0), b2, voffB); PG8_STAGE(PG8_SB(0, 1), b2 + hstepB, voffB); PG8_STAGE(PG8_SA(0, 0), a2, voffA);
            PG8_WAIT_V(8); PG8_WAIT_L(0); PG8_BAR; PG8_MMA(1, 0, At, B0); PG8_MMA(1, 1, At, B1); PG8_BAR; PG8_SCHED;
            PG8_LDB(B0, 1, 0); PG8_LDB(B1, 1, 1); PG8_SCHED; PG8_LDA(At, 1, 0); PG8_STAGE(PG8_SA(0, 1), a2 + hstepA, voffA);
            PG8_WAIT_V(8); PG8_WAIT_L(0); PG8_BAR; PG8_MMA(0, 0, At, B0); PG8_MMA(0, 1, At, B1); PG8_BAR; PG8_SCHED;
            PG8_LDA(At, 1, 1); PG8_STAGE(PG8_SB(1, 0), b3, voffB); PG8_STAGE(PG8_SB(1, 1), b3 + hstepB, voffB); PG8_STAGE(PG8_SA(1, 0), a3, voffA);
            PG8_WAIT_V(8); PG8_WAIT_L(0); PG8_BAR; PG8_MMA(1, 0, At, B0); PG8_MMA(1, 1, At, B1); PG8_BAR; PG8_SCHED;
            } else {
            PG8_LDB(B0, 0, 0); PG8_SCHED; PG8_LDA(At, 0, 0); PG8_STAGE(PG8_SA(1, 1), a1 + hstepA, voffA);
            PG8_WAIT_L(8); PG8_BAR; PG8_WAIT_L(0); PG8_MMA(0, 0, At, B0); PG8_BAR; PG8_SCHED;
            PG8_LDB(B1, 0, 1); PG8_STAGE(PG8_SB(0, 0), b2, voffB);
            PG8_BAR; PG8_WAIT_L(0); PG8_MMA(0, 1, At, B1); PG8_BAR;
            PG8_LDA(At, 0, 1); PG8_STAGE(PG8_SA(0, 0), a2, voffA);
            PG8_BAR; PG8_WAIT_L(0); PG8_MMA(1, 0, At, B0); PG8_BAR; PG8_SCHED;
            PG8_STAGE(PG8_SB(0, 1), b2 + hstepB, voffB);
            PG8_WAIT_V(6); PG8_BAR; PG8_MMA(1, 1, At, B1); PG8_BAR;
            PG8_LDB(B0, 1, 0); PG8_SCHED; PG8_LDA(At, 1, 0); PG8_STAGE(PG8_SA(0, 1), a2 + hstepA, voffA);
            PG8_WAIT_L(8); PG8_BAR; PG8_WAIT_L(0); PG8_MMA(0, 0, At, B0); PG8_BAR; PG8_SCHED;
            PG8_LDB(B1, 1, 1); PG8_STAGE(PG8_SB(1, 0), b3, voffB);
            PG8_BAR; PG8_WAIT_L(0); PG8_MMA(0, 1, At, B1); PG8_BAR;
            PG8_LDA(At, 1, 1); PG8_STAGE(PG8_SA(1, 0), a3, voffA);
            PG8_BAR; PG8_WAIT_L(0); PG8_MMA(1, 0, At, B0); PG8_BAR; PG8_SCHED;
            PG8_STAGE(PG8_SB(1, 1), b3 + hstepB, voffB);
            PG8_WAIT_V(6); PG8_BAR; PG8_MMA(1, 1, At, B1); PG8_BAR;
            }
        }
        if constexpr (ALIGN_EPI) { if (wr == 0) PG8_BAR; }
        if constexpr (!Epi::AFTER_DRAIN) { E(acc, cur, wr, wc, fr, fq); S.done(cur); }
        if (!has_next) break;
#pragma unroll
        for (int a = 0; a < 2; ++a)
#pragma unroll
            for (int b = 0; b < 2; ++b)
#pragma unroll
                for (int m = 0; m < 4; ++m)
#pragma unroll
                    for (int n = 0; n < 2; ++n) acc[a][b][m][n] = (f32x4){0.f, 0.f, 0.f, 0.f};
        cur = nxt; cA = nA; cB = nB; ++ui;
        if constexpr (ALIGN_EPI) { if (wr == 1) PG8_BAR; }
    }
    PG8_WAIT_V(0);
    if constexpr (!ALIGN_EPI) { if (wr == 0) PG8_BAR; }
    PG8_BAR;
    if constexpr (Epi::AFTER_DRAIN) { E.fused(acc, cur, wr, wc, fr, fq, lds, wid, lane); S.done(cur); }
#undef PG8_SA
#undef PG8_SB
#undef PG8_STAGE
#undef PG8_LDA
#undef PG8_LDB
#undef PG8_MMA
#undef PG8_WAIT_V
#undef PG8_WAIT_L
#undef PG8_BAR
#undef PG8_SCHED
}
}

#ifndef MK_N_LAUNCHES
#define MK_N_LAUNCHES 1
#endif
constexpr int NPHASE = 10;
constexpr int NWAVES = 8;

constexpr int D = 1024, SEQ = 2048, NBP = 8, NBS = 128, TS = 4;
constexpr int MP = NBP * SEQ;
constexpr int MS = NBS * TS;
constexpr int MT = MP + MS;
constexpr int MH = MT + 256;
constexpr int ACOLS = 2048, BCOLS = 1792, GCOLS = 2048, NIN = ACOLS + BCOLS + GCOLS, DFF = 4096;
constexpr int AW = 512, BW = 512;
constexpr float NORM_EPS = 1e-6f, HGRN_EPS = 1e-5f, GN_EPS = 64e-5f, DECAY_SCALE = 0.6065306597126334f;

constexpr size_t O_Y = 0, O_HGRN_P = (size_t)MT * D, O_WKV_P = O_HGRN_P + (size_t)NBP * 4 * 128 * 128, O_SHIFT_P = O_WKV_P + (size_t)NBP * 8 * 64 * 64,
                 O_HGRN_S = O_SHIFT_P + (size_t)NBP * D, O_WKV_S = O_HGRN_S + (size_t)NBS * 4 * 128 * 128, O_SHIFT_S = O_WKV_S + (size_t)NBS * 8 * 64 * 64,
                 O_END = O_SHIFT_S + (size_t)NBS * D;
static_assert(O_END == 30810112, "d_out size");

constexpr size_t WS_CTL = 0, CTL_BYTES = 65536;
constexpr size_t WS_WIN = WS_CTL + CTL_BYTES;
constexpr size_t WS_WA  = WS_WIN + (size_t)NIN * D * 2;
constexpr size_t WS_WB  = WS_WA + (size_t)D * AW * 2;
constexpr size_t WS_WO  = WS_WB + (size_t)D * BW * 2;
constexpr size_t WS_WUP = WS_WO + (size_t)D * D * 2;
constexpr size_t WS_WDN = WS_WUP + (size_t)DFF * D * 2;
constexpr size_t WS_UB  = WS_WDN + (size_t)D * DFF * 2;
constexpr size_t WS_UA  = WS_UB + (size_t)MH * BCOLS * 2;
constexpr size_t WS_UG  = WS_UA + (size_t)MT * ACOLS * 2;
constexpr size_t WS_BONUS = WS_UG + (size_t)MT * GCOLS * 2;
constexpr size_t WS_NS = WS_BONUS + (size_t)MT * 8 * 4;
constexpr size_t WS_GAMMA = WS_NS + (size_t)1024 * 16384 * 2;
constexpr size_t WS_WDT = WS_GAMMA + (size_t)1024 * 128 * 4;
constexpr size_t WS_WAT = WS_WDT + 512 * 64 * 2;
constexpr size_t WS_WGT = WS_WAT + 512 * 64 * 2;
constexpr size_t WS_END = WS_WGT + 512 * 128 * 2;
constexpr size_t WS_SSQ1 = WS_NS;
constexpr size_t WS_SSQ2 = WS_SSQ1 + (size_t)MT * 16 * 4;
static_assert(WS_END <= 268435456, "d_ws map");
static_assert(WS_UA + (size_t)MT * DFF * 2 == WS_BONUS, "hidden overlays UA|UG exactly");
static_assert((size_t)MT * 2048 * 2 == (size_t)MT * D * 4, "P fits the y region exactly");

constexpr int CW_TMO = 0, CW_BAR = 1024;

constexpr int RING_BYTES = 159744, LDSCTL_OFF = RING_BYTES, MISC_OFF = LDSCTL_OFF + 320, LDS_BYTES = 163840;

#define GAS __attribute__((address_space(1)))
#define LAS __attribute__((address_space(3)))
typedef unsigned short bf16;
typedef unsigned v4u __attribute__((ext_vector_type(4)));
typedef unsigned v2u __attribute__((ext_vector_type(2)));
typedef float f32x4 __attribute__((ext_vector_type(4)));
typedef GAS unsigned gu32;
#define RLX_AGENT __ATOMIC_RELAXED, __HIP_MEMORY_SCOPE_AGENT
#define LDS_WAIT() asm volatile("s_waitcnt lgkmcnt(0)" ::: "memory")
#define VM_WAIT() asm volatile("s_waitcnt vmcnt(0)" ::: "memory")
__device__ __forceinline__ unsigned f2bf(float f) { unsigned u = __builtin_bit_cast(unsigned, f); return (u + 0x7fffu + ((u >> 16) & 1u)) >> 16; }
__device__ __forceinline__ unsigned pk2(float lo, float hi) { return f2bf(lo) | (f2bf(hi) << 16); }
__device__ __forceinline__ float bf2f(unsigned b) { return __builtin_bit_cast(float, b << 16); }
__device__ __forceinline__ float bflo(unsigned w) { return __builtin_bit_cast(float, w << 16); }
__device__ __forceinline__ float bfhi(unsigned w) { return __builtin_bit_cast(float, w & 0xffff0000u); }
__device__ __forceinline__ float sigmoidf_(float x) { return __builtin_amdgcn_rcpf(1.0f + __expf(-x)); }
__device__ __forceinline__ float tanhf_(float x) { return 1.0f - 2.0f * __builtin_amdgcn_rcpf(1.0f + __expf(2.0f * x)); }
__device__ __forceinline__ float wave_sum(float v) {
#pragma unroll
    for (int o = 1; o < 64; o <<= 1) v += __shfl_xor(v, o);
    return v;
}
__device__ __forceinline__ float row_sum16(float x) {
    x += __builtin_bit_cast(float, __builtin_amdgcn_update_dpp(0, __builtin_bit_cast(int, x), 0xB1, 0xF, 0xF, true));
    x += __builtin_bit_cast(float, __builtin_amdgcn_update_dpp(0, __builtin_bit_cast(int, x), 0x4E, 0xF, 0xF, true));
    x += __builtin_bit_cast(float, __builtin_amdgcn_update_dpp(0, __builtin_bit_cast(int, x), 0x141, 0xF, 0xF, true));
    x += __builtin_bit_cast(float, __builtin_amdgcn_update_dpp(0, __builtin_bit_cast(int, x), 0x140, 0xF, 0xF, true));
    return x;
}
#define XB_TMO      128
#define XB_XCNT(j)  (256  + 64 * (j))
#define XB_XSUB(j)  (1280 + 64 * (j))
#define XB_XGEN(j)  (2304 + 64 * (j))
#define XB_TOP      3328
#define XB_TOPGEN   3392
#define XCD_BAR_WORDS 3456
#define XB_SPIN_CAP (1u << 18)

__device__ __forceinline__ unsigned xb_ld(unsigned* p)              { return __hip_atomic_load(p, __ATOMIC_RELAXED, __HIP_MEMORY_SCOPE_AGENT); }
__device__ __forceinline__ unsigned xb_add(unsigned* p, unsigned v) { return __hip_atomic_fetch_add(p, v, __ATOMIC_RELAXED, __HIP_MEMORY_SCOPE_AGENT); }
__device__ __forceinline__ unsigned xb_xcc_id() { return (unsigned)__builtin_amdgcn_s_getreg((3 << 11) | 20) & 0xFu; }
#define XB_SPIN(cond, bar) do { unsigned _sp = 0; while (cond) { __builtin_amdgcn_s_sleep(1); \
    if ((++_sp & 255u) == 0u) { if (xb_ld(&(bar)[XB_TMO])) break; if (_sp > XB_SPIN_CAP) { atomicAdd(&(bar)[XB_TMO], 1u); break; } } } } while (0)

struct XcdBarrier {
    unsigned* bar; unsigned x;
    volatile LAS unsigned* st;
};

__device__ __forceinline__ XcdBarrier xcd_barrier_post(unsigned* bar, volatile LAS unsigned* st) {
    XcdBarrier b; b.bar = bar; b.x = xb_xcc_id(); b.st = st;
    if (threadIdx.x == 0) (void)xb_add(&bar[XB_XCNT(b.x)], 1u);
    return b;
}
__device__ __forceinline__ void xcd_barrier_complete(unsigned* bar, unsigned x, unsigned& nloc, unsigned& nx) {
    const unsigned G = gridDim.x * gridDim.y * gridDim.z;
    unsigned sum, cnt, mine, sp = 0u;
    for (;;) {
        sum = 0u; cnt = 0u; mine = 0u;
#pragma unroll
        for (unsigned j = 0; j < 16; ++j) { const unsigned c = xb_ld(&bar[XB_XCNT(j)]); sum += c; cnt += (c > 0u) ? 1u : 0u; mine = (j == x) ? c : mine; }
        if (sum == G) break;
        __builtin_amdgcn_s_sleep(1);
        if ((++sp & 255u) == 0u) { if (xb_ld(&bar[XB_TMO])) break; if (sp > XB_SPIN_CAP) { atomicAdd(&bar[XB_TMO], 1u); break; } }
    }
    nloc = mine > 0u ? mine : 1u; nx = cnt > 0u ? cnt : 1u;
}

__device__ __forceinline__ void xcd_barrier(const XcdBarrier& b) {
    asm volatile("s_waitcnt vmcnt(0)" ::: "memory");
    __syncthreads();
    if (threadIdx.x == 0) {
        unsigned* bar = b.bar;
        __builtin_amdgcn_s_waitcnt(0);
        unsigned nloc = b.st[0], nx = b.st[1];
        if (nloc == 0u) { xcd_barrier_complete(bar, b.x, nloc, nx); b.st[0] = nloc; b.st[1] = nx; }
        const unsigned old = xb_add(&bar[XB_XSUB(b.x)], 1u);
        const unsigned gen = old / nloc;
        if (old + 1u == (gen + 1u) * nloc) {
            __builtin_amdgcn_fence(__ATOMIC_RELEASE, "agent");
            asm volatile("s_waitcnt vmcnt(0)" ::: "memory");
            const unsigned og = xb_add(&bar[XB_TOP], 1u);
            const unsigned tg = og / nx;
            if (og + 1u == (tg + 1u) * nx) xb_add(&bar[XB_TOPGEN], 1u);
            else XB_SPIN(xb_ld(&bar[XB_TOPGEN]) == tg, bar);
            __builtin_amdgcn_fence(__ATOMIC_ACQUIRE, "agent");
            xb_add(&bar[XB_XGEN(b.x)], 1u);
            asm volatile("s_waitcnt vmcnt(0)" ::: "memory");
        } else {
            XB_SPIN(xb_ld(&bar[XB_XGEN(b.x)]) == gen, bar);
            __builtin_amdgcn_fence(__ATOMIC_ACQUIRE, "agent");
            asm volatile("s_waitcnt vmcnt(0)" ::: "memory");
        }
    }
    __syncthreads();
}


struct Args { const float* in[27]; float* out; unsigned char* ws; int ph_lo, ph_hi; };
struct Frame {
    LAS unsigned char* lds;
    int tid, lane, wave, vcu, G;
};

struct SchedMN {
    pg8::StaticOrder so;
    __device__ void init(int M, int N, int G, int c) { so.init(M, N, G, c); }
    __device__ __forceinline__ bool next(int i, pg8::Unit& u) const { return so.next(i, u); }
    __device__ __forceinline__ void a_ready(const pg8::Unit&) const {}
    __device__ __forceinline__ void done(const pg8::Unit&) const {}
};
struct SchedG1 {
    pg8::StaticOrder so; int G, c;
    __device__ void init(int G_, int c_) { so.init(MT, NIN, G_, c_); G = G_; c = c_; }
    __device__ __forceinline__ bool next(int i, pg8::Unit& u) const {
        const int L = i * G + c;
        if (L < so.nwg) return so.next(i, u);
        if (L < so.nwg + 7) { u.pm = MT / 256; u.pn = 8 + (L - so.nwg); return true; }
        return false;
    }
    __device__ __forceinline__ void a_ready(const pg8::Unit&) const {}
    __device__ __forceinline__ void done(const pg8::Unit&) const {}
};

using pg8::f32x4; using pg8::Unit;
typedef unsigned u32x4 __attribute__((ext_vector_type(4)));
struct EpiG1 {
    static constexpr bool PERM = true, AFTER_DRAIN = false;
    bf16 *UA, *UB, *UG, *BR;
    __device__ __forceinline__ void operator()(const f32x4 (&acc)[2][2][4][2], const Unit& u, int wr, int wc, int fr, int fq) const {
        bf16* base; int ld, colt;
        if (u.pn < 8) { base = UA; ld = ACOLS; colt = u.pn * 256; } else if (u.pn < 15) { base = UB; ld = BCOLS; colt = (u.pn - 8) * 256; } else { base = UG; ld = GCOLS; colt = (u.pn - 15) * 256; }
        const int row0 = u.pm * 256 + wr * 64 + fr, col0 = colt + wc * 32 + 8 * fq;
#pragma unroll
        for (int ai = 0; ai < 2; ++ai)
#pragma unroll
            for (int m = 0; m < 4; ++m) { bf16* rowp = base + (size_t)(row0 + ai * 128 + m * 16) * ld + col0;
#pragma unroll
                for (int bj = 0; bj < 2; ++bj) { const f32x4 v0 = acc[ai][bj][m][0], v1 = acc[ai][bj][m][1];
                    u32x4 w; w.x = pk2(v0[0], v0[1]); w.y = pk2(v0[2], v0[3]); w.z = pk2(v1[0], v1[1]); w.w = pk2(v1[2], v1[3]);
                    *(u32x4*)(rowp + bj * 128) = w;
                    if ((m & 1) && fr == 15 && u.pn >= 8 && u.pn < 14 && u.pm < MP / 256) { const int row = row0 + ai * 128 + m * 16; *(u32x4*)(BR + (size_t)(row >> 5) * 1536 + col0 + bj * 128) = w; } } }
    }
};
template <bool ADD> struct EpiMerge {
    static constexpr bool PERM = true, AFTER_DRAIN = false;
    bf16* Mg; const bf16* UG; int goff;
    __device__ __forceinline__ void operator()(const f32x4 (&acc)[2][2][4][2], const Unit& u, int wr, int wc, int fr, int fq) const {
        const int row0 = u.pm * 256 + wr * 64 + fr, col0 = u.pn * 256 + wc * 32 + 8 * fq;
#pragma unroll
        for (int ai = 0; ai < 2; ++ai)
#pragma unroll
            for (int m = 0; m < 4; ++m) { const size_t row = (size_t)(row0 + ai * 128 + m * 16);
#pragma unroll
                for (int bj = 0; bj < 2; ++bj) { const f32x4 v0 = acc[ai][bj][m][0], v1 = acc[ai][bj][m][1];
                    const u32x4 gq = *(const u32x4*)(UG + row * GCOLS + goff + col0 + bj * 128);
                    float o[8];
                    o[0] = sigmoidf_(bflo(gq.x)) * v0[0]; o[1] = sigmoidf_(bfhi(gq.x)) * v0[1]; o[2] = sigmoidf_(bflo(gq.y)) * v0[2]; o[3] = sigmoidf_(bfhi(gq.y)) * v0[3];
                    o[4] = sigmoidf_(bflo(gq.z)) * v1[0]; o[5] = sigmoidf_(bfhi(gq.z)) * v1[1]; o[6] = sigmoidf_(bflo(gq.w)) * v1[2]; o[7] = sigmoidf_(bfhi(gq.w)) * v1[3];
                    bf16* dst = Mg + row * ACOLS + col0 + bj * 128;
                    if (ADD) { const u32x4 p = *(const u32x4*)dst;
                        o[0] += bflo(p.x); o[1] += bfhi(p.x); o[2] += bflo(p.y); o[3] += bfhi(p.y); o[4] += bflo(p.z); o[5] += bfhi(p.z); o[6] += bflo(p.w); o[7] += bfhi(p.w); }
                    u32x4 w; w.x = pk2(o[0], o[1]); w.y = pk2(o[2], o[3]); w.z = pk2(o[4], o[5]); w.w = pk2(o[6], o[7]);
                    *(u32x4*)dst = w; } }
    }
};
template <bool RES_IS_X, bool WRITE_BF, bool WRITE_SSQ> struct EpiRes {
    static constexpr bool PERM = false, AFTER_DRAIN = false;
    const float* xp; const float* xs; float* out; bf16* xb; int ldb; float* ssq;
    __device__ __forceinline__ void operator()(const f32x4 (&acc)[2][2][4][2], const Unit& u, int wr, int wc, int fr, int fq) const {
        const int row0 = u.pm * 256 + wr * 64 + fr, col0 = u.pn * 256 + wc * 32 + 4 * fq;
#pragma unroll
        for (int ai = 0; ai < 2; ++ai)
#pragma unroll
            for (int m = 0; m < 4; ++m) { const int row = row0 + ai * 128 + m * 16;
                const float* rp = RES_IS_X ? (row < MP ? xp + (size_t)row * D : xs + (size_t)(row - MP) * D) : out + (size_t)row * D;
                float s = 0.f;
#pragma unroll
                for (int bj = 0; bj < 2; ++bj)
#pragma unroll
                    for (int n = 0; n < 2; ++n) { const int col = col0 + bj * 128 + n * 16;
                        const f32x4 r = *(const f32x4*)(rp + col); const f32x4 o = r + acc[ai][bj][m][n];
                        *(f32x4*)(out + (size_t)row * D + col) = o;
                        s += (o[0] * o[0] + o[1] * o[1]) + (o[2] * o[2] + o[3] * o[3]);
                        if (WRITE_BF) { v2u w; w.x = pk2(o[0], o[1]); w.y = pk2(o[2], o[3]); *(v2u*)(xb + (size_t)row * ldb + col) = w; } }
                if (WRITE_SSQ) { s += __shfl_xor(s, 16); s += __shfl_xor(s, 32);
                    if (fq == 0) ssq[(size_t)row * 16 + u.pn * 4 + wc] = s; } }
    }
};
struct EpiUp {
    static constexpr bool PERM = true, AFTER_DRAIN = false;
    bf16* Hd; const float* ssq;
    __device__ __forceinline__ void operator()(const f32x4 (&acc)[2][2][4][2], const Unit& u, int wr, int wc, int fr, int fq) const {
        const int row0 = u.pm * 256 + wr * 64 + fr, col0 = u.pn * 256 + wc * 32 + 8 * fq;
#pragma unroll
        for (int ai = 0; ai < 2; ++ai)
#pragma unroll
            for (int m = 0; m < 4; ++m) { const size_t row = (size_t)(row0 + ai * 128 + m * 16);
                const f32x4* sp = (const f32x4*)(ssq + row * 16); const f32x4 a = sp[0], b = sp[1], c = sp[2], d = sp[3];
                const float tot = ((a[0] + a[1]) + (a[2] + a[3])) + ((b[0] + b[1]) + (b[2] + b[3])) + ((c[0] + c[1]) + (c[2] + c[3])) + ((d[0] + d[1]) + (d[2] + d[3]));
                const float rstd = rsqrtf(tot * (1.0f / D) + NORM_EPS);
#pragma unroll
                for (int bj = 0; bj < 2; ++bj) { const f32x4 v0 = acc[ai][bj][m][0], v1 = acc[ai][bj][m][1];
                    float o[8] = {v0[0], v0[1], v0[2], v0[3], v1[0], v1[1], v1[2], v1[3]};
#pragma unroll
                    for (int e = 0; e < 8; ++e) { const float t = fmaxf(o[e] * rstd, 0.f); o[e] = t * t; }
                    u32x4 w; w.x = pk2(o[0], o[1]); w.y = pk2(o[2], o[3]); w.z = pk2(o[4], o[5]); w.w = pk2(o[6], o[7]);
                    *(u32x4*)(Hd + row * DFF + col0 + bj * 128) = w; } }
    }
};

__device__ __forceinline__ void p0_transpose_item(const float* W, int K, int N, bf16* WT, const float* kscale, LAS float* scr, int item, int lane) {
    const int nblk = N / 32, kb = item / nblk, nb = item % nblk, k0 = 64 * kb, n0 = 32 * nb;
#pragma unroll 8
    for (int i = 0; i < 32; ++i) { const int kk = 2 * i + (lane >> 5); float v = W[(size_t)(k0 + kk) * N + n0 + (lane & 31)]; if (kscale) v *= kscale[k0 + kk]; scr[kk * 33 + (lane & 31)] = v; }
    LDS_WAIT(); asm volatile("" ::: "memory");
    const int c = lane & 7;
#pragma unroll
    for (int j = 0; j < 4; ++j) { const int n = (lane >> 3) + 8 * j; const LAS float* s = scr + (8 * c) * 33 + n;
        v4u o; o.x = pk2(s[0 * 33], s[1 * 33]); o.y = pk2(s[2 * 33], s[3 * 33]); o.z = pk2(s[4 * 33], s[5 * 33]); o.w = pk2(s[6 * 33], s[7 * 33]);
        *(GAS v4u*)(WT + (size_t)(n0 + n) * K + k0 + 8 * c) = o; }
    LDS_WAIT(); asm volatile("" ::: "memory");
}
__device__ __forceinline__ void p0_prologue(const Frame& F, const Args& A) {
    LAS float* scr = (LAS float*)(F.lds + F.wave * 16384);
    const int gw = F.vcu * NWAVES + F.wave, NGW = F.G * NWAVES;
    unsigned char* ws = A.ws;
    constexpr int I_IN = (D / 64) * (NIN / 32), I_A = (AW / 64) * (D / 32), I_O = (D / 64) * (D / 32), I_UP = (D / 64) * (DFF / 32), I_DN = (DFF / 64) * (D / 32);
    constexpr int I_L = 16, I_G = 32;
    constexpr int NITEMS = I_IN + 2 * I_A + I_O + I_UP + I_DN + 2 * I_L + I_G;
    for (int it = gw; it < NITEMS; it += NGW) {
        int r = it;
        if (r < I_IN) { p0_transpose_item(A.in[6], D, NIN, (bf16*)(ws + WS_WIN), nullptr, scr, r, F.lane); continue; } r -= I_IN;
        if (r < I_A) { p0_transpose_item(A.in[20], AW, D, (bf16*)(ws + WS_WA), nullptr, scr, r, F.lane); continue; } r -= I_A;
        if (r < I_A) { p0_transpose_item(A.in[21], BW, D, (bf16*)(ws + WS_WB), nullptr, scr, r, F.lane); continue; } r -= I_A;
        if (r < I_O) { p0_transpose_item(A.in[22], D, D, (bf16*)(ws + WS_WO), nullptr, scr, r, F.lane); continue; } r -= I_O;
        if (r < I_UP) { p0_transpose_item(A.in[24], D, DFF, (bf16*)(ws + WS_WUP), A.in[23], scr, r, F.lane); continue; } r -= I_UP;
        if (r < I_DN) { p0_transpose_item(A.in[25], DFF, D, (bf16*)(ws + WS_WDN), nullptr, scr, r, F.lane); continue; } r -= I_DN;
        if (r < I_L) { p0_transpose_item(A.in[9], 64, BW, (bf16*)(ws + WS_WDT), nullptr, scr, r, F.lane); continue; } r -= I_L;
        if (r < I_L) { p0_transpose_item(A.in[11], 64, BW, (bf16*)(ws + WS_WAT), nullptr, scr, r, F.lane); continue; } r -= I_L;
        p0_transpose_item(A.in[12], 128, BW, (bf16*)(ws + WS_WGT), nullptr, scr, r, F.lane);
    }
    bf16* H = (bf16*)A.out;
    const float* g = A.in[5];
    f32x4 gv[4];
#pragma unroll
    for (int j = 0; j < 4; ++j) gv[j] = ((const f32x4*)g)[F.lane + 64 * j];
    for (int m = gw; m < MH; m += NGW) {
        GAS unsigned long long* o8 = (GAS unsigned long long*)(H + (size_t)m * D) + F.lane;
        if (m < MT) {
            const float* xrow = m < MP ? A.in[0] + (size_t)m * D : A.in[1] + (size_t)(m - MP) * D;
            const f32x4* xr = (const f32x4*)xrow + F.lane;
            f32x4 v[4]; float s = 0.f;
#pragma unroll
            for (int j = 0; j < 4; ++j) { v[j] = xr[64 * j]; s += (v[j][0] * v[j][0] + v[j][1] * v[j][1]) + (v[j][2] * v[j][2] + v[j][3] * v[j][3]); }
            const float rstd = rsqrtf(wave_sum(s) * (1.0f / D) + NORM_EPS);
#pragma unroll
            for (int j = 0; j < 4; ++j) v[j] = v[j] * rstd * gv[j];
#pragma unroll
            for (int j = 0; j < 4; ++j) o8[64 * j] = (unsigned long long)pk2(v[j][0], v[j][1]) | ((unsigned long long)pk2(v[j][2], v[j][3]) << 32);
            float* so = nullptr;
            if (m < MP) { if ((m & (SEQ - 1)) == SEQ - 1) so = A.out + O_SHIFT_P + (size_t)(m >> 11) * D; }
            else { const int s_ = m - MP; if ((s_ & 3) == 3) so = A.out + O_SHIFT_S + (size_t)(s_ >> 2) * D; }
            if (so) {
#pragma unroll
                for (int j = 0; j < 4; ++j) ((f32x4*)so)[F.lane + 64 * j] = v[j];
            }
        } else if (m < MT + NBS) {
            const f32x4* xr = (const f32x4*)(A.in[4] + (size_t)(m - MT) * D) + F.lane;
#pragma unroll
            for (int j = 0; j < 4; ++j) { const f32x4 v = xr[64 * j]; o8[64 * j] = (unsigned long long)pk2(v[0], v[1]) | ((unsigned long long)pk2(v[2], v[3]) << 32); }
        } else {
#pragma unroll
            for (int j = 0; j < 4; ++j) o8[64 * j] = 0ull;
        }
    }
}

__device__ __forceinline__ int prev_row(int row) {
    if (row < MP) return (row & (SEQ - 1)) ? row - 1 : -1;
    const int s = row - MP; return (s & 3) ? row - 1 : MT + (s >> 2);
}
__device__ __forceinline__ float shifted(const bf16* UB, int row, int prow, int col, float mu) {
    const float ub = bf2f(UB[(size_t)row * BCOLS + col]);
    const float up = prow >= 0 ? bf2f(UB[(size_t)prow * BCOLS + col]) : 0.f;
    return ub + (up - ub) * mu;
}

typedef short bf16x8_t __attribute__((ext_vector_type(8)));
typedef short bf16x4_t __attribute__((ext_vector_type(4)));
typedef float f32x16 __attribute__((ext_vector_type(16)));
#define MFMA32(a, b, c) __builtin_amdgcn_mfma_f32_32x32x16_bf16((a), (b), (c), 0, 0, 0)
__device__ __forceinline__ int crow(int reg, int hh) { return (reg & 3) + 8 * (reg >> 2) + 4 * hh; }
__device__ __forceinline__ bf16x8_t pack8(float a0, float a1, float a2, float a3, float a4, float a5, float a6, float a7) {
    v4u p; p.x = pk2(a0, a1); p.y = pk2(a2, a3); p.z = pk2(a4, a5); p.w = pk2(a6, a7); return __builtin_bit_cast(bf16x8_t, p);
}
constexpr int HC = 64;
constexpr int H_TP = 72;
constexpr int H_KP = 136;
constexpr int H_OP = 132;
struct HPre { float b[16], kd[16], blast, bmid; };
__device__ __forceinline__ void hgrn_ld16(const bf16* src, unsigned short (&raw)[16]) {
#pragma unroll
    for (int j = 0; j < 16; ++j) raw[j] = src[(size_t)j * ACOLS];
}
__device__ __forceinline__ void hgrn_pre(const Frame& F, const unsigned short (&fzr)[16], float lbk, LAS float* segsum, HPre& R) {
    const int k = F.tid & 127, seg = F.tid >> 7;
    float run = 0.f;
#pragma unroll
    for (int j = 0; j < 16; ++j) { const float sg = sigmoidf_(bf2f(fzr[j])); R.kd[j] = (1.0f - lbk) * (1.0f - sg); run += __logf(lbk + (1.0f - lbk) * sg); R.b[j] = run; }
    segsum[seg * 128 + k] = run;
    __syncthreads();
    const float s0 = segsum[k], s1 = segsum[128 + k], s2 = segsum[256 + k], s3 = segsum[384 + k];
    const float pre = seg == 0 ? 0.f : (seg == 1 ? s0 : (seg == 2 ? s0 + s1 : s0 + s1 + s2));
#pragma unroll
    for (int j = 0; j < 16; ++j) R.b[j] += pre;
    R.bmid = s0 + s1; R.blast = (s0 + s1) + (s2 + s3);
}
__device__ __forceinline__ void hgrn_store_vt(const Frame& F, const unsigned short (&vr)[16], LAS bf16* VT) {
    const int v = F.tid & 127, seg = F.tid >> 7;
    LAS v4u* d = (LAS v4u*)(VT + v * H_TP + 16 * seg);
    d[0] = (v4u){(unsigned)vr[0] | ((unsigned)vr[1] << 16), (unsigned)vr[2] | ((unsigned)vr[3] << 16), (unsigned)vr[4] | ((unsigned)vr[5] << 16), (unsigned)vr[6] | ((unsigned)vr[7] << 16)};
    d[1] = (v4u){(unsigned)vr[8] | ((unsigned)vr[9] << 16), (unsigned)vr[10] | ((unsigned)vr[11] << 16), (unsigned)vr[12] | ((unsigned)vr[13] << 16), (unsigned)vr[14] | ((unsigned)vr[15] << 16)};
}
__device__ __forceinline__ void h1_unit(const Frame& F, const Args& A, int unit) {
    const bf16* UA = (const bf16*)(A.ws + WS_UA);
    bf16* NS = (bf16*)(A.ws + WS_NS) + (size_t)unit * 16384;
    float* gam = (float*)(A.ws + WS_GAMMA) + (size_t)unit * 128;
    const int bh = unit >> 5, c = unit & 31, b = bh >> 2, h = bh & 3, row0 = b * SEQ + c * HC;
    LAS bf16* KhT = (LAS bf16*)F.lds;
    LAS bf16* VT = KhT + 128 * H_TP;
    LAS float* segsum = (LAS float*)(VT + 128 * H_TP);
    const int k = F.tid & 127, seg = F.tid >> 7;
    const float lbk = __builtin_amdgcn_rcpf(1.0f + __expf(A.in[18][512 + h * 128 + k] - A.in[18][h * 128 + k]));
    unsigned short fzr[16], vr[16];
    { const bf16* rb = UA + (size_t)(row0 + 16 * seg) * ACOLS + h * 128 + k; hgrn_ld16(rb + 512, fzr); hgrn_ld16(rb + 1024, vr); }
    asm volatile("" ::: "memory");
    HPre R; hgrn_pre(F, fzr, lbk, segsum, R);
    {   unsigned w[8];
#pragma unroll
        for (int j = 0; j < 8; ++j) w[j] = pk2(R.kd[2 * j] * __expf(R.blast - R.b[2 * j]), R.kd[2 * j + 1] * __expf(R.blast - R.b[2 * j + 1]));
        LAS v4u* d = (LAS v4u*)(KhT + k * H_TP + 16 * seg);
        d[0] = (v4u){w[0], w[1], w[2], w[3]}; d[1] = (v4u){w[4], w[5], w[6], w[7]}; }
    if (seg == 0) gam[k] = __expf(R.blast);
    hgrn_store_vt(F, vr, VT);
    __syncthreads();
    const int r = F.lane & 31, hh = F.lane >> 5, vt = F.wave >> 1, kt0 = (F.wave & 1) * 2;
    f32x16 acc0, acc1;
#pragma unroll
    for (int i = 0; i < 16; ++i) { acc0[i] = 0.f; acc1[i] = 0.f; }
#pragma unroll
    for (int s = 0; s < 4; ++s) {
        const bf16x8_t a = *(const LAS bf16x8_t*)(VT + (vt * 32 + r) * H_TP + 16 * s + 8 * hh);
        const bf16x8_t b0 = *(const LAS bf16x8_t*)(KhT + (kt0 * 32 + r) * H_TP + 16 * s + 8 * hh);
        const bf16x8_t b1 = *(const LAS bf16x8_t*)(KhT + ((kt0 + 1) * 32 + r) * H_TP + 16 * s + 8 * hh);
        acc0 = MFMA32(a, b0, acc0); acc1 = MFMA32(a, b1, acc1);
    }
#pragma unroll
    for (int i = 0; i < 16; ++i) { const int v = vt * 32 + crow(i, hh);
        NS[v * 128 + kt0 * 32 + r] = (bf16)f2bf(acc0[i]); NS[v * 128 + (kt0 + 1) * 32 + r] = (bf16)f2bf(acc1[i]); }
    __syncthreads();
}
__device__ __forceinline__ void h2_part(const Frame& F, const Args& A, int start, int stride) {
    bf16* NS = (bf16*)(A.ws + WS_NS);
    const float* gam = (const float*)(A.ws + WS_GAMMA);
    for (int e = start; e < 32 * 2048; e += stride) {
        const int bh = e >> 11, vk = e & 2047, v = vk >> 4, k0 = (vk & 15) * 8;
        float S[8];
#pragma unroll
        for (int j = 0; j < 8; ++j) S[j] = 0.f;
        for (int c0 = 0; c0 < 32; c0 += 8) {
            v4u n[8]; f32x4 g0[8], g1[8];
#pragma unroll
            for (int u = 0; u < 8; ++u) { const size_t un = (size_t)(bh * 32 + c0 + u);
                n[u] = *(const v4u*)(NS + un * 16384 + v * 128 + k0); g0[u] = *(const f32x4*)(gam + un * 128 + k0); g1[u] = *(const f32x4*)(gam + un * 128 + k0 + 4); }
#pragma unroll
            for (int u = 0; u < 8; ++u) {
                v4u o; o.x = pk2(S[0], S[1]); o.y = pk2(S[2], S[3]); o.z = pk2(S[4], S[5]); o.w = pk2(S[6], S[7]);
                *(v4u*)(NS + (size_t)(bh * 32 + c0 + u) * 16384 + v * 128 + k0) = o;
                S[0] = g0[u][0] * S[0] + bflo(n[u].x); S[1] = g0[u][1] * S[1] + bfhi(n[u].x); S[2] = g0[u][2] * S[2] + bflo(n[u].y); S[3] = g0[u][3] * S[3] + bfhi(n[u].y);
                S[4] = g1[u][0] * S[4] + bflo(n[u].z); S[5] = g1[u][1] * S[5] + bfhi(n[u].z); S[6] = g1[u][2] * S[6] + bflo(n[u].w); S[7] = g1[u][3] * S[7] + bfhi(n[u].w);
            }
        }
        float* so = A.out + O_HGRN_P + (size_t)bh * 16384 + v;
#pragma unroll
        for (int j = 0; j < 8; ++j) so[(size_t)(k0 + j) * 128] = S[j];
    }
}
__device__ __forceinline__ void h3_unit(const Frame& F, const Args& A, int unit) {
    bf16* UA = (bf16*)(A.ws + WS_UA);
    const bf16* NS = (const bf16*)(A.ws + WS_NS) + (size_t)unit * 16384;
    const int bh = unit >> 5, c = unit & 31, b = bh >> 2, h = bh & 3, row0 = b * SEQ + c * HC;
    LAS bf16* Qh = (LAS bf16*)F.lds;
    LAS bf16* Qt = Qh + 64 * H_KP;
    LAS bf16* Kt = Qt + 64 * H_KP;
    LAS bf16* VT = Kt + 64 * H_KP;
    LAS float* segsum = (LAS float*)(VT + 128 * H_TP);
    LAS float* ssq = segsum + 512;
    LAS float* Ost = ssq + 256;
    const int k = F.tid & 127, seg = F.tid >> 7;
    const float lbk = __builtin_amdgcn_rcpf(1.0f + __expf(A.in[18][512 + h * 128 + k] - A.in[18][h * 128 + k]));
    unsigned short fzr[16], qr[16], vr[16];
    { const bf16* rb = UA + (size_t)(row0 + 16 * seg) * ACOLS + h * 128 + k; hgrn_ld16(rb + 512, fzr); hgrn_ld16(rb, qr); hgrn_ld16(rb + 1024, vr); }
    asm volatile("" ::: "memory");
    HPre R; hgrn_pre(F, fzr, lbk, segsum, R);
    {
#pragma unroll
        for (int j = 0; j < 16; ++j) { const float q = bf2f(qr[j]); const float qs = q * sigmoidf_(q); const int t = 16 * seg + j;
            Qh[t * H_KP + k] = (bf16)f2bf(qs * __expf(R.b[j]));
            Qt[t * H_KP + k] = (bf16)f2bf(qs * __expf(R.b[j] - R.bmid));
            Kt[t * H_KP + k] = (bf16)f2bf(R.kd[j] * __expf(R.bmid - R.b[j])); } }
    hgrn_store_vt(F, vr, VT);
    __syncthreads();
    const int r = F.lane & 31, hh = F.lane >> 5, vt = F.wave >> 1, tt = F.wave & 1;
    f32x16 o;
#pragma unroll
    for (int i = 0; i < 16; ++i) o[i] = 0.f;
#pragma unroll
    for (int st = 0; st < 2; ++st) {
        if (st <= tt) {
            f32x16 at;
#pragma unroll
            for (int i = 0; i < 16; ++i) at[i] = 0.f;
#pragma unroll
            for (int ks = 0; ks < 8; ++ks) {
                const bf16x8_t a = *(const LAS bf16x8_t*)(Kt + (st * 32 + r) * H_KP + 16 * ks + 8 * hh);
                const bf16x8_t bq = *(const LAS bf16x8_t*)(Qt + (tt * 32 + r) * H_KP + 16 * ks + 8 * hh);
                at = MFMA32(a, bq, at);
            }
            if (st == tt) {
#pragma unroll
                for (int i = 0; i < 16; ++i) if (crow(i, hh) > r) at[i] = 0.f;
            }
#pragma unroll
            for (int ks = 0; ks < 2; ++ks) {
                const bf16x4_t lo = *(const LAS bf16x4_t*)(VT + (vt * 32 + r) * H_TP + st * 32 + 16 * ks + 4 * hh);
                const bf16x4_t hi = *(const LAS bf16x4_t*)(VT + (vt * 32 + r) * H_TP + st * 32 + 16 * ks + 8 + 4 * hh);
                const bf16x8_t a = __builtin_shufflevector(lo, hi, 0, 1, 2, 3, 4, 5, 6, 7);
                const bf16x8_t bx = pack8(at[8 * ks], at[8 * ks + 1], at[8 * ks + 2], at[8 * ks + 3], at[8 * ks + 4], at[8 * ks + 5], at[8 * ks + 6], at[8 * ks + 7]);
                o = MFMA32(a, bx, o);
            }
        }
    }
    if (c > 0) {
#pragma unroll
        for (int ks = 0; ks < 8; ++ks) {
            const bf16x8_t a = *(const bf16x8_t*)(NS + (vt * 32 + r) * 128 + 16 * ks + 8 * hh);
            const bf16x8_t bq = *(const LAS bf16x8_t*)(Qh + (tt * 32 + r) * H_KP + 16 * ks + 8 * hh);
            o = MFMA32(a, bq, o);
        }
    }
    {   float s = 0.f;
#pragma unroll
        for (int i = 0; i < 16; ++i) { s += o[i] * o[i]; Ost[(tt * 32 + r) * H_OP + vt * 32 + crow(i, hh)] = o[i]; }
        s += __shfl_xor(s, 32);
        if (hh == 0) ssq[vt * 64 + tt * 32 + r] = s; }
    __syncthreads();
    {   const int t = F.tid >> 3, vg = F.tid & 7, row = row0 + t;
        const float tot = (ssq[t] + ssq[64 + t]) + (ssq[128 + t] + ssq[192 + t]);
        const float rs = rsqrtf(tot * (1.0f / 128.0f) + HGRN_EPS);
        const LAS f32x4* op = (const LAS f32x4*)(Ost + t * H_OP + 16 * vg);
        const v4u* gp = (const v4u*)(UA + (size_t)row * ACOLS + 1536 + h * 128 + 16 * vg);
        const f32x4* nwp = (const f32x4*)(A.in[19] + h * 128 + 16 * vg);
        v4u outw[2];
#pragma unroll
        for (int half = 0; half < 2; ++half) {
            const v4u g = gp[half]; const f32x4 o0 = op[2 * half], o1 = op[2 * half + 1], n0 = nwp[2 * half], n1 = nwp[2 * half + 1];
            const float gg[8] = {bflo(g.x), bfhi(g.x), bflo(g.y), bfhi(g.y), bflo(g.z), bfhi(g.z), bflo(g.w), bfhi(g.w)};
            const float ov[8] = {o0[0] * n0[0], o0[1] * n0[1], o0[2] * n0[2], o0[3] * n0[3], o1[0] * n1[0], o1[1] * n1[1], o1[2] * n1[2], o1[3] * n1[3]};
            float f[8];
#pragma unroll
            for (int e = 0; e < 8; ++e) f[e] = ov[e] * rs * (gg[e] * sigmoidf_(gg[e]));
            outw[half] = (v4u){pk2(f[0], f[1]), pk2(f[2], f[3]), pk2(f[4], f[5]), pk2(f[6], f[7])};
        }
        v4u* dst = (v4u*)(UA + (size_t)row * ACOLS + 1024 + h * 128 + 16 * vg);
        dst[0] = outw[0]; dst[1] = outw[1]; }
    __syncthreads();
}
__device__ __forceinline__ void hgrn_sample_unit(const Frame& F, const Args& A, int bh) {
    bf16* UA = (bf16*)(A.ws + WS_UA);
    const int b = bh >> 2, h = bh & 3, row0 = MP + 4 * b;
    LAS float* vec = (LAS float*)F.lds;
    LAS float* opart = vec + 4 * 384;
    LAS float* red = opart + 2048;
    const int v = F.tid & 127, kq = F.tid >> 7;
    {   const int t = kq, k = v, ch = h * 128 + k;
        const float lbk = __builtin_amdgcn_rcpf(1.0f + __expf(A.in[18][512 + ch] - A.in[18][ch]));
        const float sg = sigmoidf_(bf2f(UA[(size_t)(row0 + t) * ACOLS + 512 + ch])), q = bf2f(UA[(size_t)(row0 + t) * ACOLS + ch]);
        vec[t * 384 + k] = lbk + (1.0f - lbk) * sg; vec[t * 384 + 128 + k] = (1.0f - lbk) * (1.0f - sg); vec[t * 384 + 256 + k] = q * sigmoidf_(q); }
    float iv[4];
#pragma unroll
    for (int t = 0; t < 4; ++t) iv[t] = bf2f(UA[(size_t)(row0 + t) * ACOLS + 1024 + h * 128 + v]);
    const float* sin_ = A.in[2] + (size_t)bh * 16384 + (size_t)(32 * kq) * 128 + v;
    float S[32];
#pragma unroll
    for (int j = 0; j < 32; ++j) S[j] = sin_[(size_t)j * 128];
    __syncthreads();
#pragma unroll
    for (int t = 0; t < 4; ++t) {
        const LAS float* fv = vec + t * 384 + 32 * kq;
        float o = 0.f;
#pragma unroll
        for (int j4 = 0; j4 < 8; ++j4) { const f32x4 f = *(const LAS f32x4*)(fv + 4 * j4), d = *(const LAS f32x4*)(fv + 128 + 4 * j4), q = *(const LAS f32x4*)(fv + 256 + 4 * j4);
#pragma unroll
            for (int e = 0; e < 4; ++e) { S[4 * j4 + e] = f[e] * S[4 * j4 + e] + d[e] * iv[t]; o += S[4 * j4 + e] * q[e]; } }
        opart[(t * 4 + kq) * 128 + v] = o;
    }
    float* sout = A.out + O_HGRN_S + (size_t)bh * 16384 + (size_t)(32 * kq) * 128 + v;
#pragma unroll
    for (int j = 0; j < 32; ++j) sout[(size_t)j * 128] = S[j];
    __syncthreads();
    {   const int t = kq;
        const float o = (opart[(t * 4 + 0) * 128 + v] + opart[(t * 4 + 1) * 128 + v]) + (opart[(t * 4 + 2) * 128 + v] + opart[(t * 4 + 3) * 128 + v]);
        const float ss = wave_sum(o * o);
        if (F.lane == 0) red[F.wave] = ss;
        __syncthreads();
        const float tot = red[F.wave & ~1] + red[F.wave | 1];
        const int ch = h * 128 + v; const size_t row = (size_t)(row0 + t);
        const float g = bf2f(UA[row * ACOLS + 1536 + ch]);
        UA[row * ACOLS + 1024 + ch] = (bf16)f2bf(o * rsqrtf(tot * (1.0f / 128.0f) + HGRN_EPS) * A.in[19][ch] * (g * sigmoidf_(g))); }
    __syncthreads();
}


typedef float f32x4_t __attribute__((ext_vector_type(4)));
#define MFMA16(a, b, c) __builtin_amdgcn_mfma_f32_16x16x32_bf16((a), (b), (c), 0, 0, 0)
constexpr int RC = 32;
constexpr int R_TP = 72;
constexpr int R_CP = 40;
constexpr int RL_A = 0;
constexpr int RL_B = RL_A + 9216;
constexpr int RL_C = RL_B + 16384;
constexpr int RL_D = RL_C + 9216;
constexpr int RL_E = RL_D + 18432;
constexpr int RL_F = RL_E + 20480;
constexpr int RL_UNIT = RL_F + 512;
constexpr int RL_PAR = 2 * RL_UNIT;
static_assert(RL_PAR + 5 * 512 * 4 <= RING_BYTES, "two R1 units + parameters in LDS");
__device__ __forceinline__ float red8(float x) {
    x += __builtin_bit_cast(float, __builtin_amdgcn_update_dpp(0, __builtin_bit_cast(int, x), 0xB1, 0xF, 0xF, true));
    x += __builtin_bit_cast(float, __builtin_amdgcn_update_dpp(0, __builtin_bit_cast(int, x), 0x4E, 0xF, 0xF, true));
    x += __builtin_bit_cast(float, __builtin_amdgcn_update_dpp(0, __builtin_bit_cast(int, x), 0x141, 0xF, 0xF, true));
    return x;
}
__device__ __forceinline__ void unpack8(const v4u w, float (&o)[8]) { o[0] = bflo(w.x); o[1] = bfhi(w.x); o[2] = bflo(w.y); o[3] = bfhi(w.y); o[4] = bflo(w.z); o[5] = bfhi(w.z); o[6] = bflo(w.w); o[7] = bfhi(w.w); }
__device__ __forceinline__ v4u packw8(const float (&f)[8]) { return (v4u){pk2(f[0], f[1]), pk2(f[2], f[3]), pk2(f[4], f[5]), pk2(f[6], f[7])}; }

__device__ __forceinline__ void r1_pass(const Frame& F, const Args& A, int unit, bool active) {
    bf16* UB = (bf16*)(A.ws + WS_UB);
    const bf16* BR = (const bf16*)(A.out + O_HGRN_S);
    const bf16* Wdt = (const bf16*)(A.ws + WS_WDT); const bf16* Wat = (const bf16*)(A.ws + WS_WAT);
    float* bonus = (float*)(A.ws + WS_BONUS);
    const int sub = F.wave >> 2, w4 = F.wave & 3, tid4 = F.tid & 255, r = F.lane & 31, hh = F.lane >> 5;
    LAS unsigned char* L = F.lds + sub * RL_UNIT;
    LAS bf16* AWs = (LAS bf16*)(L + RL_A); LAS bf16* AAs = AWs + 32 * R_TP;
    LAS bf16* Bm = (LAS bf16*)(L + RL_A); LAS bf16* RAm = Bm + 32 * R_CP; LAS bf16* RKm = RAm + 32 * R_CP;
    LAS float* DEC = (LAS float*)(L + RL_B); LAS float* AAo = DEC + 32 * 64;
    LAS float* BVf = (LAS float*)(L + RL_B); LAS float* Af = BVf + 32 * 64;
    LAS float* CUM = (LAS float*)(L + RL_C); LAS float* SEG = CUM + 32 * 64;
    LAS bf16* Kt = (LAS bf16*)(L + RL_D); LAS bf16* Ah = Kt + 32 * R_TP; LAS bf16* Kh = Ah + 32 * R_TP; LAS bf16* Rt = Kh + 32 * R_TP;
    LAS bf16* KbT = (LAS bf16*)(L + RL_D); LAS bf16* VbT = KbT + 64 * R_CP;
    LAS bf16* KtT = (LAS bf16*)(L + RL_E); LAS bf16* AcT = KtT + 64 * R_CP; LAS bf16* KcT = AcT + 64 * R_CP; LAS bf16* VT = KcT + 64 * R_CP;
    LAS float* GC = (LAS float*)(L + RL_F); LAS float* CL = GC + 64;
    const LAS float* PAR = (const LAS float*)(F.lds + RL_PAR);
    const int b = unit >> 9, h = (unit >> 6) & 7, c = unit & 63, row0 = b * SEQ + c * RC;
    unsigned char* mn = (unsigned char*)A.out + (size_t)unit * 16384;
    const int t = tid4 >> 3, jg = tid4 & 7, row = row0 + t;
    float xr[8], xk[8], xv[8];
    if (active) {
        const float* mu = A.in[7];
        const int cols[5] = {h * 64 + 8 * jg, 512 + h * 64 + 8 * jg, 1024 + h * 64 + 8 * jg, 1536 + 8 * jg, 1600 + 8 * jg};
        float x5[5][8];
#pragma unroll
        for (int q = 0; q < 5; ++q) {
            float cur[8], prv[8];
            unpack8(*(const v4u*)(UB + (size_t)row * BCOLS + cols[q]), cur);
            v4u pw = (v4u){0, 0, 0, 0};
            if (t > 0 || q >= 3) { if (t > 0 || c > 0) pw = *(const v4u*)(UB + (size_t)(row - 1) * BCOLS + cols[q]); }
            else if (c > 0) pw = *(const v4u*)(BR + (size_t)(b * 64 + c - 1) * 1536 + cols[q]);
            unpack8(pw, prv);
            const f32x4 m0 = *(const f32x4*)(mu + cols[q]), m1 = *(const f32x4*)(mu + cols[q] + 4);
#pragma unroll
            for (int e = 0; e < 8; ++e) x5[q][e] = cur[e] + (prv[e] - cur[e]) * (e < 4 ? m0[e] : m1[e - 4]);
        }
#pragma unroll
        for (int e = 0; e < 8; ++e) { xr[e] = x5[0][e]; xk[e] = x5[1][e]; xv[e] = x5[2][e]; x5[3][e] = tanhf_(x5[3][e]); }
        *(LAS v4u*)(AWs + t * R_TP + 8 * jg) = packw8(x5[3]);
        *(LAS v4u*)(AAs + t * R_TP + 8 * jg) = packw8(x5[4]);
    }
    __syncthreads();
    if (active) {
        const int which = w4 >> 1, jt = w4 & 1;
        const LAS bf16* As = which ? AAs : AWs; const bf16* Wt = (which ? Wat : Wdt) + (size_t)(h * 64 + jt * 32 + r) * 64;
        f32x16 acc;
#pragma unroll
        for (int i = 0; i < 16; ++i) acc[i] = 0.f;
#pragma unroll
        for (int s = 0; s < 4; ++s) acc = MFMA32(*(const LAS bf16x8_t*)(As + r * R_TP + 16 * s + 8 * hh), *(const bf16x8_t*)(Wt + 16 * s + 8 * hh), acc);
        LAS float* O = which ? AAo : DEC;
#pragma unroll
        for (int i = 0; i < 16; ++i) O[crow(i, hh) * 64 + jt * 32 + r] = acc[i];
    }
    __syncthreads();
    float lw[8], kk[8], al[8], k2[8];
    if (active) {
        const int ch = h * 64 + 8 * jg;
        float dec[8], aa[8];
        { const f32x4 d0 = *(const LAS f32x4*)(DEC + t * 64 + 8 * jg), d1 = *(const LAS f32x4*)(DEC + t * 64 + 8 * jg + 4), a0 = *(const LAS f32x4*)(AAo + t * 64 + 8 * jg), a1 = *(const LAS f32x4*)(AAo + t * 64 + 8 * jg + 4);
#pragma unroll
          for (int e = 0; e < 4; ++e) { dec[e] = d0[e]; dec[4 + e] = d1[e]; aa[e] = a0[e]; aa[4 + e] = a1[e]; } }
        float n2 = 0.f, bs = 0.f, kp[8], av[8];
#pragma unroll
        for (int e = 0; e < 8; ++e) {
            lw[e] = -DECAY_SCALE * sigmoidf_(PAR[ch + e] + dec[e]);
            av[e] = sigmoidf_(PAR[512 + ch + e] + aa[e]);
            kp[e] = xk[e] * PAR[1024 + ch + e]; n2 += kp[e] * kp[e];
            k2[e] = xk[e] * (1.0f + (av[e] - 1.0f) * PAR[1536 + ch + e]);
            bs += xr[e] * k2[e] * PAR[2048 + ch + e];
        }
        n2 = red8(n2); bs = red8(bs);
        const float inv = 1.0f / fmaxf(sqrtf(n2), 1e-12f);
#pragma unroll
        for (int e = 0; e < 8; ++e) { kk[e] = kp[e] * inv; al[e] = kk[e] * av[e]; }
        if (jg == 0) bonus[(size_t)row * 8 + h] = bs;
        *(LAS f32x4*)(CUM + t * 64 + 8 * jg) = (f32x4){lw[0], lw[1], lw[2], lw[3]};
        *(LAS f32x4*)(CUM + t * 64 + 8 * jg + 4) = (f32x4){lw[4], lw[5], lw[6], lw[7]};
    }
    __syncthreads();
    {
        const int j = tid4 & 63, seg = tid4 >> 6;
        float v8[8], run = 0.f;
        if (active) {
#pragma unroll
            for (int e = 0; e < 8; ++e) { run += CUM[(8 * seg + e) * 64 + j]; v8[e] = run; }
            SEG[seg * 64 + j] = run;
        }
        __syncthreads();
        if (active) {
            const float s0 = SEG[j], s1 = SEG[64 + j], s2 = SEG[128 + j], s3 = SEG[192 + j];
            const float pre = seg == 0 ? 0.f : (seg == 1 ? s0 : (seg == 2 ? s0 + s1 : s0 + s1 + s2));
#pragma unroll
            for (int e = 0; e < 8; ++e) CUM[(8 * seg + e) * 64 + j] = v8[e] + pre;
            if (seg == 0) { const float tot = (s0 + s1) + (s2 + s3); CL[j] = tot; GC[j] = __expf(tot); }
        }
    }
    __syncthreads();
    if (active) {
        float cum[8], cl[8];
        { const f32x4 c0 = *(const LAS f32x4*)(CUM + t * 64 + 8 * jg), c1 = *(const LAS f32x4*)(CUM + t * 64 + 8 * jg + 4), l0 = *(const LAS f32x4*)(CL + 8 * jg), l1 = *(const LAS f32x4*)(CL + 8 * jg + 4);
#pragma unroll
          for (int e = 0; e < 4; ++e) { cum[e] = c0[e]; cum[4 + e] = c1[e]; cl[e] = l0[e]; cl[4 + e] = l1[e]; } }
        float fKt[8], fAh[8], fKh[8], fRt[8];
#pragma unroll
        for (int e = 0; e < 8; ++e) {
            const float gt = __expf(cum[e]), gm1 = __expf(cum[e] - lw[e]), gi = __expf(-cum[e]), gc = __expf(cl[e] - cum[e]);
            fKt[e] = kk[e] * gm1; fAh[e] = al[e] * gi; fKh[e] = k2[e] * gi; fRt[e] = xr[e] * gt;
            const int j = 8 * jg + e;
            KtT[j * R_CP + t] = (bf16)f2bf(fKt[e]); AcT[j * R_CP + t] = (bf16)f2bf(al[e] * gc); KcT[j * R_CP + t] = (bf16)f2bf(k2[e] * gc); VT[j * R_CP + t] = (bf16)f2bf(xv[e]);
        }
        *(LAS v4u*)(Kt + t * R_TP + 8 * jg) = packw8(fKt); *(LAS v4u*)(Ah + t * R_TP + 8 * jg) = packw8(fAh);
        *(LAS v4u*)(Kh + t * R_TP + 8 * jg) = packw8(fKh); *(LAS v4u*)(Rt + t * R_TP + 8 * jg) = packw8(fRt);
        *(v4u*)(UB + (size_t)row * BCOLS + 1024 + h * 64 + 8 * jg) = packw8(xv);
    }
    __syncthreads();
    LAS bf16* BVT = (LAS bf16*)(L + RL_B);
    LAS bf16* QA = BVT + 64 * R_CP; LAS bf16* QT = QA + 32 * R_CP; LAS bf16* PP = QT + 32 * R_CP; LAS bf16* TT = PP + 32 * R_CP;
    f32x16 pacc;
    if (active) {
        const LAS bf16* Ls = (w4 < 2) ? Kt : Rt; const LAS bf16* Rs = (w4 & 1) ? Kh : Ah;
        f32x16 acc;
#pragma unroll
        for (int i = 0; i < 16; ++i) acc[i] = 0.f;
#pragma unroll
        for (int s = 0; s < 4; ++s) acc = MFMA32(*(const LAS bf16x8_t*)(Ls + r * R_TP + 16 * s + 8 * hh), *(const LAS bf16x8_t*)(Rs + r * R_TP + 16 * s + 8 * hh), acc);
#pragma unroll
        for (int i = 0; i < 16; ++i) { const int tt = crow(i, hh); const bool keep = (w4 < 2) ? (r < tt) : (r <= tt); acc[i] = keep ? acc[i] : 0.f; }
        if (w4 == 0) {
#pragma unroll
            for (int i = 0; i < 16; ++i) { const int tt = crow(i, hh); pacc[i] = (tt == r ? 1.0f : 0.0f) - acc[i]; QA[tt * R_CP + r] = (bf16)f2bf(acc[i]); PP[tt * R_CP + r] = (bf16)f2bf(pacc[i]); }
#pragma unroll
            for (int g = 0; g < 4; ++g) { v2u w; w.x = pk2(acc[4 * g], acc[4 * g + 1]); w.y = pk2(acc[4 * g + 2], acc[4 * g + 3]); *(LAS v2u*)(QT + r * R_CP + 8 * g + 4 * hh) = w; }
        } else {
            LAS bf16* O = w4 == 1 ? Bm : (w4 == 2 ? RAm : RKm);
#pragma unroll
            for (int i = 0; i < 16; ++i) O[crow(i, hh) * R_CP + r] = (bf16)f2bf(acc[i]);
        }
    }
    __syncthreads();
    if (active && w4 == 0) {
#pragma unroll
        for (int st = 0; st < 5; ++st) {
            asm volatile("s_waitcnt lgkmcnt(0)" ::: "memory");
            const bf16x8_t qt0 = *(const LAS bf16x8_t*)(QT + r * R_CP + 8 * hh), qt1 = *(const LAS bf16x8_t*)(QT + r * R_CP + 16 + 8 * hh);
            if (st > 0) { const bf16x8_t p0 = *(const LAS bf16x8_t*)(PP + r * R_CP + 8 * hh), p1 = *(const LAS bf16x8_t*)(PP + r * R_CP + 16 + 8 * hh);
                pacc = MFMA32(p0, qt0, pacc); pacc = MFMA32(p1, qt1, pacc); }
            if (st < 4) {
                const bf16x8_t q0 = *(const LAS bf16x8_t*)(QA + r * R_CP + 8 * hh), q1 = *(const LAS bf16x8_t*)(QA + r * R_CP + 16 + 8 * hh);
                f32x16 qacc;
#pragma unroll
                for (int i = 0; i < 16; ++i) qacc[i] = 0.f;
                qacc = MFMA32(q0, qt0, qacc); qacc = MFMA32(q1, qt1, qacc);
#pragma unroll
                for (int i = 0; i < 16; ++i) QA[crow(i, hh) * R_CP + r] = (bf16)f2bf(qacc[i]);
#pragma unroll
                for (int g = 0; g < 4; ++g) { v2u w; w.x = pk2(qacc[4 * g], qacc[4 * g + 1]); w.y = pk2(qacc[4 * g + 2], qacc[4 * g + 3]); *(LAS v2u*)(QT + r * R_CP + 8 * g + 4 * hh) = w; }
            }
            if (st > 0 && st < 4) {
#pragma unroll
                for (int i = 0; i < 16; ++i) PP[crow(i, hh) * R_CP + r] = (bf16)f2bf(pacc[i]);
            }
        }
#pragma unroll
        for (int i = 0; i < 16; ++i) TT[crow(i, hh) * R_CP + r] = (bf16)f2bf(pacc[i]);
    }
    if (active && (w4 == 1 || w4 == 2)) {
        const int it = w4 - 1;
        f32x16 acc;
#pragma unroll
        for (int i = 0; i < 16; ++i) acc[i] = 0.f;
#pragma unroll
        for (int s = 0; s < 2; ++s) acc = MFMA32(*(const LAS bf16x8_t*)(Bm + r * R_CP + 16 * s + 8 * hh), *(const LAS bf16x8_t*)(VT + (it * 32 + r) * R_CP + 16 * s + 8 * hh), acc);
#pragma unroll
        for (int g = 0; g < 4; ++g) { v2u w; w.x = pk2(acc[4 * g], acc[4 * g + 1]); w.y = pk2(acc[4 * g + 2], acc[4 * g + 3]); *(LAS v2u*)(BVT + (it * 32 + r) * R_CP + 8 * g + 4 * hh) = w; }
    }
    __syncthreads();
    if (active) {
        const LAS bf16* Asrc = (w4 < 2 ? KtT : BVT) + ((w4 & 1) * 32 + r) * R_CP;
        f32x16 acc;
#pragma unroll
        for (int i = 0; i < 16; ++i) acc[i] = 0.f;
#pragma unroll
        for (int s = 0; s < 2; ++s) acc = MFMA32(*(const LAS bf16x8_t*)(Asrc + 16 * s + 8 * hh), *(const LAS bf16x8_t*)(TT + r * R_CP + 16 * s + 8 * hh), acc);
        LAS bf16* O = (w4 < 2 ? KbT : VbT) + (w4 & 1) * 32 * R_CP;
#pragma unroll
        for (int i = 0; i < 16; ++i) O[crow(i, hh) * R_CP + r] = (bf16)f2bf(-acc[i]);
    }
    __syncthreads();
    if (active) {
        const int jt = w4 >> 1, ct = w4 & 1;
        f32x16 am, an;
#pragma unroll
        for (int i = 0; i < 16; ++i) { am[i] = 0.f; an[i] = 0.f; }
#pragma unroll
        for (int s = 0; s < 2; ++s) {
            const bf16x8_t a_ac = *(const LAS bf16x8_t*)(AcT + (jt * 32 + r) * R_CP + 16 * s + 8 * hh), a_kc = *(const LAS bf16x8_t*)(KcT + (jt * 32 + r) * R_CP + 16 * s + 8 * hh);
            am = MFMA32(a_ac, *(const LAS bf16x8_t*)(KbT + (ct * 32 + r) * R_CP + 16 * s + 8 * hh), am);
            an = MFMA32(a_kc, *(const LAS bf16x8_t*)(VT + (ct * 32 + r) * R_CP + 16 * s + 8 * hh), an);
            an = MFMA32(a_ac, *(const LAS bf16x8_t*)(VbT + (ct * 32 + r) * R_CP + 16 * s + 8 * hh), an);
        }
        LAS bf16* Mp = (LAS bf16*)(L + RL_B); LAS bf16* Np = Mp + 4096;
        LAS bf16* RYs = (LAS bf16*)(L + RL_C);
        const int cj = ct * 32 + r;
#pragma unroll
        for (int i = 0; i < 16; ++i) {
            const int j = jt * 32 + crow(i, hh);
            float mv = am[i]; if (j == cj) mv += GC[j];
            const int s2 = cj >> 5, rem = cj & 31, e = 4 * (rem >> 4) + (rem & 3), q = (rem >> 2) & 3;
            Mp[j * 64 + s2 * 32 + q * 8 + e] = (bf16)f2bf(mv);
            Np[cj * 64 + ((j >> 2) & 3) * 16 + (j >> 4) * 4 + (j & 3)] = (bf16)f2bf(an[i]);
        }
        f32x16 ay;
        if (w4 < 2) {
#pragma unroll
            for (int i = 0; i < 16; ++i) ay[i] = bf2f(Rt[crow(i, hh) * R_TP + w4 * 32 + r]);
#pragma unroll
            for (int s = 0; s < 2; ++s) ay = MFMA32(*(const LAS bf16x8_t*)(RAm + r * R_CP + 16 * s + 8 * hh), *(const LAS bf16x8_t*)(KbT + (w4 * 32 + r) * R_CP + 16 * s + 8 * hh), ay);
#pragma unroll
            for (int i = 0; i < 16; ++i) RYs[crow(i, hh) * 64 + w4 * 32 + r] = (bf16)f2bf(ay[i]);
        } else {
            const int it = w4 - 2;
#pragma unroll
            for (int i = 0; i < 16; ++i) ay[i] = 0.f;
#pragma unroll
            for (int s = 0; s < 2; ++s) {
                ay = MFMA32(*(const LAS bf16x8_t*)(RKm + r * R_CP + 16 * s + 8 * hh), *(const LAS bf16x8_t*)(VT + (it * 32 + r) * R_CP + 16 * s + 8 * hh), ay);
                ay = MFMA32(*(const LAS bf16x8_t*)(RAm + r * R_CP + 16 * s + 8 * hh), *(const LAS bf16x8_t*)(VbT + (it * 32 + r) * R_CP + 16 * s + 8 * hh), ay);
            }
#pragma unroll
            for (int i = 0; i < 16; ++i) RYs[2048 + crow(i, hh) * 64 + it * 32 + r] = (bf16)f2bf(ay[i]);
        }
    }
    __syncthreads();
    if (active) {
        const LAS v4u* src = (const LAS v4u*)(L + RL_B);
#pragma unroll
        for (int q = 0; q < 4; ++q) ((v4u*)mn)[tid4 + 256 * q] = src[tid4 + 256 * q];
        const LAS v4u* ry = (const LAS v4u*)(L + RL_C);
        const int tr = tid4 >> 3, pc = tid4 & 7;
        *(v4u*)(UB + (size_t)(row0 + tr) * BCOLS + h * 64 + 8 * pc) = ry[tr * 8 + pc];
        *(v4u*)(UB + (size_t)(row0 + tr) * BCOLS + 512 + h * 64 + 8 * pc) = ry[256 + tr * 8 + pc];
    }
    __syncthreads();
}

__device__ __forceinline__ void r2_wave(const Frame& F, const Args& A, int bh, int wq) {
    const int m = F.lane & 15, q = F.lane >> 4, i = 16 * wq + m;
    f32x4_t acc[4];
#pragma unroll
    for (int jt = 0; jt < 4; ++jt) acc[jt] = (f32x4_t){0.f, 0.f, 0.f, 0.f};
    unsigned char* base = (unsigned char*)A.out + (size_t)bh * 64 * 16384;
    v4u Mf[3][8], Nf[3][2];
#define R2_LOAD(buf, c) do { const unsigned char* u_ = base + (size_t)(c) * 16384; \
        _Pragma("unroll") for (int jt = 0; jt < 4; ++jt) _Pragma("unroll") for (int s2 = 0; s2 < 2; ++s2) Mf[buf][2 * jt + s2] = *(const v4u*)(u_ + ((16 * jt + m) * 64 + s2 * 32 + q * 8) * 2); \
        Nf[buf][0] = *(const v4u*)(u_ + 8192 + (i * 64 + q * 16) * 2); Nf[buf][1] = *(const v4u*)(u_ + 8192 + (i * 64 + q * 16 + 8) * 2); } while (0)
#define R2_STEP(u, c) do { \
            const bf16x8_t b0 = pack8(acc[0][0], acc[0][1], acc[0][2], acc[0][3], acc[1][0], acc[1][1], acc[1][2], acc[1][3]); \
            const bf16x8_t b1 = pack8(acc[2][0], acc[2][1], acc[2][2], acc[2][3], acc[3][0], acc[3][1], acc[3][2], acc[3][3]); \
            float nf[16]; \
            { float t8[8]; unpack8(Nf[u][0], t8); _Pragma("unroll") for (int e = 0; e < 8; ++e) nf[e] = t8[e]; \
              unpack8(Nf[u][1], t8); _Pragma("unroll") for (int e = 0; e < 8; ++e) nf[8 + e] = t8[e]; } \
            _Pragma("unroll") for (int jt = 0; jt < 4; ++jt) { \
                f32x4_t n = (f32x4_t){nf[4 * jt], nf[4 * jt + 1], nf[4 * jt + 2], nf[4 * jt + 3]}; \
                n = MFMA16(__builtin_bit_cast(bf16x8_t, Mf[u][2 * jt]), b0, n); \
                n = MFMA16(__builtin_bit_cast(bf16x8_t, Mf[u][2 * jt + 1]), b1, n); \
                acc[jt] = n; } \
              \
            { unsigned char* us = base + (size_t)(c) * 16384 + 8192; const v4u w0 = __builtin_bit_cast(v4u, b0), w1 = __builtin_bit_cast(v4u, b1); \
              *(v2u*)(us + (i * 64 + 0 + 4 * q) * 2) = (v2u){w0.x, w0.y}; *(v2u*)(us + (i * 64 + 16 + 4 * q) * 2) = (v2u){w0.z, w0.w}; \
              *(v2u*)(us + (i * 64 + 32 + 4 * q) * 2) = (v2u){w1.x, w1.y}; *(v2u*)(us + (i * 64 + 48 + 4 * q) * 2) = (v2u){w1.z, w1.w}; } \
            if ((c) + 3 < 64) R2_LOAD(u, (c) + 3); } while (0)
    R2_LOAD(0, 0); R2_LOAD(1, 1); R2_LOAD(2, 2);
    for (int c3 = 0; c3 < 21; ++c3) { R2_STEP(0, 3 * c3); R2_STEP(1, 3 * c3 + 1); R2_STEP(2, 3 * c3 + 2); }
    R2_STEP(0, 63);
#undef R2_STEP
#undef R2_LOAD
    float* so = A.out + O_WKV_P + (size_t)bh * 4096 + i * 64;
#pragma unroll
    for (int jt = 0; jt < 4; ++jt) *(f32x4*)(so + 16 * jt + 4 * q) = (f32x4){acc[jt][0], acc[jt][1], acc[jt][2], acc[jt][3]};
}

constexpr int R3_PAR_OFF = 122880;
__device__ __forceinline__ void r3_unit(const Frame& F, const Args& A, int unit) {
    bf16* UB = (bf16*)(A.ws + WS_UB);
    const bf16* Wgt = (const bf16*)(A.ws + WS_WGT);
    const float* bonus = (const float*)(A.ws + WS_BONUS);
    const LAS float* mug = (const LAS float*)(F.lds + R3_PAR_OFF); const LAS float* lnw = mug + 128; const LAS float* lnb = lnw + 512;
    const int b = unit >> 9, h = (unit >> 6) & 7, c = unit & 63, row0 = b * SEQ + c * RC;
    const bf16* Sc = (const bf16*)((const unsigned char*)A.out + (size_t)unit * 16384 + 8192);
    const int r = F.lane & 31, hh = F.lane >> 5, row = row0 + r;
    const bool hasprev = (r > 0) || (c > 0);
    f32x16 y0, y1, g0, g1;
#pragma unroll
    for (int i = 0; i < 16; ++i) { y0[i] = 0.f; y1[i] = 0.f; g0[i] = 0.f; g1[i] = 0.f; }
    {
        v4u gc[8], gp[8], wa[8], wb[8];
#pragma unroll
        for (int s = 0; s < 8; ++s) { gc[s] = *(const v4u*)(UB + (size_t)row * BCOLS + 1664 + 16 * s + 8 * hh);
            gp[s] = (v4u){0, 0, 0, 0}; if (hasprev) gp[s] = *(const v4u*)(UB + (size_t)(row - 1) * BCOLS + 1664 + 16 * s + 8 * hh);
            wa[s] = *(const v4u*)(Wgt + (size_t)(h * 64 + r) * 128 + 16 * s + 8 * hh); wb[s] = *(const v4u*)(Wgt + (size_t)(h * 64 + 32 + r) * 128 + 16 * s + 8 * hh); }
        asm volatile("" ::: "memory");
#pragma unroll
        for (int s = 0; s < 8; ++s) {
            float cur[8], prv[8]; unpack8(gc[s], cur); unpack8(gp[s], prv);
            const f32x4 m0 = *(const LAS f32x4*)(mug + 16 * s + 8 * hh), m1 = *(const LAS f32x4*)(mug + 16 * s + 8 * hh + 4);
            float sg[8];
#pragma unroll
            for (int e = 0; e < 8; ++e) sg[e] = sigmoidf_(cur[e] + (prv[e] - cur[e]) * (e < 4 ? m0[e] : m1[e - 4]));
            const bf16x8_t sgp = __builtin_bit_cast(bf16x8_t, packw8(sg));
            g0 = MFMA32(__builtin_bit_cast(bf16x8_t, wa[s]), sgp, g0); g1 = MFMA32(__builtin_bit_cast(bf16x8_t, wb[s]), sgp, g1);
        }
    }
    const bf16* ub2 = UB + (size_t)row * BCOLS + h * 64;
    asm volatile("" : "+v"(ub2), "+v"(g0[0]), "+v"(g1[0]));
    v4u sa0[4], sa1[4], rb[4]; v2u yb[8], vb[8];
#pragma unroll
    for (int s = 0; s < 4; ++s) { rb[s] = *(const v4u*)(ub2 + 16 * s + 8 * hh);
        sa0[s] = (v4u){0, 0, 0, 0}; sa1[s] = (v4u){0, 0, 0, 0};
        if (c > 0) { sa0[s] = *(const v4u*)(Sc + r * 64 + 16 * s + 8 * hh); sa1[s] = *(const v4u*)(Sc + (32 + r) * 64 + 16 * s + 8 * hh); } }
#pragma unroll
    for (int x = 0; x < 8; ++x) { const int i0 = 32 * (x >> 2) + 8 * (x & 3) + 4 * hh; yb[x] = *(const v2u*)(ub2 + 512 + i0); vb[x] = *(const v2u*)(ub2 + 1024 + i0); }
    const float bn = bonus[(size_t)row * 8 + h];
    asm volatile("" ::: "memory");
#pragma unroll
    for (int s = 0; s < 4; ++s) { y0 = MFMA32(__builtin_bit_cast(bf16x8_t, sa0[s]), __builtin_bit_cast(bf16x8_t, rb[s]), y0); y1 = MFMA32(__builtin_bit_cast(bf16x8_t, sa1[s]), __builtin_bit_cast(bf16x8_t, rb[s]), y1); }
    float yv[32]; float sum = 0.f;
#pragma unroll
    for (int x = 0; x < 8; ++x) { const int it = x >> 2, gq = x & 3;
        const float ybf[4] = {bflo(yb[x].x), bfhi(yb[x].x), bflo(yb[x].y), bfhi(yb[x].y)};
#pragma unroll
        for (int e = 0; e < 4; ++e) { const float v = (it ? y1[4 * gq + e] : y0[4 * gq + e]) + ybf[e]; yv[16 * it + 4 * gq + e] = v; sum += v; } }
    sum += __shfl_xor(sum, 32);
    const float mean = sum * (1.0f / 64.0f);
    float var = 0.f;
#pragma unroll
    for (int x = 0; x < 32; ++x) { yv[x] -= mean; var += yv[x] * yv[x]; }
    var += __shfl_xor(var, 32);
    const float rs = rsqrtf(var * (1.0f / 64.0f) + GN_EPS);
#pragma unroll
    for (int x = 0; x < 8; ++x) { const int it = x >> 2, gq = x & 3, i0 = 32 * it + 8 * gq + 4 * hh, ch = h * 64 + i0;
        const float vv[4] = {bflo(vb[x].x), bfhi(vb[x].x), bflo(vb[x].y), bfhi(vb[x].y)};
        const f32x4 lw = *(const LAS f32x4*)(lnw + ch), lb = *(const LAS f32x4*)(lnb + ch);
        float o[4];
#pragma unroll
        for (int e = 0; e < 4; ++e) { const float gg = it ? g1[4 * gq + e] : g0[4 * gq + e]; o[e] = (yv[16 * it + 4 * gq + e] * rs * lw[e] + lb[e] + bn * vv[e]) * gg; }
        v2u ow; ow.x = pk2(o[0], o[1]); ow.y = pk2(o[2], o[3]);
        *(v2u*)(UB + (size_t)row * BCOLS + 512 + ch) = ow; }
}

__device__ __forceinline__ float rdl(float x, int k) { return __builtin_bit_cast(float, __builtin_amdgcn_readlane(__builtin_bit_cast(int, x), k)); }
__device__ __forceinline__ void rwkv_sample_wave(const Frame& F, const Args& A, int bh, LAS float* wl) {
    bf16* UB = (bf16*)(A.ws + WS_UB);
    const int b = bh >> 3, h = bh & 7, row0 = MP + 4 * b, l = F.lane, ch = h * 64 + l;
    const float* mu = A.in[7];
    float xr[4], xk[4], xv[4], tw[4], ad[4], sg0[4], sg1[4];
#pragma unroll
    for (int t = 0; t < 4; ++t) {
        const int row = row0 + t, prow = t ? row - 1 : MT + b;
        xr[t] = shifted(UB, row, prow, ch, mu[ch]); xk[t] = shifted(UB, row, prow, 512 + ch, mu[512 + ch]); xv[t] = shifted(UB, row, prow, 1024 + ch, mu[1024 + ch]);
        tw[t] = tanhf_(shifted(UB, row, prow, 1536 + l, mu[1536 + l])); ad[t] = shifted(UB, row, prow, 1600 + l, mu[1600 + l]);
        sg0[t] = sigmoidf_(shifted(UB, row, prow, 1664 + l, mu[1664 + l])); sg1[t] = sigmoidf_(shifted(UB, row, prow, 1728 + l, mu[1728 + l]));
    }
    float dec[4] = {0.f, 0.f, 0.f, 0.f}, aa[4] = {0.f, 0.f, 0.f, 0.f}, g[4] = {0.f, 0.f, 0.f, 0.f};
    {   const float* pd = A.in[9] + ch; const float* pa = A.in[11] + ch; const float* pg = A.in[12] + ch;
        float wd[2][8], wa[2][8], wg0[2][8], wg1[2][8];
#define SW_LOAD(bf, k0) do { _Pragma("unroll") for (int u = 0; u < 8; ++u) { wd[bf][u] = pd[((k0) + u) * BW]; wa[bf][u] = pa[((k0) + u) * BW]; wg0[bf][u] = pg[((k0) + u) * BW]; wg1[bf][u] = pg[(64 + (k0) + u) * BW]; } } while (0)
#define SW_USE(bf, k0) do { _Pragma("unroll") for (int u = 0; u < 8; ++u) { _Pragma("unroll") for (int t = 0; t < 4; ++t) { \
            dec[t] += rdl(tw[t], (k0) + u) * wd[bf][u]; aa[t] += rdl(ad[t], (k0) + u) * wa[bf][u]; g[t] += rdl(sg0[t], (k0) + u) * wg0[bf][u] + rdl(sg1[t], (k0) + u) * wg1[bf][u]; } } } while (0)
        SW_LOAD(0, 0);
#pragma unroll 1
        for (int kb = 0; kb < 8; kb += 2) {
            SW_LOAD(1, 8 * kb + 8); asm volatile("" ::: "memory"); SW_USE(0, 8 * kb);
            if (kb + 2 < 8) SW_LOAD(0, 8 * kb + 16);
            asm volatile("" ::: "memory"); SW_USE(1, 8 * kb + 8);
        }
#undef SW_LOAD
#undef SW_USE
    }
    const float w0 = A.in[8][ch], a0 = A.in[10][ch], kkc = A.in[13][ch], kac = A.in[14][ch], rkc = A.in[15][ch];
    float bon[4];
#pragma unroll
    for (int t = 0; t < 4; ++t) {
        const float w = __expf(-DECAY_SCALE * sigmoidf_(w0 + dec[t])), a = sigmoidf_(a0 + aa[t]);
        const float kp = xk[t] * kkc, kk = kp / fmaxf(sqrtf(wave_sum(kp * kp)), 1e-12f), k2 = xk[t] * (1.0f + (a - 1.0f) * kac);
        bon[t] = wave_sum(xr[t] * k2 * rkc);
        LAS float* v = wl + t * 384;
        v[l] = w; v[64 + l] = kk; v[128 + l] = kk * a; v[192 + l] = k2; v[256 + l] = xr[t];
    }
    asm volatile("s_waitcnt lgkmcnt(0)" ::: "memory");
    float S[64];
    const float* sin_ = A.in[3] + (size_t)bh * 4096 + l * 64;
#pragma unroll
    for (int j4 = 0; j4 < 16; ++j4) { const f32x4 s = *(const f32x4*)(sin_ + 4 * j4); S[4 * j4] = s[0]; S[4 * j4 + 1] = s[1]; S[4 * j4 + 2] = s[2]; S[4 * j4 + 3] = s[3]; }
#pragma unroll
    for (int t = 0; t < 4; ++t) {
        const LAS float* v = wl + t * 384;
        float sk = 0.f;
#pragma unroll
        for (int j4 = 0; j4 < 16; ++j4) { const f32x4 k4 = *(const LAS f32x4*)(v + 64 + 4 * j4); sk += (S[4 * j4] * k4[0] + S[4 * j4 + 1] * k4[1]) + (S[4 * j4 + 2] * k4[2] + S[4 * j4 + 3] * k4[3]);
            if ((j4 & 3) == 3) asm volatile("" : "+v"(v), "+v"(sk)); }
        float y = 0.f;
#pragma unroll
        for (int j4 = 0; j4 < 16; ++j4) {
            const f32x4 w4 = *(const LAS f32x4*)(v + 4 * j4), ka = *(const LAS f32x4*)(v + 128 + 4 * j4), k4 = *(const LAS f32x4*)(v + 192 + 4 * j4), r4 = *(const LAS f32x4*)(v + 256 + 4 * j4);
#pragma unroll
            for (int e = 0; e < 4; ++e) { const float s = S[4 * j4 + e] * w4[e] - sk * ka[e] + xv[t] * k4[e]; S[4 * j4 + e] = s; y += s * r4[e]; }
            if (j4 & 1) asm volatile("" : "+v"(v), "+v"(y));
        }
        const float mean = wave_sum(y) * (1.0f / 64.0f), d = y - mean, var = wave_sum(d * d) * (1.0f / 64.0f);
        const float yn = d * rsqrtf(var + GN_EPS) * A.in[16][ch] + A.in[17][ch];
        UB[(size_t)(row0 + t) * BCOLS + 512 + ch] = (bf16)f2bf((yn + bon[t] * xv[t]) * g[t]);
    }
    float* so = A.out + O_WKV_S + (size_t)bh * 4096 + l * 64;
#pragma unroll
    for (int j4 = 0; j4 < 16; ++j4) *(f32x4*)(so + 4 * j4) = (f32x4){S[4 * j4], S[4 * j4 + 1], S[4 * j4 + 2], S[4 * j4 + 3]};
    asm volatile("s_waitcnt lgkmcnt(0)" ::: "memory");
}

__device__ __forceinline__ void p3_seq(const Frame& F, const Args& A) {
    if (F.wave == 0) { for (int u = F.vcu; u < 256; u += F.G) r2_wave(F, A, u >> 2, u & 3); }
    else {
        const int wk = F.vcu * 7 + F.wave - 1, NW = F.G * 7;
        h2_part(F, A, wk * 64 + F.lane, NW * 64);
        LAS float* wl = (LAS float*)F.lds + F.wave * 1536;
        for (int bh = wk; bh < 1024; bh += NW) rwkv_sample_wave(F, A, bh, wl);
    }
}


constexpr int SK_P = 72, SK_BUF = (64 + 128) * SK_P;
template <bool SSQ> __device__ __forceinline__ void sk_gemm(const Frame& F, f32x16& acc, const bf16* Ag, int lda, const bf16* Bg, int ldb, int K, float& ssq) {
    LAS bf16* L = (LAS bf16*)F.lds;
    const int prow = F.tid >> 3, c8 = F.tid & 7, r = F.lane & 31, hh = F.lane >> 5, wm = F.wave >> 2, wn = F.wave & 3;
    const bf16* ap = Ag + (size_t)prow * lda + 8 * c8; const bf16* bp0 = Bg + (size_t)prow * ldb + 8 * c8; const bf16* bp1 = bp0 + (size_t)64 * ldb;
    v4u ra = *(const v4u*)ap, rb0 = *(const v4u*)bp0, rb1 = *(const v4u*)bp1;
    const int nk = K / 64;
    __syncthreads();
    for (int it = 0; it < nk; ++it) {
        LAS bf16* B_ = L + (it & 1) * SK_BUF;
        *(LAS v4u*)(B_ + prow * SK_P + 8 * c8) = ra; *(LAS v4u*)(B_ + (64 + prow) * SK_P + 8 * c8) = rb0; *(LAS v4u*)(B_ + (128 + prow) * SK_P + 8 * c8) = rb1;
        if (SSQ) { float f8[8]; unpack8(ra, f8);
#pragma unroll
            for (int e = 0; e < 8; ++e) ssq += f8[e] * f8[e]; }
        __syncthreads();
        if (it + 1 < nk) { const int k = (it + 1) * 64; ra = *(const v4u*)(ap + k); rb0 = *(const v4u*)(bp0 + k); rb1 = *(const v4u*)(bp1 + k); }
#pragma unroll
        for (int s = 0; s < 4; ++s)
            acc = MFMA32(*(const LAS bf16x8_t*)(B_ + (32 * wm + r) * SK_P + 16 * s + 8 * hh), *(const LAS bf16x8_t*)(B_ + (64 + 32 * wn + r) * SK_P + 16 * s + 8 * hh), acc);
    }
}
template <int WHICH> __device__ __forceinline__ void skinny_unit(const Frame& F, const Args& A, int mt, int nt, int ks) {
    unsigned char* ws = A.ws;
    bf16* UA = (bf16*)(ws + WS_UA); bf16* UB = (bf16*)(ws + WS_UB); const bf16* UG = (const bf16*)(ws + WS_UG);
    const int wm = F.wave >> 2, wn = F.wave & 3, r = F.lane & 31, hh = F.lane >> 5;
    const int mb = MP + 64 * mt, m0 = mb + 32 * wm, nb = 128 * nt, n = nb + 32 * wn + r;
    f32x16 acc;
#pragma unroll
    for (int i = 0; i < 16; ++i) acc[i] = 0.f;
    float ssq = 0.f;
    if (WHICH == 0) {
        f32x16 accb;
#pragma unroll
        for (int i = 0; i < 16; ++i) accb[i] = 0.f;
        sk_gemm<false>(F, acc, UA + (size_t)mb * ACOLS + 1024, ACOLS, (const bf16*)(ws + WS_WA) + (size_t)nb * AW, AW, AW, ssq);
        sk_gemm<false>(F, accb, UB + (size_t)mb * BCOLS + 512, BCOLS, (const bf16*)(ws + WS_WB) + (size_t)nb * BW, BW, BW, ssq);
#pragma unroll
        for (int i = 0; i < 16; ++i) { const size_t m = (size_t)(m0 + crow(i, hh));
            const float ga = bf2f(UG[m * GCOLS + n]), gb = bf2f(UG[m * GCOLS + 1024 + n]);
            UA[m * ACOLS + n] = (bf16)f2bf(sigmoidf_(ga) * acc[i] + sigmoidf_(gb) * accb[i]); }
    } else if (WHICH == 1) {
        sk_gemm<false>(F, acc, UA + (size_t)mb * ACOLS, ACOLS, (const bf16*)(ws + WS_WO) + (size_t)nb * D, D, D, ssq);
#pragma unroll
        for (int i = 0; i < 16; ++i) { const size_t m = (size_t)(m0 + crow(i, hh));
            const float o = A.in[1][(m - MP) * D + n] + acc[i];
            A.out[m * D + n] = o; UB[m * BCOLS + n] = (bf16)f2bf(o); }
    } else if (WHICH == 2) {
        sk_gemm<true>(F, acc, UB + (size_t)mb * BCOLS, BCOLS, (const bf16*)(ws + WS_WUP) + (size_t)nb * D, D, D, ssq);
        LAS float* rs = (LAS float*)(F.lds + 2 * SK_BUF * 2);
        ssq = red8(ssq);
        if ((F.tid & 7) == 0) rs[F.tid >> 3] = rsqrtf(ssq * (1.0f / D) + NORM_EPS);
        __syncthreads();
        bf16* Hd = UA;
#pragma unroll
        for (int i = 0; i < 16; ++i) { const int ml = 32 * wm + crow(i, hh); const size_t m = (size_t)(mb + ml);
            const float t = fmaxf(acc[i] * rs[ml], 0.f);
            Hd[m * DFF + n] = (bf16)f2bf(t * t); }
    } else {
        sk_gemm<false>(F, acc, UA + (size_t)mb * DFF + 1024 * ks, DFF, (const bf16*)(ws + WS_WDN) + (size_t)nb * DFF + 1024 * ks, DFF, 1024, ssq);
#pragma unroll
        for (int i = 0; i < 16; ++i) { const size_t m = (size_t)(m0 + crow(i, hh)); atomicAdd(A.out + m * D + n, acc[i]); }
    }
    __syncthreads();
}

__device__ __forceinline__ void p9_final(const Frame& F, const Args& A) {
    const int gw = F.vcu * NWAVES + F.wave, NGW = F.G * NWAVES;
    f32x4 gv[4];
#pragma unroll
    for (int j = 0; j < 4; ++j) gv[j] = ((const f32x4*)A.in[26])[F.lane + 64 * j];
    for (int m = gw; m < MT; m += NGW) {
        f32x4* xr = (f32x4*)(A.out + (size_t)m * D) + F.lane;
        f32x4 v[4]; float s = 0.f;
#pragma unroll
        for (int j = 0; j < 4; ++j) { v[j] = xr[64 * j]; s += (v[j][0] * v[j][0] + v[j][1] * v[j][1]) + (v[j][2] * v[j][2] + v[j][3] * v[j][3]); }
        const float rstd = rsqrtf(wave_sum(s) * (1.0f / D) + NORM_EPS);
#pragma unroll
        for (int j = 0; j < 4; ++j) xr[64 * j] = v[j] * rstd * gv[j];
    }
}

__global__ void __launch_bounds__(NWAVES * 64, 2) fwd(Args args) {
    extern __shared__ __attribute__((aligned(16))) unsigned char lds[];
    Frame F;
    F.lds = (LAS unsigned char*)lds;
    F.tid = threadIdx.x; F.lane = F.tid & 63; F.wave = __builtin_amdgcn_readfirstlane(F.tid >> 6);
    F.G = gridDim.x; { const int bx = blockIdx.x; F.vcu = (F.G % 8 == 0) ? (bx % 8) * (F.G / 8) + bx / 8 : bx; }
    unsigned char* ws = args.ws;
    gu32* ctl = (gu32*)(ws + WS_CTL);
    for (int u = F.tid; u < (LDS_BYTES - LDSCTL_OFF) / 4; u += NWAVES * 64) ((LAS unsigned*)(F.lds + LDSCTL_OFF))[u] = 0u;
    __syncthreads();
    volatile LAS unsigned* MISC = (volatile LAS unsigned*)(F.lds + MISC_OFF);
    XcdBarrier bar; bar.bar = (unsigned*)(ctl + CW_BAR); bar.x = 0; bar.st = nullptr;
    if (MK_N_LAUNCHES == 1) bar = xcd_barrier_post((unsigned*)(ctl + CW_BAR), MISC + 8);
    const int lo = args.ph_lo, hi = args.ph_hi;
#ifndef PH_MASK
#define PH_MASK 0x3ff
#endif
#ifndef DUP_MASK
#define DUP_MASK 0
#endif
#define REP(k) for (int rep_ = 0; rep_ < (((DUP_MASK >> (k)) & 1) ? 2 : 1); ++rep_)
#define IN(k) (((PH_MASK >> (k)) & 1) && lo <= (k) && (k) < hi)
#define SEAM(k) do { if (IN(k) && IN((k) + 1)) xcd_barrier(bar); } while (0)
    bf16* UA = (bf16*)(ws + WS_UA); bf16* UB = (bf16*)(ws + WS_UB); bf16* UG = (bf16*)(ws + WS_UG);

    if (IN(0)) REP(0) { p0_prologue(F, args); } SEAM(0);
    if (IN(1)) REP(1) {
        pg8::Gemm g{(const bf16*)args.out, (const bf16*)(ws + WS_WIN), MH, NIN, D, D, D};
        SchedG1 S; S.init(F.G, (int)blockIdx.x);
        EpiG1 E{UA, UB, UG, (bf16*)(args.out + O_HGRN_S)};
        pg8::gemm_phase<EpiG1, SchedG1, true, true>(F.lds, g, S, E);
    } SEAM(1);
    if (IN(2)) {
        { LAS float* PAR = (LAS float*)(F.lds + RL_PAR); const int c_ = F.tid;
          PAR[c_] = args.in[8][c_]; PAR[512 + c_] = args.in[10][c_]; PAR[1024 + c_] = args.in[13][c_]; PAR[1536 + c_] = args.in[14][c_]; PAR[2048 + c_] = args.in[15][c_]; }
        for (int ps = 0; ps * 2 * F.G < 4096; ++ps) { const int unit = (ps * F.G + F.vcu) * 2 + (F.wave >> 2); r1_pass(F, args, unit < 4096 ? unit : 0, unit < 4096); }
        for (int u = F.vcu; u < 1024; u += F.G) h1_unit(F, args, u);
    } SEAM(2);
    if (IN(3)) { p3_seq(F, args); } SEAM(3);
    if (IN(4)) { { LAS float* pr_ = (LAS float*)(F.lds + R3_PAR_OFF); if (F.tid < 128) pr_[F.tid] = args.in[7][1664 + F.tid]; pr_[128 + F.tid] = args.in[16][F.tid]; pr_[640 + F.tid] = args.in[17][F.tid]; __syncthreads(); }
        for (int u = F.vcu * NWAVES + F.wave; u < 4096; u += F.G * NWAVES) r3_unit(F, args, u); __syncthreads(); for (int u = F.vcu; u < 1024; u += F.G) h3_unit(F, args, u); for (int u = F.vcu; u < 512; u += F.G) hgrn_sample_unit(F, args, u); } SEAM(4);
    if (IN(5)) REP(5) {
        SchedMN S; S.init(MP, D, F.G, (int)blockIdx.x);
        { pg8::Gemm g{UA + 1024, (const bf16*)(ws + WS_WA), MP, D, AW, ACOLS, AW}; EpiMerge<false> E{UA, UG, 0};
          pg8::gemm_phase<EpiMerge<false>, SchedMN, true, true>(F.lds, g, S, E); }
        { pg8::Gemm g{UB + 512, (const bf16*)(ws + WS_WB), MP, D, BW, BCOLS, BW}; EpiMerge<true> E{UA, UG, 1024};
          pg8::gemm_phase<EpiMerge<true>, SchedMN, true, true>(F.lds, g, S, E); }
        for (int u = F.G - 1 - F.vcu; u < 64; u += F.G) skinny_unit<0>(F, args, u >> 3, u & 7, 0);
    } SEAM(5);
    if (IN(6)) REP(6) {
        SchedMN S; S.init(MP, D, F.G, (int)blockIdx.x);
        pg8::Gemm g{UA, (const bf16*)(ws + WS_WO), MP, D, D, ACOLS, D};
        EpiRes<true, true, true> E{args.in[0], args.in[1], args.out, UB, BCOLS, (float*)(ws + WS_SSQ1)};
        pg8::gemm_phase<EpiRes<true, true, true>, SchedMN, true, true>(F.lds, g, S, E);
        for (int u = F.G - 1 - F.vcu; u < 64; u += F.G) skinny_unit<1>(F, args, u >> 3, u & 7, 0);
    } SEAM(6);
    if (IN(7)) REP(7) {
        SchedMN S; S.init(MP, DFF, F.G, (int)blockIdx.x);
        pg8::Gemm g{UB, (const bf16*)(ws + WS_WUP), MP, DFF, D, BCOLS, D};
        EpiUp E{UA, (const float*)(ws + WS_SSQ1)};
        pg8::gemm_phase<EpiUp, SchedMN, true, true>(F.lds, g, S, E);
        for (int u = F.vcu; u < 256; u += F.G) skinny_unit<2>(F, args, u >> 5, u & 31, 0);
    } SEAM(7);
    if (IN(8)) {
        SchedMN S; S.init(MP, D, F.G, (int)blockIdx.x);
        pg8::Gemm g{UA, (const bf16*)(ws + WS_WDN), MP, D, DFF, DFF, DFF};
        EpiRes<false, false, false> E{nullptr, nullptr, args.out, nullptr, 0, nullptr};
        pg8::gemm_phase<EpiRes<false, false, false>, SchedMN, true, true>(F.lds, g, S, E);
        for (int u = F.vcu; u < 256; u += F.G) skinny_unit<3>(F, args, (u >> 3) & 7, u & 7, u >> 6);
    } SEAM(8);
    if (IN(9)) { p9_final(F, args); }
#undef IN
#undef SEAM
}

extern "C" void kernel_launch(void* const* d_in, const int* in_sizes, int n_in, void* d_out, int out_size, void* d_ws, size_t ws_size, hipStream_t stream) {
    static int grid = 0;
    if (grid == 0) {
        if (n_in != 27 || out_size != (int)O_END || ws_size < WS_END) { fprintf(stderr, "kernel_launch: unexpected shapes (n_in %d, out %d, ws %zu)\n", n_in, out_size, ws_size); grid = -1; return; }
        int dev = 0, cus = 0, per_cu = 0;
        if (hipGetDevice(&dev) != hipSuccess || hipDeviceGetAttribute(&cus, hipDeviceAttributeMultiprocessorCount, dev) != hipSuccess) { grid = -1; return; }
        if (hipFuncSetAttribute((const void*)fwd, hipFuncAttributeMaxDynamicSharedMemorySize, LDS_BYTES) != hipSuccess) { fprintf(stderr, "kernel_launch: hipFuncSetAttribute failed\n"); grid = -1; return; }
        if (hipOccupancyMaxActiveBlocksPerMultiprocessor(&per_cu, (const void*)fwd, NWAVES * 64, LDS_BYTES) != hipSuccess || per_cu < 1) { fprintf(stderr, "kernel_launch: occupancy query says %d\n", per_cu); }
        (void)hipGetLastError();
        grid = cus;
    }
    if (grid < 0) return;
    (void)hipMemsetAsync((char*)d_ws + WS_CTL, 0, CTL_BYTES, stream);
    Args a{};
    for (int i = 0; i < 27; ++i) a.in[i] = (const float*)d_in[i];
    a.out = (float*)d_out; a.ws = (unsigned char*)d_ws;
    if (MK_N_LAUNCHES == 1) { a.ph_lo = 0; a.ph_hi = NPHASE; hipLaunchKernelGGL(fwd, dim3(grid), dim3(NWAVES * 64), LDS_BYTES, stream, a); }
    else for (int p = 0; p < NPHASE; ++p) { a.ph_lo = p; a.ph_hi = p + 1; hipLaunchKernelGGL(fwd, dim3(grid), dim3(NWAVES * 64), LDS_BYTES, stream, a); }
}
```
